# Optimizing an MI355X kernel written in HIP

```python
import jax, jax.numpy as jnp
from jax import lax
import numpy as np

D_MODEL = 1024
BATCH = 8
SEQ = 4096
DEPTH = 2
DEC_BATCH = 32
DEC_SEQ = 32
PAST_LEN = 2048

CHUNK = 64
Q_BLOCK = 128
MIX_WIDTH = D_MODEL
FOX_HEADS = 8
FOX_HEAD_DIM = MIX_WIDTH // 2 // FOX_HEADS
FOX_WIDTH = FOX_HEADS * FOX_HEAD_DIM
MLA_HEADS = 4
MLA_NOPE_DIM = 128
MLA_ROPE_DIM = 64
MLA_V_DIM = MIX_WIDTH // 2 // MLA_HEADS
MLA_WIDTH = MLA_HEADS * MLA_V_DIM
MLA_Q_RANK = 256
MLA_KV_RANK = 128
ROPE_THETA = 10000.0
N_MEM = 256
X_HEADS = 4
X_HEAD_DIM = D_MODEL // X_HEADS
D_FF = 4 * D_MODEL
EPS = 1e-6
FORGET_BIAS = 2.0
IN_SPLITS = [FOX_WIDTH, 2 * FOX_WIDTH, 3 * FOX_WIDTH, 3 * FOX_WIDTH + FOX_HEADS,
             3 * FOX_WIDTH + FOX_HEADS + MLA_Q_RANK,
             3 * FOX_WIDTH + FOX_HEADS + MLA_Q_RANK + MLA_KV_RANK]
IN_COLS = 3 * FOX_WIDTH + FOX_HEADS + MLA_Q_RANK + MLA_KV_RANK + MLA_ROPE_DIM

kernel_name = "hybrid_fox_mla_streaming_encoder_step"


def rmsnorm(x, g):
    xf = x.astype(jnp.float32)
    y = xf * lax.rsqrt(jnp.mean(jnp.square(xf), axis=-1, keepdims=True) + EPS)
    return (y * g.astype(jnp.float32)).astype(x.dtype)


def rope(x, pos):
    half = x.shape[-1] // 2
    inv = ROPE_THETA ** (-jnp.arange(half, dtype=jnp.float32) / half)
    ang = pos.astype(jnp.float32)[:, None] * inv[None, :]
    shape = (1, x.shape[1]) + (1,) * (x.ndim - 3) + (half,)
    cos = jnp.cos(ang).reshape(shape)
    sin = jnp.sin(ang).reshape(shape)
    xf = x.astype(jnp.float32)
    x1, x2 = xf[..., :half], xf[..., half:]
    return jnp.concatenate([x1 * cos - x2 * sin, x2 * cos + x1 * sin], axis=-1).astype(x.dtype)


def attend(q, k, v, q_pos, k_pos, mask_kind, f_q=None, f_k=None):
    scale = q.shape[-1] ** -0.5
    s = jnp.einsum("bqhd,bkhd->bhqk", q, k).astype(jnp.float32) * scale
    if f_q is not None:
        s = s + (jnp.swapaxes(f_q, 1, 2)[:, :, :, None] - jnp.swapaxes(f_k, 1, 2)[:, :, None, :])
    if mask_kind == "frame":
        allowed = k_pos[None, :] <= q_pos[:, None]
    else:
        allowed = (k_pos[None, :] // CHUNK) <= (q_pos[:, None] // CHUNK)
    s = jnp.where(allowed[None, None], s, -jnp.inf)
    p = jax.nn.softmax(s, axis=-1)
    return jnp.einsum("bhqk,bkhd->bqhd", p.astype(v.dtype), v)


def sweep_attention(q, k, v, q_pos, k_pos, mask_kind, f_q=None, f_k=None):
    b, sq, h, _ = q.shape
    if sq % Q_BLOCK != 0:
        return attend(q, k, v, q_pos, k_pos, mask_kind, f_q, f_k)
    nb = sq // Q_BLOCK

    def to_blocks(a):
        return jnp.moveaxis(a.reshape((b, nb, Q_BLOCK) + a.shape[2:]), 1, 0)

    qb = to_blocks(q)
    pb = q_pos.reshape(nb, Q_BLOCK)
    if f_q is None:
        out = lax.map(lambda a: attend(a[0], k, v, a[1], k_pos, mask_kind), (qb, pb))
    else:
        out = lax.map(lambda a: attend(a[0], k, v, a[1], k_pos, mask_kind, a[2], f_k),
                      (qb, pb, to_blocks(f_q)))
    return jnp.moveaxis(out, 0, 1).reshape(b, sq, h, v.shape[-1])


def memory_kv(mem, g, w_mk, w_mv):
    b, n, _ = mem.shape
    m = rmsnorm(mem, g)
    return ((m @ w_mk).reshape(b, n, X_HEADS, X_HEAD_DIM),
            (m @ w_mv).reshape(b, n, X_HEADS, X_HEAD_DIM))


def cross_attention(h, mk, mv, w_xq, w_xo):
    b, s, _ = h.shape
    q = (h @ w_xq).reshape(b, s, X_HEADS, X_HEAD_DIM)
    sc = jnp.einsum("bqhd,bkhd->bhqk", q, mk).astype(jnp.float32) * (X_HEAD_DIM ** -0.5)
    p = jax.nn.softmax(sc, axis=-1)
    o = jnp.einsum("bhqk,bkhd->bqhd", p.astype(mv.dtype), mv)
    return o.reshape(b, s, X_HEADS * X_HEAD_DIM) @ w_xo


def setup_inputs(seed: int = 0) -> dict:
    key = jax.random.key(seed)
    ks = jax.random.split(key, 28)
    f32 = jnp.float32

    def nrm(i, shape, scale=1.0):
        return jax.random.normal(ks[i], shape, f32) * scale

    def gain(i, shape):
        return 1.0 + 0.1 * nrm(i, shape)

    return {
        "x_prompt": nrm(0, (BATCH, SEQ, D_MODEL)),
        "x_sample": nrm(1, (DEC_BATCH, DEC_SEQ, D_MODEL)),
        "mem_prompt": nrm(2, (BATCH, N_MEM, D_MODEL)),
        "cache_fox_k": nrm(3, (DEPTH, DEC_BATCH, PAST_LEN, FOX_HEADS, FOX_HEAD_DIM)),
        "cache_fox_v": nrm(4, (DEPTH, DEC_BATCH, PAST_LEN, FOX_HEADS, FOX_HEAD_DIM)),
        "cache_fox_logf": jax.nn.log_sigmoid(FORGET_BIAS + nrm(5, (DEPTH, DEC_BATCH, PAST_LEN, FOX_HEADS))),
        "cache_mla_ckv": nrm(6, (DEPTH, DEC_BATCH, PAST_LEN, MLA_KV_RANK)),
        "cache_mla_krope": nrm(7, (DEPTH, DEC_BATCH, PAST_LEN, MLA_ROPE_DIM)),
        "cache_mem_k": nrm(8, (DEPTH, DEC_BATCH, N_MEM, X_HEADS, X_HEAD_DIM)),
        "cache_mem_v": nrm(9, (DEPTH, DEC_BATCH, N_MEM, X_HEADS, X_HEAD_DIM)),
        "norm_mix": gain(10, (DEPTH, D_MODEL)),
        "w_in": nrm(11, (DEPTH, D_MODEL, IN_COLS), D_MODEL ** -0.5),
        "b_forget": FORGET_BIAS + 0.1 * nrm(12, (DEPTH, FOX_HEADS)),
        "mla_q_norm": gain(13, (DEPTH, MLA_Q_RANK)),
        "w_uq": nrm(14, (DEPTH, MLA_Q_RANK, MLA_HEADS * (MLA_NOPE_DIM + MLA_ROPE_DIM)), MLA_Q_RANK ** -0.5),
        "mla_kv_norm": gain(15, (DEPTH, MLA_KV_RANK)),
        "w_ukv": nrm(16, (DEPTH, MLA_KV_RANK, MLA_HEADS * (MLA_NOPE_DIM + MLA_V_DIM)), MLA_KV_RANK ** -0.5),
        "w_out": nrm(17, (DEPTH, MIX_WIDTH, D_MODEL), MIX_WIDTH ** -0.5),
        "norm_cross": gain(18, (DEPTH, D_MODEL)),
        "norm_mem": gain(19, (DEPTH, D_MODEL)),
        "w_xq": nrm(20, (DEPTH, D_MODEL, X_HEADS * X_HEAD_DIM), D_MODEL ** -0.5),
        "w_mk": nrm(21, (DEPTH, D_MODEL, X_HEADS * X_HEAD_DIM), D_MODEL ** -0.5),
        "w_mv": nrm(22, (DEPTH, D_MODEL, X_HEADS * X_HEAD_DIM), D_MODEL ** -0.5),
        "w_xo": nrm(23, (DEPTH, X_HEADS * X_HEAD_DIM, D_MODEL), (X_HEADS * X_HEAD_DIM) ** -0.5),
        "norm_mlp": gain(24, (DEPTH, D_MODEL)),
        "w_up": nrm(25, (DEPTH, D_MODEL, D_FF), D_MODEL ** -0.5),
        "w_down": nrm(26, (DEPTH, D_FF, D_MODEL), D_FF ** -0.5),
        "norm_final": gain(27, (D_MODEL,)),
    }


def reference(x_prompt, x_sample, mem_prompt, cache_fox_k, cache_fox_v, cache_fox_logf,
              cache_mla_ckv, cache_mla_krope, cache_mem_k, cache_mem_v,
              norm_mix, w_in, b_forget, mla_q_norm, w_uq, mla_kv_norm, w_ukv, w_out,
              norm_cross, norm_mem, w_xq, w_mk, w_mv, w_xo, norm_mlp, w_up, w_down, norm_final):

    def mixers(h, pos, l, past):
        b, s, _ = h.shape
        z = h @ w_in[l]
        q_f, k_f, v_f, g_f, c_q, c_kv, k_r = jnp.split(z, IN_SPLITS, axis=-1)
        q_f = q_f.reshape(b, s, FOX_HEADS, FOX_HEAD_DIM)
        k_f = k_f.reshape(b, s, FOX_HEADS, FOX_HEAD_DIM)
        v_f = v_f.reshape(b, s, FOX_HEADS, FOX_HEAD_DIM)
        logf = jax.nn.log_sigmoid((g_f + b_forget[l]).astype(jnp.float32))
        c_kv = rmsnorm(c_kv, mla_kv_norm[l])
        k_r = rope(k_r, pos)
        rows = (k_f, v_f, logf, c_kv, k_r)
        if past is None:
            kf, vf, lf, ckv, kr, k_pos = k_f, v_f, logf, c_kv, k_r, pos
        else:
            pk, pv, plf, pckv, pkr = past
            kf = jnp.concatenate([pk, k_f], axis=1)
            vf = jnp.concatenate([pv, v_f], axis=1)
            lf = jnp.concatenate([plf.astype(jnp.float32), logf], axis=1)
            ckv = jnp.concatenate([pckv, c_kv], axis=1)
            kr = jnp.concatenate([pkr, k_r], axis=1)
            k_pos = jnp.arange(pk.shape[1] + s)
        cum = jnp.cumsum(lf, axis=1)
        fox = sweep_attention(q_f, kf, vf, pos, k_pos, "frame", cum[:, -s:], cum)
        sk = ckv.shape[1]
        q_m = (rmsnorm(c_q, mla_q_norm[l]) @ w_uq[l]).reshape(b, s, MLA_HEADS, MLA_NOPE_DIM + MLA_ROPE_DIM)
        q_m = jnp.concatenate([q_m[..., :MLA_NOPE_DIM], rope(q_m[..., MLA_NOPE_DIM:], pos)], axis=-1)
        kv = (ckv @ w_ukv[l]).reshape(b, sk, MLA_HEADS, MLA_NOPE_DIM + MLA_V_DIM)
        k_m = jnp.concatenate([kv[..., :MLA_NOPE_DIM],
                               jnp.broadcast_to(kr[:, :, None, :], (b, sk, MLA_HEADS, MLA_ROPE_DIM))], axis=-1)
        mla = sweep_attention(q_m, k_m, kv[..., MLA_NOPE_DIM:], pos, k_pos, "chunk")
        mixed = jnp.concatenate([fox.reshape(b, s, FOX_WIDTH), mla.reshape(b, s, MLA_WIDTH)], axis=-1)
        return mixed @ w_out[l], rows

    def layer(x, pos, l, past, mk, mv):
        mix, rows = mixers(rmsnorm(x, norm_mix[l]), pos, l, past)
        x = x + mix
        x = x + cross_attention(rmsnorm(x, norm_cross[l]), mk, mv, w_xq[l], w_xo[l])
        hm = rmsnorm(x, norm_mlp[l])
        x = x + jnp.square(jax.nn.relu(hm @ w_up[l])) @ w_down[l]
        return x, rows

    pos_p = jnp.arange(x_prompt.shape[1])
    pos_s = cache_fox_k.shape[2] + jnp.arange(x_sample.shape[1])
    xp, xs = x_prompt, x_sample
    rows_p, rows_s, mk_p, mv_p = [], [], [], []
    for l in range(DEPTH):
        mk, mv = memory_kv(mem_prompt, norm_mem[l], w_mk[l], w_mv[l])
        xp, rp = layer(xp, pos_p, l, None, mk, mv)
        past = (cache_fox_k[l], cache_fox_v[l], cache_fox_logf[l], cache_mla_ckv[l], cache_mla_krope[l])
        xs, rs = layer(xs, pos_s, l, past, cache_mem_k[l], cache_mem_v[l])
        rows_p.append(rp)
        rows_s.append(rs)
        mk_p.append(mk)
        mv_p.append(mv)

    def stack(rows, i):
        return jnp.stack([r[i] for r in rows])

    y_prompt = rmsnorm(xp, norm_final)
    y_sample = rmsnorm(xs, norm_final)
    return (y_prompt, y_sample,
            stack(rows_p, 0), stack(rows_p, 1), stack(rows_p, 2), stack(rows_p, 3), stack(rows_p, 4),
            jnp.stack(mk_p), jnp.stack(mv_p),
            stack(rows_s, 0), stack(rows_s, 1), stack(rows_s, 2), stack(rows_s, 3), stack(rows_s, 4))
```

```cpp
#include <hip/hip_runtime.h>
#include <hip/hip_cooperative_groups.h>
#include <stdint.h>
#include <string.h>
#include <stdio.h>
namespace cg = cooperative_groups;

#ifndef COOP
#define COOP 1
#endif

#ifndef FOX_PF
#define FOX_PF true
#endif
#ifndef MLA_PF
#define MLA_PF true
#endif
#ifndef LB_MIN
#define LB_MIN 1
#endif
#define DI __device__ __forceinline__
typedef unsigned short u16;
typedef short s16x8 __attribute__((ext_vector_type(8)));
typedef short s16x4 __attribute__((ext_vector_type(4)));
typedef __bf16 bfx8 __attribute__((ext_vector_type(8)));
typedef __bf16 bfx2 __attribute__((ext_vector_type(2)));
typedef float f32x16 __attribute__((ext_vector_type(16)));
typedef float f32x4 __attribute__((ext_vector_type(4)));
typedef float f32x2 __attribute__((ext_vector_type(2)));
typedef unsigned u32x4 __attribute__((ext_vector_type(4)));
typedef unsigned u32x2 __attribute__((ext_vector_type(2)));

constexpr int DM = 1024, NB = 8, SEQ = 4096, NL = 2, DB = 32, DS = 32, PAST = 2048;
constexpr int TP = NB * SEQ;
constexpr int TS = DB * DS;
constexpr int TT = TP + TS;
constexpr int SKS = PAST + DS;
constexpr int KROWS = TP + DB * SKS;
constexpr int INC = 1992, INP = 2048;
constexpr int NMEM = 256, MB = NB + DB;
constexpr int DFF = 4096;

constexpr size_t O_Y = 0;
constexpr size_t O_FKP = (size_t)TT * DM;
constexpr size_t O_FVP = O_FKP + (size_t)NL * TP * 512;
constexpr size_t O_FLP = O_FVP + (size_t)NL * TP * 512;
constexpr size_t O_CKP = O_FLP + (size_t)NL * TP * 8;
constexpr size_t O_KRP = O_CKP + (size_t)NL * TP * 128;
constexpr size_t O_MKP = O_KRP + (size_t)NL * TP * 64;
constexpr size_t O_MVP = O_MKP + (size_t)NL * NB * NMEM * 1024;
constexpr size_t O_FKS = O_MVP + (size_t)NL * NB * NMEM * 1024;
constexpr size_t O_FVS = O_FKS + (size_t)NL * TS * 512;
constexpr size_t O_FLS = O_FVS + (size_t)NL * TS * 512;
constexpr size_t O_CKS = O_FLS + (size_t)NL * TS * 8;
constexpr size_t O_KRS = O_CKS + (size_t)NL * TS * 128;
constexpr size_t O_END = O_KRS + (size_t)NL * TS * 64;

constexpr size_t al256(size_t x) { return (x + 255) / 256 * 256; }
constexpr size_t WE_IN = 0;
constexpr size_t WE_UQ = WE_IN + (size_t)INP * 1024;
constexpr size_t WE_UKV = WE_UQ + (size_t)768 * 256;
constexpr size_t WE_OUT = WE_UKV + (size_t)1024 * 128;
constexpr size_t WE_XQ = WE_OUT + (size_t)1024 * 1024;
constexpr size_t WE_MKV = WE_XQ + (size_t)1024 * 1024;
constexpr size_t WE_XO = WE_MKV + (size_t)2048 * 1024;
constexpr size_t WE_UP = WE_XO + (size_t)1024 * 1024;
constexpr size_t WE_DN = WE_UP + (size_t)4096 * 1024;
constexpr size_t WE_LAYER = WE_DN + (size_t)1024 * 4096;
constexpr size_t WS_WT = 0;
constexpr size_t WS_ROPE = al256(WS_WT + WE_LAYER * 2 * NL);
constexpr size_t WS_ACTA = al256(WS_ROPE + (size_t)4096 * 32 * 8);
constexpr size_t WS_QF = al256(WS_ACTA + (size_t)TT * 1024 * 2);
constexpr size_t WS_FOXK = al256(WS_QF + (size_t)TT * 512 * 2);
constexpr size_t WS_FOXV = al256(WS_FOXK + (size_t)KROWS * 512 * 2);
constexpr size_t WS_CUM = al256(WS_FOXV + (size_t)KROWS * 512 * 2);
constexpr size_t WS_ZC = al256(WS_CUM + (size_t)KROWS * 8 * 4);
constexpr size_t WS_CQN = al256(WS_ZC + (size_t)TT * 448 * 4);
constexpr size_t WS_CKV = al256(WS_CQN + (size_t)TT * 256 * 2);
constexpr size_t WS_KROPE = al256(WS_CKV + (size_t)KROWS * 128 * 2);
constexpr size_t WS_MEMK = al256(WS_KROPE + (size_t)KROWS * 64 * 2);
constexpr size_t WS_MEMV = al256(WS_MEMK + (size_t)NL * MB * NMEM * 1024 * 2);
constexpr size_t WS_HMEM = al256(WS_MEMV + (size_t)NL * MB * NMEM * 1024 * 2);
constexpr size_t WS_R1 = al256(WS_HMEM + (size_t)NL * NB * NMEM * 1024 * 2);
constexpr size_t R1_KV = 0;
constexpr size_t R1_QM = al256((size_t)KROWS * 1024 * 2);
constexpr size_t R1_U = 0;
constexpr size_t R1_XQ = 0;
constexpr size_t WS_END = al256(WS_R1 + (size_t)TT * 4096 * 2);
static_assert(R1_QM + (size_t)TT * 768 * 2 <= (size_t)TT * 4096 * 2, "R1 overflow");

constexpr int SMEM_BYTES = 64 * (256 * 2 + 16) + 64 * 128 * 2 + 256;

struct Params {
  const float* in[28];
  float* out;
  char* ws;
};

DI int get_tid() { int t = threadIdx.x; asm volatile("" : "+v"(t)); return t; }
DI unsigned pk2(float a, float b) { f32x2 v = {a, b}; return __builtin_bit_cast(unsigned, __builtin_convertvector(v, bfx2)); }
DI u16 f2bf(float a) { return (u16)(pk2(a, 0.f) & 0xffffu); }
DI f32x16 mfma(s16x8 a, s16x8 b, f32x16 c) {
  return __builtin_amdgcn_mfma_f32_32x32x16_bf16(__builtin_bit_cast(bfx8, a), __builtin_bit_cast(bfx8, b), c, 0, 0, 0);
}
DI int crow(int i, int h) { return (i & 3) + 8 * (i >> 2) + 4 * h; }
DI float wave_sum(float v) {
#pragma unroll
  for (int m = 32; m >= 1; m >>= 1) v += __shfl_xor(v, m);
  return v;
}
DI float xhalf_max(float v) {
  auto rr = __builtin_amdgcn_permlane32_swap(__float_as_uint(v), __float_as_uint(v), false, false);
  return fmaxf(__uint_as_float(rr[0]), __uint_as_float(rr[1]));
}
DI float xhalf_sum(float v) {
  auto rr = __builtin_amdgcn_permlane32_swap(__float_as_uint(v), __float_as_uint(v), false, false);
  return __uint_as_float(rr[0]) + __uint_as_float(rr[1]);
}
DI int tok_krow(int tok) {
  if (tok < TP) return tok;
  const int s = tok - TP;
  return TP + (s >> 5) * SKS + PAST + (s & 31);
}
DI int tok_pos(int tok) { return tok < TP ? (tok & (SEQ - 1)) : PAST + ((tok - TP) & 31); }

enum { EPI_IN = 0, EPI_MEM, EPI_UQ, EPI_KV, EPI_RESID, EPI_XQ, EPI_UP };

template <int EPI>
DI void epilogue(const Params& P, int l, f32x16 (&acc)[2][2], int mw, int nw, int r, int h) {
  float* out = P.out;
  char* ws = P.ws;
  if constexpr (EPI == EPI_IN) {
    u16* qf = (u16*)(ws + WS_QF);
    u16* fk = (u16*)(ws + WS_FOXK);
    u16* fv = (u16*)(ws + WS_FOXV);
    float* zc = (float*)(ws + WS_ZC);
    const float* bfg = P.in[12] + l * 8;
#pragma unroll
    for (int mi = 0; mi < 2; mi++) {
#pragma unroll
      for (int i = 0; i < 16; i++) {
        const int row = mw + mi * 32 + crow(i, h);
        const int kr = tok_krow(row);
        const bool isp = row < TP;
        const size_t orow = isp ? ((size_t)l * TP + row) : ((size_t)l * TS + (row - TP));
#pragma unroll
        for (int ni = 0; ni < 2; ni++) {
          const int col = nw + ni * 32 + r;
          const float v = acc[mi][ni][i];
          if (col < 512) {
            qf[(size_t)row * 512 + col] = f2bf(v);
          } else if (col < 1024) {
            const int c = col - 512;
            out[(isp ? O_FKP : O_FKS) + orow * 512 + c] = v;
            fk[(size_t)kr * 512 + c] = f2bf(v);
          } else if (col < 1536) {
            const int c = col - 1024;
            out[(isp ? O_FVP : O_FVS) + orow * 512 + c] = v;
            fv[(size_t)kr * 512 + c] = f2bf(v);
          } else if (col < 1544) {
            const int c = col - 1536;
            const float g = v + bfg[c];
            const float ls = fminf(g, 0.f) - log1pf(__expf(-fabsf(g)));
            out[(isp ? O_FLP : O_FLS) + orow * 8 + c] = ls;
          } else if (col < INC) {
            zc[(size_t)row * 448 + (col - 1544)] = v;
          }
        }
      }
    }
  } else if constexpr (EPI == EPI_MEM) {
    u16* mk = (u16*)(ws + WS_MEMK);
    u16* mv = (u16*)(ws + WS_MEMV);
#pragma unroll
    for (int mi = 0; mi < 2; mi++) {
#pragma unroll
      for (int i = 0; i < 16; i++) {
        const int row = mw + mi * 32 + crow(i, h);
#pragma unroll
        for (int ni = 0; ni < 2; ni++) {
          const int col = nw + ni * 32 + r;
          const float v = acc[mi][ni][i];
          const int c = col & 1023;
          const size_t oidx = ((size_t)l * (NB * NMEM) + row) * 1024 + c;
          const size_t bidx = ((size_t)l * (MB * NMEM) + row) * 1024 + c;
          if (col < 1024) { out[O_MKP + oidx] = v; mk[bidx] = f2bf(v); }
          else { out[O_MVP + oidx] = v; mv[bidx] = f2bf(v); }
        }
      }
    }
  } else if constexpr (EPI == EPI_UQ) {
    u16* qm = (u16*)(ws + WS_R1 + R1_QM);
    const f32x2* rt = (const f32x2*)(ws + WS_ROPE);
    const bool isrope = (nw % 192) == 128;
#pragma unroll
    for (int mi = 0; mi < 2; mi++) {
#pragma unroll
      for (int i = 0; i < 16; i++) {
        const int row = mw + mi * 32 + crow(i, h);
        float x1 = acc[mi][0][i], x2 = acc[mi][1][i];
        if (isrope) {
          const f32x2 cs = rt[tok_pos(row) * 32 + r];
          const float o1 = x1 * cs[0] - x2 * cs[1];
          const float o2 = x2 * cs[0] + x1 * cs[1];
          x1 = o1; x2 = o2;
        }
        qm[(size_t)row * 768 + nw + r] = f2bf(x1);
        qm[(size_t)row * 768 + nw + 32 + r] = f2bf(x2);
      }
    }
  } else if constexpr (EPI == EPI_KV || EPI == EPI_XQ || EPI == EPI_UP) {
    u16* dst; int ld;
    if constexpr (EPI == EPI_KV) { dst = (u16*)(ws + WS_R1 + R1_KV); ld = 1024; }
    else if constexpr (EPI == EPI_XQ) { dst = (u16*)(ws + WS_R1 + R1_XQ); ld = 1024; }
    else { dst = (u16*)(ws + WS_R1 + R1_U); ld = DFF; }
#pragma unroll
    for (int mi = 0; mi < 2; mi++) {
#pragma unroll
      for (int i = 0; i < 16; i++) {
        const int row = mw + mi * 32 + crow(i, h);
#pragma unroll
        for (int ni = 0; ni < 2; ni++) {
          float v = acc[mi][ni][i];
          if constexpr (EPI == EPI_UP) { v = fmaxf(v, 0.f); v = v * v; }
          dst[(size_t)row * ld + nw + ni * 32 + r] = f2bf(v);
        }
      }
    }
  } else if constexpr (EPI == EPI_RESID) {
#pragma unroll
    for (int mi = 0; mi < 2; mi++) {
#pragma unroll
      for (int i = 0; i < 16; i++) {
        const int row = mw + mi * 32 + crow(i, h);
#pragma unroll
        for (int ni = 0; ni < 2; ni++) {
          float* p = out + (size_t)row * DM + nw + ni * 32 + r;
          *p = *p + acc[mi][ni][i];
        }
      }
    }
  }
}

template <int EPI>
DI void gemm_tile(const Params& P, int l, const u16* __restrict__ A, int lda, const u16* __restrict__ Bt, int ldb,
                  int K, int m0, int n0, char* smem) {
  const int tid = get_tid(), wave = tid >> 6, lane = tid & 63, r = lane & 31, h = lane >> 5;
  const int wm = wave >> 1, wn = wave & 1;
  char* As = smem;
  char* Bs = smem + 128 * 144;
  f32x16 acc[2][2];
#pragma unroll
  for (int a = 0; a < 2; a++)
#pragma unroll
    for (int b = 0; b < 2; b++)
#pragma unroll
      for (int i = 0; i < 16; i++) acc[a][b][i] = 0.f;
  const int lrow = tid >> 3, lc = tid & 7;
  const u16* ag = A + (size_t)(m0 + lrow) * lda + lc * 8;
  const u16* bg = Bt + (size_t)(n0 + lrow) * ldb + lc * 8;
  u32x4 ra[4], rb[4];
#pragma unroll
  for (int i = 0; i < 4; i++) {
    ra[i] = *(const u32x4*)(ag + (size_t)i * 32 * lda);
    rb[i] = *(const u32x4*)(bg + (size_t)i * 32 * ldb);
  }
  const int nk = K >> 6;
  const char* ar = As + (wm * 64 + r) * 144 + h * 16;
  const char* br = Bs + (wn * 64 + r) * 144 + h * 16;
  for (int kt = 0; kt < nk; kt++) {
    __syncthreads();
#pragma unroll
    for (int i = 0; i < 4; i++) {
      *(u32x4*)(As + (lrow + 32 * i) * 144 + lc * 16) = ra[i];
      *(u32x4*)(Bs + (lrow + 32 * i) * 144 + lc * 16) = rb[i];
    }
    __syncthreads();
    if (kt + 1 < nk) {
      const int ko = (kt + 1) * 64;
#pragma unroll
      for (int i = 0; i < 4; i++) {
        ra[i] = *(const u32x4*)(ag + (size_t)i * 32 * lda + ko);
        rb[i] = *(const u32x4*)(bg + (size_t)i * 32 * ldb + ko);
      }
    }
#pragma unroll
    for (int kk = 0; kk < 4; kk++) {
      const s16x8 a0 = *(const s16x8*)(ar + kk * 32);
      const s16x8 a1 = *(const s16x8*)(ar + 32 * 144 + kk * 32);
      const s16x8 b0 = *(const s16x8*)(br + kk * 32);
      const s16x8 b1 = *(const s16x8*)(br + 32 * 144 + kk * 32);
      acc[0][0] = mfma(a0, b0, acc[0][0]);
      acc[0][1] = mfma(a0, b1, acc[0][1]);
      acc[1][0] = mfma(a1, b0, acc[1][0]);
      acc[1][1] = mfma(a1, b1, acc[1][1]);
    }
  }
  epilogue<EPI>(P, l, acc, m0 + wm * 64, n0 + wn * 64, r, h);
}

enum { MASK_NONE = 0, MASK_FRAME = 1, MASK_CHUNK = 2 };
struct AttnJob {
  const u16* Q; int ldq;
  const u16* K1; int ldk1;
  const u16* K2; int ldk2;
  const u16* V; int ldv;
  u16* O; int ldo;
  const float* cq;
  const float* ck;
  int nq, Sk, qpos0;
  float scale_log2;
};

template <int DQK, int D1, int DVT, int MASK, bool BIAS, bool PREFETCH>
DI void attn_block(const AttnJob& J, char* smem) {
  constexpr int KP = DQK * 2 + 16;
  constexpr int VP = DVT * 2;
  constexpr int CK = DQK / 8, CV = DVT / 8;
  constexpr int NKC = CK / 4, NVC = CV / 4;
  constexpr int NKK = DQK / 16, NDV = DVT / 32;
  constexpr float LOG2E = 1.4426950408889634f;
  char* Ks = smem;
  char* Vs = smem + 64 * KP;
  float* cks = (float*)(smem + 64 * KP + 64 * VP);
  const int tid = get_tid(), wave = tid >> 6, lane = tid & 63, r = lane & 31, h = lane >> 5;
  const int wq0 = wave * 32;
  const bool active = wq0 < J.nq;
  const int qi = wq0 + r;
  const int qpos = J.qpos0 + qi;
  const int wqmax = J.qpos0 + wq0 + 31;
  const int qmax = J.qpos0 + J.nq - 1;
  const int ntk = (J.Sk + 63) >> 6;
  int nt = ntk;
  if (MASK != MASK_NONE) { const int t2 = (qmax >> 6) + 1; nt = t2 < ntk ? t2 : ntk; }

  s16x8 qf[NKK];
  {
    const u16* qp = J.Q + (size_t)qi * J.ldq + h * 8;
#pragma unroll
    for (int kk = 0; kk < NKK; kk++) {
      if (active) qf[kk] = *(const s16x8*)(qp + kk * 16);
      else { s16x8 z = {0, 0, 0, 0, 0, 0, 0, 0}; qf[kk] = z; }
    }
  }
  float cqv = 0.f;
  if (BIAS) { if (active) cqv = J.cq[(size_t)qi * 8] * LOG2E; }

  f32x16 o[NDV];
#pragma unroll
  for (int d = 0; d < NDV; d++)
#pragma unroll
    for (int i = 0; i < 16; i++) o[d][i] = 0.f;
  float m_run = -1e30f, l_run = 0.f;

  u32x4 rk[NKC], rv[NVC];
  float rck = 0.f;
  const int tq = (lane & 15) >> 2, tp = lane & 3, tblk = (lane >> 4) & 1;
  const int vswz = (DVT >= 128) ? tq : (tq >> 1);
  const char* vrd = Vs + (4 * h + tq) * VP + (16 * tblk + 4 * tp) * 2;
  const char* krd = Ks + r * KP + h * 16;

  auto load_tile = [&](int j) {
#pragma unroll
    for (int i = 0; i < NKC; i++) {
      const int id = tid + 256 * i;
      const int row = id / CK, c = id % CK;
      const int key = j * 64 + row;
      u32x4 v = {0u, 0u, 0u, 0u};
      if (key < J.Sk) {
        const u16* src = (c * 8 < D1) ? (J.K1 + (size_t)key * J.ldk1 + c * 8) : (J.K2 + (size_t)key * J.ldk2 + (c * 8 - D1));
        v = *(const u32x4*)src;
      }
      rk[i] = v;
    }
#pragma unroll
    for (int i = 0; i < NVC; i++) {
      const int id = tid + 256 * i;
      const int row = id / CV, c = id % CV;
      const int key = j * 64 + row;
      u32x4 v = {0u, 0u, 0u, 0u};
      if (key < J.Sk) v = *(const u32x4*)(J.V + (size_t)key * J.ldv + c * 8);
      rv[i] = v;
    }
    if (BIAS) {
      if (tid < 64) { const int key = j * 64 + tid; rck = key < J.Sk ? J.ck[(size_t)key * 8] * LOG2E : 0.f; }
    }
  };
  auto store_tile = [&]() {
#pragma unroll
    for (int i = 0; i < NKC; i++) {
      const int id = tid + 256 * i;
      const int row = id / CK, c = id % CK;
      *(u32x4*)(Ks + row * KP + c * 16) = rk[i];
    }
#pragma unroll
    for (int i = 0; i < NVC; i++) {
      const int id = tid + 256 * i;
      const int row = id / CV, c = id % CV;
      const int sw = (DVT >= 128) ? (row & 3) : ((row >> 1) & 1);
      *(u32x4*)(Vs + row * VP + (((c >> 2) ^ sw) * 64) + (c & 3) * 16) = rv[i];
    }
    if (BIAS) { if (tid < 64) cks[tid] = rck; }
  };

  if (PREFETCH) load_tile(0);
  for (int j = 0; j < nt; j++) {
    __syncthreads();
    if (!PREFETCH) load_tile(j);
    store_tile();
    __syncthreads();
    if (PREFETCH) { if (j + 1 < nt) load_tile(j + 1); }
    const bool need = active && (MASK == MASK_NONE || j * 64 <= wqmax);
    if (need) {
      f32x16 p0, p1;
#pragma unroll
      for (int i = 0; i < 16; i++) { p0[i] = 0.f; p1[i] = 0.f; }
#pragma unroll
      for (int kk = 0; kk < NKK; kk++) {
        const s16x8 k0 = *(const s16x8*)(krd + kk * 32);
        const s16x8 k1 = *(const s16x8*)(krd + 32 * KP + kk * 32);
        p0 = mfma(k0, qf[kk], p0);
        p1 = mfma(k1, qf[kk], p1);
        if ((kk & 3) == 3) __builtin_amdgcn_sched_barrier(0);
      }
      if (BIAS) {
#pragma unroll
        for (int g = 0; g < 4; g++) {
          const f32x4 c0 = *(const f32x4*)(cks + 8 * g + 4 * h);
          const f32x4 c1 = *(const f32x4*)(cks + 32 + 8 * g + 4 * h);
#pragma unroll
          for (int e = 0; e < 4; e++) {
            p0[4 * g + e] = fmaf(p0[4 * g + e], J.scale_log2, cqv - c0[e]);
            p1[4 * g + e] = fmaf(p1[4 * g + e], J.scale_log2, cqv - c1[e]);
          }
        }
      } else {
#pragma unroll
        for (int i = 0; i < 16; i++) { p0[i] *= J.scale_log2; p1[i] *= J.scale_log2; }
      }
      const bool needmask = (MASK == MASK_FRAME && j * 64 + 63 > J.qpos0 + wq0) || (j * 64 + 63 >= J.Sk);
      if (needmask) {
#pragma unroll
        for (int i = 0; i < 16; i++) {
          const int k0 = j * 64 + crow(i, h), k1 = k0 + 32;
          bool a0 = k0 < J.Sk, a1 = k1 < J.Sk;
          if (MASK == MASK_FRAME) { a0 = a0 && (k0 <= qpos); a1 = a1 && (k1 <= qpos); }
          p0[i] = a0 ? p0[i] : -1e30f;
          p1[i] = a1 ? p1[i] : -1e30f;
        }
      }
      float mx = p0[0];
#pragma unroll
      for (int i = 1; i < 16; i++) mx = fmaxf(mx, p0[i]);
#pragma unroll
      for (int i = 0; i < 16; i++) mx = fmaxf(mx, p1[i]);
      mx = xhalf_max(mx);
      const float m_new = fmaxf(m_run, mx);
      const float alpha = __builtin_amdgcn_exp2f(m_run - m_new);
      m_run = m_new;
      float ps = 0.f;
#pragma unroll
      for (int i = 0; i < 16; i++) {
        p0[i] = __builtin_amdgcn_exp2f(p0[i] - m_new);
        p1[i] = __builtin_amdgcn_exp2f(p1[i] - m_new);
        ps += p0[i] + p1[i];
      }
      l_run = l_run * alpha + ps;
      if (__any(alpha != 1.f)) {
#pragma unroll
        for (int d = 0; d < NDV; d++)
#pragma unroll
          for (int i = 0; i < 16; i++) o[d][i] *= alpha;
      }
      s16x8 pb[4];
      {
        u32x4 w;
        w[0] = pk2(p0[0], p0[1]); w[1] = pk2(p0[2], p0[3]); w[2] = pk2(p0[4], p0[5]); w[3] = pk2(p0[6], p0[7]);
        pb[0] = __builtin_bit_cast(s16x8, w);
        w[0] = pk2(p0[8], p0[9]); w[1] = pk2(p0[10], p0[11]); w[2] = pk2(p0[12], p0[13]); w[3] = pk2(p0[14], p0[15]);
        pb[1] = __builtin_bit_cast(s16x8, w);
        w[0] = pk2(p1[0], p1[1]); w[1] = pk2(p1[2], p1[3]); w[2] = pk2(p1[4], p1[5]); w[3] = pk2(p1[6], p1[7]);
        pb[2] = __builtin_bit_cast(s16x8, w);
        w[0] = pk2(p1[8], p1[9]); w[1] = pk2(p1[10], p1[11]); w[2] = pk2(p1[12], p1[13]); w[3] = pk2(p1[14], p1[15]);
        pb[3] = __builtin_bit_cast(s16x8, w);
      }
#pragma unroll
      for (int d = 0; d < NDV; d++) {
        const char* vb = vrd + ((d ^ vswz) * 64);
#pragma unroll
        for (int ks = 0; ks < 4; ks++) {
          const s16x4 lo = __builtin_amdgcn_ds_read_tr16_b64_v4i16(
              (__attribute__((address_space(3))) s16x4*)(uintptr_t)(vb + (16 * ks) * VP));
          const s16x4 hi = __builtin_amdgcn_ds_read_tr16_b64_v4i16(
              (__attribute__((address_space(3))) s16x4*)(uintptr_t)(vb + (16 * ks + 8) * VP));
          const s16x8 vf = __builtin_shufflevector(lo, hi, 0, 1, 2, 3, 4, 5, 6, 7);
          o[d] = mfma(vf, pb[ks], o[d]);
        }
        __builtin_amdgcn_sched_barrier(0);
      }
    }
  }
  const float lt = xhalf_sum(l_run);
  if (active && qi < J.nq) {
    const float inv = 1.f / lt;
    u16* op = J.O + (size_t)qi * J.ldo + 4 * h;
#pragma unroll
    for (int d = 0; d < NDV; d++) {
#pragma unroll
      for (int g = 0; g < 4; g++) {
        u32x2 w;
        w[0] = pk2(o[d][4 * g] * inv, o[d][4 * g + 1] * inv);
        w[1] = pk2(o[d][4 * g + 2] * inv, o[d][4 * g + 3] * inv);
        *(u32x2*)(op + d * 32 + 8 * g) = w;
      }
    }
  }
}

DI void rms_row_bf16(const float* __restrict__ x, const float* __restrict__ g, u16* __restrict__ dst, float* xcopy, int lane) {
  f32x4 v[4];
  float ss = 0.f;
#pragma unroll
  for (int i = 0; i < 4; i++) {
    v[i] = *(const f32x4*)(x + i * 256 + lane * 4);
    ss += v[i][0] * v[i][0] + v[i][1] * v[i][1] + v[i][2] * v[i][2] + v[i][3] * v[i][3];
  }
  ss = wave_sum(ss);
  const float rs = rsqrtf(ss * (1.f / 1024.f) + 1e-6f);
#pragma unroll
  for (int i = 0; i < 4; i++) {
    const f32x4 gg = *(const f32x4*)(g + i * 256 + lane * 4);
    u32x2 w;
    w[0] = pk2(v[i][0] * rs * gg[0], v[i][1] * rs * gg[1]);
    w[1] = pk2(v[i][2] * rs * gg[2], v[i][3] * rs * gg[3]);
    *(u32x2*)(dst + i * 256 + lane * 4) = w;
    if (xcopy) *(f32x4*)(xcopy + i * 256 + lane * 4) = v[i];
  }
}

DI void cvt_job(const float* __restrict__ src, u16* __restrict__ dst, int nseg, size_t seglen, size_t sstride, size_t dstride) {
  const size_t upseg = seglen / 8;
  const size_t total = upseg * nseg;
  for (size_t u = (size_t)blockIdx.x * 256 + get_tid(); u < total; u += (size_t)gridDim.x * 256) {
    const size_t sg = u / upseg, off = (u - sg * upseg) * 8;
    const f32x4 a = *(const f32x4*)(src + sg * sstride + off);
    const f32x4 b = *(const f32x4*)(src + sg * sstride + off + 4);
    u32x4 w;
    w[0] = pk2(a[0], a[1]); w[1] = pk2(a[2], a[3]); w[2] = pk2(b[0], b[1]); w[3] = pk2(b[2], b[3]);
    *(u32x4*)(dst + sg * dstride + off) = w;
  }
}

DI void transpose_job(const float* __restrict__ src, u16* __restrict__ dst, int K, int N, int Npad, int& rot, char* smem) {
  float* tile = (float*)smem;
  const int tk = K / 64, tn = Npad / 64, ntiles = tk * tn;
  const int G = gridDim.x;
  const int tid = get_tid();
  for (int t = (blockIdx.x + G - (rot % G)) % G; t < ntiles; t += G) {
    const int k0 = (t % tk) * 64, n0 = (t / tk) * 64;
    __syncthreads();
#pragma unroll 4
    for (int i = 0; i < 16; i++) {
      const int k = i * 4 + (tid >> 6), n = tid & 63;
      tile[k * 65 + n] = (n0 + n < N) ? src[(size_t)(k0 + k) * N + n0 + n] : 0.f;
    }
    __syncthreads();
#pragma unroll 4
    for (int i = 0; i < 16; i++) {
      const int n = i * 4 + (tid >> 6), k = tid & 63;
      dst[(size_t)(n0 + n) * K + k0 + k] = f2bf(tile[k * 65 + n]);
    }
  }
  rot += ntiles;
}

DI u16* wt_ptr(const Params& P, int l, size_t eoff) { return (u16*)(P.ws + WS_WT) + (size_t)l * WE_LAYER + eoff; }

DI void phase_prep(const Params& P, char* smem) {
  const int tid = get_tid(), lane = tid & 63;
  const int gw = blockIdx.x * 4 + (tid >> 6), nw = gridDim.x * 4;
  int rot = 0;
  for (int l = 0; l < NL; l++) {
    transpose_job(P.in[11] + (size_t)l * 1024 * INC, wt_ptr(P, l, WE_IN), 1024, INC, INP, rot, smem);
    transpose_job(P.in[14] + (size_t)l * 256 * 768, wt_ptr(P, l, WE_UQ), 256, 768, 768, rot, smem);
    transpose_job(P.in[16] + (size_t)l * 128 * 1024, wt_ptr(P, l, WE_UKV), 128, 1024, 1024, rot, smem);
    transpose_job(P.in[17] + (size_t)l * 1024 * 1024, wt_ptr(P, l, WE_OUT), 1024, 1024, 1024, rot, smem);
    transpose_job(P.in[20] + (size_t)l * 1024 * 1024, wt_ptr(P, l, WE_XQ), 1024, 1024, 1024, rot, smem);
    transpose_job(P.in[21] + (size_t)l * 1024 * 1024, wt_ptr(P, l, WE_MKV), 1024, 1024, 1024, rot, smem);
    transpose_job(P.in[22] + (size_t)l * 1024 * 1024, wt_ptr(P, l, WE_MKV) + (size_t)1024 * 1024, 1024, 1024, 1024, rot, smem);
    transpose_job(P.in[23] + (size_t)l * 1024 * 1024, wt_ptr(P, l, WE_XO), 1024, 1024, 1024, rot, smem);
    transpose_job(P.in[25] + (size_t)l * 1024 * 4096, wt_ptr(P, l, WE_UP), 1024, 4096, 4096, rot, smem);
    transpose_job(P.in[26] + (size_t)l * 4096 * 1024, wt_ptr(P, l, WE_DN), 4096, 1024, 1024, rot, smem);
  }
  {
    f32x2* rt = (f32x2*)(P.ws + WS_ROPE);
    for (int i = blockIdx.x * 256 + tid; i < 4096 * 32; i += gridDim.x * 256) {
      const int pos = i >> 5, j = i & 31;
      const float inv = powf(10000.f, -(float)j / 32.f);
      const float ang = (float)pos * inv;
      f32x2 cs; cs[0] = cosf(ang); cs[1] = sinf(ang);
      rt[i] = cs;
    }
  }
  for (int l = 0; l < NL; l++) {
    const size_t seg = (size_t)DB * NMEM * 1024;
    cvt_job(P.in[8] + l * seg, (u16*)(P.ws + WS_MEMK) + ((size_t)l * MB + NB) * NMEM * 1024, 1, seg, 0, 0);
    cvt_job(P.in[9] + l * seg, (u16*)(P.ws + WS_MEMV) + ((size_t)l * MB + NB) * NMEM * 1024, 1, seg, 0, 0);
  }
  for (int rr = gw; rr < NL * NB * NMEM; rr += nw) {
    const int l = rr / (NB * NMEM), row = rr % (NB * NMEM);
    rms_row_bf16(P.in[2] + (size_t)row * 1024, P.in[19] + l * 1024, (u16*)(P.ws + WS_HMEM) + (size_t)rr * 1024, nullptr, lane);
  }
  {
    const size_t n4 = (size_t)TT * 256;
    const size_t np4 = (size_t)TP * 256;
    for (size_t i = (size_t)blockIdx.x * 256 + tid; i < n4; i += (size_t)gridDim.x * 256) {
      const f32x4 v = (i < np4) ? *(const f32x4*)(P.in[0] + i * 4) : *(const f32x4*)(P.in[1] + (i - np4) * 4);
      *(f32x4*)(P.out + i * 4) = v;
    }
  }
}

DI void phase_norm(const Params& P, const float* g, int cache_layer) {
  const int tid = get_tid(), lane = tid & 63;
  const int gw = blockIdx.x * 4 + (tid >> 6), nw = gridDim.x * 4;
  u16* h = (u16*)(P.ws + WS_ACTA);
  for (int row = gw; row < TT; row += nw)
    rms_row_bf16(P.out + (size_t)row * 1024, g, h + (size_t)row * 1024, nullptr, lane);
  if (cache_layer >= 0) {
    const int l = cache_layer;
    cvt_job(P.in[3] + (size_t)l * DB * PAST * 512, (u16*)(P.ws + WS_FOXK) + (size_t)TP * 512, DB, (size_t)PAST * 512, (size_t)PAST * 512, (size_t)SKS * 512);
    cvt_job(P.in[4] + (size_t)l * DB * PAST * 512, (u16*)(P.ws + WS_FOXV) + (size_t)TP * 512, DB, (size_t)PAST * 512, (size_t)PAST * 512, (size_t)SKS * 512);
    cvt_job(P.in[6] + (size_t)l * DB * PAST * 128, (u16*)(P.ws + WS_CKV) + (size_t)TP * 128, DB, (size_t)PAST * 128, (size_t)PAST * 128, (size_t)SKS * 128);
    cvt_job(P.in[7] + (size_t)l * DB * PAST * 64, (u16*)(P.ws + WS_KROPE) + (size_t)TP * 64, DB, (size_t)PAST * 64, (size_t)PAST * 64, (size_t)SKS * 64);
  }
}

DI void phase_final(const Params& P) {
  const int tid = get_tid(), lane = tid & 63;
  const int gw = blockIdx.x * 4 + (tid >> 6), nw = gridDim.x * 4;
  const float* g = P.in[27];
  for (int row = gw; row < TT; row += nw) {
    float* x = P.out + (size_t)row * 1024;
    f32x4 v[4];
    float ss = 0.f;
#pragma unroll
    for (int i = 0; i < 4; i++) {
      v[i] = *(const f32x4*)(x + i * 256 + lane * 4);
      ss += v[i][0] * v[i][0] + v[i][1] * v[i][1] + v[i][2] * v[i][2] + v[i][3] * v[i][3];
    }
    ss = wave_sum(ss);
    const float rs = rsqrtf(ss * (1.f / 1024.f) + 1e-6f);
#pragma unroll
    for (int i = 0; i < 4; i++) {
      const f32x4 gg = *(const f32x4*)(g + i * 256 + lane * 4);
      f32x4 w;
      w[0] = v[i][0] * rs * gg[0]; w[1] = v[i][1] * rs * gg[1]; w[2] = v[i][2] * rs * gg[2]; w[3] = v[i][3] * rs * gg[3];
      *(f32x4*)(x + i * 256 + lane * 4) = w;
    }
  }
}

DI void phase_post(const Params& P, int l, char* smem) {
  const int tid = get_tid(), lane = tid & 63;
  const int gw = blockIdx.x * 4 + (tid >> 6), nw = gridDim.x * 4;
  const float* zc = (const float*)(P.ws + WS_ZC);
  u16* cqn = (u16*)(P.ws + WS_CQN);
  u16* ckv = (u16*)(P.ws + WS_CKV);
  u16* krp = (u16*)(P.ws + WS_KROPE);
  const f32x2* rt = (const f32x2*)(P.ws + WS_ROPE);
  const float* gq = P.in[13] + l * 256;
  const float* gkv = P.in[15] + l * 128;
  for (int tok = gw; tok < TT; tok += nw) {
    const float* z = zc + (size_t)tok * 448;
    const bool isp = tok < TP;
    const size_t orow = isp ? ((size_t)l * TP + tok) : ((size_t)l * TS + (tok - TP));
    const int kr = tok_krow(tok);
    {
      const f32x4 v = *(const f32x4*)(z + lane * 4);
      const float ss = wave_sum(v[0] * v[0] + v[1] * v[1] + v[2] * v[2] + v[3] * v[3]);
      const float rs = rsqrtf(ss * (1.f / 256.f) + 1e-6f);
      const f32x4 gg = *(const f32x4*)(gq + lane * 4);
      u32x2 w;
      w[0] = pk2(v[0] * rs * gg[0], v[1] * rs * gg[1]);
      w[1] = pk2(v[2] * rs * gg[2], v[3] * rs * gg[3]);
      *(u32x2*)(cqn + (size_t)tok * 256 + lane * 4) = w;
    }
    {
      const f32x2 v = *(const f32x2*)(z + 256 + lane * 2);
      const float ss = wave_sum(v[0] * v[0] + v[1] * v[1]);
      const float rs = rsqrtf(ss * (1.f / 128.f) + 1e-6f);
      const f32x2 gg = *(const f32x2*)(gkv + lane * 2);
      f32x2 o; o[0] = v[0] * rs * gg[0]; o[1] = v[1] * rs * gg[1];
      *(f32x2*)(P.out + (isp ? O_CKP : O_CKS) + orow * 128 + lane * 2) = o;
      *(unsigned*)(ckv + (size_t)kr * 128 + lane * 2) = pk2(o[0], o[1]);
    }
    {
      const float x = z[384 + lane];
      const float y = __shfl_xor(x, 32);
      const f32x2 cs = rt[tok_pos(tok) * 32 + (lane & 31)];
      const float o = (lane < 32) ? (x * cs[0] - y * cs[1]) : (x * cs[0] + y * cs[1]);
      P.out[(isp ? O_KRP : O_KRS) + orow * 64 + lane] = o;
      krp[(size_t)kr * 64 + lane] = f2bf(o);
    }
  }
  float* cum = (float*)(P.ws + WS_CUM);
  float* ssum = (float*)smem;
  const int hh = tid & 7, seg = tid >> 3;
  for (int it = blockIdx.x; it < NB + DB; it += gridDim.x) {
    const bool isp = it < NB;
    const int b = isp ? it : it - NB;
    const int seglen = isp ? 128 : 65;
    const float* srcA; const float* srcB; int nA;
    size_t krow0;
    if (isp) { srcA = P.out + O_FLP + ((size_t)l * TP + (size_t)b * SEQ) * 8; srcB = srcA; nA = SEQ; krow0 = (size_t)b * SEQ; }
    else {
      srcA = P.in[5] + ((size_t)l * DB + b) * PAST * 8;
      srcB = P.out + O_FLS + ((size_t)l * TS + (size_t)b * DS) * 8 - (size_t)PAST * 8;
      nA = PAST; krow0 = (size_t)TP + (size_t)b * SKS;
    }
    const int p0 = seg * seglen;
    float s = 0.f;
    for (int p = p0; p < p0 + seglen; p++) s += (p < nA ? srcA : srcB)[(size_t)p * 8 + hh];
    __syncthreads();
    ssum[tid] = s;
    __syncthreads();
    float run = 0.f;
    for (int s2 = 0; s2 < seg; s2++) run += ssum[s2 * 8 + hh];
    for (int p = p0; p < p0 + seglen; p++) {
      run += (p < nA ? srcA : srcB)[(size_t)p * 8 + hh];
      cum[(krow0 + p) * 8 + hh] = run;
    }
  }
}

template <int EPI>
DI void gemm_phase(const Params& P, int l, const u16* A, int lda, const u16* Bt, int ldb, int K, int M, int N, char* smem, int& rot) {
  const int tn = N / 128, ntiles = (M / 128) * tn;
  const int G = gridDim.x;
  for (int t = (blockIdx.x + G - (rot % G)) % G; t < ntiles; t += G) {
    const int mt = t / tn, nt = t % tn;
    gemm_tile<EPI>(P, l, A, lda, Bt, ldb, K, mt * 128, nt * 128, smem);
  }
  rot += ntiles;
}

DI void phase_attn(const Params& P, int l, char* smem) {
  const u16* qf = (const u16*)(P.ws + WS_QF);
  const u16* fk = (const u16*)(P.ws + WS_FOXK);
  const u16* fv = (const u16*)(P.ws + WS_FOXV);
  const float* cum = (const float*)(P.ws + WS_CUM);
  const u16* qm = (const u16*)(P.ws + WS_R1 + R1_QM);
  const u16* kv = (const u16*)(P.ws + WS_R1 + R1_KV);
  const u16* krp = (const u16*)(P.ws + WS_KROPE);
  u16* mixed = (u16*)(P.ws + WS_ACTA);
  constexpr float LOG2E = 1.4426950408889634f;
  const int total = 384 + 32 * 96;
  for (int t = blockIdx.x; t < total; t += gridDim.x) {
    bool isfox, issample; int b, hd, qb = 0;
    if (t < 256) { isfox = true; issample = true; b = t >> 3; hd = t & 7; }
    else if (t < 384) { isfox = false; issample = true; const int u = t - 256; b = u >> 2; hd = u & 3; }
    else {
      const int u = t - 384; const int grp = u / 96; int w = u % 96; qb = 31 - grp; issample = false;
      if (w < 32) { isfox = false; b = w >> 2; hd = w & 3; }
      else { w -= 32; isfox = true; b = w >> 3; hd = w & 7; }
    }
    AttnJob J;
    size_t tok0, krow0;
    if (issample) { tok0 = (size_t)TP + (size_t)b * DS; krow0 = (size_t)TP + (size_t)b * SKS; J.nq = DS; J.Sk = SKS; J.qpos0 = PAST; }
    else { tok0 = (size_t)b * SEQ + (size_t)qb * 128; krow0 = (size_t)b * SEQ; J.nq = 128; J.Sk = SEQ; J.qpos0 = qb * 128; }
    if (isfox) {
      J.Q = qf + tok0 * 512 + hd * 64; J.ldq = 512;
      J.K1 = fk + krow0 * 512 + hd * 64; J.ldk1 = 512; J.K2 = J.K1; J.ldk2 = 512;
      J.V = fv + krow0 * 512 + hd * 64; J.ldv = 512;
      J.O = mixed + tok0 * 1024 + hd * 64; J.ldo = 1024;
      J.cq = cum + (krow0 + (size_t)J.qpos0) * 8 + hd;
      J.ck = cum + krow0 * 8 + hd;
      J.scale_log2 = 0.125f * LOG2E;
      attn_block<64, 64, 64, MASK_FRAME, true, FOX_PF>(J, smem);
    } else {
      J.Q = qm + tok0 * 768 + hd * 192; J.ldq = 768;
      J.K1 = kv + krow0 * 1024 + hd * 256; J.ldk1 = 1024;
      J.K2 = krp + krow0 * 64; J.ldk2 = 64;
      J.V = kv + krow0 * 1024 + hd * 256 + 128; J.ldv = 1024;
      J.O = mixed + tok0 * 1024 + 512 + hd * 128; J.ldo = 1024;
      J.cq = nullptr; J.ck = nullptr;
      J.scale_log2 = 0.07216878364870322f * LOG2E;
      attn_block<192, 128, 128, MASK_CHUNK, false, MLA_PF>(J, smem);
    }
  }
}

DI void phase_cross(const Params& P, int l, char* smem) {
  const u16* xq = (const u16*)(P.ws + WS_R1 + R1_XQ);
  const u16* mk = (const u16*)(P.ws + WS_MEMK) + (size_t)l * MB * NMEM * 1024;
  const u16* mv = (const u16*)(P.ws + WS_MEMV) + (size_t)l * MB * NMEM * 1024;
  u16* xo = (u16*)(P.ws + WS_ACTA);
  constexpr float LOG2E = 1.4426950408889634f;
  const int nsamp = DB * 4 * 2;
  const int total = nsamp + 256 * 4 * 2;
  for (int t = blockIdx.x; t < total; t += gridDim.x) {
    AttnJob J;
    size_t tok0; int mb, hd, half;
    if (t < nsamp) { const int b = t >> 3; hd = (t >> 1) & 3; half = t & 1; tok0 = (size_t)TP + (size_t)b * DS; mb = NB + b; J.nq = DS; }
    else { const int u = t - nsamp; const int qbk = u >> 3; hd = (u >> 1) & 3; half = u & 1; tok0 = (size_t)qbk * 128; mb = qbk >> 5; J.nq = 128; }
    J.Sk = NMEM; J.qpos0 = 0;
    J.Q = xq + tok0 * 1024 + hd * 256; J.ldq = 1024;
    J.K1 = mk + (size_t)mb * NMEM * 1024 + hd * 256; J.ldk1 = 1024; J.K2 = J.K1; J.ldk2 = 1024;
    J.V = mv + (size_t)mb * NMEM * 1024 + hd * 256 + half * 128; J.ldv = 1024;
    J.O = xo + tok0 * 1024 + hd * 256 + half * 128; J.ldo = 1024;
    J.cq = nullptr; J.ck = nullptr;
    J.scale_log2 = 0.0625f * LOG2E;
    attn_block<256, 256, 128, MASK_NONE, false, false>(J, smem);
  }
}

constexpr int NPHASE = 2 + 13 * NL;

DI void run_phase(const Params& P, int ph, char* smem) {
  if (ph == 0) { phase_prep(P, smem); return; }
  if (ph == NPHASE - 1) { phase_final(P); return; }
  const int l = (ph - 1) / 13, k = (ph - 1) % 13;
  char* ws = P.ws;
  const u16* actA = (const u16*)(ws + WS_ACTA);
  int rot = 0;
  switch (k) {
    case 0: phase_norm(P, P.in[10] + l * 1024, l); break;
    case 1:
      gemm_phase<EPI_IN>(P, l, actA, 1024, wt_ptr(P, l, WE_IN), 1024, 1024, TT, INP, smem, rot);
      if (l == 0) {
        for (int l2 = 0; l2 < NL; l2++)
          gemm_phase<EPI_MEM>(P, l2, (const u16*)(ws + WS_HMEM) + (size_t)l2 * NB * NMEM * 1024, 1024, wt_ptr(P, l2, WE_MKV), 1024, 1024,
                              NB * NMEM, 2048, smem, rot);
      }
      break;
    case 2: phase_post(P, l, smem); break;
    case 3:
      gemm_phase<EPI_KV>(P, l, (const u16*)(ws + WS_CKV), 128, wt_ptr(P, l, WE_UKV), 128, 128, KROWS, 1024, smem, rot);
      gemm_phase<EPI_UQ>(P, l, (const u16*)(ws + WS_CQN), 256, wt_ptr(P, l, WE_UQ), 256, 256, TT, 768, smem, rot);
      break;
    case 4: phase_attn(P, l, smem); break;
    case 5: gemm_phase<EPI_RESID>(P, l, actA, 1024, wt_ptr(P, l, WE_OUT), 1024, 1024, TT, 1024, smem, rot); break;
    case 6: phase_norm(P, P.in[18] + l * 1024, -1); break;
    case 7: gemm_phase<EPI_XQ>(P, l, actA, 1024, wt_ptr(P, l, WE_XQ), 1024, 1024, TT, 1024, smem, rot); break;
    case 8: phase_cross(P, l, smem); break;
    case 9: gemm_phase<EPI_RESID>(P, l, actA, 1024, wt_ptr(P, l, WE_XO), 1024, 1024, TT, 1024, smem, rot); break;
    case 10: phase_norm(P, P.in[24] + l * 1024, -1); break;
    case 11: gemm_phase<EPI_UP>(P, l, actA, 1024, wt_ptr(P, l, WE_UP), 1024, 1024, TT, DFF, smem, rot); break;
    case 12: gemm_phase<EPI_RESID>(P, l, (const u16*)(ws + WS_R1 + R1_U), DFF, wt_ptr(P, l, WE_DN), DFF, DFF, TT, 1024, smem, rot); break;
  }
}

__global__ void __launch_bounds__(256, LB_MIN) mega(Params P, int ph_lo, int ph_hi) {
  __shared__ __attribute__((aligned(16))) char smem[SMEM_BYTES];
  cg::grid_group grid = cg::this_grid();
  for (int ph = ph_lo; ph < ph_hi; ph++) {
    Params Q = P;
    asm volatile("" : "+s"(Q.out), "+s"(Q.ws));
    run_phase(Q, ph, smem);
    if (ph + 1 < ph_hi) grid.sync();
  }
}

extern "C" void kernel_launch(void* const* d_in, const int* in_sizes, int n_in, void* d_out, int out_size, void* d_ws,
                              size_t ws_size, hipStream_t stream) {
  static int grid_blocks = 0;
  if (!grid_blocks) {
    int dev = 0, cus = 0, per_cu = 0;
    hipGetDevice(&dev);
    hipDeviceGetAttribute(&cus, hipDeviceAttributeMultiprocessorCount, dev);
    hipOccupancyMaxActiveBlocksPerMultiprocessor(&per_cu, mega, 256, 0);
    if (per_cu < 1) per_cu = 1;
    if (per_cu > 2) per_cu = 2;
    grid_blocks = cus * per_cu;
  }
  if (n_in != 28 || (size_t)out_size != O_END || ws_size < WS_END) {
    fprintf(stderr, "kernel_launch: shape/ws mismatch n_in %d out %d (want %zu) ws %zu (want %zu)\n", n_in, out_size, (size_t)O_END, ws_size, (size_t)WS_END);
    return;
  }
  Params p;
  memset(&p, 0, sizeof(p));
  for (int i = 0; i < 28; i++) p.in[i] = (const float*)d_in[i];
  p.out = (float*)d_out;
  p.ws = (char*)d_ws;
#if COOP
  int lo = 0, hi = NPHASE;
  void* args[] = {&p, &lo, &hi};
  hipError_t e = hipLaunchCooperativeKernel((void*)mega, dim3(grid_blocks), dim3(256), args, 0, stream);
  if (e != hipSuccess) fprintf(stderr, "cooperative launch failed: %s (grid %d)\n", hipGetErrorString(e), grid_blocks);
#else
  for (int ph = 0; ph < NPHASE; ph++) hipLaunchKernelGGL(mega, dim3(grid_blocks), dim3(256), 0, stream, p, ph, ph + 1);
#endif
}
```

```cpp
#include <hip/hip_runtime.h>
#include <hip/hip_cooperative_groups.h>
#include <stdint.h>
#include <string.h>
#include <stdio.h>
namespace cg = cooperative_groups;

#ifndef COOP
#define COOP 1
#endif

#ifndef FOX_PF
#define FOX_PF true
#endif
#ifndef MLA_PF
#define MLA_PF true
#endif
#ifndef LB_MIN
#define LB_MIN 2
#endif
#define DI __device__ __forceinline__
typedef unsigned short u16;
typedef short s16x8 __attribute__((ext_vector_type(8)));
typedef short s16x4 __attribute__((ext_vector_type(4)));
typedef __bf16 bfx8 __attribute__((ext_vector_type(8)));
typedef __bf16 bfx2 __attribute__((ext_vector_type(2)));
typedef float f32x16 __attribute__((ext_vector_type(16)));
typedef float f32x4 __attribute__((ext_vector_type(4)));
typedef float f32x2 __attribute__((ext_vector_type(2)));
typedef unsigned u32x4 __attribute__((ext_vector_type(4)));
typedef unsigned u32x2 __attribute__((ext_vector_type(2)));

constexpr int DM = 1024, NB = 8, SEQ = 4096, NL = 2, DB = 32, DS = 32, PAST = 2048;
constexpr int TP = NB * SEQ;
constexpr int TS = DB * DS;
constexpr int TT = TP + TS;
constexpr int SKS = PAST + DS;
constexpr int KROWS = TP + DB * SKS;
constexpr int INC = 1992, INP = 2048;
constexpr int NMEM = 256, MB = NB + DB;
constexpr int DFF = 4096;

constexpr size_t O_Y = 0;
constexpr size_t O_FKP = (size_t)TT * DM;
constexpr size_t O_FVP = O_FKP + (size_t)NL * TP * 512;
constexpr size_t O_FLP = O_FVP + (size_t)NL * TP * 512;
constexpr size_t O_CKP = O_FLP + (size_t)NL * TP * 8;
constexpr size_t O_KRP = O_CKP + (size_t)NL * TP * 128;
constexpr size_t O_MKP = O_KRP + (size_t)NL * TP * 64;
constexpr size_t O_MVP = O_MKP + (size_t)NL * NB * NMEM * 1024;
constexpr size_t O_FKS = O_MVP + (size_t)NL * NB * NMEM * 1024;
constexpr size_t O_FVS = O_FKS + (size_t)NL * TS * 512;
constexpr size_t O_FLS = O_FVS + (size_t)NL * TS * 512;
constexpr size_t O_CKS = O_FLS + (size_t)NL * TS * 8;
constexpr size_t O_KRS = O_CKS + (size_t)NL * TS * 128;
constexpr size_t O_END = O_KRS + (size_t)NL * TS * 64;

constexpr size_t al256(size_t x) { return (x + 255) / 256 * 256; }
constexpr size_t WE_IN = 0;
constexpr size_t WE_UQ = WE_IN + (size_t)INP * 1024;
constexpr size_t WE_UKV = WE_UQ + (size_t)768 * 256;
constexpr size_t WE_OUT = WE_UKV + (size_t)1024 * 128;
constexpr size_t WE_XQ = WE_OUT + (size_t)1024 * 1024;
constexpr size_t WE_MKV = WE_XQ + (size_t)1024 * 1024;
constexpr size_t WE_XO = WE_MKV + (size_t)2048 * 1024;
constexpr size_t WE_UP = WE_XO + (size_t)1024 * 1024;
constexpr size_t WE_DN = WE_UP + (size_t)4096 * 1024;
constexpr size_t WE_LAYER = WE_DN + (size_t)1024 * 4096;
constexpr size_t WS_WT = 0;
constexpr size_t WS_ROPE = al256(WS_WT + WE_LAYER * 2 * NL);
constexpr size_t WS_ACTA = al256(WS_ROPE + (size_t)4096 * 32 * 8);
constexpr size_t WS_QF = al256(WS_ACTA + (size_t)TT * 1024 * 2);
constexpr size_t WS_FOXK = al256(WS_QF + (size_t)TT * 512 * 2);
constexpr size_t WS_FOXV = al256(WS_FOXK + (size_t)KROWS * 512 * 2);
constexpr size_t WS_CUM = al256(WS_FOXV + (size_t)KROWS * 512 * 2);
constexpr size_t WS_ZC = al256(WS_CUM + (size_t)KROWS * 8 * 4);
constexpr size_t WS_CQN = al256(WS_ZC + (size_t)TT * 448 * 4);
constexpr size_t WS_CKV = al256(WS_CQN + (size_t)TT * 256 * 2);
constexpr size_t WS_KROPE = al256(WS_CKV + (size_t)KROWS * 128 * 2);
constexpr size_t WS_MEMK = al256(WS_KROPE + (size_t)KROWS * 64 * 2);
constexpr size_t WS_MEMV = al256(WS_MEMK + (size_t)NL * MB * NMEM * 1024 * 2);
constexpr size_t WS_HMEM = al256(WS_MEMV + (size_t)NL * MB * NMEM * 1024 * 2);
constexpr size_t WS_R1 = al256(WS_HMEM + (size_t)NL * NB * NMEM * 1024 * 2);
constexpr size_t R1_KV = 0;
constexpr size_t R1_QM = al256((size_t)KROWS * 1024 * 2);
constexpr size_t R1_U = 0;
constexpr size_t R1_XQ = 0;
constexpr size_t WS_END = al256(WS_R1 + (size_t)TT * 4096 * 2);
static_assert(R1_QM + (size_t)TT * 768 * 2 <= (size_t)TT * 4096 * 2, "R1 overflow");

constexpr int SMEM_BYTES = 65536;

struct Params {
  const float* in[28];
  float* out;
  char* ws;
};

DI int get_bid() { int t = blockIdx.x; asm volatile("" : "+s"(t)); return t; }
DI int get_nblk() { int t = gridDim.x; asm volatile("" : "+s"(t)); return t; }
DI int get_tid() { int t = threadIdx.x; asm volatile("" : "+v"(t)); return t; }
DI unsigned pk2(float a, float b) { f32x2 v = {a, b}; return __builtin_bit_cast(unsigned, __builtin_convertvector(v, bfx2)); }
DI u16 f2bf(float a) { return (u16)(pk2(a, 0.f) & 0xffffu); }
DI f32x16 mfma(s16x8 a, s16x8 b, f32x16 c) {
  return __builtin_amdgcn_mfma_f32_32x32x16_bf16(__builtin_bit_cast(bfx8, a), __builtin_bit_cast(bfx8, b), c, 0, 0, 0);
}
DI int crow(int i, int h) { return (i & 3) + 8 * (i >> 2) + 4 * h; }
DI float wave_sum(float v) {
#pragma unroll
  for (int m = 32; m >= 1; m >>= 1) v += __shfl_xor(v, m);
  return v;
}
DI float xhalf_max(float v) {
  auto rr = __builtin_amdgcn_permlane32_swap(__float_as_uint(v), __float_as_uint(v), false, false);
  return fmaxf(__uint_as_float(rr[0]), __uint_as_float(rr[1]));
}
DI float xhalf_sum(float v) {
  auto rr = __builtin_amdgcn_permlane32_swap(__float_as_uint(v), __float_as_uint(v), false, false);
  return __uint_as_float(rr[0]) + __uint_as_float(rr[1]);
}
DI int tok_krow(int tok) {
  if (tok < TP) return tok;
  const int s = tok - TP;
  return TP + (s >> 5) * SKS + PAST + (s & 31);
}
DI int tok_pos(int tok) { return tok < TP ? (tok & (SEQ - 1)) : PAST + ((tok - TP) & 31); }

enum { EPI_IN = 0, EPI_MEM, EPI_UQ, EPI_KV, EPI_RESID, EPI_XQ, EPI_UP, EPI_RESID0 };

template <int EPI>
DI void epilogue(const Params& P, int l, f32x16 (&acc)[2][2], int mw, int nw, int r, int h) {
  float* out = P.out;
  char* ws = P.ws;
  if constexpr (EPI == EPI_IN) {
    u16* qf = (u16*)(ws + WS_QF);
    u16* fk = (u16*)(ws + WS_FOXK);
    u16* fv = (u16*)(ws + WS_FOXV);
    float* zc = (float*)(ws + WS_ZC);
    const float* bfg = P.in[12] + l * 8;
#pragma unroll
    for (int mi = 0; mi < 2; mi++) {
#pragma unroll
      for (int i = 0; i < 16; i++) {
        const int row = mw + mi * 32 + crow(i, h);
        const int kr = tok_krow(row);
        const bool isp = row < TP;
        const size_t orow = isp ? ((size_t)l * TP + row) : ((size_t)l * TS + (row - TP));
#pragma unroll
        for (int ni = 0; ni < 2; ni++) {
          const int col = nw + ni * 32 + r;
          const float v = acc[mi][ni][i];
          if (col < 512) {
            qf[(size_t)row * 512 + col] = f2bf(v);
          } else if (col < 1024) {
            const int c = col - 512;
            out[(isp ? O_FKP : O_FKS) + orow * 512 + c] = v;
            fk[(size_t)kr * 512 + c] = f2bf(v);
          } else if (col < 1536) {
            const int c = col - 1024;
            out[(isp ? O_FVP : O_FVS) + orow * 512 + c] = v;
            fv[(size_t)kr * 512 + c] = f2bf(v);
          } else if (col < 1544) {
            const int c = col - 1536;
            const float g = v + bfg[c];
            const float ls = fminf(g, 0.f) - log1pf(__expf(-fabsf(g)));
            out[(isp ? O_FLP : O_FLS) + orow * 8 + c] = ls;
          } else if (col < INC) {
            zc[(size_t)row * 448 + (col - 1544)] = v;
          }
        }
      }
    }
  } else if constexpr (EPI == EPI_MEM) {
    u16* mk = (u16*)(ws + WS_MEMK);
    u16* mv = (u16*)(ws + WS_MEMV);
#pragma unroll
    for (int mi = 0; mi < 2; mi++) {
#pragma unroll
      for (int i = 0; i < 16; i++) {
        const int row = mw + mi * 32 + crow(i, h);
#pragma unroll
        for (int ni = 0; ni < 2; ni++) {
          const int col = nw + ni * 32 + r;
          const float v = acc[mi][ni][i];
          const int c = col & 1023;
          const size_t oidx = ((size_t)l * (NB * NMEM) + row) * 1024 + c;
          const size_t bidx = ((size_t)l * (MB * NMEM) + row) * 1024 + c;
          if (col < 1024) { out[O_MKP + oidx] = v; mk[bidx] = f2bf(v); }
          else { out[O_MVP + oidx] = v; mv[bidx] = f2bf(v); }
        }
      }
    }
  } else if constexpr (EPI == EPI_UQ) {
    u16* qm = (u16*)(ws + WS_R1 + R1_QM);
    const f32x2* rt = (const f32x2*)(ws + WS_ROPE);
    const bool isrope = (nw % 192) == 128;
#pragma unroll
    for (int mi = 0; mi < 2; mi++) {
#pragma unroll
      for (int i = 0; i < 16; i++) {
        const int row = mw + mi * 32 + crow(i, h);
        float x1 = acc[mi][0][i], x2 = acc[mi][1][i];
        if (isrope) {
          const f32x2 cs = rt[tok_pos(row) * 32 + r];
          const float o1 = x1 * cs[0] - x2 * cs[1];
          const float o2 = x2 * cs[0] + x1 * cs[1];
          x1 = o1; x2 = o2;
        }
        qm[(size_t)row * 768 + nw + r] = f2bf(x1);
        qm[(size_t)row * 768 + nw + 32 + r] = f2bf(x2);
      }
    }
  } else if constexpr (EPI == EPI_KV || EPI == EPI_XQ || EPI == EPI_UP) {
    u16* dst; int ld;
    if constexpr (EPI == EPI_KV) { dst = (u16*)(ws + WS_R1 + R1_KV); ld = 1024; }
    else if constexpr (EPI == EPI_XQ) { dst = (u16*)(ws + WS_R1 + R1_XQ); ld = 1024; }
    else { dst = (u16*)(ws + WS_R1 + R1_U); ld = DFF; }
#pragma unroll
    for (int mi = 0; mi < 2; mi++) {
#pragma unroll
      for (int i = 0; i < 16; i++) {
        const int row = mw + mi * 32 + crow(i, h);
#pragma unroll
        for (int ni = 0; ni < 2; ni++) {
          float v = acc[mi][ni][i];
          if constexpr (EPI == EPI_UP) { v = fmaxf(v, 0.f); v = v * v; }
          dst[(size_t)row * ld + nw + ni * 32 + r] = f2bf(v);
        }
      }
    }
  } else if constexpr (EPI == EPI_RESID || EPI == EPI_RESID0) {
#pragma unroll
    for (int mi = 0; mi < 2; mi++) {
#pragma unroll
      for (int i = 0; i < 16; i++) {
        const int row = mw + mi * 32 + crow(i, h);
#pragma unroll
        for (int ni = 0; ni < 2; ni++) {
          unsafeAtomicAdd(out + (size_t)row * DM + nw + ni * 32 + r, EPI == EPI_RESID0 ? acc[mi][ni][i] * 0.f : acc[mi][ni][i]);
        }
      }
    }
  }
}

enum { MASK_NONE = 0, MASK_FRAME = 1, MASK_CHUNK = 2 };
struct AttnJob {
  const u16* Q; int ldq;
  const u16* K1; int ldk1;
  const u16* K2; int ldk2;
  const u16* V; int ldv;
  u16* O; int ldo;
  const float* cq;
  const float* ck;
  int nq, Sk, qpos0;
  float scale_log2;
};

template <int DQK, int D1, int DVT, int MASK, bool BIAS, bool PREFETCH, int LDQ, int LDK1, int LDK2, int LDV, int LDO>
DI void attn_block(const AttnJob& J, char* smem) {
  constexpr int KP = DQK * 2 + 16;
  constexpr int VP = DVT * 2;
  constexpr int CV = DVT / 8;
  constexpr int NKK = DQK / 16, NDV = DVT / 32;
  constexpr float LOG2E = 1.4426950408889634f;
  char* Ks = smem;
  char* Vs = smem + 64 * KP;
  float* cks = (float*)(smem + 64 * KP + 64 * VP);
  const int tid = get_tid(), wave = tid >> 6, lane = tid & 63, r = lane & 31, h = lane >> 5;
  const int wq0 = wave * 32;
  const bool active = wq0 < J.nq;
  const int qi = wq0 + r;
  const int qpos = J.qpos0 + qi;
  const int wqmax = J.qpos0 + wq0 + 31;
  const int qmax = J.qpos0 + J.nq - 1;
  const int ntk = (J.Sk + 63) >> 6;
  int nt = ntk;
  if (MASK != MASK_NONE) { const int t2 = (qmax >> 6) + 1; nt = t2 < ntk ? t2 : ntk; }

  s16x8 qf[NKK];
  {
    const u16* qp = J.Q + (size_t)qi * LDQ + h * 8;
#pragma unroll
    for (int kk = 0; kk < NKK; kk++) {
      if (active) qf[kk] = *(const s16x8*)(qp + kk * 16);
      else { s16x8 z = {0, 0, 0, 0, 0, 0, 0, 0}; qf[kk] = z; }
    }
  }
  float cqv = 0.f;
  if (BIAS) { if (active) cqv = J.cq[(size_t)qi * 8] * LOG2E; }

  f32x16 o[NDV];
#pragma unroll
  for (int d = 0; d < NDV; d++)
#pragma unroll
    for (int i = 0; i < 16; i++) o[d][i] = 0.f;
  float m_run = -1e30f, l_run = 0.f;

  constexpr int CK1 = D1 / 8, CK2 = (DQK - D1) / 8;
  constexpr int RP1 = 256 / CK1, NP1 = 64 / RP1;
  constexpr int RP2 = CK2 ? 256 / (CK2 ? CK2 : 1) : 64, NP2 = CK2 ? 64 / RP2 : 0;
  constexpr int RPV = 256 / CV, NPV = 64 / RPV;
  u32x4 rk1[NP1], rk2[NP2 ? NP2 : 1], rv[NPV];
  float rck = 0.f;
  const int tq = (lane & 15) >> 2, tp = lane & 3, tblk = (lane >> 4) & 1;
  const int vswz = (DVT >= 128) ? tq : (tq >> 1);
  const int r1 = tid / CK1, c1 = tid % CK1;
  const int r2 = CK2 ? tid / (CK2 ? CK2 : 1) : 0, c2 = CK2 ? tid % (CK2 ? CK2 : 1) : 0;
  const int r3 = tid / CV, c3 = tid % CV;
  const unsigned k1o = (unsigned)(r1 * LDK1 + c1 * 8) * 2u;
  const unsigned k2o = (unsigned)(r2 * LDK2 + c2 * 8) * 2u;
  const unsigned vo = (unsigned)(r3 * LDV + c3 * 8) * 2u;
  const int k1so = r1 * KP + c1 * 16;
  const int k2so = r2 * KP + D1 * 2 + c2 * 16;
  const int vsw = (DVT >= 128) ? (r3 & 3) : ((r3 >> 1) & 1);
  const int vso = 64 * KP + r3 * VP + (((c3 >> 2) ^ vsw) * 64) + (c3 & 3) * 16;
  const int vro = 64 * KP + (4 * h + tq) * VP + (16 * tblk + 4 * tp) * 2;
  const int kro = r * KP + h * 16;

  auto load_tile = [&](int j) {
    const int kb = j * 64;
#pragma unroll
    for (int i = 0; i < NP1; i++) {
      u32x4 v = {0u, 0u, 0u, 0u};
      if (kb + r1 + i * RP1 < J.Sk) v = *(const u32x4*)((const char*)(J.K1 + (size_t)(kb + i * RP1) * LDK1) + k1o);
      rk1[i] = v;
    }
#pragma unroll
    for (int i = 0; i < NP2; i++) {
      u32x4 v = {0u, 0u, 0u, 0u};
      if (kb + r2 + i * RP2 < J.Sk) v = *(const u32x4*)((const char*)(J.K2 + (size_t)(kb + i * RP2) * LDK2) + k2o);
      rk2[i] = v;
    }
#pragma unroll
    for (int i = 0; i < NPV; i++) {
      u32x4 v = {0u, 0u, 0u, 0u};
      if (kb + r3 + i * RPV < J.Sk) v = *(const u32x4*)((const char*)(J.V + (size_t)(kb + i * RPV) * LDV) + vo);
      rv[i] = v;
    }
    if (BIAS) {
      if (tid < 64) { const int key = kb + tid; rck = key < J.Sk ? J.ck[(size_t)key * 8] * LOG2E : 0.f; }
    }
  };
  auto store_tile = [&]() {
    int a1 = k1so, a2 = k2so, a3 = vso;
    asm volatile("" : "+v"(a1), "+v"(a2), "+v"(a3));
#pragma unroll
    for (int i = 0; i < NP1; i++) *(u32x4*)(smem + a1 + i * RP1 * KP) = rk1[i];
#pragma unroll
    for (int i = 0; i < NP2; i++) *(u32x4*)(smem + a2 + i * RP2 * KP) = rk2[i];
#pragma unroll
    for (int i = 0; i < NPV; i++) *(u32x4*)(smem + a3 + i * RPV * VP) = rv[i];
    if (BIAS) { if (tid < 64) cks[tid] = rck; }
  };

  if (PREFETCH) load_tile(0);
  for (int j = 0; j < nt; j++) {
    __syncthreads();
    if (!PREFETCH) load_tile(j);
    store_tile();
    __syncthreads();
    if (PREFETCH) { if (j + 1 < nt) load_tile(j + 1); }
    const bool need = active && (MASK == MASK_NONE || j * 64 <= wqmax);
    if (need) {
      int kro_l = kro, vro_l = vro;
      asm volatile("" : "+v"(kro_l), "+v"(vro_l));
      const char* krd = smem + kro_l;
      const bool needmask = (MASK == MASK_FRAME && j * 64 + 63 > J.qpos0 + wq0) || (j * 64 + 63 >= J.Sk);
      const int dq = (MASK == MASK_FRAME ? min(qpos, J.Sk - 1) : J.Sk - 1) - j * 64 - 4 * h;
#pragma unroll
      for (int hb = 0; hb < 2; hb++) {
        if (MASK == MASK_FRAME && j * 64 + hb * 32 > wqmax) continue;
        f32x16 p;
#pragma unroll
        for (int i = 0; i < 16; i++) p[i] = 0.f;
#pragma unroll
        for (int kk = 0; kk < NKK; kk++) {
          const s16x8 kf = *(const s16x8*)(krd + hb * 32 * KP + kk * 32);
          p = mfma(kf, qf[kk], p);
        }
        if (BIAS) {
#pragma unroll
          for (int g = 0; g < 4; g++) {
            const f32x4 c0 = *(const f32x4*)(cks + hb * 32 + 8 * g + 4 * h);
#pragma unroll
            for (int e = 0; e < 4; e++) p[4 * g + e] = fmaf(p[4 * g + e], J.scale_log2, cqv - c0[e]);
          }
        } else {
#pragma unroll
          for (int i = 0; i < 16; i++) p[i] *= J.scale_log2;
        }
        if (needmask) {
#pragma unroll
          for (int i = 0; i < 16; i++) {
            const int cc = (i & 3) + 8 * (i >> 2) + 32 * hb;
            p[i] = (cc <= dq) ? p[i] : -1e30f;
          }
        }
        float mx = p[0];
#pragma unroll
        for (int i = 1; i < 16; i++) mx = fmaxf(mx, p[i]);
        mx = xhalf_max(mx);
        const float m_new = fmaxf(m_run, mx);
        const float alpha = __builtin_amdgcn_exp2f(m_run - m_new);
        m_run = m_new;
        float ps = 0.f;
#pragma unroll
        for (int i = 0; i < 16; i++) { p[i] = __builtin_amdgcn_exp2f(p[i] - m_new); ps += p[i]; }
        l_run = l_run * alpha + ps;
        if (__any(alpha != 1.f)) {
#pragma unroll
          for (int d = 0; d < NDV; d++)
#pragma unroll
            for (int i = 0; i < 16; i++) o[d][i] *= alpha;
        }
        s16x8 pb[2];
        {
          u32x4 w;
          w[0] = pk2(p[0], p[1]); w[1] = pk2(p[2], p[3]); w[2] = pk2(p[4], p[5]); w[3] = pk2(p[6], p[7]);
          pb[0] = __builtin_bit_cast(s16x8, w);
          w[0] = pk2(p[8], p[9]); w[1] = pk2(p[10], p[11]); w[2] = pk2(p[12], p[13]); w[3] = pk2(p[14], p[15]);
          pb[1] = __builtin_bit_cast(s16x8, w);
        }
#pragma unroll
        for (int d = 0; d < NDV; d++) {
          const char* vb = smem + (vro_l + ((d ^ vswz) * 64)) + hb * 32 * VP;
#pragma unroll
          for (int s = 0; s < 2; s++) {
            const s16x4 lo = __builtin_amdgcn_ds_read_tr16_b64_v4i16(
                (__attribute__((address_space(3))) s16x4*)(uintptr_t)(vb + (16 * s) * VP));
            const s16x4 hi = __builtin_amdgcn_ds_read_tr16_b64_v4i16(
                (__attribute__((address_space(3))) s16x4*)(uintptr_t)(vb + (16 * s + 8) * VP));
            const s16x8 vf = __builtin_shufflevector(lo, hi, 0, 1, 2, 3, 4, 5, 6, 7);
            o[d] = mfma(vf, pb[s], o[d]);
          }
        }
      }
    }
  }
  const float lt = xhalf_sum(l_run);
  if (active && qi < J.nq) {
    const float inv = 1.f / lt;
    u16* op = J.O + (size_t)qi * LDO + 4 * h;
#pragma unroll
    for (int d = 0; d < NDV; d++) {
#pragma unroll
      for (int g = 0; g < 4; g++) {
        u32x2 w;
        w[0] = pk2(o[d][4 * g] * inv, o[d][4 * g + 1] * inv);
        w[1] = pk2(o[d][4 * g + 2] * inv, o[d][4 * g + 3] * inv);
        *(u32x2*)(op + d * 32 + 8 * g) = w;
      }
    }
  }
}

template <int NR, bool F32OUT>
DI void rms_rows(const float* __restrict__ xbase, size_t rstride, int nvalid, const float* __restrict__ g, void* dbase, size_t dstride, int lane) {
  f32x4 v[NR][4];
#pragma unroll
  for (int j = 0; j < NR; j++)
#pragma unroll
    for (int i = 0; i < 4; i++) {
      if (j < nvalid) v[j][i] = *(const f32x4*)(xbase + (size_t)j * rstride + i * 256 + lane * 4);
      else { f32x4 z = {0.f, 0.f, 0.f, 0.f}; v[j][i] = z; }
    }
  f32x4 gg[4];
#pragma unroll
  for (int i = 0; i < 4; i++) gg[i] = *(const f32x4*)(g + i * 256 + lane * 4);
#pragma unroll
  for (int j = 0; j < NR; j++) {
    float ss = 0.f;
#pragma unroll
    for (int i = 0; i < 4; i++) ss += v[j][i][0] * v[j][i][0] + v[j][i][1] * v[j][i][1] + v[j][i][2] * v[j][i][2] + v[j][i][3] * v[j][i][3];
    ss = wave_sum(ss);
    const float rs = rsqrtf(ss * (1.f / 1024.f) + 1e-6f);
    if (j < nvalid) {
#pragma unroll
      for (int i = 0; i < 4; i++) {
        if (F32OUT) {
          f32x4 w;
          w[0] = v[j][i][0] * rs * gg[i][0]; w[1] = v[j][i][1] * rs * gg[i][1]; w[2] = v[j][i][2] * rs * gg[i][2]; w[3] = v[j][i][3] * rs * gg[i][3];
          *(f32x4*)((float*)dbase + (size_t)j * dstride + i * 256 + lane * 4) = w;
        } else {
          u32x2 w;
          w[0] = pk2(v[j][i][0] * rs * gg[i][0], v[j][i][1] * rs * gg[i][1]);
          w[1] = pk2(v[j][i][2] * rs * gg[i][2], v[j][i][3] * rs * gg[i][3]);
          *(u32x2*)((u16*)dbase + (size_t)j * dstride + i * 256 + lane * 4) = w;
        }
      }
    }
  }
}

DI void cvt_job(const float* __restrict__ src, u16* __restrict__ dst, int nseg, size_t seglen, size_t sstride, size_t dstride) {
  const size_t upseg = seglen / 8;
  const size_t total = upseg * nseg;
  const size_t stride = (size_t)get_nblk() * 256;
  for (size_t u0 = (size_t)get_bid() * 256 + get_tid(); u0 < total; u0 += 4 * stride) {
    f32x4 a[4], b[4];
    size_t so[4], dd[4];
#pragma unroll
    for (int q = 0; q < 4; q++) {
      const size_t u = u0 + q * stride;
      const size_t uu = u < total ? u : u0;
      const size_t sg = uu / upseg, off = (uu - sg * upseg) * 8;
      so[q] = sg * sstride + off; dd[q] = sg * dstride + off;
      a[q] = *(const f32x4*)(src + so[q]);
      b[q] = *(const f32x4*)(src + so[q] + 4);
    }
#pragma unroll
    for (int q = 0; q < 4; q++) {
      if (u0 + q * stride < total) {
        u32x4 w;
        w[0] = pk2(a[q][0], a[q][1]); w[1] = pk2(a[q][2], a[q][3]); w[2] = pk2(b[q][0], b[q][1]); w[3] = pk2(b[q][2], b[q][3]);
        *(u32x4*)(dst + dd[q]) = w;
      }
    }
  }
}

DI void transpose_job(const float* __restrict__ src, u16* __restrict__ dst, int K, int N, int Npad, int& rot, char* smem) {
  float* tile = (float*)smem;
  const int tk = K / 64, tn = Npad / 64, ntiles = tk * tn;
  const int G = get_nblk();
  const int tid = get_tid();
  for (int t = (get_bid() + G - (rot % G)) % G; t < ntiles; t += G) {
    const int k0 = (t % tk) * 64, n0 = (t / tk) * 64;
    __syncthreads();
#pragma unroll 4
    for (int i = 0; i < 16; i++) {
      const int k = i * 4 + (tid >> 6), n = tid & 63;
      tile[k * 65 + n] = (n0 + n < N) ? src[(size_t)(k0 + k) * N + n0 + n] : 0.f;
    }
    __syncthreads();
#pragma unroll 4
    for (int i = 0; i < 16; i++) {
      const int n = i * 4 + (tid >> 6), k = tid & 63;
      dst[(size_t)(n0 + n) * K + k0 + k] = f2bf(tile[k * 65 + n]);
    }
  }
  rot += ntiles;
}

DI u16* wt_ptr(const Params& P, int l, size_t eoff) { return (u16*)(P.ws + WS_WT) + (size_t)l * WE_LAYER + eoff; }

DI void phase_prep(const Params& P, char* smem) {
  const int tid = get_tid(), lane = tid & 63;
  const int gw = get_bid() * 4 + (tid >> 6), nw = get_nblk() * 4;
  int rot = 0;
  for (int l = 0; l < NL; l++) {
    transpose_job(P.in[11] + (size_t)l * 1024 * INC, wt_ptr(P, l, WE_IN), 1024, INC, INP, rot, smem);
    transpose_job(P.in[14] + (size_t)l * 256 * 768, wt_ptr(P, l, WE_UQ), 256, 768, 768, rot, smem);
    transpose_job(P.in[16] + (size_t)l * 128 * 1024, wt_ptr(P, l, WE_UKV), 128, 1024, 1024, rot, smem);
    transpose_job(P.in[17] + (size_t)l * 1024 * 1024, wt_ptr(P, l, WE_OUT), 1024, 1024, 1024, rot, smem);
    transpose_job(P.in[20] + (size_t)l * 1024 * 1024, wt_ptr(P, l, WE_XQ), 1024, 1024, 1024, rot, smem);
    transpose_job(P.in[21] + (size_t)l * 1024 * 1024, wt_ptr(P, l, WE_MKV), 1024, 1024, 1024, rot, smem);
    transpose_job(P.in[22] + (size_t)l * 1024 * 1024, wt_ptr(P, l, WE_MKV) + (size_t)1024 * 1024, 1024, 1024, 1024, rot, smem);
    transpose_job(P.in[23] + (size_t)l * 1024 * 1024, wt_ptr(P, l, WE_XO), 1024, 1024, 1024, rot, smem);
    transpose_job(P.in[25] + (size_t)l * 1024 * 4096, wt_ptr(P, l, WE_UP), 1024, 4096, 4096, rot, smem);
    transpose_job(P.in[26] + (size_t)l * 4096 * 1024, wt_ptr(P, l, WE_DN), 4096, 1024, 1024, rot, smem);
  }
  {
    f32x2* rt = (f32x2*)(P.ws + WS_ROPE);
    for (int i = get_bid() * 256 + tid; i < 4096 * 32; i += get_nblk() * 256) {
      const int pos = i >> 5, j = i & 31;
      const float inv = powf(10000.f, -(float)j / 32.f);
      const float ang = (float)pos * inv;
      f32x2 cs; cs[0] = cosf(ang); cs[1] = sinf(ang);
      rt[i] = cs;
    }
  }
  for (int l = 0; l < NL; l++) {
    const size_t seg = (size_t)DB * NMEM * 1024;
    cvt_job(P.in[8] + l * seg, (u16*)(P.ws + WS_MEMK) + ((size_t)l * MB + NB) * NMEM * 1024, 1, seg, 0, 0);
    cvt_job(P.in[9] + l * seg, (u16*)(P.ws + WS_MEMV) + ((size_t)l * MB + NB) * NMEM * 1024, 1, seg, 0, 0);
  }
  for (int rr = gw; rr < NL * NB * NMEM; rr += nw) {
    const int l = rr / (NB * NMEM), row = rr % (NB * NMEM);
    rms_rows<1, false>(P.in[2] + (size_t)row * 1024, 0, 1, P.in[19] + l * 1024, (u16*)(P.ws + WS_HMEM) + (size_t)rr * 1024, 0, lane);
  }
  {
    const size_t n4 = (size_t)TT * 256;
    const size_t np4 = (size_t)TP * 256;
    const size_t stride = (size_t)get_nblk() * 256;
    for (size_t i0 = (size_t)get_bid() * 256 + tid; i0 < n4; i0 += 4 * stride) {
      f32x4 v[4];
#pragma unroll
      for (int q = 0; q < 4; q++) {
        const size_t i = i0 + q * stride;
        const size_t ii = i < n4 ? i : i0;
        v[q] = (ii < np4) ? *(const f32x4*)(P.in[0] + ii * 4) : *(const f32x4*)(P.in[1] + (ii - np4) * 4);
      }
#pragma unroll
      for (int q = 0; q < 4; q++) {
        const size_t i = i0 + q * stride;
        if (i < n4) *(f32x4*)(P.out + i * 4) = v[q];
      }
    }
  }
}

DI void phase_norm(const Params& P, const float* g, int cache_layer) {
  const int tid = get_tid(), lane = tid & 63;
  const int gw = get_bid() * 4 + (tid >> 6), nw = get_nblk() * 4;
  u16* h = (u16*)(P.ws + WS_ACTA);
  for (int row = gw; row < TT; row += 4 * nw) {
    const int nv = (TT - row + nw - 1) / nw;
    rms_rows<4, false>(P.out + (size_t)row * 1024, (size_t)nw * 1024, nv < 4 ? nv : 4, g, h + (size_t)row * 1024, (size_t)nw * 1024, lane);
  }
  if (cache_layer >= 0) {
    const int l = cache_layer;
    cvt_job(P.in[3] + (size_t)l * DB * PAST * 512, (u16*)(P.ws + WS_FOXK) + (size_t)TP * 512, DB, (size_t)PAST * 512, (size_t)PAST * 512, (size_t)SKS * 512);
    cvt_job(P.in[4] + (size_t)l * DB * PAST * 512, (u16*)(P.ws + WS_FOXV) + (size_t)TP * 512, DB, (size_t)PAST * 512, (size_t)PAST * 512, (size_t)SKS * 512);
    cvt_job(P.in[6] + (size_t)l * DB * PAST * 128, (u16*)(P.ws + WS_CKV) + (size_t)TP * 128, DB, (size_t)PAST * 128, (size_t)PAST * 128, (size_t)SKS * 128);
    cvt_job(P.in[7] + (size_t)l * DB * PAST * 64, (u16*)(P.ws + WS_KROPE) + (size_t)TP * 64, DB, (size_t)PAST * 64, (size_t)PAST * 64, (size_t)SKS * 64);
  }
}

DI void phase_final(const Params& P) {
  const int tid = get_tid(), lane = tid & 63;
  const int gw = get_bid() * 4 + (tid >> 6), nw = get_nblk() * 4;
  const float* g = P.in[27];
  for (int row = gw; row < TT; row += 4 * nw) {
    const int nv = (TT - row + nw - 1) / nw;
    rms_rows<4, true>(P.out + (size_t)row * 1024, (size_t)nw * 1024, nv < 4 ? nv : 4, g, P.out + (size_t)row * 1024, (size_t)nw * 1024, lane);
  }
}

DI void phase_post(const Params& P, int l, char* smem) {
  const int tid = get_tid(), lane = tid & 63;
  const int gw = get_bid() * 4 + (tid >> 6), nw = get_nblk() * 4;
  const float* zc = (const float*)(P.ws + WS_ZC);
  u16* cqn = (u16*)(P.ws + WS_CQN);
  u16* ckv = (u16*)(P.ws + WS_CKV);
  u16* krp = (u16*)(P.ws + WS_KROPE);
  const f32x2* rt = (const f32x2*)(P.ws + WS_ROPE);
  const float* gq = P.in[13] + l * 256;
  const float* gkv = P.in[15] + l * 128;
  for (int tok0 = gw; tok0 < TT; tok0 += 4 * nw) {
    f32x4 vq[4]; f32x2 vk[4]; float vr[4];
#pragma unroll
    for (int j = 0; j < 4; j++) {
      const int tk = tok0 + j * nw;
      const float* z = zc + (size_t)(tk < TT ? tk : tok0) * 448;
      vq[j] = *(const f32x4*)(z + lane * 4);
      vk[j] = *(const f32x2*)(z + 256 + lane * 2);
      vr[j] = z[384 + lane];
    }
    const f32x4 ggq = *(const f32x4*)(gq + lane * 4);
    const f32x2 ggk = *(const f32x2*)(gkv + lane * 2);
#pragma unroll
    for (int j = 0; j < 4; j++) {
      const int tok = tok0 + j * nw;
      if (tok >= TT) break;
      const bool isp = tok < TP;
      const size_t orow = isp ? ((size_t)l * TP + tok) : ((size_t)l * TS + (tok - TP));
      const int kr = tok_krow(tok);
      {
        const f32x4 v = vq[j];
        const float ss = wave_sum(v[0] * v[0] + v[1] * v[1] + v[2] * v[2] + v[3] * v[3]);
        const float rs = rsqrtf(ss * (1.f / 256.f) + 1e-6f);
        u32x2 w;
        w[0] = pk2(v[0] * rs * ggq[0], v[1] * rs * ggq[1]);
        w[1] = pk2(v[2] * rs * ggq[2], v[3] * rs * ggq[3]);
        *(u32x2*)(cqn + (size_t)tok * 256 + lane * 4) = w;
      }
      {
        const f32x2 v = vk[j];
        const float ss = wave_sum(v[0] * v[0] + v[1] * v[1]);
        const float rs = rsqrtf(ss * (1.f / 128.f) + 1e-6f);
        f32x2 o; o[0] = v[0] * rs * ggk[0]; o[1] = v[1] * rs * ggk[1];
        *(f32x2*)(P.out + (isp ? O_CKP : O_CKS) + orow * 128 + lane * 2) = o;
        *(unsigned*)(ckv + (size_t)kr * 128 + lane * 2) = pk2(o[0], o[1]);
      }
      {
        const float x = vr[j];
        const float y = __shfl_xor(x, 32);
        const f32x2 cs = rt[tok_pos(tok) * 32 + (lane & 31)];
        const float o = (lane < 32) ? (x * cs[0] - y * cs[1]) : (x * cs[0] + y * cs[1]);
        P.out[(isp ? O_KRP : O_KRS) + orow * 64 + lane] = o;
        krp[(size_t)kr * 64 + lane] = f2bf(o);
      }
    }
  }
  float* cum = (float*)(P.ws + WS_CUM);
  float* wtot = (float*)smem;
  const int wave = tid >> 6;
  for (int it = get_bid(); it < NB + DB; it += get_nblk()) {
    const bool isp = it < NB;
    const int b = isp ? it : it - NB;
    const int ppt = isp ? 16 : 9;
    const int npos = isp ? SEQ : SKS;
    const float* srcA; const float* srcB; int nA;
    size_t krow0;
    if (isp) { srcA = P.out + O_FLP + ((size_t)l * TP + (size_t)b * SEQ) * 8; srcB = srcA; nA = SEQ; krow0 = (size_t)b * SEQ; }
    else {
      srcA = P.in[5] + ((size_t)l * DB + b) * PAST * 8;
      srcB = P.out + O_FLS + ((size_t)l * TS + (size_t)b * DS) * 8 - (size_t)PAST * 8;
      nA = PAST; krow0 = (size_t)TP + (size_t)b * SKS;
    }
    const int p0 = tid * ppt;
    f32x4 va[16], vb[16];
#pragma unroll
    for (int j = 0; j < 16; j++) {
      const int p = p0 + j;
      f32x4 z = {0.f, 0.f, 0.f, 0.f};
      va[j] = z; vb[j] = z;
      if (j < ppt && p < npos) {
        const float* s = (p < nA ? srcA : srcB) + (size_t)p * 8;
        va[j] = *(const f32x4*)s; vb[j] = *(const f32x4*)(s + 4);
      }
    }
#pragma unroll
    for (int j = 1; j < 16; j++) { va[j] += va[j - 1]; vb[j] += vb[j - 1]; }
    f32x4 ta = va[15], tb = vb[15];
#pragma unroll
    for (int d = 1; d < 64; d <<= 1) {
#pragma unroll
      for (int e = 0; e < 4; e++) {
        const float ua = __shfl_up(ta[e], d), ub = __shfl_up(tb[e], d);
        if (lane >= d) { ta[e] += ua; tb[e] += ub; }
      }
    }
    __syncthreads();
    if (lane == 63) { *(f32x4*)(wtot + wave * 8) = ta; *(f32x4*)(wtot + wave * 8 + 4) = tb; }
    __syncthreads();
    f32x4 pa = ta - va[15], pb = tb - vb[15];
    for (int w2 = 0; w2 < wave; w2++) { pa += *(const f32x4*)(wtot + w2 * 8); pb += *(const f32x4*)(wtot + w2 * 8 + 4); }
#pragma unroll
    for (int j = 0; j < 16; j++) {
      const int p = p0 + j;
      if (j < ppt && p < npos) {
        float* d = cum + (krow0 + p) * 8;
        *(f32x4*)d = va[j] + pa; *(f32x4*)(d + 4) = vb[j] + pb;
      }
    }
  }
}

template <int EPI>
DI void gemm_phase(const Params& P, int l, const u16* __restrict__ A, int lda, const u16* __restrict__ Bt, int ldb, int K, int M, int N,
                   char* smem, int& rot) {
  const int tid = get_tid(), wave = tid >> 6, lane = tid & 63, r = lane & 31, h = lane >> 5;
  const int wm = wave >> 1, wn = wave & 1;
  const int TM = M >> 7, TN = N >> 7;
  const int G = get_nblk();
  const int bid = get_bid();
  const bool sup = (G == 512) && ((TN & 7) == 0) && ((TM & 7) == 0);
  const int SN = TN >> 3;
  const int nunits = sup ? (TM >> 3) * SN : TM * TN;
  const int ustep = sup ? 8 : G;
  const int slot8 = bid >> 3;
  int u = sup ? (int)((bid + 8 - (rot & 7)) & 7) : (int)((bid + G - (rot % G)) % G);
  rot += nunits;
  if (u >= nunits) return;
  const int lrow = tid >> 2, lc = tid & 3;
  const int pc = (lc ^ ((tid >> 4) & 3)) * 8;
  const int nk = K >> 5;
  const int sw = (r >> 2) & 3;
  const int xo0 = ((0 + h) ^ sw) * 16, xo1 = ((2 + h) ^ sw) * 16;
  const int aro = (wm * 64 + r) * 64, bro = 8192 + (wn * 64 + r) * 64;
  auto tile_of = [&](int uu, int& m0, int& n0) {
    if (sup) { const int sm = uu / SN, sn = uu - sm * SN; m0 = (sm * 8 + (slot8 >> 3)) << 7; n0 = (sn * 8 + (slot8 & 7)) << 7; }
    else { const int mt = uu / TN; m0 = mt << 7; n0 = (uu - mt * TN) << 7; }
  };
  auto issue = [&](int m0, int n0, int ks, int slot) {
    const u16* ag = A + (size_t)(m0 + lrow) * lda + pc + ks * 32;
    const u16* bg = Bt + (size_t)(n0 + lrow) * ldb + pc + ks * 32;
    char* dst = smem + slot * 16384 + tid * 16;
#pragma unroll
    for (int i = 0; i < 2; i++) {
      __builtin_amdgcn_global_load_lds((const unsigned*)(ag + (size_t)i * 64 * lda), (__attribute__((address_space(3))) unsigned*)(dst + i * 4096), 16, 0, 0);
      __builtin_amdgcn_global_load_lds((const unsigned*)(bg + (size_t)i * 64 * ldb), (__attribute__((address_space(3))) unsigned*)(dst + 8192 + i * 4096), 16, 0, 0);
    }
  };
  int m0, n0;
  tile_of(u, m0, n0);
  int ui = u, ki = 0, mi0 = m0, ni0 = n0;
  bool idone = false;
  int pend = 0;
  unsigned g = 0;
  asm volatile("s_waitcnt vmcnt(0) lgkmcnt(0)" ::: "memory");
  __builtin_amdgcn_s_barrier();
#pragma unroll 1
  for (int s = 0; s < 3; s++) {
    if (!idone) {
      issue(mi0, ni0, ki, (g + pend) & 3);
      pend++;
      if (++ki == nk) { ki = 0; ui += ustep; if (ui < nunits) tile_of(ui, mi0, ni0); else idone = true; }
    }
  }
  while (true) {
    f32x16 acc[2][2];
#pragma unroll
    for (int a = 0; a < 2; a++)
#pragma unroll
      for (int b = 0; b < 2; b++)
#pragma unroll
        for (int i = 0; i < 16; i++) acc[a][b][i] = 0.f;
#pragma unroll 1
    for (int kt = 0; kt < nk; kt++) {
      if (pend >= 3) asm volatile("s_waitcnt vmcnt(8)" ::: "memory");
      else if (pend == 2) asm volatile("s_waitcnt vmcnt(4)" ::: "memory");
      else asm volatile("s_waitcnt vmcnt(0)" ::: "memory");
      asm volatile("s_waitcnt lgkmcnt(0)" ::: "memory");
      __builtin_amdgcn_s_barrier();
      if (!idone) {
        issue(mi0, ni0, ki, (g + pend) & 3);
        if (++ki == nk) { ki = 0; ui += ustep; if (ui < nunits) tile_of(ui, mi0, ni0); else idone = true; }
      } else {
        pend--;
      }
      const char* sb = smem + (g & 3) * 16384;
      g++;
      {
        const s16x8 a0 = *(const s16x8*)(sb + aro + xo0);
        const s16x8 a1 = *(const s16x8*)(sb + aro + 32 * 64 + xo0);
        const s16x8 b0 = *(const s16x8*)(sb + bro + xo0);
        const s16x8 b1 = *(const s16x8*)(sb + bro + 32 * 64 + xo0);
        const s16x8 a2 = *(const s16x8*)(sb + aro + xo1);
        const s16x8 a3 = *(const s16x8*)(sb + aro + 32 * 64 + xo1);
        const s16x8 b2 = *(const s16x8*)(sb + bro + xo1);
        const s16x8 b3 = *(const s16x8*)(sb + bro + 32 * 64 + xo1);
        acc[0][0] = mfma(a0, b0, acc[0][0]);
        acc[0][1] = mfma(a0, b1, acc[0][1]);
        acc[1][0] = mfma(a1, b0, acc[1][0]);
        acc[1][1] = mfma(a1, b1, acc[1][1]);
        acc[0][0] = mfma(a2, b2, acc[0][0]);
        acc[0][1] = mfma(a2, b3, acc[0][1]);
        acc[1][0] = mfma(a3, b2, acc[1][0]);
        acc[1][1] = mfma(a3, b3, acc[1][1]);
      }
    }
    epilogue<EPI>(P, l, acc, m0 + wm * 64, n0 + wn * 64, r, h);
    u += ustep;
    if (u >= nunits) break;
    tile_of(u, m0, n0);
  }
  asm volatile("s_waitcnt vmcnt(0) lgkmcnt(0)" ::: "memory");
}

DI void phase_attn(const Params& P, int l, char* smem) {
  const u16* qf = (const u16*)(P.ws + WS_QF);
  const u16* fk = (const u16*)(P.ws + WS_FOXK);
  const u16* fv = (const u16*)(P.ws + WS_FOXV);
  const float* cum = (const float*)(P.ws + WS_CUM);
  const u16* qm = (const u16*)(P.ws + WS_R1 + R1_QM);
  const u16* kv = (const u16*)(P.ws + WS_R1 + R1_KV);
  const u16* krp = (const u16*)(P.ws + WS_KROPE);
  u16* mixed = (u16*)(P.ws + WS_ACTA);
  constexpr float LOG2E = 1.4426950408889634f;
  const int total = 384 + 32 * 96;
  for (int t = get_bid(); t < total; t += get_nblk()) {
    bool isfox, issample; int b, hd, qb = 0;
    if (t < 256) { isfox = true; issample = true; b = t >> 3; hd = t & 7; }
    else if (t < 384) { isfox = false; issample = true; const int u = t - 256; b = u >> 2; hd = u & 3; }
    else {
      const int u = t - 384; const int grp = u / 96; int w = u % 96; qb = 31 - grp; issample = false;
      if (w < 32) { isfox = false; b = w >> 2; hd = w & 3; }
      else { w -= 32; isfox = true; b = w >> 3; hd = w & 7; }
    }
    AttnJob J;
    size_t tok0, krow0;
    if (issample) { tok0 = (size_t)TP + (size_t)b * DS; krow0 = (size_t)TP + (size_t)b * SKS; J.nq = DS; J.Sk = SKS; J.qpos0 = PAST; }
    else { tok0 = (size_t)b * SEQ + (size_t)qb * 128; krow0 = (size_t)b * SEQ; J.nq = 128; J.Sk = SEQ; J.qpos0 = qb * 128; }
    if (isfox) {
      J.Q = qf + tok0 * 512 + hd * 64; J.ldq = 512;
      J.K1 = fk + krow0 * 512 + hd * 64; J.ldk1 = 512; J.K2 = J.K1; J.ldk2 = 512;
      J.V = fv + krow0 * 512 + hd * 64; J.ldv = 512;
      J.O = mixed + tok0 * 1024 + hd * 64; J.ldo = 1024;
      J.cq = cum + (krow0 + (size_t)J.qpos0) * 8 + hd;
      J.ck = cum + krow0 * 8 + hd;
      J.scale_log2 = 0.125f * LOG2E;
      attn_block<64, 64, 64, MASK_FRAME, true, FOX_PF, 512, 512, 512, 512, 1024>(J, smem);
    } else {
      J.Q = qm + tok0 * 768 + hd * 192; J.ldq = 768;
      J.K1 = kv + krow0 * 1024 + hd * 256; J.ldk1 = 1024;
      J.K2 = krp + krow0 * 64; J.ldk2 = 64;
      J.V = kv + krow0 * 1024 + hd * 256 + 128; J.ldv = 1024;
      J.O = mixed + tok0 * 1024 + 512 + hd * 128; J.ldo = 1024;
      J.cq = nullptr; J.ck = nullptr;
      J.scale_log2 = 0.07216878364870322f * LOG2E;
      attn_block<192, 128, 128, MASK_CHUNK, false, MLA_PF, 768, 1024, 64, 1024, 1024>(J, smem);
    }
  }
}

DI void phase_cross(const Params& P, int l, char* smem) {
  const u16* xq = (const u16*)(P.ws + WS_R1 + R1_XQ);
  const u16* mk = (const u16*)(P.ws + WS_MEMK) + (size_t)l * MB * NMEM * 1024;
  const u16* mv = (const u16*)(P.ws + WS_MEMV) + (size_t)l * MB * NMEM * 1024;
  u16* xo = (u16*)(P.ws + WS_ACTA);
  constexpr float LOG2E = 1.4426950408889634f;
  const int nsamp = DB * 4 * 2;
  const int total = nsamp + 256 * 4 * 2;
  for (int t = get_bid(); t < total; t += get_nblk()) {
    AttnJob J;
    size_t tok0; int mb, hd, half;
    if (t < nsamp) { const int b = t >> 3; hd = (t >> 1) & 3; half = t & 1; tok0 = (size_t)TP + (size_t)b * DS; mb = NB + b; J.nq = DS; }
    else { const int u = t - nsamp; const int qbk = u >> 3; hd = (u >> 1) & 3; half = u & 1; tok0 = (size_t)qbk * 128; mb = qbk >> 5; J.nq = 128; }
    J.Sk = NMEM; J.qpos0 = 0;
    J.Q = xq + tok0 * 1024 + hd * 256; J.ldq = 1024;
    J.K1 = mk + (size_t)mb * NMEM * 1024 + hd * 256; J.ldk1 = 1024; J.K2 = J.K1; J.ldk2 = 1024;
    J.V = mv + (size_t)mb * NMEM * 1024 + hd * 256 + half * 128; J.ldv = 1024;
    J.O = xo + tok0 * 1024 + hd * 256 + half * 128; J.ldo = 1024;
    J.cq = nullptr; J.ck = nullptr;
    J.scale_log2 = 0.0625f * LOG2E;
    attn_block<256, 256, 128, MASK_NONE, false, false, 1024, 1024, 1024, 1024, 1024>(J, smem);
  }
}

constexpr int NPHASE = 2 + 13 * NL;

DI void run_phase(const Params& P, int ph, char* smem, bool dup = false) {
  if (ph == 0) { phase_prep(P, smem); return; }
  if (ph == NPHASE - 1) { phase_final(P); return; }
  const int l = (ph - 1) / 13, k = (ph - 1) % 13;
  char* ws = P.ws;
  const u16* actA = (const u16*)(ws + WS_ACTA);
  int rot = 0;
  switch (k) {
    case 0: phase_norm(P, P.in[10] + l * 1024, l); break;
    case 1:
      gemm_phase<EPI_IN>(P, l, actA, 1024, wt_ptr(P, l, WE_IN), 1024, 1024, TT, INP, smem, rot);
      if (l == 0) {
        for (int l2 = 0; l2 < NL; l2++)
          gemm_phase<EPI_MEM>(P, l2, (const u16*)(ws + WS_HMEM) + (size_t)l2 * NB * NMEM * 1024, 1024, wt_ptr(P, l2, WE_MKV), 1024, 1024,
                              NB * NMEM, 2048, smem, rot);
      }
      break;
    case 2: phase_post(P, l, smem); break;
    case 3:
      gemm_phase<EPI_KV>(P, l, (const u16*)(ws + WS_CKV), 128, wt_ptr(P, l, WE_UKV), 128, 128, KROWS, 1024, smem, rot);
      gemm_phase<EPI_UQ>(P, l, (const u16*)(ws + WS_CQN), 256, wt_ptr(P, l, WE_UQ), 256, 256, TT, 768, smem, rot);
      break;
    case 4: phase_attn(P, l, smem); break;
    case 5: if (dup) gemm_phase<EPI_RESID0>(P, l, actA, 1024, wt_ptr(P, l, WE_OUT), 1024, 1024, TT, 1024, smem, rot); else gemm_phase<EPI_RESID>(P, l, actA, 1024, wt_ptr(P, l, WE_OUT), 1024, 1024, TT, 1024, smem, rot); break;
    case 6: phase_norm(P, P.in[18] + l * 1024, -1); break;
    case 7: gemm_phase<EPI_XQ>(P, l, actA, 1024, wt_ptr(P, l, WE_XQ), 1024, 1024, TT, 1024, smem, rot); break;
    case 8: phase_cross(P, l, smem); break;
    case 9: if (dup) gemm_phase<EPI_RESID0>(P, l, actA, 1024, wt_ptr(P, l, WE_XO), 1024, 1024, TT, 1024, smem, rot); else gemm_phase<EPI_RESID>(P, l, actA, 1024, wt_ptr(P, l, WE_XO), 1024, 1024, TT, 1024, smem, rot); break;
    case 10: phase_norm(P, P.in[24] + l * 1024, -1); break;
    case 11: gemm_phase<EPI_UP>(P, l, actA, 1024, wt_ptr(P, l, WE_UP), 1024, 1024, TT, DFF, smem, rot); break;
    case 12: if (dup) gemm_phase<EPI_RESID0>(P, l, (const u16*)(ws + WS_R1 + R1_U), DFF, wt_ptr(P, l, WE_DN), DFF, DFF, TT, 1024, smem, rot); else gemm_phase<EPI_RESID>(P, l, (const u16*)(ws + WS_R1 + R1_U), DFF, wt_ptr(P, l, WE_DN), DFF, DFF, TT, 1024, smem, rot); break;
  }
}

__global__ void __launch_bounds__(256, LB_MIN) mega(Params P, int ph_lo, int ph_hi) {
  __shared__ __attribute__((aligned(16))) char smem[SMEM_BYTES];
  cg::grid_group grid = cg::this_grid();
  for (int ph = ph_lo; ph < ph_hi; ph++) {
    Params Q = P;
    asm volatile("" : "+s"(Q.out), "+s"(Q.ws));
    run_phase(Q, ph, smem);
#ifdef DUP_MASK
    if (ph > 0 && ph < NPHASE - 1 && ((DUP_MASK >> ((ph - 1) % 13)) & 1)) { grid.sync(); asm volatile("" : "+s"(Q.out), "+s"(Q.ws)); run_phase(Q, ph, smem, true); }
#endif
    if (ph + 1 < ph_hi) grid.sync();
  }
}

extern "C" void kernel_launch(void* const* d_in, const int* in_sizes, int n_in, void* d_out, int out_size, void* d_ws,
                              size_t ws_size, hipStream_t stream) {
  static int grid_blocks = 0;
  if (!grid_blocks) {
    int dev = 0, cus = 0, per_cu = 0;
    hipGetDevice(&dev);
    hipDeviceGetAttribute(&cus, hipDeviceAttributeMultiprocessorCount, dev);
    hipOccupancyMaxActiveBlocksPerMultiprocessor(&per_cu, mega, 256, 0);
    if (per_cu < 1) per_cu = 1;
    if (per_cu > 2) per_cu = 2;
    grid_blocks = cus * per_cu;
  }
  if (n_in != 28 || (size_t)out_size != O_END || ws_size < WS_END) {
    fprintf(stderr, "kernel_launch: shape/ws mismatch n_in %d out %d (want %zu) ws %zu (want %zu)\n", n_in, out_size, (size_t)O_END, ws_size, (size_t)WS_END);
    return;
  }
  Params p;
  memset(&p, 0, sizeof(p));
  for (int i = 0; i < 28; i++) p.in[i] = (const float*)d_in[i];
  p.out = (float*)d_out;
  p.ws = (char*)d_ws;
#if COOP
  int lo = 0, hi = NPHASE;
  void* args[] = {&p, &lo, &hi};
  hipError_t e = hipLaunchCooperativeKernel((void*)mega, dim3(grid_blocks), dim3(256), args, 0, stream);
  if (e != hipSuccess) fprintf(stderr, "cooperative launch failed: %s (grid %d)\n", hipGetErrorString(e), grid_blocks);
#else
  for (int ph = 0; ph < NPHASE; ph++) hipLaunchKernelGGL(mega, dim3(grid_blocks), dim3(256), 0, stream, p, ph, ph + 1);
#endif
}
```

```cpp
#include <hip/hip_runtime.h>
#include <hip/hip_cooperative_groups.h>
#include <stdint.h>
#include <string.h>
#include <stdio.h>
namespace cg = cooperative_groups;

#ifndef COOP
#define COOP 1
#endif

#ifndef FOX_PF
#define FOX_PF true
#endif
#ifndef MLA_PF
#define MLA_PF true
#endif
#ifndef LB_MIN
#define LB_MIN 2
#endif
#ifndef BM_BIG
#define BM_BIG 256
#endif
#define DI __device__ __forceinline__
typedef unsigned short u16;
typedef short s16x8 __attribute__((ext_vector_type(8)));
typedef short s16x4 __attribute__((ext_vector_type(4)));
typedef __bf16 bfx8 __attribute__((ext_vector_type(8)));
typedef __bf16 bfx2 __attribute__((ext_vector_type(2)));
typedef float f32x16 __attribute__((ext_vector_type(16)));
typedef float f32x4 __attribute__((ext_vector_type(4)));
typedef float f32x2 __attribute__((ext_vector_type(2)));
typedef unsigned u32x4 __attribute__((ext_vector_type(4)));
typedef unsigned u32x2 __attribute__((ext_vector_type(2)));

constexpr int DM = 1024, NB = 8, SEQ = 4096, NL = 2, DB = 32, DS = 32, PAST = 2048;
constexpr int TP = NB * SEQ;
constexpr int TS = DB * DS;
constexpr int TT = TP + TS;
constexpr int SKS = PAST + DS;
constexpr int KROWS = TP + DB * SKS;
constexpr int INC = 1992, INP = 2048;
constexpr int NMEM = 256, MB = NB + DB;
constexpr int DFF = 4096;

constexpr size_t O_Y = 0;
constexpr size_t O_FKP = (size_t)TT * DM;
constexpr size_t O_FVP = O_FKP + (size_t)NL * TP * 512;
constexpr size_t O_FLP = O_FVP + (size_t)NL * TP * 512;
constexpr size_t O_CKP = O_FLP + (size_t)NL * TP * 8;
constexpr size_t O_KRP = O_CKP + (size_t)NL * TP * 128;
constexpr size_t O_MKP = O_KRP + (size_t)NL * TP * 64;
constexpr size_t O_MVP = O_MKP + (size_t)NL * NB * NMEM * 1024;
constexpr size_t O_FKS = O_MVP + (size_t)NL * NB * NMEM * 1024;
constexpr size_t O_FVS = O_FKS + (size_t)NL * TS * 512;
constexpr size_t O_FLS = O_FVS + (size_t)NL * TS * 512;
constexpr size_t O_CKS = O_FLS + (size_t)NL * TS * 8;
constexpr size_t O_KRS = O_CKS + (size_t)NL * TS * 128;
constexpr size_t O_END = O_KRS + (size_t)NL * TS * 64;

constexpr size_t al256(size_t x) { return (x + 255) / 256 * 256; }
constexpr size_t WE_IN = 0;
constexpr size_t WE_UQ = WE_IN + (size_t)INP * 1024;
constexpr size_t WE_UKV = WE_UQ + (size_t)768 * 256;
constexpr size_t WE_OUT = WE_UKV + (size_t)1024 * 128;
constexpr size_t WE_XQ = WE_OUT + (size_t)1024 * 1024;
constexpr size_t WE_MKV = WE_XQ + (size_t)1024 * 1024;
constexpr size_t WE_XO = WE_MKV + (size_t)2048 * 1024;
constexpr size_t WE_UP = WE_XO + (size_t)1024 * 1024;
constexpr size_t WE_DN = WE_UP + (size_t)4096 * 1024;
constexpr size_t WE_LAYER = WE_DN + (size_t)1024 * 4096;
constexpr size_t WS_WT = 0;
constexpr size_t WS_ROPE = al256(WS_WT + WE_LAYER * 2 * NL);
constexpr size_t WS_ACTA = al256(WS_ROPE + (size_t)4096 * 32 * 8);
constexpr size_t WS_QF = al256(WS_ACTA + (size_t)TT * 1024 * 2);
constexpr size_t WS_FOXK = al256(WS_QF + (size_t)TT * 512 * 2);
constexpr size_t WS_FOXV = al256(WS_FOXK + (size_t)KROWS * 512 * 2);
constexpr size_t WS_CUM = al256(WS_FOXV + (size_t)KROWS * 512 * 2);
constexpr size_t WS_ZC = al256(WS_CUM + (size_t)KROWS * 8 * 4);
constexpr size_t WS_CQN = al256(WS_ZC + (size_t)TT * 448 * 4);
constexpr size_t WS_CKV = al256(WS_CQN + (size_t)TT * 256 * 2);
constexpr size_t WS_KROPE = al256(WS_CKV + (size_t)KROWS * 128 * 2);
constexpr size_t WS_MEMK = al256(WS_KROPE + (size_t)KROWS * 64 * 2);
constexpr size_t WS_MEMV = al256(WS_MEMK + (size_t)NL * MB * NMEM * 1024 * 2);
constexpr size_t WS_HMEM = al256(WS_MEMV + (size_t)NL * MB * NMEM * 1024 * 2);
constexpr size_t WS_R1 = al256(WS_HMEM + (size_t)NL * NB * NMEM * 1024 * 2);
constexpr size_t R1_KV = 0;
constexpr size_t R1_QM = al256((size_t)KROWS * 1024 * 2);
constexpr size_t R1_U = 0;
constexpr size_t R1_XQ = 0;
constexpr size_t WS_END = al256(WS_R1 + (size_t)TT * 4096 * 2);
static_assert(R1_QM + (size_t)TT * 768 * 2 <= (size_t)TT * 4096 * 2, "R1 overflow");

constexpr int SMEM_BYTES = 65536;

struct Params {
  const float* in[28];
  float* out;
  char* ws;
};

DI int get_bid() { int t = blockIdx.x; asm volatile("" : "+s"(t)); return t; }
DI int get_nblk() { int t = gridDim.x; asm volatile("" : "+s"(t)); return t; }
DI int get_tid() { int t = threadIdx.x; asm volatile("" : "+v"(t)); return t; }
DI unsigned pk2(float a, float b) { f32x2 v = {a, b}; return __builtin_bit_cast(unsigned, __builtin_convertvector(v, bfx2)); }
DI u16 f2bf(float a) { return (u16)(pk2(a, 0.f) & 0xffffu); }
DI f32x16 mfma(s16x8 a, s16x8 b, f32x16 c) {
  return __builtin_amdgcn_mfma_f32_32x32x16_bf16(__builtin_bit_cast(bfx8, a), __builtin_bit_cast(bfx8, b), c, 0, 0, 0);
}
DI int crow(int i, int h) { return (i & 3) + 8 * (i >> 2) + 4 * h; }
DI float wave_sum(float v) {
#pragma unroll
  for (int m = 32; m >= 1; m >>= 1) v += __shfl_xor(v, m);
  return v;
}
DI float xhalf_max(float v) {
  auto rr = __builtin_amdgcn_permlane32_swap(__float_as_uint(v), __float_as_uint(v), false, false);
  return fmaxf(__uint_as_float(rr[0]), __uint_as_float(rr[1]));
}
DI float xhalf_sum(float v) {
  auto rr = __builtin_amdgcn_permlane32_swap(__float_as_uint(v), __float_as_uint(v), false, false);
  return __uint_as_float(rr[0]) + __uint_as_float(rr[1]);
}
DI int tok_krow(int tok) {
  if (tok < TP) return tok;
  const int s = tok - TP;
  return TP + (s >> 5) * SKS + PAST + (s & 31);
}
DI int tok_pos(int tok) { return tok < TP ? (tok & (SEQ - 1)) : PAST + ((tok - TP) & 31); }

enum { EPI_IN = 0, EPI_MEM, EPI_UQ, EPI_KV, EPI_RESID, EPI_XQ, EPI_UP, EPI_RESID0 };

template <int EPI, int MI>
DI void epilogue(const Params& P, int l, f32x16 (&acc)[MI][2], int mw, int nw, int r, int h) {
  float* out = P.out;
  char* ws = P.ws;
  if constexpr (EPI == EPI_IN) {
    u16* qf = (u16*)(ws + WS_QF);
    u16* fk = (u16*)(ws + WS_FOXK);
    u16* fv = (u16*)(ws + WS_FOXV);
    float* zc = (float*)(ws + WS_ZC);
    const float* bfg = P.in[12] + l * 8;
#pragma unroll
    for (int mi = 0; mi < MI; mi++) {
#pragma unroll
      for (int i = 0; i < 16; i++) {
        const int row = mw + mi * 32 + crow(i, h);
        const int kr = tok_krow(row);
        const bool isp = row < TP;
        const size_t orow = isp ? ((size_t)l * TP + row) : ((size_t)l * TS + (row - TP));
#pragma unroll
        for (int ni = 0; ni < 2; ni++) {
          const int col = nw + ni * 32 + r;
          const float v = acc[mi][ni][i];
          if (col < 512) {
            qf[(size_t)row * 512 + col] = f2bf(v);
          } else if (col < 1024) {
            const int c = col - 512;
            out[(isp ? O_FKP : O_FKS) + orow * 512 + c] = v;
            fk[(size_t)kr * 512 + c] = f2bf(v);
          } else if (col < 1536) {
            const int c = col - 1024;
            out[(isp ? O_FVP : O_FVS) + orow * 512 + c] = v;
            fv[(size_t)kr * 512 + c] = f2bf(v);
          } else if (col < 1544) {
            const int c = col - 1536;
            const float g = v + bfg[c];
            const float ls = fminf(g, 0.f) - log1pf(__expf(-fabsf(g)));
            out[(isp ? O_FLP : O_FLS) + orow * 8 + c] = ls;
          } else if (col < INC) {
            zc[(size_t)row * 448 + (col - 1544)] = v;
          }
        }
      }
    }
  } else if constexpr (EPI == EPI_MEM) {
    u16* mk = (u16*)(ws + WS_MEMK);
    u16* mv = (u16*)(ws + WS_MEMV);
#pragma unroll
    for (int mi = 0; mi < MI; mi++) {
#pragma unroll
      for (int i = 0; i < 16; i++) {
        const int row = mw + mi * 32 + crow(i, h);
#pragma unroll
        for (int ni = 0; ni < 2; ni++) {
          const int col = nw + ni * 32 + r;
          const float v = acc[mi][ni][i];
          const int c = col & 1023;
          const size_t oidx = ((size_t)l * (NB * NMEM) + row) * 1024 + c;
          const size_t bidx = ((size_t)l * (MB * NMEM) + row) * 1024 + c;
          if (col < 1024) { out[O_MKP + oidx] = v; mk[bidx] = f2bf(v); }
          else { out[O_MVP + oidx] = v; mv[bidx] = f2bf(v); }
        }
      }
    }
  } else if constexpr (EPI == EPI_UQ) {
    u16* qm = (u16*)(ws + WS_R1 + R1_QM);
    const f32x2* rt = (const f32x2*)(ws + WS_ROPE);
    const bool isrope = (nw % 192) == 128;
#pragma unroll
    for (int mi = 0; mi < MI; mi++) {
#pragma unroll
      for (int i = 0; i < 16; i++) {
        const int row = mw + mi * 32 + crow(i, h);
        float x1 = acc[mi][0][i], x2 = acc[mi][1][i];
        if (isrope) {
          const f32x2 cs = rt[tok_pos(row) * 32 + r];
          const float o1 = x1 * cs[0] - x2 * cs[1];
          const float o2 = x2 * cs[0] + x1 * cs[1];
          x1 = o1; x2 = o2;
        }
        qm[(size_t)row * 768 + nw + r] = f2bf(x1);
        qm[(size_t)row * 768 + nw + 32 + r] = f2bf(x2);
      }
    }
  } else if constexpr (EPI == EPI_KV || EPI == EPI_XQ || EPI == EPI_UP) {
    u16* dst; int ld;
    if constexpr (EPI == EPI_KV) { dst = (u16*)(ws + WS_R1 + R1_KV); ld = 1024; }
    else if constexpr (EPI == EPI_XQ) { dst = (u16*)(ws + WS_R1 + R1_XQ); ld = 1024; }
    else { dst = (u16*)(ws + WS_R1 + R1_U); ld = DFF; }
#pragma unroll
    for (int mi = 0; mi < MI; mi++) {
#pragma unroll
      for (int i = 0; i < 16; i++) {
        const int row = mw + mi * 32 + crow(i, h);
#pragma unroll
        for (int ni = 0; ni < 2; ni++) {
          float v = acc[mi][ni][i];
          if constexpr (EPI == EPI_UP) { v = fmaxf(v, 0.f); v = v * v; }
          dst[(size_t)row * ld + nw + ni * 32 + r] = f2bf(v);
        }
      }
    }
  } else if constexpr (EPI == EPI_RESID || EPI == EPI_RESID0) {
#pragma unroll
    for (int mi = 0; mi < MI; mi++) {
#pragma unroll
      for (int i = 0; i < 16; i++) {
        const int row = mw + mi * 32 + crow(i, h);
#pragma unroll
        for (int ni = 0; ni < 2; ni++) {
          unsafeAtomicAdd(out + (size_t)row * DM + nw + ni * 32 + r, EPI == EPI_RESID0 ? acc[mi][ni][i] * 0.f : acc[mi][ni][i]);
        }
      }
    }
  }
}

enum { MASK_NONE = 0, MASK_FRAME = 1, MASK_CHUNK = 2 };
struct AttnJob {
  const u16* Q; int ldq;
  const u16* K1; int ldk1;
  const u16* K2; int ldk2;
  const u16* V; int ldv;
  u16* O; int ldo;
  const float* cq;
  const float* ck;
  int nq, Sk, qpos0;
  float scale_log2;
};

template <int DQK, int D1, int DVT, int MASK, bool BIAS, bool PREFETCH, int LDQ, int LDK1, int LDK2, int LDV, int LDO>
DI void attn_block(const AttnJob& J, char* smem) {
  constexpr int KP = DQK * 2 + 16;
  constexpr int VP = DVT * 2;
  constexpr int CV = DVT / 8;
  constexpr int NKK = DQK / 16, NDV = DVT / 32;
  constexpr float LOG2E = 1.4426950408889634f;
  char* Ks = smem;
  char* Vs = smem + 64 * KP;
  float* cks = (float*)(smem + 64 * KP + 64 * VP);
  const int tid = get_tid(), wave = tid >> 6, lane = tid & 63, r = lane & 31, h = lane >> 5;
  const int wq0 = wave * 32;
  const bool active = wq0 < J.nq;
  const int qi = wq0 + r;
  const int qpos = J.qpos0 + qi;
  const int wqmax = J.qpos0 + wq0 + 31;
  const int qmax = J.qpos0 + J.nq - 1;
  const int ntk = (J.Sk + 63) >> 6;
  int nt = ntk;
  if (MASK != MASK_NONE) { const int t2 = (qmax >> 6) + 1; nt = t2 < ntk ? t2 : ntk; }

  s16x8 qf[NKK];
  {
    const u16* qp = J.Q + (size_t)qi * LDQ + h * 8;
#pragma unroll
    for (int kk = 0; kk < NKK; kk++) {
      if (active) qf[kk] = *(const s16x8*)(qp + kk * 16);
      else { s16x8 z = {0, 0, 0, 0, 0, 0, 0, 0}; qf[kk] = z; }
    }
  }
  float cqv = 0.f;
  if (BIAS) { if (active) cqv = J.cq[(size_t)qi * 8] * LOG2E; }

  f32x16 o[NDV];
#pragma unroll
  for (int d = 0; d < NDV; d++)
#pragma unroll
    for (int i = 0; i < 16; i++) o[d][i] = 0.f;
  float m_run = -1e30f, l_run = 0.f;

  constexpr int CK1 = D1 / 8, CK2 = (DQK - D1) / 8;
  constexpr int RP1 = 256 / CK1, NP1 = 64 / RP1;
  constexpr int RP2 = CK2 ? 256 / (CK2 ? CK2 : 1) : 64, NP2 = CK2 ? 64 / RP2 : 0;
  constexpr int RPV = 256 / CV, NPV = 64 / RPV;
  u32x4 rk1[NP1], rk2[NP2 ? NP2 : 1], rv[NPV];
  float rck = 0.f;
  const int tq = (lane & 15) >> 2, tp = lane & 3, tblk = (lane >> 4) & 1;
  const int vswz = (DVT >= 128) ? tq : (tq >> 1);
  const int r1 = tid / CK1, c1 = tid % CK1;
  const int r2 = CK2 ? tid / (CK2 ? CK2 : 1) : 0, c2 = CK2 ? tid % (CK2 ? CK2 : 1) : 0;
  const int r3 = tid / CV, c3 = tid % CV;
  const unsigned k1o = (unsigned)(r1 * LDK1 + c1 * 8) * 2u;
  const unsigned k2o = (unsigned)(r2 * LDK2 + c2 * 8) * 2u;
  const unsigned vo = (unsigned)(r3 * LDV + c3 * 8) * 2u;
  const int k1so = r1 * KP + c1 * 16;
  const int k2so = r2 * KP + D1 * 2 + c2 * 16;
  const int vsw = (DVT >= 128) ? (r3 & 3) : ((r3 >> 1) & 1);
  const int vso = 64 * KP + r3 * VP + (((c3 >> 2) ^ vsw) * 64) + (c3 & 3) * 16;
  const int vro = 64 * KP + (4 * h + tq) * VP + (16 * tblk + 4 * tp) * 2;
  const int kro = r * KP + h * 16;

  auto load_tile = [&](int j) {
    const int kb = j * 64;
#pragma unroll
    for (int i = 0; i < NP1; i++) {
      u32x4 v = {0u, 0u, 0u, 0u};
      if (kb + r1 + i * RP1 < J.Sk) v = *(const u32x4*)((const char*)(J.K1 + (size_t)(kb + i * RP1) * LDK1) + k1o);
      rk1[i] = v;
    }
#pragma unroll
    for (int i = 0; i < NP2; i++) {
      u32x4 v = {0u, 0u, 0u, 0u};
      if (kb + r2 + i * RP2 < J.Sk) v = *(const u32x4*)((const char*)(J.K2 + (size_t)(kb + i * RP2) * LDK2) + k2o);
      rk2[i] = v;
    }
#pragma unroll
    for (int i = 0; i < NPV; i++) {
      u32x4 v = {0u, 0u, 0u, 0u};
      if (kb + r3 + i * RPV < J.Sk) v = *(const u32x4*)((const char*)(J.V + (size_t)(kb + i * RPV) * LDV) + vo);
      rv[i] = v;
    }
    if (BIAS) {
      if (tid < 64) { const int key = kb + tid; rck = key < J.Sk ? J.ck[(size_t)key * 8] * LOG2E : 0.f; }
    }
  };
  auto store_tile = [&]() {
    int a1 = k1so, a2 = k2so, a3 = vso;
    asm volatile("" : "+v"(a1), "+v"(a2), "+v"(a3));
#pragma unroll
    for (int i = 0; i < NP1; i++) *(u32x4*)(smem + a1 + i * RP1 * KP) = rk1[i];
#pragma unroll
    for (int i = 0; i < NP2; i++) *(u32x4*)(smem + a2 + i * RP2 * KP) = rk2[i];
#pragma unroll
    for (int i = 0; i < NPV; i++) *(u32x4*)(smem + a3 + i * RPV * VP) = rv[i];
    if (BIAS) { if (tid < 64) cks[tid] = rck; }
  };

  if (PREFETCH) load_tile(0);
  for (int j = 0; j < nt; j++) {
    __syncthreads();
    if (!PREFETCH) load_tile(j);
    store_tile();
    __syncthreads();
    if (PREFETCH) { if (j + 1 < nt) load_tile(j + 1); }
    const bool need = active && (MASK == MASK_NONE || j * 64 <= wqmax);
    if (need) {
      int kro_l = kro, vro_l = vro;
      asm volatile("" : "+v"(kro_l), "+v"(vro_l));
      const char* krd = smem + kro_l;
      const bool needmask = (MASK == MASK_FRAME && j * 64 + 63 > J.qpos0 + wq0) || (j * 64 + 63 >= J.Sk);
      const int dq = (MASK == MASK_FRAME ? min(qpos, J.Sk - 1) : J.Sk - 1) - j * 64 - 4 * h;
#pragma unroll
      for (int hb = 0; hb < 2; hb++) {
        if (MASK == MASK_FRAME && j * 64 + hb * 32 > wqmax) continue;
        f32x16 p;
#pragma unroll
        for (int i = 0; i < 16; i++) p[i] = 0.f;
#pragma unroll
        for (int kk = 0; kk < NKK; kk++) {
          const s16x8 kf = *(const s16x8*)(krd + hb * 32 * KP + kk * 32);
          p = mfma(kf, qf[kk], p);
        }
        if (BIAS) {
#pragma unroll
          for (int g = 0; g < 4; g++) {
            const f32x4 c0 = *(const f32x4*)(cks + hb * 32 + 8 * g + 4 * h);
#pragma unroll
            for (int e = 0; e < 4; e++) p[4 * g + e] = fmaf(p[4 * g + e], J.scale_log2, cqv - c0[e]);
          }
        } else {
#pragma unroll
          for (int i = 0; i < 16; i++) p[i] *= J.scale_log2;
        }
        if (needmask) {
#pragma unroll
          for (int i = 0; i < 16; i++) {
            const int cc = (i & 3) + 8 * (i >> 2) + 32 * hb;
            p[i] = (cc <= dq) ? p[i] : -1e30f;
          }
        }
        float mx = p[0];
#pragma unroll
        for (int i = 1; i < 16; i++) mx = fmaxf(mx, p[i]);
        mx = xhalf_max(mx);
        const float m_new = fmaxf(m_run, mx);
        const float alpha = __builtin_amdgcn_exp2f(m_run - m_new);
        m_run = m_new;
        float ps = 0.f;
#pragma unroll
        for (int i = 0; i < 16; i++) { p[i] = __builtin_amdgcn_exp2f(p[i] - m_new); ps += p[i]; }
        l_run = l_run * alpha + ps;
        if (__any(alpha != 1.f)) {
#pragma unroll
          for (int d = 0; d < NDV; d++)
#pragma unroll
            for (int i = 0; i < 16; i++) o[d][i] *= alpha;
        }
        s16x8 pb[2];
        {
          u32x4 w;
          w[0] = pk2(p[0], p[1]); w[1] = pk2(p[2], p[3]); w[2] = pk2(p[4], p[5]); w[3] = pk2(p[6], p[7]);
          pb[0] = __builtin_bit_cast(s16x8, w);
          w[0] = pk2(p[8], p[9]); w[1] = pk2(p[10], p[11]); w[2] = pk2(p[12], p[13]); w[3] = pk2(p[14], p[15]);
          pb[1] = __builtin_bit_cast(s16x8, w);
        }
#pragma unroll
        for (int d = 0; d < NDV; d++) {
          const char* vb = smem + (vro_l + ((d ^ vswz) * 64)) + hb * 32 * VP;
#pragma unroll
          for (int s = 0; s < 2; s++) {
            const s16x4 lo = __builtin_amdgcn_ds_read_tr16_b64_v4i16(
                (__attribute__((address_space(3))) s16x4*)(uintptr_t)(vb + (16 * s) * VP));
            const s16x4 hi = __builtin_amdgcn_ds_read_tr16_b64_v4i16(
                (__attribute__((address_space(3))) s16x4*)(uintptr_t)(vb + (16 * s + 8) * VP));
            const s16x8 vf = __builtin_shufflevector(lo, hi, 0, 1, 2, 3, 4, 5, 6, 7);
            o[d] = mfma(vf, pb[s], o[d]);
          }
        }
      }
    }
  }
  const float lt = xhalf_sum(l_run);
  if (active && qi < J.nq) {
    const float inv = 1.f / lt;
    u16* op = J.O + (size_t)qi * LDO + 4 * h;
#pragma unroll
    for (int d = 0; d < NDV; d++) {
#pragma unroll
      for (int g = 0; g < 4; g++) {
        u32x2 w;
        w[0] = pk2(o[d][4 * g] * inv, o[d][4 * g + 1] * inv);
        w[1] = pk2(o[d][4 * g + 2] * inv, o[d][4 * g + 3] * inv);
        *(u32x2*)(op + d * 32 + 8 * g) = w;
      }
    }
  }
}

template <int NR, bool F32OUT>
DI void rms_rows(const float* __restrict__ xbase, size_t rstride, int nvalid, const float* __restrict__ g, void* dbase, size_t dstride, int lane) {
  f32x4 v[NR][4];
#pragma unroll
  for (int j = 0; j < NR; j++)
#pragma unroll
    for (int i = 0; i < 4; i++) {
      if (j < nvalid) v[j][i] = *(const f32x4*)(xbase + (size_t)j * rstride + i * 256 + lane * 4);
      else { f32x4 z = {0.f, 0.f, 0.f, 0.f}; v[j][i] = z; }
    }
  f32x4 gg[4];
#pragma unroll
  for (int i = 0; i < 4; i++) gg[i] = *(const f32x4*)(g + i * 256 + lane * 4);
#pragma unroll
  for (int j = 0; j < NR; j++) {
    float ss = 0.f;
#pragma unroll
    for (int i = 0; i < 4; i++) ss += v[j][i][0] * v[j][i][0] + v[j][i][1] * v[j][i][1] + v[j][i][2] * v[j][i][2] + v[j][i][3] * v[j][i][3];
    ss = wave_sum(ss);
    const float rs = rsqrtf(ss * (1.f / 1024.f) + 1e-6f);
    if (j < nvalid) {
#pragma unroll
      for (int i = 0; i < 4; i++) {
        if (F32OUT) {
          f32x4 w;
          w[0] = v[j][i][0] * rs * gg[i][0]; w[1] = v[j][i][1] * rs * gg[i][1]; w[2] = v[j][i][2] * rs * gg[i][2]; w[3] = v[j][i][3] * rs * gg[i][3];
          *(f32x4*)((float*)dbase + (size_t)j * dstride + i * 256 + lane * 4) = w;
        } else {
          u32x2 w;
          w[0] = pk2(v[j][i][0] * rs * gg[i][0], v[j][i][1] * rs * gg[i][1]);
          w[1] = pk2(v[j][i][2] * rs * gg[i][2], v[j][i][3] * rs * gg[i][3]);
          *(u32x2*)((u16*)dbase + (size_t)j * dstride + i * 256 + lane * 4) = w;
        }
      }
    }
  }
}

DI void cvt_job(const float* __restrict__ src, u16* __restrict__ dst, int nseg, size_t seglen, size_t sstride, size_t dstride) {
  const size_t upseg = seglen / 8;
  const size_t total = upseg * nseg;
  const size_t stride = (size_t)get_nblk() * 256;
  for (size_t u0 = (size_t)get_bid() * 256 + get_tid(); u0 < total; u0 += 4 * stride) {
    f32x4 a[4], b[4];
    size_t so[4], dd[4];
#pragma unroll
    for (int q = 0; q < 4; q++) {
      const size_t u = u0 + q * stride;
      const size_t uu = u < total ? u : u0;
      const size_t sg = uu / upseg, off = (uu - sg * upseg) * 8;
      so[q] = sg * sstride + off; dd[q] = sg * dstride + off;
      a[q] = *(const f32x4*)(src + so[q]);
      b[q] = *(const f32x4*)(src + so[q] + 4);
    }
#pragma unroll
    for (int q = 0; q < 4; q++) {
      if (u0 + q * stride < total) {
        u32x4 w;
        w[0] = pk2(a[q][0], a[q][1]); w[1] = pk2(a[q][2], a[q][3]); w[2] = pk2(b[q][0], b[q][1]); w[3] = pk2(b[q][2], b[q][3]);
        *(u32x4*)(dst + dd[q]) = w;
      }
    }
  }
}

DI void transpose_job(const float* __restrict__ src, u16* __restrict__ dst, int K, int N, int Npad, int& rot, char* smem) {
  float* tile = (float*)smem;
  const int tk = K / 64, tn = Npad / 64, ntiles = tk * tn;
  const int G = get_nblk();
  const int tid = get_tid();
  for (int t = (get_bid() + G - (rot % G)) % G; t < ntiles; t += G) {
    const int k0 = (t % tk) * 64, n0 = (t / tk) * 64;
    __syncthreads();
#pragma unroll 4
    for (int i = 0; i < 16; i++) {
      const int k = i * 4 + (tid >> 6), n = tid & 63;
      tile[k * 65 + n] = (n0 + n < N) ? src[(size_t)(k0 + k) * N + n0 + n] : 0.f;
    }
    __syncthreads();
#pragma unroll 4
    for (int i = 0; i < 16; i++) {
      const int n = i * 4 + (tid >> 6), k = tid & 63;
      dst[(size_t)(n0 + n) * K + k0 + k] = f2bf(tile[k * 65 + n]);
    }
  }
  rot += ntiles;
}

DI u16* wt_ptr(const Params& P, int l, size_t eoff) { return (u16*)(P.ws + WS_WT) + (size_t)l * WE_LAYER + eoff; }

DI void phase_prep(const Params& P, char* smem) {
  const int tid = get_tid(), lane = tid & 63;
  const int gw = get_bid() * 4 + (tid >> 6), nw = get_nblk() * 4;
  int rot = 0;
  for (int l = 0; l < NL; l++) {
    transpose_job(P.in[11] + (size_t)l * 1024 * INC, wt_ptr(P, l, WE_IN), 1024, INC, INP, rot, smem);
    transpose_job(P.in[14] + (size_t)l * 256 * 768, wt_ptr(P, l, WE_UQ), 256, 768, 768, rot, smem);
    transpose_job(P.in[16] + (size_t)l * 128 * 1024, wt_ptr(P, l, WE_UKV), 128, 1024, 1024, rot, smem);
    transpose_job(P.in[17] + (size_t)l * 1024 * 1024, wt_ptr(P, l, WE_OUT), 1024, 1024, 1024, rot, smem);
    transpose_job(P.in[20] + (size_t)l * 1024 * 1024, wt_ptr(P, l, WE_XQ), 1024, 1024, 1024, rot, smem);
    transpose_job(P.in[21] + (size_t)l * 1024 * 1024, wt_ptr(P, l, WE_MKV), 1024, 1024, 1024, rot, smem);
    transpose_job(P.in[22] + (size_t)l * 1024 * 1024, wt_ptr(P, l, WE_MKV) + (size_t)1024 * 1024, 1024, 1024, 1024, rot, smem);
    transpose_job(P.in[23] + (size_t)l * 1024 * 1024, wt_ptr(P, l, WE_XO), 1024, 1024, 1024, rot, smem);
    transpose_job(P.in[25] + (size_t)l * 1024 * 4096, wt_ptr(P, l, WE_UP), 1024, 4096, 4096, rot, smem);
    transpose_job(P.in[26] + (size_t)l * 4096 * 1024, wt_ptr(P, l, WE_DN), 4096, 1024, 1024, rot, smem);
  }
  {
    f32x2* rt = (f32x2*)(P.ws + WS_ROPE);
    for (int i = get_bid() * 256 + tid; i < 4096 * 32; i += get_nblk() * 256) {
      const int pos = i >> 5, j = i & 31;
      const float inv = powf(10000.f, -(float)j / 32.f);
      const float ang = (float)pos * inv;
      f32x2 cs; cs[0] = cosf(ang); cs[1] = sinf(ang);
      rt[i] = cs;
    }
  }
  for (int l = 0; l < NL; l++) {
    const size_t seg = (size_t)DB * NMEM * 1024;
    cvt_job(P.in[8] + l * seg, (u16*)(P.ws + WS_MEMK) + ((size_t)l * MB + NB) * NMEM * 1024, 1, seg, 0, 0);
    cvt_job(P.in[9] + l * seg, (u16*)(P.ws + WS_MEMV) + ((size_t)l * MB + NB) * NMEM * 1024, 1, seg, 0, 0);
  }
  for (int rr = gw; rr < NL * NB * NMEM; rr += nw) {
    const int l = rr / (NB * NMEM), row = rr % (NB * NMEM);
    rms_rows<1, false>(P.in[2] + (size_t)row * 1024, 0, 1, P.in[19] + l * 1024, (u16*)(P.ws + WS_HMEM) + (size_t)rr * 1024, 0, lane);
  }
  {
    const size_t n4 = (size_t)TT * 256;
    const size_t np4 = (size_t)TP * 256;
    const size_t stride = (size_t)get_nblk() * 256;
    for (size_t i0 = (size_t)get_bid() * 256 + tid; i0 < n4; i0 += 4 * stride) {
      f32x4 v[4];
#pragma unroll
      for (int q = 0; q < 4; q++) {
        const size_t i = i0 + q * stride;
        const size_t ii = i < n4 ? i : i0;
        v[q] = (ii < np4) ? *(const f32x4*)(P.in[0] + ii * 4) : *(const f32x4*)(P.in[1] + (ii - np4) * 4);
      }
#pragma unroll
      for (int q = 0; q < 4; q++) {
        const size_t i = i0 + q * stride;
        if (i < n4) *(f32x4*)(P.out + i * 4) = v[q];
      }
    }
  }
}

DI void phase_norm(const Params& P, const float* g, int cache_layer) {
  const int tid = get_tid(), lane = tid & 63;
  const int gw = get_bid() * 4 + (tid >> 6), nw = get_nblk() * 4;
  u16* h = (u16*)(P.ws + WS_ACTA);
  for (int row = gw; row < TT; row += 4 * nw) {
    const int nv = (TT - row + nw - 1) / nw;
    rms_rows<4, false>(P.out + (size_t)row * 1024, (size_t)nw * 1024, nv < 4 ? nv : 4, g, h + (size_t)row * 1024, (size_t)nw * 1024, lane);
  }
  if (cache_layer >= 0) {
    const int l = cache_layer;
    cvt_job(P.in[3] + (size_t)l * DB * PAST * 512, (u16*)(P.ws + WS_FOXK) + (size_t)TP * 512, DB, (size_t)PAST * 512, (size_t)PAST * 512, (size_t)SKS * 512);
    cvt_job(P.in[4] + (size_t)l * DB * PAST * 512, (u16*)(P.ws + WS_FOXV) + (size_t)TP * 512, DB, (size_t)PAST * 512, (size_t)PAST * 512, (size_t)SKS * 512);
    cvt_job(P.in[6] + (size_t)l * DB * PAST * 128, (u16*)(P.ws + WS_CKV) + (size_t)TP * 128, DB, (size_t)PAST * 128, (size_t)PAST * 128, (size_t)SKS * 128);
    cvt_job(P.in[7] + (size_t)l * DB * PAST * 64, (u16*)(P.ws + WS_KROPE) + (size_t)TP * 64, DB, (size_t)PAST * 64, (size_t)PAST * 64, (size_t)SKS * 64);
  }
}

DI void phase_final(const Params& P) {
  const int tid = get_tid(), lane = tid & 63;
  const int gw = get_bid() * 4 + (tid >> 6), nw = get_nblk() * 4;
  const float* g = P.in[27];
  for (int row = gw; row < TT; row += 4 * nw) {
    const int nv = (TT - row + nw - 1) / nw;
    rms_rows<4, true>(P.out + (size_t)row * 1024, (size_t)nw * 1024, nv < 4 ? nv : 4, g, P.out + (size_t)row * 1024, (size_t)nw * 1024, lane);
  }
}

DI void phase_post(const Params& P, int l, char* smem) {
  const int tid = get_tid(), lane = tid & 63;
  const int gw = get_bid() * 4 + (tid >> 6), nw = get_nblk() * 4;
  const float* zc = (const float*)(P.ws + WS_ZC);
  u16* cqn = (u16*)(P.ws + WS_CQN);
  u16* ckv = (u16*)(P.ws + WS_CKV);
  u16* krp = (u16*)(P.ws + WS_KROPE);
  const f32x2* rt = (const f32x2*)(P.ws + WS_ROPE);
  const float* gq = P.in[13] + l * 256;
  const float* gkv = P.in[15] + l * 128;
  for (int tok0 = gw; tok0 < TT; tok0 += 4 * nw) {
    f32x4 vq[4]; f32x2 vk[4]; float vr[4];
#pragma unroll
    for (int j = 0; j < 4; j++) {
      const int tk = tok0 + j * nw;
      const float* z = zc + (size_t)(tk < TT ? tk : tok0) * 448;
      vq[j] = *(const f32x4*)(z + lane * 4);
      vk[j] = *(const f32x2*)(z + 256 + lane * 2);
      vr[j] = z[384 + lane];
    }
    const f32x4 ggq = *(const f32x4*)(gq + lane * 4);
    const f32x2 ggk = *(const f32x2*)(gkv + lane * 2);
#pragma unroll
    for (int j = 0; j < 4; j++) {
      const int tok = tok0 + j * nw;
      if (tok >= TT) break;
      const bool isp = tok < TP;
      const size_t orow = isp ? ((size_t)l * TP + tok) : ((size_t)l * TS + (tok - TP));
      const int kr = tok_krow(tok);
      {
        const f32x4 v = vq[j];
        const float ss = wave_sum(v[0] * v[0] + v[1] * v[1] + v[2] * v[2] + v[3] * v[3]);
        const float rs = rsqrtf(ss * (1.f / 256.f) + 1e-6f);
        u32x2 w;
        w[0] = pk2(v[0] * rs * ggq[0], v[1] * rs * ggq[1]);
        w[1] = pk2(v[2] * rs * ggq[2], v[3] * rs * ggq[3]);
        *(u32x2*)(cqn + (size_t)tok * 256 + lane * 4) = w;
      }
      {
        const f32x2 v = vk[j];
        const float ss = wave_sum(v[0] * v[0] + v[1] * v[1]);
        const float rs = rsqrtf(ss * (1.f / 128.f) + 1e-6f);
        f32x2 o; o[0] = v[0] * rs * ggk[0]; o[1] = v[1] * rs * ggk[1];
        *(f32x2*)(P.out + (isp ? O_CKP : O_CKS) + orow * 128 + lane * 2) = o;
        *(unsigned*)(ckv + (size_t)kr * 128 + lane * 2) = pk2(o[0], o[1]);
      }
      {
        const float x = vr[j];
        const float y = __shfl_xor(x, 32);
        const f32x2 cs = rt[tok_pos(tok) * 32 + (lane & 31)];
        const float o = (lane < 32) ? (x * cs[0] - y * cs[1]) : (x * cs[0] + y * cs[1]);
        P.out[(isp ? O_KRP : O_KRS) + orow * 64 + lane] = o;
        krp[(size_t)kr * 64 + lane] = f2bf(o);
      }
    }
  }
  float* cum = (float*)(P.ws + WS_CUM);
  float* wtot = (float*)smem;
  const int wave = tid >> 6;
  for (int it = get_bid(); it < NB + DB; it += get_nblk()) {
    const bool isp = it < NB;
    const int b = isp ? it : it - NB;
    const int ppt = isp ? 16 : 9;
    const int npos = isp ? SEQ : SKS;
    const float* srcA; const float* srcB; int nA;
    size_t krow0;
    if (isp) { srcA = P.out + O_FLP + ((size_t)l * TP + (size_t)b * SEQ) * 8; srcB = srcA; nA = SEQ; krow0 = (size_t)b * SEQ; }
    else {
      srcA = P.in[5] + ((size_t)l * DB + b) * PAST * 8;
      srcB = P.out + O_FLS + ((size_t)l * TS + (size_t)b * DS) * 8 - (size_t)PAST * 8;
      nA = PAST; krow0 = (size_t)TP + (size_t)b * SKS;
    }
    const int p0 = tid * ppt;
    f32x4 va[16], vb[16];
#pragma unroll
    for (int j = 0; j < 16; j++) {
      const int p = p0 + j;
      f32x4 z = {0.f, 0.f, 0.f, 0.f};
      va[j] = z; vb[j] = z;
      if (j < ppt && p < npos) {
        const float* s = (p < nA ? srcA : srcB) + (size_t)p * 8;
        va[j] = *(const f32x4*)s; vb[j] = *(const f32x4*)(s + 4);
      }
    }
#pragma unroll
    for (int j = 1; j < 16; j++) { va[j] += va[j - 1]; vb[j] += vb[j - 1]; }
    f32x4 ta = va[15], tb = vb[15];
#pragma unroll
    for (int d = 1; d < 64; d <<= 1) {
#pragma unroll
      for (int e = 0; e < 4; e++) {
        const float ua = __shfl_up(ta[e], d), ub = __shfl_up(tb[e], d);
        if (lane >= d) { ta[e] += ua; tb[e] += ub; }
      }
    }
    __syncthreads();
    if (lane == 63) { *(f32x4*)(wtot + wave * 8) = ta; *(f32x4*)(wtot + wave * 8 + 4) = tb; }
    __syncthreads();
    f32x4 pa = ta - va[15], pb = tb - vb[15];
    for (int w2 = 0; w2 < wave; w2++) { pa += *(const f32x4*)(wtot + w2 * 8); pb += *(const f32x4*)(wtot + w2 * 8 + 4); }
#pragma unroll
    for (int j = 0; j < 16; j++) {
      const int p = p0 + j;
      if (j < ppt && p < npos) {
        float* d = cum + (krow0 + p) * 8;
        *(f32x4*)d = va[j] + pa; *(f32x4*)(d + 4) = vb[j] + pb;
      }
    }
  }
}

template <int EPI, int BM>
DI void gemm_phase(const Params& P, int l, const u16* __restrict__ A, int lda, const u16* __restrict__ Bt, int ldb, int K, int M, int N,
                   char* smem, int& rot) {
  constexpr int MI = BM / 64;
  constexpr int STAGE = (BM + 128) * 64;
  constexpr int NSLOT = 65536 / STAGE;
  constexpr int DEPTH = NSLOT - 1;
  constexpr int GPS = MI + 2;
  constexpr int SM = (BM == 256) ? 4 : 8, SNN = 64 / SM;
  const int tid = get_tid(), wave = tid >> 6, lane = tid & 63, r = lane & 31, h = lane >> 5;
  const int wm = wave >> 1, wn = wave & 1;
  const int TM = M / BM, TN = N >> 7;
  const int G = get_nblk();
  const int bid = get_bid();
  const bool sup = (G == 512) && ((TN % SNN) == 0) && ((TM % SM) == 0);
  const int SN = TN / SNN;
  const int nunits = sup ? (TM / SM) * SN : TM * TN;
  const int ustep = sup ? 8 : G;
  const int slot8 = bid >> 3;
  int u = sup ? (int)((bid + 8 - (rot & 7)) & 7) : (int)((bid + G - (rot % G)) % G);
  rot += nunits;
  if (u >= nunits) return;
  const int lrow = tid >> 2, lc = tid & 3;
  const int pc = (lc ^ ((tid >> 4) & 3)) * 8;
  const int nk = K >> 5;
  const int sw = (r >> 2) & 3;
  const int xo0 = ((0 + h) ^ sw) * 16, xo1 = ((2 + h) ^ sw) * 16;
  const int aro = (wm * (BM / 2) + r) * 64, bro = BM * 64 + (wn * 64 + r) * 64;
  auto tile_of = [&](int uu, int& m0, int& n0) {
    if (sup) { const int sm = uu / SN, sn = uu - sm * SN; m0 = (sm * SM + (slot8 / SNN)) * BM; n0 = (sn * SNN + (slot8 % SNN)) << 7; }
    else { const int mt = uu / TN; m0 = mt * BM; n0 = (uu - mt * TN) << 7; }
  };
  auto issue = [&](int m0, int n0, int ks, int slot) {
    const u16* ag = A + (size_t)(m0 + lrow) * lda + pc + ks * 32;
    const u16* bg = Bt + (size_t)(n0 + lrow) * ldb + pc + ks * 32;
    char* dst = smem + slot * STAGE + tid * 16;
#pragma unroll
    for (int i = 0; i < MI; i++)
      __builtin_amdgcn_global_load_lds((const unsigned*)(ag + (size_t)i * 64 * lda), (__attribute__((address_space(3))) unsigned*)(dst + i * 4096), 16, 0, 0);
#pragma unroll
    for (int i = 0; i < 2; i++)
      __builtin_amdgcn_global_load_lds((const unsigned*)(bg + (size_t)i * 64 * ldb), (__attribute__((address_space(3))) unsigned*)(dst + BM * 64 + i * 4096), 16, 0, 0);
  };
  int m0, n0;
  tile_of(u, m0, n0);
  int ui = u, ki = 0, mi0 = m0, ni0 = n0;
  bool idone = false;
  int pend = 0;
  unsigned g = 0;
  asm volatile("s_waitcnt vmcnt(0) lgkmcnt(0)" ::: "memory");
  __builtin_amdgcn_s_barrier();
#pragma unroll 1
  for (int s = 0; s < DEPTH; s++) {
    if (!idone) {
      issue(mi0, ni0, ki, (g + pend) % NSLOT);
      pend++;
      if (++ki == nk) { ki = 0; ui += ustep; if (ui < nunits) tile_of(ui, mi0, ni0); else idone = true; }
    }
  }
  while (true) {
    f32x16 acc[MI][2];
#pragma unroll
    for (int a = 0; a < MI; a++)
#pragma unroll
      for (int b = 0; b < 2; b++)
#pragma unroll
        for (int i = 0; i < 16; i++) acc[a][b][i] = 0.f;
#pragma unroll 1
    for (int kt = 0; kt < nk; kt++) {
      if (DEPTH == 3) {
        if (pend >= 3) asm volatile("s_waitcnt vmcnt(8)" ::: "memory");
        else if (pend == 2) asm volatile("s_waitcnt vmcnt(4)" ::: "memory");
        else asm volatile("s_waitcnt vmcnt(0)" ::: "memory");
      } else {
        asm volatile("s_waitcnt vmcnt(0)" ::: "memory");
      }
      asm volatile("s_waitcnt lgkmcnt(0)" ::: "memory");
      __builtin_amdgcn_s_barrier();
      if (DEPTH == 1) pend = 0;
      if (!idone) {
        issue(mi0, ni0, ki, (g + (DEPTH == 1 ? 1 : pend)) % NSLOT);
        if (DEPTH == 1) pend = 1;
        if (++ki == nk) { ki = 0; ui += ustep; if (ui < nunits) tile_of(ui, mi0, ni0); else idone = true; }
      } else {
        if (DEPTH != 1) pend--;
      }
      const char* sb = smem + (g % NSLOT) * STAGE;
      g++;
      {
        s16x8 a[MI], a2[MI];
#pragma unroll
        for (int i = 0; i < MI; i++) { a[i] = *(const s16x8*)(sb + aro + i * 32 * 64 + xo0); a2[i] = *(const s16x8*)(sb + aro + i * 32 * 64 + xo1); }
        const s16x8 b0 = *(const s16x8*)(sb + bro + xo0);
        const s16x8 b1 = *(const s16x8*)(sb + bro + 32 * 64 + xo0);
        const s16x8 b2 = *(const s16x8*)(sb + bro + xo1);
        const s16x8 b3 = *(const s16x8*)(sb + bro + 32 * 64 + xo1);
#pragma unroll
        for (int i = 0; i < MI; i++) { acc[i][0] = mfma(a[i], b0, acc[i][0]); acc[i][1] = mfma(a[i], b1, acc[i][1]); }
#pragma unroll
        for (int i = 0; i < MI; i++) { acc[i][0] = mfma(a2[i], b2, acc[i][0]); acc[i][1] = mfma(a2[i], b3, acc[i][1]); }
      }
    }
    epilogue<EPI, MI>(P, l, acc, m0 + wm * (BM / 2), n0 + wn * 64, r, h);
    u += ustep;
    if (u >= nunits) break;
    tile_of(u, m0, n0);
  }
  asm volatile("s_waitcnt vmcnt(0) lgkmcnt(0)" ::: "memory");
}

DI void phase_attn(const Params& P, int l, char* smem) {
  const u16* qf = (const u16*)(P.ws + WS_QF);
  const u16* fk = (const u16*)(P.ws + WS_FOXK);
  const u16* fv = (const u16*)(P.ws + WS_FOXV);
  const float* cum = (const float*)(P.ws + WS_CUM);
  const u16* qm = (const u16*)(P.ws + WS_R1 + R1_QM);
  const u16* kv = (const u16*)(P.ws + WS_R1 + R1_KV);
  const u16* krp = (const u16*)(P.ws + WS_KROPE);
  u16* mixed = (u16*)(P.ws + WS_ACTA);
  constexpr float LOG2E = 1.4426950408889634f;
  const int total = 384 + 32 * 96;
  for (int t = get_bid(); t < total; t += get_nblk()) {
    bool isfox, issample; int b, hd, qb = 0;
    if (t < 256) { isfox = true; issample = true; b = t >> 3; hd = t & 7; }
    else if (t < 384) { isfox = false; issample = true; const int u = t - 256; b = u >> 2; hd = u & 3; }
    else {
      const int u = t - 384; const int grp = u / 96; int w = u % 96; qb = 31 - grp; issample = false;
      if (w < 32) { isfox = false; b = w >> 2; hd = w & 3; }
      else { w -= 32; isfox = true; b = w >> 3; hd = w & 7; }
    }
    AttnJob J;
    size_t tok0, krow0;
    if (issample) { tok0 = (size_t)TP + (size_t)b * DS; krow0 = (size_t)TP + (size_t)b * SKS; J.nq = DS; J.Sk = SKS; J.qpos0 = PAST; }
    else { tok0 = (size_t)b * SEQ + (size_t)qb * 128; krow0 = (size_t)b * SEQ; J.nq = 128; J.Sk = SEQ; J.qpos0 = qb * 128; }
    if (isfox) {
      J.Q = qf + tok0 * 512 + hd * 64; J.ldq = 512;
      J.K1 = fk + krow0 * 512 + hd * 64; J.ldk1 = 512; J.K2 = J.K1; J.ldk2 = 512;
      J.V = fv + krow0 * 512 + hd * 64; J.ldv = 512;
      J.O = mixed + tok0 * 1024 + hd * 64; J.ldo = 1024;
      J.cq = cum + (krow0 + (size_t)J.qpos0) * 8 + hd;
      J.ck = cum + krow0 * 8 + hd;
      J.scale_log2 = 0.125f * LOG2E;
      attn_block<64, 64, 64, MASK_FRAME, true, FOX_PF, 512, 512, 512, 512, 1024>(J, smem);
    } else {
      J.Q = qm + tok0 * 768 + hd * 192; J.ldq = 768;
      J.K1 = kv + krow0 * 1024 + hd * 256; J.ldk1 = 1024;
      J.K2 = krp + krow0 * 64; J.ldk2 = 64;
      J.V = kv + krow0 * 1024 + hd * 256 + 128; J.ldv = 1024;
      J.O = mixed + tok0 * 1024 + 512 + hd * 128; J.ldo = 1024;
      J.cq = nullptr; J.ck = nullptr;
      J.scale_log2 = 0.07216878364870322f * LOG2E;
      attn_block<192, 128, 128, MASK_CHUNK, false, MLA_PF, 768, 1024, 64, 1024, 1024>(J, smem);
    }
  }
}

DI void phase_cross(const Params& P, int l, char* smem) {
  const u16* xq = (const u16*)(P.ws + WS_R1 + R1_XQ);
  const u16* mk = (const u16*)(P.ws + WS_MEMK) + (size_t)l * MB * NMEM * 1024;
  const u16* mv = (const u16*)(P.ws + WS_MEMV) + (size_t)l * MB * NMEM * 1024;
  u16* xo = (u16*)(P.ws + WS_ACTA);
  constexpr float LOG2E = 1.4426950408889634f;
  const int nsamp = DB * 4 * 2;
  const int total = nsamp + 256 * 4 * 2;
  for (int t = get_bid(); t < total; t += get_nblk()) {
    AttnJob J;
    size_t tok0; int mb, hd, half;
    if (t < nsamp) { const int b = t >> 3; hd = (t >> 1) & 3; half = t & 1; tok0 = (size_t)TP + (size_t)b * DS; mb = NB + b; J.nq = DS; }
    else { const int u = t - nsamp; const int qbk = u >> 3; hd = (u >> 1) & 3; half = u & 1; tok0 = (size_t)qbk * 128; mb = qbk >> 5; J.nq = 128; }
    J.Sk = NMEM; J.qpos0 = 0;
    J.Q = xq + tok0 * 1024 + hd * 256; J.ldq = 1024;
    J.K1 = mk + (size_t)mb * NMEM * 1024 + hd * 256; J.ldk1 = 1024; J.K2 = J.K1; J.ldk2 = 1024;
    J.V = mv + (size_t)mb * NMEM * 1024 + hd * 256 + half * 128; J.ldv = 1024;
    J.O = xo + tok0 * 1024 + hd * 256 + half * 128; J.ldo = 1024;
    J.cq = nullptr; J.ck = nullptr;
    J.scale_log2 = 0.0625f * LOG2E;
    attn_block<256, 256, 128, MASK_NONE, false, false, 1024, 1024, 1024, 1024, 1024>(J, smem);
  }
}

constexpr int NPHASE = 2 + 13 * NL;

DI void run_phase(const Params& P, int ph, char* smem, bool dup = false) {
  if (ph == 0) { phase_prep(P, smem); return; }
  if (ph == NPHASE - 1) { phase_final(P); return; }
  const int l = (ph - 1) / 13, k = (ph - 1) % 13;
  char* ws = P.ws;
  const u16* actA = (const u16*)(ws + WS_ACTA);
  int rot = 0;
  switch (k) {
    case 0: phase_norm(P, P.in[10] + l * 1024, l); break;
    case 1:
      gemm_phase<EPI_IN, 128>(P, l, actA, 1024, wt_ptr(P, l, WE_IN), 1024, 1024, TT, INP, smem, rot);
      if (l == 0) {
        for (int l2 = 0; l2 < NL; l2++)
          gemm_phase<EPI_MEM, 128>(P, l2, (const u16*)(ws + WS_HMEM) + (size_t)l2 * NB * NMEM * 1024, 1024, wt_ptr(P, l2, WE_MKV), 1024, 1024,
                              NB * NMEM, 2048, smem, rot);
      }
      break;
    case 2: phase_post(P, l, smem); break;
    case 3:
      gemm_phase<EPI_KV, 128>(P, l, (const u16*)(ws + WS_CKV), 128, wt_ptr(P, l, WE_UKV), 128, 128, KROWS, 1024, smem, rot);
      gemm_phase<EPI_UQ, 128>(P, l, (const u16*)(ws + WS_CQN), 256, wt_ptr(P, l, WE_UQ), 256, 256, TT, 768, smem, rot);
      break;
    case 4: phase_attn(P, l, smem); break;
    case 5: if (dup) gemm_phase<EPI_RESID0, 128>(P, l, actA, 1024, wt_ptr(P, l, WE_OUT), 1024, 1024, TT, 1024, smem, rot); else gemm_phase<EPI_RESID, 128>(P, l, actA, 1024, wt_ptr(P, l, WE_OUT), 1024, 1024, TT, 1024, smem, rot); break;
    case 6: phase_norm(P, P.in[18] + l * 1024, -1); break;
    case 7: gemm_phase<EPI_XQ, 128>(P, l, actA, 1024, wt_ptr(P, l, WE_XQ), 1024, 1024, TT, 1024, smem, rot); break;
    case 8: phase_cross(P, l, smem); break;
    case 9: if (dup) gemm_phase<EPI_RESID0, 128>(P, l, actA, 1024, wt_ptr(P, l, WE_XO), 1024, 1024, TT, 1024, smem, rot); else gemm_phase<EPI_RESID, 128>(P, l, actA, 1024, wt_ptr(P, l, WE_XO), 1024, 1024, TT, 1024, smem, rot); break;
    case 10: phase_norm(P, P.in[24] + l * 1024, -1); break;
    case 11: gemm_phase<EPI_UP, BM_BIG>(P, l, actA, 1024, wt_ptr(P, l, WE_UP), 1024, 1024, TT, DFF, smem, rot); break;
    case 12: if (dup) gemm_phase<EPI_RESID0, 128>(P, l, (const u16*)(ws + WS_R1 + R1_U), DFF, wt_ptr(P, l, WE_DN), DFF, DFF, TT, 1024, smem, rot); else gemm_phase<EPI_RESID, 128>(P, l, (const u16*)(ws + WS_R1 + R1_U), DFF, wt_ptr(P, l, WE_DN), DFF, DFF, TT, 1024, smem, rot); break;
  }
}

__global__ void __launch_bounds__(256, LB_MIN) mega(Params P, int ph_lo, int ph_hi) {
  __shared__ __attribute__((aligned(16))) char smem[SMEM_BYTES];
  cg::grid_group grid = cg::this_grid();
  for (int ph = ph_lo; ph < ph_hi; ph++) {
    Params Q = P;
    asm volatile("" : "+s"(Q.out), "+s"(Q.ws));
    run_phase(Q, ph, smem);
#ifdef DUP_MASK
    if (ph > 0 && ph < NPHASE - 1 && ((DUP_MASK >> ((ph - 1) % 13)) & 1)) { grid.sync(); asm volatile("" : "+s"(Q.out), "+s"(Q.ws)); run_phase(Q, ph, smem, true); }
#endif
    if (ph + 1 < ph_hi) grid.sync();
  }
}

extern "C" void kernel_launch(void* const* d_in, const int* in_sizes, int n_in, void* d_out, int out_size, void* d_ws,
                              size_t ws_size, hipStream_t stream) {
  static int grid_blocks = 0;
  if (!grid_blocks) {
    int dev = 0, cus = 0, per_cu = 0;
    hipGetDevice(&dev);
    hipDeviceGetAttribute(&cus, hipDeviceAttributeMultiprocessorCount, dev);
    hipOccupancyMaxActiveBlocksPerMultiprocessor(&per_cu, mega, 256, 0);
    if (per_cu < 1) per_cu = 1;
    if (per_cu > 2) per_cu = 2;
    grid_blocks = cus * per_cu;
  }
  if (n_in != 28 || (size_t)out_size != O_END || ws_size < WS_END) {
    fprintf(stderr, "kernel_launch: shape/ws mismatch n_in %d out %d (want %zu) ws %zu (want %zu)\n", n_in, out_size, (size_t)O_END, ws_size, (size_t)WS_END);
    return;
  }
  Params p;
  memset(&p, 0, sizeof(p));
  for (int i = 0; i < 28; i++) p.in[i] = (const float*)d_in[i];
  p.out = (float*)d_out;
  p.ws = (char*)d_ws;
#if COOP
  int lo = 0, hi = NPHASE;
  void* args[] = {&p, &lo, &hi};
  hipError_t e = hipLaunchCooperativeKernel((void*)mega, dim3(grid_blocks), dim3(256), args, 0, stream);
  if (e != hipSuccess) fprintf(stderr, "cooperative launch failed: %s (grid %d)\n", hipGetErrorString(e), grid_blocks);
#else
  for (int ph = 0; ph < NPHASE; ph++) hipLaunchKernelGGL(mega, dim3(grid_blocks), dim3(256), 0, stream, p, ph, ph + 1);
#endif
}
```

```cpp
#include <hip/hip_runtime.h>
#include <hip/hip_cooperative_groups.h>
#include <stdint.h>
#include <string.h>
#include <stdio.h>
namespace cg = cooperative_groups;

#ifndef COOP
#define COOP 1
#endif

#ifndef FOX_PF
#define FOX_PF true
#endif
#ifndef MLA_PF
#define MLA_PF true
#endif
#ifndef LB_MIN
#define LB_MIN 2
#endif
#ifndef BM_BIG
#define BM_BIG 256
#endif
#define DI __device__ __forceinline__
typedef unsigned short u16;
typedef short s16x8 __attribute__((ext_vector_type(8)));
typedef short s16x4 __attribute__((ext_vector_type(4)));
typedef __bf16 bfx8 __attribute__((ext_vector_type(8)));
typedef __bf16 bfx2 __attribute__((ext_vector_type(2)));
typedef float f32x16 __attribute__((ext_vector_type(16)));
typedef float f32x4 __attribute__((ext_vector_type(4)));
typedef float f32x2 __attribute__((ext_vector_type(2)));
typedef unsigned u32x4 __attribute__((ext_vector_type(4)));
typedef unsigned u32x2 __attribute__((ext_vector_type(2)));

constexpr int DM = 1024, NB = 8, SEQ = 4096, NL = 2, DB = 32, DS = 32, PAST = 2048;
constexpr int TP = NB * SEQ;
constexpr int TS = DB * DS;
constexpr int TT = TP + TS;
constexpr int SKS = PAST + DS;
constexpr int KROWS = TP + DB * SKS;
constexpr int INC = 1992, INP = 2048;
constexpr int NMEM = 256, MB = NB + DB;
constexpr int DFF = 4096;

constexpr size_t O_Y = 0;
constexpr size_t O_FKP = (size_t)TT * DM;
constexpr size_t O_FVP = O_FKP + (size_t)NL * TP * 512;
constexpr size_t O_FLP = O_FVP + (size_t)NL * TP * 512;
constexpr size_t O_CKP = O_FLP + (size_t)NL * TP * 8;
constexpr size_t O_KRP = O_CKP + (size_t)NL * TP * 128;
constexpr size_t O_MKP = O_KRP + (size_t)NL * TP * 64;
constexpr size_t O_MVP = O_MKP + (size_t)NL * NB * NMEM * 1024;
constexpr size_t O_FKS = O_MVP + (size_t)NL * NB * NMEM * 1024;
constexpr size_t O_FVS = O_FKS + (size_t)NL * TS * 512;
constexpr size_t O_FLS = O_FVS + (size_t)NL * TS * 512;
constexpr size_t O_CKS = O_FLS + (size_t)NL * TS * 8;
constexpr size_t O_KRS = O_CKS + (size_t)NL * TS * 128;
constexpr size_t O_END = O_KRS + (size_t)NL * TS * 64;

constexpr size_t al256(size_t x) { return (x + 255) / 256 * 256; }
constexpr size_t WE_IN = 0;
constexpr size_t WE_UQ = WE_IN + (size_t)INP * 1024;
constexpr size_t WE_UKV = WE_UQ + (size_t)768 * 256;
constexpr size_t WE_OUT = WE_UKV + (size_t)1024 * 128;
constexpr size_t WE_XQ = WE_OUT + (size_t)1024 * 1024;
constexpr size_t WE_MKV = WE_XQ + (size_t)1024 * 1024;
constexpr size_t WE_XO = WE_MKV + (size_t)2048 * 1024;
constexpr size_t WE_UP = WE_XO + (size_t)1024 * 1024;
constexpr size_t WE_DN = WE_UP + (size_t)4096 * 1024;
constexpr size_t WE_LAYER = WE_DN + (size_t)1024 * 4096;
constexpr size_t WS_WT = 0;
constexpr size_t WS_ROPE = al256(WS_WT + WE_LAYER * 2 * NL);
constexpr size_t WS_ACTA = al256(WS_ROPE + (size_t)4096 * 32 * 8);
constexpr size_t WS_QF = al256(WS_ACTA + (size_t)TT * 1024 * 2);
constexpr size_t WS_FOXK = al256(WS_QF + (size_t)TT * 512 * 2);
constexpr size_t WS_FOXV = al256(WS_FOXK + (size_t)KROWS * 512 * 2);
constexpr size_t WS_CUM = al256(WS_FOXV + (size_t)KROWS * 512 * 2);
constexpr size_t WS_ZC = al256(WS_CUM + (size_t)KROWS * 8 * 4);
constexpr size_t WS_CQN = al256(WS_ZC + (size_t)TT * 448 * 4);
constexpr size_t WS_CKV = al256(WS_CQN + (size_t)TT * 256 * 2);
constexpr size_t WS_KROPE = al256(WS_CKV + (size_t)KROWS * 128 * 2);
constexpr size_t WS_MEMK = al256(WS_KROPE + (size_t)KROWS * 64 * 2);
constexpr size_t WS_MEMV = al256(WS_MEMK + (size_t)NL * MB * NMEM * 1024 * 2);
constexpr size_t WS_HMEM = al256(WS_MEMV + (size_t)NL * MB * NMEM * 1024 * 2);
constexpr size_t WS_R1 = al256(WS_HMEM + (size_t)NL * NB * NMEM * 1024 * 2);
constexpr size_t R1_KV = 0;
constexpr size_t R1_QM = al256((size_t)KROWS * 1024 * 2);
constexpr size_t R1_U = 0;
constexpr size_t R1_XQ = 0;
constexpr size_t WS_BAR = al256(WS_R1 + (size_t)TT * 4096 * 2);
constexpr size_t WS_END = al256(WS_BAR + 3456 * 4);
static_assert(R1_QM + (size_t)TT * 768 * 2 <= (size_t)TT * 4096 * 2, "R1 overflow");

constexpr int SMEM_BYTES = 65536;

struct Params {
  const float* in[28];
  float* out;
  char* ws;
  int wv;
  int pad;
};

DI int get_bid() { int t = blockIdx.x; asm volatile("" : "+s"(t)); return t; }
DI int get_nblk() { int t = gridDim.x; asm volatile("" : "+s"(t)); return t; }
DI int lane_id() { return (int)__builtin_amdgcn_mbcnt_hi(~0u, __builtin_amdgcn_mbcnt_lo(~0u, 0u)); }
DI int get_tid(int wv) { int t = (wv << 6) | lane_id(); asm volatile("" : "+v"(t)); return t; }
DI unsigned pk2(float a, float b) { f32x2 v = {a, b}; return __builtin_bit_cast(unsigned, __builtin_convertvector(v, bfx2)); }
DI u16 f2bf(float a) { return (u16)(pk2(a, 0.f) & 0xffffu); }
DI f32x16 mfma(s16x8 a, s16x8 b, f32x16 c) {
  return __builtin_amdgcn_mfma_f32_32x32x16_bf16(__builtin_bit_cast(bfx8, a), __builtin_bit_cast(bfx8, b), c, 0, 0, 0);
}
DI int crow(int i, int h) { return (i & 3) + 8 * (i >> 2) + 4 * h; }
DI float wave_sum(float v) {
#pragma unroll
  for (int m = 32; m >= 1; m >>= 1) v += __shfl_xor(v, m);
  return v;
}
DI float xhalf_max(float v) {
  auto rr = __builtin_amdgcn_permlane32_swap(__float_as_uint(v), __float_as_uint(v), false, false);
  return fmaxf(__uint_as_float(rr[0]), __uint_as_float(rr[1]));
}
DI float xhalf_sum(float v) {
  auto rr = __builtin_amdgcn_permlane32_swap(__float_as_uint(v), __float_as_uint(v), false, false);
  return __uint_as_float(rr[0]) + __uint_as_float(rr[1]);
}
DI int tok_krow(int tok) {
  if (tok < TP) return tok;
  const int s = tok - TP;
  return TP + (s >> 5) * SKS + PAST + (s & 31);
}
DI int tok_pos(int tok) { return tok < TP ? (tok & (SEQ - 1)) : PAST + ((tok - TP) & 31); }

enum { EPI_IN = 0, EPI_MEM, EPI_UQ, EPI_KV, EPI_RESID, EPI_XQ, EPI_UP, EPI_RESID0 };

template <int EPI, int MI>
DI void epilogue(const Params& P, int l, f32x16 (&acc)[MI][2], int mw, int nw, int r, int h) {
  float* out = P.out;
  char* ws = P.ws;
  if constexpr (EPI == EPI_IN) {
    u16* qf = (u16*)(ws + WS_QF);
    u16* fk = (u16*)(ws + WS_FOXK);
    u16* fv = (u16*)(ws + WS_FOXV);
    float* zc = (float*)(ws + WS_ZC);
    const float* bfg = P.in[12] + l * 8;
#pragma unroll
    for (int mi = 0; mi < MI; mi++) {
#pragma unroll
      for (int i = 0; i < 16; i++) {
        const int row = mw + mi * 32 + crow(i, h);
        const int kr = tok_krow(row);
        const bool isp = row < TP;
        const size_t orow = isp ? ((size_t)l * TP + row) : ((size_t)l * TS + (row - TP));
#pragma unroll
        for (int ni = 0; ni < 2; ni++) {
          const int col = nw + ni * 32 + r;
          const float v = acc[mi][ni][i];
          if (col < 512) {
            qf[(size_t)row * 512 + col] = f2bf(v);
          } else if (col < 1024) {
            const int c = col - 512;
            out[(isp ? O_FKP : O_FKS) + orow * 512 + c] = v;
            fk[(size_t)kr * 512 + c] = f2bf(v);
          } else if (col < 1536) {
            const int c = col - 1024;
            out[(isp ? O_FVP : O_FVS) + orow * 512 + c] = v;
            fv[(size_t)kr * 512 + c] = f2bf(v);
          } else if (col < 1544) {
            const int c = col - 1536;
            const float g = v + bfg[c];
            const float ls = fminf(g, 0.f) - log1pf(__expf(-fabsf(g)));
            out[(isp ? O_FLP : O_FLS) + orow * 8 + c] = ls;
          } else if (col < INC) {
            zc[(size_t)row * 448 + (col - 1544)] = v;
          }
        }
      }
    }
  } else if constexpr (EPI == EPI_MEM) {
    u16* mk = (u16*)(ws + WS_MEMK);
    u16* mv = (u16*)(ws + WS_MEMV);
#pragma unroll
    for (int mi = 0; mi < MI; mi++) {
#pragma unroll
      for (int i = 0; i < 16; i++) {
        const int row = mw + mi * 32 + crow(i, h);
#pragma unroll
        for (int ni = 0; ni < 2; ni++) {
          const int col = nw + ni * 32 + r;
          const float v = acc[mi][ni][i];
          const int c = col & 1023;
          const size_t oidx = ((size_t)l * (NB * NMEM) + row) * 1024 + c;
          const size_t bidx = ((size_t)l * (MB * NMEM) + row) * 1024 + c;
          if (col < 1024) { out[O_MKP + oidx] = v; mk[bidx] = f2bf(v); }
          else { out[O_MVP + oidx] = v; mv[bidx] = f2bf(v); }
        }
      }
    }
  } else if constexpr (EPI == EPI_UQ) {
    u16* qm = (u16*)(ws + WS_R1 + R1_QM);
    const f32x2* rt = (const f32x2*)(ws + WS_ROPE);
    const bool isrope = (nw % 192) == 128;
#pragma unroll
    for (int mi = 0; mi < MI; mi++) {
#pragma unroll
      for (int i = 0; i < 16; i++) {
        const int row = mw + mi * 32 + crow(i, h);
        float x1 = acc[mi][0][i], x2 = acc[mi][1][i];
        if (isrope) {
          const f32x2 cs = rt[tok_pos(row) * 32 + r];
          const float o1 = x1 * cs[0] - x2 * cs[1];
          const float o2 = x2 * cs[0] + x1 * cs[1];
          x1 = o1; x2 = o2;
        }
        qm[(size_t)row * 768 + nw + r] = f2bf(x1);
        qm[(size_t)row * 768 + nw + 32 + r] = f2bf(x2);
      }
    }
  } else if constexpr (EPI == EPI_KV || EPI == EPI_XQ || EPI == EPI_UP) {
    u16* dst; int ld;
    if constexpr (EPI == EPI_KV) { dst = (u16*)(ws + WS_R1 + R1_KV); ld = 1024; }
    else if constexpr (EPI == EPI_XQ) { dst = (u16*)(ws + WS_R1 + R1_XQ); ld = 1024; }
    else { dst = (u16*)(ws + WS_R1 + R1_U); ld = DFF; }
#pragma unroll
    for (int mi = 0; mi < MI; mi++) {
#pragma unroll
      for (int i = 0; i < 16; i++) {
        const int row = mw + mi * 32 + crow(i, h);
#pragma unroll
        for (int ni = 0; ni < 2; ni++) {
          float v = acc[mi][ni][i];
          if constexpr (EPI == EPI_UP) { v = fmaxf(v, 0.f); v = v * v; }
          dst[(size_t)row * ld + nw + ni * 32 + r] = f2bf(v);
        }
      }
    }
  } else if constexpr (EPI == EPI_RESID || EPI == EPI_RESID0) {
#pragma unroll
    for (int mi = 0; mi < MI; mi++) {
#pragma unroll
      for (int i = 0; i < 16; i++) {
        const int row = mw + mi * 32 + crow(i, h);
#pragma unroll
        for (int ni = 0; ni < 2; ni++) {
          unsafeAtomicAdd(out + (size_t)row * DM + nw + ni * 32 + r, EPI == EPI_RESID0 ? acc[mi][ni][i] * 0.f : acc[mi][ni][i]);
        }
      }
    }
  }
}

enum { MASK_NONE = 0, MASK_FRAME = 1, MASK_CHUNK = 2 };
struct AttnJob {
  const u16* Q; int ldq;
  const u16* K1; int ldk1;
  const u16* K2; int ldk2;
  const u16* V; int ldv;
  u16* O; int ldo;
  const float* cq;
  const float* ck;
  int nq, Sk, qpos0;
  float scale_log2;
  int wv;
};

template <int DQK, int D1, int DVT, int MASK, bool BIAS, bool PREFETCH, int LDQ, int LDK1, int LDK2, int LDV, int LDO>
DI void attn_block(const AttnJob& J, char* smem) {
  constexpr int KP = DQK * 2 + 16;
  constexpr int VP = DVT * 2;
  constexpr int CV = DVT / 8;
  constexpr int NKK = DQK / 16, NDV = DVT / 32;
  constexpr float LOG2E = 1.4426950408889634f;
  char* Ks = smem;
  char* Vs = smem + 64 * KP;
  float* cks = (float*)(smem + 64 * KP + 64 * VP);
  const int tid = get_tid(J.wv), wave = tid >> 6, lane = tid & 63, r = lane & 31, h = lane >> 5;
  const int wq0 = wave * 32;
  const bool active = wq0 < J.nq;
  const int qi = wq0 + r;
  const int qpos = J.qpos0 + qi;
  const int wqmax = J.qpos0 + wq0 + 31;
  const int qmax = J.qpos0 + J.nq - 1;
  const int ntk = (J.Sk + 63) >> 6;
  int nt = ntk;
  if (MASK != MASK_NONE) { const int t2 = (qmax >> 6) + 1; nt = t2 < ntk ? t2 : ntk; }

  s16x8 qf[NKK];
  {
    const u16* qp = J.Q + (size_t)qi * LDQ + h * 8;
#pragma unroll
    for (int kk = 0; kk < NKK; kk++) {
      if (active) qf[kk] = *(const s16x8*)(qp + kk * 16);
      else { s16x8 z = {0, 0, 0, 0, 0, 0, 0, 0}; qf[kk] = z; }
    }
  }
  float cqv = 0.f;
  if (BIAS) { if (active) cqv = J.cq[(size_t)qi * 8] * LOG2E; }

  f32x16 o[NDV];
#pragma unroll
  for (int d = 0; d < NDV; d++)
#pragma unroll
    for (int i = 0; i < 16; i++) o[d][i] = 0.f;
  float m_run = -1e30f, l_run = 0.f;

  constexpr int CK1 = D1 / 8, CK2 = (DQK - D1) / 8;
  constexpr int RP1 = 256 / CK1, NP1 = 64 / RP1;
  constexpr int RP2 = CK2 ? 256 / (CK2 ? CK2 : 1) : 64, NP2 = CK2 ? 64 / RP2 : 0;
  constexpr int RPV = 256 / CV, NPV = 64 / RPV;
  u32x4 rk1[NP1], rk2[NP2 ? NP2 : 1], rv[NPV];
  float rck = 0.f;
  const int tq = (lane & 15) >> 2, tp = lane & 3, tblk = (lane >> 4) & 1;
  const int vswz = (DVT >= 128) ? tq : (tq >> 1);
  const int r1 = tid / CK1, c1 = tid % CK1;
  const int r2 = CK2 ? tid / (CK2 ? CK2 : 1) : 0, c2 = CK2 ? tid % (CK2 ? CK2 : 1) : 0;
  const int r3 = tid / CV, c3 = tid % CV;
  const unsigned k1o = (unsigned)(r1 * LDK1 + c1 * 8) * 2u;
  const unsigned k2o = (unsigned)(r2 * LDK2 + c2 * 8) * 2u;
  const unsigned vo = (unsigned)(r3 * LDV + c3 * 8) * 2u;
  const int k1so = r1 * KP + c1 * 16;
  const int k2so = r2 * KP + D1 * 2 + c2 * 16;
  const int vsw = (DVT >= 128) ? (r3 & 3) : ((r3 >> 1) & 1);
  const int vso = 64 * KP + r3 * VP + (((c3 >> 2) ^ vsw) * 64) + (c3 & 3) * 16;
  const int vro = 64 * KP + (4 * h + tq) * VP + (16 * tblk + 4 * tp) * 2;
  const int kro = r * KP + h * 16;

  auto load_tile = [&](int j) {
    const int kb = j * 64;
#pragma unroll
    for (int i = 0; i < NP1; i++) {
      u32x4 v = {0u, 0u, 0u, 0u};
      if (kb + r1 + i * RP1 < J.Sk) v = *(const u32x4*)((const char*)(J.K1 + (size_t)(kb + i * RP1) * LDK1) + k1o);
      rk1[i] = v;
    }
#pragma unroll
    for (int i = 0; i < NP2; i++) {
      u32x4 v = {0u, 0u, 0u, 0u};
      if (kb + r2 + i * RP2 < J.Sk) v = *(const u32x4*)((const char*)(J.K2 + (size_t)(kb + i * RP2) * LDK2) + k2o);
      rk2[i] = v;
    }
#pragma unroll
    for (int i = 0; i < NPV; i++) {
      u32x4 v = {0u, 0u, 0u, 0u};
      if (kb + r3 + i * RPV < J.Sk) v = *(const u32x4*)((const char*)(J.V + (size_t)(kb + i * RPV) * LDV) + vo);
      rv[i] = v;
    }
    if (BIAS) {
      if (tid < 64) { const int key = kb + tid; rck = key < J.Sk ? J.ck[(size_t)key * 8] * LOG2E : 0.f; }
    }
  };
  auto store_tile = [&]() {
    int a1 = k1so, a2 = k2so, a3 = vso;
    asm volatile("" : "+v"(a1), "+v"(a2), "+v"(a3));
#pragma unroll
    for (int i = 0; i < NP1; i++) *(u32x4*)(smem + a1 + i * RP1 * KP) = rk1[i];
#pragma unroll
    for (int i = 0; i < NP2; i++) *(u32x4*)(smem + a2 + i * RP2 * KP) = rk2[i];
#pragma unroll
    for (int i = 0; i < NPV; i++) *(u32x4*)(smem + a3 + i * RPV * VP) = rv[i];
    if (BIAS) { if (tid < 64) cks[tid] = rck; }
  };

  if (PREFETCH) load_tile(0);
  for (int j = 0; j < nt; j++) {
    __syncthreads();
    if (!PREFETCH) load_tile(j);
    store_tile();
    __syncthreads();
    if (PREFETCH) { if (j + 1 < nt) load_tile(j + 1); }
    const bool need = active && (MASK == MASK_NONE || j * 64 <= wqmax);
    if (need) {
      int kro_l = kro, vro_l = vro;
      asm volatile("" : "+v"(kro_l), "+v"(vro_l));
      const char* krd = smem + kro_l;
      const bool needmask = (MASK == MASK_FRAME && j * 64 + 63 > J.qpos0 + wq0) || (j * 64 + 63 >= J.Sk);
      const int dq = (MASK == MASK_FRAME ? min(qpos, J.Sk - 1) : J.Sk - 1) - j * 64 - 4 * h;
#pragma unroll
      for (int hb = 0; hb < 2; hb++) {
        if (MASK == MASK_FRAME && j * 64 + hb * 32 > wqmax) continue;
        f32x16 p;
#pragma unroll
        for (int i = 0; i < 16; i++) p[i] = 0.f;
#pragma unroll
        for (int kk = 0; kk < NKK; kk++) {
          const s16x8 kf = *(const s16x8*)(krd + hb * 32 * KP + kk * 32);
          p = mfma(kf, qf[kk], p);
        }
        if (BIAS) {
#pragma unroll
          for (int g = 0; g < 4; g++) {
            const f32x4 c0 = *(const f32x4*)(cks + hb * 32 + 8 * g + 4 * h);
#pragma unroll
            for (int e = 0; e < 4; e++) p[4 * g + e] = fmaf(p[4 * g + e], J.scale_log2, cqv - c0[e]);
          }
        } else {
#pragma unroll
          for (int i = 0; i < 16; i++) p[i] *= J.scale_log2;
        }
        if (needmask) {
#pragma unroll
          for (int i = 0; i < 16; i++) {
            const int cc = (i & 3) + 8 * (i >> 2) + 32 * hb;
            p[i] = (cc <= dq) ? p[i] : -1e30f;
          }
        }
        float mx = p[0];
#pragma unroll
        for (int i = 1; i < 16; i++) mx = fmaxf(mx, p[i]);
        mx = xhalf_max(mx);
        const float m_new = fmaxf(m_run, mx);
        const float alpha = __builtin_amdgcn_exp2f(m_run - m_new);
        m_run = m_new;
        float ps = 0.f;
#pragma unroll
        for (int i = 0; i < 16; i++) { p[i] = __builtin_amdgcn_exp2f(p[i] - m_new); ps += p[i]; }
        l_run = l_run * alpha + ps;
        if (__any(alpha != 1.f)) {
#pragma unroll
          for (int d = 0; d < NDV; d++)
#pragma unroll
            for (int i = 0; i < 16; i++) o[d][i] *= alpha;
        }
        s16x8 pb[2];
        {
          u32x4 w;
          w[0] = pk2(p[0], p[1]); w[1] = pk2(p[2], p[3]); w[2] = pk2(p[4], p[5]); w[3] = pk2(p[6], p[7]);
          pb[0] = __builtin_bit_cast(s16x8, w);
          w[0] = pk2(p[8], p[9]); w[1] = pk2(p[10], p[11]); w[2] = pk2(p[12], p[13]); w[3] = pk2(p[14], p[15]);
          pb[1] = __builtin_bit_cast(s16x8, w);
        }
#pragma unroll
        for (int d = 0; d < NDV; d++) {
          const char* vb = smem + (vro_l + ((d ^ vswz) * 64)) + hb * 32 * VP;
#pragma unroll
          for (int s = 0; s < 2; s++) {
            const s16x4 lo = __builtin_amdgcn_ds_read_tr16_b64_v4i16(
                (__attribute__((address_space(3))) s16x4*)(uintptr_t)(vb + (16 * s) * VP));
            const s16x4 hi = __builtin_amdgcn_ds_read_tr16_b64_v4i16(
                (__attribute__((address_space(3))) s16x4*)(uintptr_t)(vb + (16 * s + 8) * VP));
            const s16x8 vf = __builtin_shufflevector(lo, hi, 0, 1, 2, 3, 4, 5, 6, 7);
            o[d] = mfma(vf, pb[s], o[d]);
          }
        }
      }
    }
  }
  const float lt = xhalf_sum(l_run);
  if (active && qi < J.nq) {
    const float inv = 1.f / lt;
    u16* op = J.O + (size_t)qi * LDO + 4 * h;
#pragma unroll
    for (int d = 0; d < NDV; d++) {
#pragma unroll
      for (int g = 0; g < 4; g++) {
        u32x2 w;
        w[0] = pk2(o[d][4 * g] * inv, o[d][4 * g + 1] * inv);
        w[1] = pk2(o[d][4 * g + 2] * inv, o[d][4 * g + 3] * inv);
        *(u32x2*)(op + d * 32 + 8 * g) = w;
      }
    }
  }
}

template <int NR, bool F32OUT>
DI void rms_rows(const float* __restrict__ xbase, size_t rstride, int nvalid, const float* __restrict__ g, void* dbase, size_t dstride, int lane) {
  f32x4 v[NR][4];
#pragma unroll
  for (int j = 0; j < NR; j++)
#pragma unroll
    for (int i = 0; i < 4; i++) {
      if (j < nvalid) v[j][i] = *(const f32x4*)(xbase + (size_t)j * rstride + i * 256 + lane * 4);
      else { f32x4 z = {0.f, 0.f, 0.f, 0.f}; v[j][i] = z; }
    }
  f32x4 gg[4];
#pragma unroll
  for (int i = 0; i < 4; i++) gg[i] = *(const f32x4*)(g + i * 256 + lane * 4);
#pragma unroll
  for (int j = 0; j < NR; j++) {
    float ss = 0.f;
#pragma unroll
    for (int i = 0; i < 4; i++) ss += v[j][i][0] * v[j][i][0] + v[j][i][1] * v[j][i][1] + v[j][i][2] * v[j][i][2] + v[j][i][3] * v[j][i][3];
    ss = wave_sum(ss);
    const float rs = rsqrtf(ss * (1.f / 1024.f) + 1e-6f);
    if (j < nvalid) {
#pragma unroll
      for (int i = 0; i < 4; i++) {
        if (F32OUT) {
          f32x4 w;
          w[0] = v[j][i][0] * rs * gg[i][0]; w[1] = v[j][i][1] * rs * gg[i][1]; w[2] = v[j][i][2] * rs * gg[i][2]; w[3] = v[j][i][3] * rs * gg[i][3];
          *(f32x4*)((float*)dbase + (size_t)j * dstride + i * 256 + lane * 4) = w;
        } else {
          u32x2 w;
          w[0] = pk2(v[j][i][0] * rs * gg[i][0], v[j][i][1] * rs * gg[i][1]);
          w[1] = pk2(v[j][i][2] * rs * gg[i][2], v[j][i][3] * rs * gg[i][3]);
          *(u32x2*)((u16*)dbase + (size_t)j * dstride + i * 256 + lane * 4) = w;
        }
      }
    }
  }
}

DI void cvt_job(const float* __restrict__ src, u16* __restrict__ dst, int nseg, size_t seglen, size_t sstride, size_t dstride, int wv) {
  const size_t upseg = seglen / 8;
  const size_t total = upseg * nseg;
  const size_t stride = (size_t)get_nblk() * 256;
  for (size_t u0 = (size_t)get_bid() * 256 + get_tid(wv); u0 < total; u0 += 4 * stride) {
    f32x4 a[4], b[4];
    size_t so[4], dd[4];
#pragma unroll
    for (int q = 0; q < 4; q++) {
      const size_t u = u0 + q * stride;
      const size_t uu = u < total ? u : u0;
      const size_t sg = uu / upseg, off = (uu - sg * upseg) * 8;
      so[q] = sg * sstride + off; dd[q] = sg * dstride + off;
      a[q] = *(const f32x4*)(src + so[q]);
      b[q] = *(const f32x4*)(src + so[q] + 4);
    }
#pragma unroll
    for (int q = 0; q < 4; q++) {
      if (u0 + q * stride < total) {
        u32x4 w;
        w[0] = pk2(a[q][0], a[q][1]); w[1] = pk2(a[q][2], a[q][3]); w[2] = pk2(b[q][0], b[q][1]); w[3] = pk2(b[q][2], b[q][3]);
        *(u32x4*)(dst + dd[q]) = w;
      }
    }
  }
}

DI void transpose_job(const float* __restrict__ src, u16* __restrict__ dst, int K, int N, int Npad, int& rot, char* smem, int wv) {
  float* tile = (float*)smem;
  const int tk = K / 64, tn = Npad / 64, ntiles = tk * tn;
  const int G = get_nblk();
  const int tid = get_tid(wv);
  for (int t = (get_bid() + G - (rot % G)) % G; t < ntiles; t += G) {
    const int k0 = (t % tk) * 64, n0 = (t / tk) * 64;
    __syncthreads();
#pragma unroll 4
    for (int i = 0; i < 16; i++) {
      const int k = i * 4 + (tid >> 6), n = tid & 63;
      tile[k * 65 + n] = (n0 + n < N) ? src[(size_t)(k0 + k) * N + n0 + n] : 0.f;
    }
    __syncthreads();
#pragma unroll 4
    for (int i = 0; i < 16; i++) {
      const int n = i * 4 + (tid >> 6), k = tid & 63;
      dst[(size_t)(n0 + n) * K + k0 + k] = f2bf(tile[k * 65 + n]);
    }
  }
  rot += ntiles;
}

DI u16* wt_ptr(const Params& P, int l, size_t eoff) { return (u16*)(P.ws + WS_WT) + (size_t)l * WE_LAYER + eoff; }

DI void phase_prep(const Params& P, char* smem) {
  const int tid = get_tid(P.wv), lane = tid & 63;
  const int gw = get_bid() * 4 + (tid >> 6), nw = get_nblk() * 4;
  int rot = 0;
  for (int l = 0; l < NL; l++) {
    transpose_job(P.in[11] + (size_t)l * 1024 * INC, wt_ptr(P, l, WE_IN), 1024, INC, INP, rot, smem, P.wv);
    transpose_job(P.in[14] + (size_t)l * 256 * 768, wt_ptr(P, l, WE_UQ), 256, 768, 768, rot, smem, P.wv);
    transpose_job(P.in[16] + (size_t)l * 128 * 1024, wt_ptr(P, l, WE_UKV), 128, 1024, 1024, rot, smem, P.wv);
    transpose_job(P.in[17] + (size_t)l * 1024 * 1024, wt_ptr(P, l, WE_OUT), 1024, 1024, 1024, rot, smem, P.wv);
    transpose_job(P.in[20] + (size_t)l * 1024 * 1024, wt_ptr(P, l, WE_XQ), 1024, 1024, 1024, rot, smem, P.wv);
    transpose_job(P.in[21] + (size_t)l * 1024 * 1024, wt_ptr(P, l, WE_MKV), 1024, 1024, 1024, rot, smem, P.wv);
    transpose_job(P.in[22] + (size_t)l * 1024 * 1024, wt_ptr(P, l, WE_MKV) + (size_t)1024 * 1024, 1024, 1024, 1024, rot, smem, P.wv);
    transpose_job(P.in[23] + (size_t)l * 1024 * 1024, wt_ptr(P, l, WE_XO), 1024, 1024, 1024, rot, smem, P.wv);
    transpose_job(P.in[25] + (size_t)l * 1024 * 4096, wt_ptr(P, l, WE_UP), 1024, 4096, 4096, rot, smem, P.wv);
    transpose_job(P.in[26] + (size_t)l * 4096 * 1024, wt_ptr(P, l, WE_DN), 4096, 1024, 1024, rot, smem, P.wv);
  }
  {
    f32x2* rt = (f32x2*)(P.ws + WS_ROPE);
    for (int i = get_bid() * 256 + tid; i < 4096 * 32; i += get_nblk() * 256) {
      const int pos = i >> 5, j = i & 31;
      const float inv = powf(10000.f, -(float)j / 32.f);
      const float ang = (float)pos * inv;
      f32x2 cs; cs[0] = cosf(ang); cs[1] = sinf(ang);
      rt[i] = cs;
    }
  }
  for (int l = 0; l < NL; l++) {
    const size_t seg = (size_t)DB * NMEM * 1024;
    cvt_job(P.in[8] + l * seg, (u16*)(P.ws + WS_MEMK) + ((size_t)l * MB + NB) * NMEM * 1024, 1, seg, 0, 0, P.wv);
    cvt_job(P.in[9] + l * seg, (u16*)(P.ws + WS_MEMV) + ((size_t)l * MB + NB) * NMEM * 1024, 1, seg, 0, 0, P.wv);
  }
  for (int rr = gw; rr < NL * NB * NMEM; rr += nw) {
    const int l = rr / (NB * NMEM), row = rr % (NB * NMEM);
    rms_rows<1, false>(P.in[2] + (size_t)row * 1024, 0, 1, P.in[19] + l * 1024, (u16*)(P.ws + WS_HMEM) + (size_t)rr * 1024, 0, lane);
  }
  {
    const size_t n4 = (size_t)TT * 256;
    const size_t np4 = (size_t)TP * 256;
    const size_t stride = (size_t)get_nblk() * 256;
    for (size_t i0 = (size_t)get_bid() * 256 + tid; i0 < n4; i0 += 4 * stride) {
      f32x4 v[4];
#pragma unroll
      for (int q = 0; q < 4; q++) {
        const size_t i = i0 + q * stride;
        const size_t ii = i < n4 ? i : i0;
        v[q] = (ii < np4) ? *(const f32x4*)(P.in[0] + ii * 4) : *(const f32x4*)(P.in[1] + (ii - np4) * 4);
      }
#pragma unroll
      for (int q = 0; q < 4; q++) {
        const size_t i = i0 + q * stride;
        if (i < n4) *(f32x4*)(P.out + i * 4) = v[q];
      }
    }
  }
}

DI void phase_norm(const Params& P, const float* g, int cache_layer) {
  const int tid = get_tid(P.wv), lane = tid & 63;
  const int gw = get_bid() * 4 + (tid >> 6), nw = get_nblk() * 4;
  u16* h = (u16*)(P.ws + WS_ACTA);
  for (int row = gw; row < TT; row += 4 * nw) {
    const int nv = (TT - row + nw - 1) / nw;
    rms_rows<4, false>(P.out + (size_t)row * 1024, (size_t)nw * 1024, nv < 4 ? nv : 4, g, h + (size_t)row * 1024, (size_t)nw * 1024, lane);
  }
  if (cache_layer >= 0) {
    const int l = cache_layer;
    cvt_job(P.in[3] + (size_t)l * DB * PAST * 512, (u16*)(P.ws + WS_FOXK) + (size_t)TP * 512, DB, (size_t)PAST * 512, (size_t)PAST * 512, (size_t)SKS * 512, P.wv);
    cvt_job(P.in[4] + (size_t)l * DB * PAST * 512, (u16*)(P.ws + WS_FOXV) + (size_t)TP * 512, DB, (size_t)PAST * 512, (size_t)PAST * 512, (size_t)SKS * 512, P.wv);
    cvt_job(P.in[6] + (size_t)l * DB * PAST * 128, (u16*)(P.ws + WS_CKV) + (size_t)TP * 128, DB, (size_t)PAST * 128, (size_t)PAST * 128, (size_t)SKS * 128, P.wv);
    cvt_job(P.in[7] + (size_t)l * DB * PAST * 64, (u16*)(P.ws + WS_KROPE) + (size_t)TP * 64, DB, (size_t)PAST * 64, (size_t)PAST * 64, (size_t)SKS * 64, P.wv);
  }
}

DI void phase_final(const Params& P) {
  const int tid = get_tid(P.wv), lane = tid & 63;
  const int gw = get_bid() * 4 + (tid >> 6), nw = get_nblk() * 4;
  const float* g = P.in[27];
  for (int row = gw; row < TT; row += 4 * nw) {
    const int nv = (TT - row + nw - 1) / nw;
    rms_rows<4, true>(P.out + (size_t)row * 1024, (size_t)nw * 1024, nv < 4 ? nv : 4, g, P.out + (size_t)row * 1024, (size_t)nw * 1024, lane);
  }
}

DI void phase_post(const Params& P, int l, char* smem) {
  const int tid = get_tid(P.wv), lane = tid & 63;
  const int gw = get_bid() * 4 + (tid >> 6), nw = get_nblk() * 4;
  const float* zc = (const float*)(P.ws + WS_ZC);
  u16* cqn = (u16*)(P.ws + WS_CQN);
  u16* ckv = (u16*)(P.ws + WS_CKV);
  u16* krp = (u16*)(P.ws + WS_KROPE);
  const f32x2* rt = (const f32x2*)(P.ws + WS_ROPE);
  const float* gq = P.in[13] + l * 256;
  const float* gkv = P.in[15] + l * 128;
  for (int tok0 = gw; tok0 < TT; tok0 += 4 * nw) {
    f32x4 vq[4]; f32x2 vk[4]; float vr[4];
#pragma unroll
    for (int j = 0; j < 4; j++) {
      const int tk = tok0 + j * nw;
      const float* z = zc + (size_t)(tk < TT ? tk : tok0) * 448;
      vq[j] = *(const f32x4*)(z + lane * 4);
      vk[j] = *(const f32x2*)(z + 256 + lane * 2);
      vr[j] = z[384 + lane];
    }
    const f32x4 ggq = *(const f32x4*)(gq + lane * 4);
    const f32x2 ggk = *(const f32x2*)(gkv + lane * 2);
#pragma unroll
    for (int j = 0; j < 4; j++) {
      const int tok = tok0 + j * nw;
      if (tok >= TT) break;
      const bool isp = tok < TP;
      const size_t orow = isp ? ((size_t)l * TP + tok) : ((size_t)l * TS + (tok - TP));
      const int kr = tok_krow(tok);
      {
        const f32x4 v = vq[j];
        const float ss = wave_sum(v[0] * v[0] + v[1] * v[1] + v[2] * v[2] + v[3] * v[3]);
        const float rs = rsqrtf(ss * (1.f / 256.f) + 1e-6f);
        u32x2 w;
        w[0] = pk2(v[0] * rs * ggq[0], v[1] * rs * ggq[1]);
        w[1] = pk2(v[2] * rs * ggq[2], v[3] * rs * ggq[3]);
        *(u32x2*)(cqn + (size_t)tok * 256 + lane * 4) = w;
      }
      {
        const f32x2 v = vk[j];
        const float ss = wave_sum(v[0] * v[0] + v[1] * v[1]);
        const float rs = rsqrtf(ss * (1.f / 128.f) + 1e-6f);
        f32x2 o; o[0] = v[0] * rs * ggk[0]; o[1] = v[1] * rs * ggk[1];
        *(f32x2*)(P.out + (isp ? O_CKP : O_CKS) + orow * 128 + lane * 2) = o;
        *(unsigned*)(ckv + (size_t)kr * 128 + lane * 2) = pk2(o[0], o[1]);
      }
      {
        const float x = vr[j];
        const float y = __shfl_xor(x, 32);
        const f32x2 cs = rt[tok_pos(tok) * 32 + (lane & 31)];
        const float o = (lane < 32) ? (x * cs[0] - y * cs[1]) : (x * cs[0] + y * cs[1]);
        P.out[(isp ? O_KRP : O_KRS) + orow * 64 + lane] = o;
        krp[(size_t)kr * 64 + lane] = f2bf(o);
      }
    }
  }
  float* cum = (float*)(P.ws + WS_CUM);
  float* wtot = (float*)smem;
  const int wave = tid >> 6;
  for (int it = get_bid(); it < NB + DB; it += get_nblk()) {
    const bool isp = it < NB;
    const int b = isp ? it : it - NB;
    const int ppt = isp ? 16 : 9;
    const int npos = isp ? SEQ : SKS;
    const float* srcA; const float* srcB; int nA;
    size_t krow0;
    if (isp) { srcA = P.out + O_FLP + ((size_t)l * TP + (size_t)b * SEQ) * 8; srcB = srcA; nA = SEQ; krow0 = (size_t)b * SEQ; }
    else {
      srcA = P.in[5] + ((size_t)l * DB + b) * PAST * 8;
      srcB = P.out + O_FLS + ((size_t)l * TS + (size_t)b * DS) * 8 - (size_t)PAST * 8;
      nA = PAST; krow0 = (size_t)TP + (size_t)b * SKS;
    }
    const int p0 = tid * ppt;
    f32x4 va[16], vb[16];
#pragma unroll
    for (int j = 0; j < 16; j++) {
      const int p = p0 + j;
      f32x4 z = {0.f, 0.f, 0.f, 0.f};
      va[j] = z; vb[j] = z;
      if (j < ppt && p < npos) {
        const float* s = (p < nA ? srcA : srcB) + (size_t)p * 8;
        va[j] = *(const f32x4*)s; vb[j] = *(const f32x4*)(s + 4);
      }
    }
#pragma unroll
    for (int j = 1; j < 16; j++) { va[j] += va[j - 1]; vb[j] += vb[j - 1]; }
    f32x4 ta = va[15], tb = vb[15];
#pragma unroll
    for (int d = 1; d < 64; d <<= 1) {
#pragma unroll
      for (int e = 0; e < 4; e++) {
        const float ua = __shfl_up(ta[e], d), ub = __shfl_up(tb[e], d);
        if (lane >= d) { ta[e] += ua; tb[e] += ub; }
      }
    }
    __syncthreads();
    if (lane == 63) { *(f32x4*)(wtot + wave * 8) = ta; *(f32x4*)(wtot + wave * 8 + 4) = tb; }
    __syncthreads();
    f32x4 pa = ta - va[15], pb = tb - vb[15];
    for (int w2 = 0; w2 < wave; w2++) { pa += *(const f32x4*)(wtot + w2 * 8); pb += *(const f32x4*)(wtot + w2 * 8 + 4); }
#pragma unroll
    for (int j = 0; j < 16; j++) {
      const int p = p0 + j;
      if (j < ppt && p < npos) {
        float* d = cum + (krow0 + p) * 8;
        *(f32x4*)d = va[j] + pa; *(f32x4*)(d + 4) = vb[j] + pb;
      }
    }
  }
}

template <int EPI, int BM>
DI void gemm_phase(const Params& P, int l, const u16* __restrict__ A, int lda, const u16* __restrict__ Bt, int ldb, int K, int M, int N,
                   char* smem, int& rot) {
  constexpr int MI = BM / 64;
  constexpr int STAGE = (BM + 128) * 64;
  constexpr int NSLOT = 65536 / STAGE;
  constexpr int DEPTH = NSLOT - 1;
  constexpr int GPS = MI + 2;
  constexpr int SM = (BM == 256) ? 4 : 8, SNN = 64 / SM;
  const int tid = get_tid(P.wv), wave = tid >> 6, lane = tid & 63, r = lane & 31, h = lane >> 5;
  const int wm = wave >> 1, wn = wave & 1;
  const int TM = M / BM, TN = N >> 7;
  const int G = get_nblk();
  const int bid = get_bid();
  const bool sup = (G == 512) && ((TN % SNN) == 0) && ((TM % SM) == 0);
  const int SN = TN / SNN;
  const int nunits = sup ? (TM / SM) * SN : TM * TN;
  const int ustep = sup ? 8 : G;
  const int slot8 = bid >> 3;
  int u = sup ? (int)((bid + 8 - (rot & 7)) & 7) : (int)((bid + G - (rot % G)) % G);
  rot += nunits;
  if (u >= nunits) return;
  const int lrow = tid >> 2, lc = tid & 3;
  const int pc = (lc ^ ((tid >> 4) & 3)) * 8;
  const int nk = K >> 5;
  const int sw = (r >> 2) & 3;
  const int xo0 = ((0 + h) ^ sw) * 16, xo1 = ((2 + h) ^ sw) * 16;
  const int aro = (wm * (BM / 2) + r) * 64, bro = BM * 64 + (wn * 64 + r) * 64;
  auto tile_of = [&](int uu, int& m0, int& n0) {
    if (sup) { const int sm = uu / SN, sn = uu - sm * SN; m0 = (sm * SM + (slot8 / SNN)) * BM; n0 = (sn * SNN + (slot8 % SNN)) << 7; }
    else { const int mt = uu / TN; m0 = mt * BM; n0 = (uu - mt * TN) << 7; }
  };
  auto issue = [&](int m0, int n0, int ks, int slot) {
    const u16* ag = A + (size_t)(m0 + lrow) * lda + pc + ks * 32;
    const u16* bg = Bt + (size_t)(n0 + lrow) * ldb + pc + ks * 32;
    char* dst = smem + slot * STAGE + tid * 16;
#pragma unroll
    for (int i = 0; i < MI; i++)
      __builtin_amdgcn_global_load_lds((const unsigned*)(ag + (size_t)i * 64 * lda), (__attribute__((address_space(3))) unsigned*)(dst + i * 4096), 16, 0, 0);
#pragma unroll
    for (int i = 0; i < 2; i++)
      __builtin_amdgcn_global_load_lds((const unsigned*)(bg + (size_t)i * 64 * ldb), (__attribute__((address_space(3))) unsigned*)(dst + BM * 64 + i * 4096), 16, 0, 0);
  };
  int m0, n0;
  tile_of(u, m0, n0);
  int ui = u, ki = 0, mi0 = m0, ni0 = n0;
  bool idone = false;
  int pend = 0;
  unsigned g = 0;
  asm volatile("s_waitcnt vmcnt(0) lgkmcnt(0)" ::: "memory");
  __builtin_amdgcn_s_barrier();
#pragma unroll 1
  for (int s = 0; s < DEPTH; s++) {
    if (!idone) {
      issue(mi0, ni0, ki, (g + pend) % NSLOT);
      pend++;
      if (++ki == nk) { ki = 0; ui += ustep; if (ui < nunits) tile_of(ui, mi0, ni0); else idone = true; }
    }
  }
  while (true) {
    f32x16 acc[MI][2];
#pragma unroll
    for (int a = 0; a < MI; a++)
#pragma unroll
      for (int b = 0; b < 2; b++)
#pragma unroll
        for (int i = 0; i < 16; i++) acc[a][b][i] = 0.f;
#pragma unroll 1
    for (int kt = 0; kt < nk; kt++) {
      if (DEPTH == 3) {
        if (pend >= 3) asm volatile("s_waitcnt vmcnt(8)" ::: "memory");
        else if (pend == 2) asm volatile("s_waitcnt vmcnt(4)" ::: "memory");
        else asm volatile("s_waitcnt vmcnt(0)" ::: "memory");
      } else {
        asm volatile("s_waitcnt vmcnt(0)" ::: "memory");
      }
      asm volatile("s_waitcnt lgkmcnt(0)" ::: "memory");
      __builtin_amdgcn_s_barrier();
      if (DEPTH == 1) pend = 0;
      if (!idone) {
        issue(mi0, ni0, ki, (g + (DEPTH == 1 ? 1 : pend)) % NSLOT);
        if (DEPTH == 1) pend = 1;
        if (++ki == nk) { ki = 0; ui += ustep; if (ui < nunits) tile_of(ui, mi0, ni0); else idone = true; }
      } else {
        if (DEPTH != 1) pend--;
      }
      const char* sb = smem + (g % NSLOT) * STAGE;
      g++;
      {
        s16x8 a[MI], a2[MI];
#pragma unroll
        for (int i = 0; i < MI; i++) { a[i] = *(const s16x8*)(sb + aro + i * 32 * 64 + xo0); a2[i] = *(const s16x8*)(sb + aro + i * 32 * 64 + xo1); }
        const s16x8 b0 = *(const s16x8*)(sb + bro + xo0);
        const s16x8 b1 = *(const s16x8*)(sb + bro + 32 * 64 + xo0);
        const s16x8 b2 = *(const s16x8*)(sb + bro + xo1);
        const s16x8 b3 = *(const s16x8*)(sb + bro + 32 * 64 + xo1);
#pragma unroll
        for (int i = 0; i < MI; i++) { acc[i][0] = mfma(a[i], b0, acc[i][0]); acc[i][1] = mfma(a[i], b1, acc[i][1]); }
#pragma unroll
        for (int i = 0; i < MI; i++) { acc[i][0] = mfma(a2[i], b2, acc[i][0]); acc[i][1] = mfma(a2[i], b3, acc[i][1]); }
      }
    }
    epilogue<EPI, MI>(P, l, acc, m0 + wm * (BM / 2), n0 + wn * 64, r, h);
    u += ustep;
    if (u >= nunits) break;
    tile_of(u, m0, n0);
  }
  asm volatile("s_waitcnt vmcnt(0) lgkmcnt(0)" ::: "memory");
}

DI void phase_attn(const Params& P, int l, char* smem) {
  const u16* qf = (const u16*)(P.ws + WS_QF);
  const u16* fk = (const u16*)(P.ws + WS_FOXK);
  const u16* fv = (const u16*)(P.ws + WS_FOXV);
  const float* cum = (const float*)(P.ws + WS_CUM);
  const u16* qm = (const u16*)(P.ws + WS_R1 + R1_QM);
  const u16* kv = (const u16*)(P.ws + WS_R1 + R1_KV);
  const u16* krp = (const u16*)(P.ws + WS_KROPE);
  u16* mixed = (u16*)(P.ws + WS_ACTA);
  constexpr float LOG2E = 1.4426950408889634f;
  const int total = 384 + 32 * 96;
  for (int t = get_bid(); t < total; t += get_nblk()) {
    bool isfox, issample; int b, hd, qb = 0;
    if (t < 256) { isfox = true; issample = true; b = t >> 3; hd = t & 7; }
    else if (t < 384) { isfox = false; issample = true; const int u = t - 256; b = u >> 2; hd = u & 3; }
    else {
      const int u = t - 384; const int grp = u / 96; int w = u % 96; qb = 31 - grp; issample = false;
      if (w < 32) { isfox = false; b = w >> 2; hd = w & 3; }
      else { w -= 32; isfox = true; b = w >> 3; hd = w & 7; }
    }
    AttnJob J;
    J.wv = P.wv;
    size_t tok0, krow0;
    if (issample) { tok0 = (size_t)TP + (size_t)b * DS; krow0 = (size_t)TP + (size_t)b * SKS; J.nq = DS; J.Sk = SKS; J.qpos0 = PAST; }
    else { tok0 = (size_t)b * SEQ + (size_t)qb * 128; krow0 = (size_t)b * SEQ; J.nq = 128; J.Sk = SEQ; J.qpos0 = qb * 128; }
    if (isfox) {
      J.Q = qf + tok0 * 512 + hd * 64; J.ldq = 512;
      J.K1 = fk + krow0 * 512 + hd * 64; J.ldk1 = 512; J.K2 = J.K1; J.ldk2 = 512;
      J.V = fv + krow0 * 512 + hd * 64; J.ldv = 512;
      J.O = mixed + tok0 * 1024 + hd * 64; J.ldo = 1024;
      J.cq = cum + (krow0 + (size_t)J.qpos0) * 8 + hd;
      J.ck = cum + krow0 * 8 + hd;
      J.scale_log2 = 0.125f * LOG2E;
      attn_block<64, 64, 64, MASK_FRAME, true, FOX_PF, 512, 512, 512, 512, 1024>(J, smem);
    } else {
      J.Q = qm + tok0 * 768 + hd * 192; J.ldq = 768;
      J.K1 = kv + krow0 * 1024 + hd * 256; J.ldk1 = 1024;
      J.K2 = krp + krow0 * 64; J.ldk2 = 64;
      J.V = kv + krow0 * 1024 + hd * 256 + 128; J.ldv = 1024;
      J.O = mixed + tok0 * 1024 + 512 + hd * 128; J.ldo = 1024;
      J.cq = nullptr; J.ck = nullptr;
      J.scale_log2 = 0.07216878364870322f * LOG2E;
      attn_block<192, 128, 128, MASK_CHUNK, false, MLA_PF, 768, 1024, 64, 1024, 1024>(J, smem);
    }
  }
}

DI void phase_cross(const Params& P, int l, char* smem) {
  const u16* xq = (const u16*)(P.ws + WS_R1 + R1_XQ);
  const u16* mk = (const u16*)(P.ws + WS_MEMK) + (size_t)l * MB * NMEM * 1024;
  const u16* mv = (const u16*)(P.ws + WS_MEMV) + (size_t)l * MB * NMEM * 1024;
  u16* xo = (u16*)(P.ws + WS_ACTA);
  constexpr float LOG2E = 1.4426950408889634f;
  const int nsamp = DB * 4 * 2;
  const int total = nsamp + 256 * 4 * 2;
  for (int t = get_bid(); t < total; t += get_nblk()) {
    AttnJob J;
    J.wv = P.wv;
    size_t tok0; int mb, hd, half;
    if (t < nsamp) { const int b = t >> 3; hd = (t >> 1) & 3; half = t & 1; tok0 = (size_t)TP + (size_t)b * DS; mb = NB + b; J.nq = DS; }
    else { const int u = t - nsamp; const int qbk = u >> 3; hd = (u >> 1) & 3; half = u & 1; tok0 = (size_t)qbk * 128; mb = qbk >> 5; J.nq = 128; }
    J.Sk = NMEM; J.qpos0 = 0;
    J.Q = xq + tok0 * 1024 + hd * 256; J.ldq = 1024;
    J.K1 = mk + (size_t)mb * NMEM * 1024 + hd * 256; J.ldk1 = 1024; J.K2 = J.K1; J.ldk2 = 1024;
    J.V = mv + (size_t)mb * NMEM * 1024 + hd * 256 + half * 128; J.ldv = 1024;
    J.O = xo + tok0 * 1024 + hd * 256 + half * 128; J.ldo = 1024;
    J.cq = nullptr; J.ck = nullptr;
    J.scale_log2 = 0.0625f * LOG2E;
    attn_block<256, 256, 128, MASK_NONE, false, false, 1024, 1024, 1024, 1024, 1024>(J, smem);
  }
}

#define XB_TMO      128
#define XB_XCNT(j)  (256  + 64 * (j))
#define XB_XSUB(j)  (1280 + 64 * (j))
#define XB_XGEN(j)  (2304 + 64 * (j))
#define XB_TOP      3328
#define XB_TOPGEN   3392
#define XCD_BAR_WORDS 3456
#define XB_SPIN_CAP (1u << 20)
DI unsigned xb_ld(unsigned* p) { return __hip_atomic_load(p, __ATOMIC_RELAXED, __HIP_MEMORY_SCOPE_AGENT); }
DI unsigned xb_add(unsigned* p, unsigned v) { return __hip_atomic_fetch_add(p, v, __ATOMIC_RELAXED, __HIP_MEMORY_SCOPE_AGENT); }
DI unsigned xb_xcc_id() { return (unsigned)__builtin_amdgcn_s_getreg((3 << 11) | 20) & 0xFu; }
#define XB_SPIN(cond, bar) do { unsigned _sp = 0; while (cond) { __builtin_amdgcn_s_sleep(1); \
    if ((++_sp & 255u) == 0u) { if (xb_ld(&(bar)[XB_TMO])) break; if (_sp > XB_SPIN_CAP) { atomicAdd(&(bar)[XB_TMO], 1u); break; } } } } while (0)
DI void xb_census(unsigned* bar, unsigned x, unsigned& nloc, unsigned& nx) {
  const unsigned G = gridDim.x;
  unsigned sum, cnt, mine, sp = 0u;
  for (;;) {
    sum = 0u; cnt = 0u; mine = 0u;
#pragma unroll
    for (unsigned j = 0; j < 16; ++j) { const unsigned c = xb_ld(&bar[XB_XCNT(j)]); sum += c; cnt += (c > 0u) ? 1u : 0u; mine = (j == x) ? c : mine; }
    if (sum == G) break;
    __builtin_amdgcn_s_sleep(1);
    if ((++sp & 255u) == 0u) { if (xb_ld(&bar[XB_TMO])) break; if (sp > XB_SPIN_CAP) { atomicAdd(&bar[XB_TMO], 1u); break; } }
  }
  nloc = mine > 0u ? mine : 1u; nx = cnt > 0u ? cnt : 1u;
}
DI void xcd_barrier(unsigned* bar, unsigned x, unsigned nloc, unsigned nx, int wv) {
  asm volatile("s_waitcnt vmcnt(0)" ::: "memory");
  __syncthreads();
  if (wv == 0 && lane_id() == 0) {
    __builtin_amdgcn_s_waitcnt(0);
    const unsigned old = xb_add(&bar[XB_XSUB(x)], 1u);
    const unsigned gen = old / nloc;
    if (old + 1u == (gen + 1u) * nloc) {
      __builtin_amdgcn_fence(__ATOMIC_RELEASE, "agent");
      asm volatile("s_waitcnt vmcnt(0)" ::: "memory");
      const unsigned og = xb_add(&bar[XB_TOP], 1u);
      const unsigned tg = og / nx;
      if (og + 1u == (tg + 1u) * nx) xb_add(&bar[XB_TOPGEN], 1u);
      else XB_SPIN(xb_ld(&bar[XB_TOPGEN]) == tg, bar);
      __builtin_amdgcn_fence(__ATOMIC_ACQUIRE, "agent");
      xb_add(&bar[XB_XGEN(x)], 1u);
      asm volatile("s_waitcnt vmcnt(0)" ::: "memory");
    } else {
      XB_SPIN(xb_ld(&bar[XB_XGEN(x)]) == gen, bar);
      __builtin_amdgcn_fence(__ATOMIC_ACQUIRE, "agent");
      asm volatile("s_waitcnt vmcnt(0)" ::: "memory");
    }
  }
  __syncthreads();
}

constexpr int NPHASE = 2 + 13 * NL;

DI void run_phase(const Params& P, int ph, char* smem, bool dup = false) {
  if (ph == 0) { phase_prep(P, smem); return; }
  if (ph == NPHASE - 1) { phase_final(P); return; }
  const int l = (ph - 1) / 13, k = (ph - 1) % 13;
  char* ws = P.ws;
  const u16* actA = (const u16*)(ws + WS_ACTA);
  int rot = 0;
  switch (k) {
    case 0: phase_norm(P, P.in[10] + l * 1024, l); break;
    case 1:
      gemm_phase<EPI_IN, 128>(P, l, actA, 1024, wt_ptr(P, l, WE_IN), 1024, 1024, TT, INP, smem, rot);
      if (l == 0) {
        for (int l2 = 0; l2 < NL; l2++)
          gemm_phase<EPI_MEM, 128>(P, l2, (const u16*)(ws + WS_HMEM) + (size_t)l2 * NB * NMEM * 1024, 1024, wt_ptr(P, l2, WE_MKV), 1024, 1024,
                              NB * NMEM, 2048, smem, rot);
      }
      break;
    case 2: phase_post(P, l, smem); break;
    case 3:
      gemm_phase<EPI_KV, 128>(P, l, (const u16*)(ws + WS_CKV), 128, wt_ptr(P, l, WE_UKV), 128, 128, KROWS, 1024, smem, rot);
      gemm_phase<EPI_UQ, 128>(P, l, (const u16*)(ws + WS_CQN), 256, wt_ptr(P, l, WE_UQ), 256, 256, TT, 768, smem, rot);
      break;
    case 4: phase_attn(P, l, smem); break;
    case 5: if (dup) gemm_phase<EPI_RESID0, 128>(P, l, actA, 1024, wt_ptr(P, l, WE_OUT), 1024, 1024, TT, 1024, smem, rot); else gemm_phase<EPI_RESID, 128>(P, l, actA, 1024, wt_ptr(P, l, WE_OUT), 1024, 1024, TT, 1024, smem, rot); break;
    case 6: phase_norm(P, P.in[18] + l * 1024, -1); break;
    case 7: gemm_phase<EPI_XQ, 128>(P, l, actA, 1024, wt_ptr(P, l, WE_XQ), 1024, 1024, TT, 1024, smem, rot); break;
    case 8: phase_cross(P, l, smem); break;
    case 9: if (dup) gemm_phase<EPI_RESID0, 128>(P, l, actA, 1024, wt_ptr(P, l, WE_XO), 1024, 1024, TT, 1024, smem, rot); else gemm_phase<EPI_RESID, 128>(P, l, actA, 1024, wt_ptr(P, l, WE_XO), 1024, 1024, TT, 1024, smem, rot); break;
    case 10: phase_norm(P, P.in[24] + l * 1024, -1); break;
    case 11: gemm_phase<EPI_UP, BM_BIG>(P, l, actA, 1024, wt_ptr(P, l, WE_UP), 1024, 1024, TT, DFF, smem, rot); break;
    case 12: if (dup) gemm_phase<EPI_RESID0, 128>(P, l, (const u16*)(ws + WS_R1 + R1_U), DFF, wt_ptr(P, l, WE_DN), DFF, DFF, TT, 1024, smem, rot); else gemm_phase<EPI_RESID, 128>(P, l, (const u16*)(ws + WS_R1 + R1_U), DFF, wt_ptr(P, l, WE_DN), DFF, DFF, TT, 1024, smem, rot); break;
  }
}

__global__ void __launch_bounds__(256, LB_MIN) mega(Params P, int ph_lo, int ph_hi) {
  __shared__ __attribute__((aligned(16))) char smem[SMEM_BYTES];
  cg::grid_group grid = cg::this_grid();
  if (ph_hi > 4096) grid.sync();
  unsigned* bar = (unsigned*)(P.ws + WS_BAR);
  const unsigned xb_x = xb_xcc_id();
  unsigned xb_nloc = 1u, xb_nx = 1u;
  if (threadIdx.x == 0) { (void)xb_add(&bar[XB_XCNT(xb_x)], 1u); xb_census(bar, xb_x, xb_nloc, xb_nx); }
  xb_nloc = __builtin_amdgcn_readfirstlane(xb_nloc);
  xb_nx = __builtin_amdgcn_readfirstlane(xb_nx);
  unsigned xb_pack = xb_nloc | (xb_nx << 16) | (xb_x << 24) | ((unsigned)__builtin_amdgcn_readfirstlane(threadIdx.x >> 6) << 28);
  asm volatile("" : "+s"(xb_pack));
  for (int ph = ph_lo; ph < ph_hi; ph++) {
    Params Q = P;
    unsigned pk = xb_pack;
    asm volatile("" : "+s"(Q.out), "+s"(Q.ws), "+s"(pk));
    Q.wv = (int)(pk >> 28);
    run_phase(Q, ph, smem);
    if (ph + 1 < ph_hi) {
      unsigned pk2 = xb_pack;
      asm volatile("" : "+s"(pk2));
      xcd_barrier((unsigned*)(Q.ws + WS_BAR), (pk2 >> 24) & 0xfu, pk2 & 0xffffu, (pk2 >> 16) & 0xffu, (int)(pk2 >> 28));
    }
  }
}

extern "C" void kernel_launch(void* const* d_in, const int* in_sizes, int n_in, void* d_out, int out_size, void* d_ws,
                              size_t ws_size, hipStream_t stream) {
  static int grid_blocks = 0;
  if (!grid_blocks) {
    int dev = 0, cus = 0, per_cu = 0;
    hipGetDevice(&dev);
    hipDeviceGetAttribute(&cus, hipDeviceAttributeMultiprocessorCount, dev);
    hipOccupancyMaxActiveBlocksPerMultiprocessor(&per_cu, mega, 256, 0);
    if (per_cu < 1) per_cu = 1;
    if (per_cu > 2) per_cu = 2;
    grid_blocks = cus * per_cu;
  }
  if (n_in != 28 || (size_t)out_size != O_END || ws_size < WS_END) {
    fprintf(stderr, "kernel_launch: shape/ws mismatch n_in %d out %d (want %zu) ws %zu (want %zu)\n", n_in, out_size, (size_t)O_END, ws_size, (size_t)WS_END);
    return;
  }
  Params p;
  memset(&p, 0, sizeof(p));
  for (int i = 0; i < 28; i++) p.in[i] = (const float*)d_in[i];
  p.out = (float*)d_out;
  p.ws = (char*)d_ws;
  hipMemsetAsync((char*)d_ws + WS_BAR, 0, XCD_BAR_WORDS * 4, stream);
  int lo = 0, hi = NPHASE;
  void* args[] = {&p, &lo, &hi};
  hipError_t e = hipLaunchCooperativeKernel((void*)mega, dim3(grid_blocks), dim3(256), args, 0, stream);
  if (e != hipSuccess) fprintf(stderr, "cooperative launch failed: %s (grid %d)\n", hipGetErrorString(e), grid_blocks);
}
```

```cpp
#include <hip/hip_runtime.h>
#include <hip/hip_cooperative_groups.h>
#include <stdint.h>
#include <string.h>
#include <stdio.h>
namespace cg = cooperative_groups;

#ifndef COOP
#define COOP 1
#endif

#ifndef FOX_PF
#define FOX_PF true
#endif
#ifndef MLA_PF
#define MLA_PF true
#endif
#ifndef LB_MIN
#define LB_MIN 2
#endif
#ifndef BM_BIG
#define BM_BIG 256
#endif
#define DI __device__ __forceinline__
typedef unsigned short u16;
typedef short s16x8 __attribute__((ext_vector_type(8)));
typedef short s16x4 __attribute__((ext_vector_type(4)));
typedef __bf16 bfx8 __attribute__((ext_vector_type(8)));
typedef __bf16 bfx2 __attribute__((ext_vector_type(2)));
typedef float f32x16 __attribute__((ext_vector_type(16)));
typedef float f32x4 __attribute__((ext_vector_type(4)));
typedef float f32x2 __attribute__((ext_vector_type(2)));
typedef unsigned u32x4 __attribute__((ext_vector_type(4)));
typedef unsigned u32x2 __attribute__((ext_vector_type(2)));

constexpr int DM = 1024, NB = 8, SEQ = 4096, NL = 2, DB = 32, DS = 32, PAST = 2048;
constexpr int TP = NB * SEQ;
constexpr int TS = DB * DS;
constexpr int TT = TP + TS;
constexpr int SKS = PAST + DS;
constexpr int KROWS = TP + DB * SKS;
constexpr int INC = 1992, INP = 2048;
constexpr int NMEM = 256, MB = NB + DB;
constexpr int DFF = 4096;

constexpr size_t O_Y = 0;
constexpr size_t O_FKP = (size_t)TT * DM;
constexpr size_t O_FVP = O_FKP + (size_t)NL * TP * 512;
constexpr size_t O_FLP = O_FVP + (size_t)NL * TP * 512;
constexpr size_t O_CKP = O_FLP + (size_t)NL * TP * 8;
constexpr size_t O_KRP = O_CKP + (size_t)NL * TP * 128;
constexpr size_t O_MKP = O_KRP + (size_t)NL * TP * 64;
constexpr size_t O_MVP = O_MKP + (size_t)NL * NB * NMEM * 1024;
constexpr size_t O_FKS = O_MVP + (size_t)NL * NB * NMEM * 1024;
constexpr size_t O_FVS = O_FKS + (size_t)NL * TS * 512;
constexpr size_t O_FLS = O_FVS + (size_t)NL * TS * 512;
constexpr size_t O_CKS = O_FLS + (size_t)NL * TS * 8;
constexpr size_t O_KRS = O_CKS + (size_t)NL * TS * 128;
constexpr size_t O_END = O_KRS + (size_t)NL * TS * 64;

constexpr size_t al256(size_t x) { return (x + 255) / 256 * 256; }
constexpr size_t WE_IN = 0;
constexpr size_t WE_UQ = WE_IN + (size_t)INP * 1024;
constexpr size_t WE_UKV = WE_UQ + (size_t)768 * 256;
constexpr size_t WE_OUT = WE_UKV + (size_t)1024 * 128;
constexpr size_t WE_XQ = WE_OUT + (size_t)1024 * 1024;
constexpr size_t WE_MKV = WE_XQ + (size_t)1024 * 1024;
constexpr size_t WE_XO = WE_MKV + (size_t)2048 * 1024;
constexpr size_t WE_UP = WE_XO + (size_t)1024 * 1024;
constexpr size_t WE_DN = WE_UP + (size_t)4096 * 1024;
constexpr size_t WE_LAYER = WE_DN + (size_t)1024 * 4096;
constexpr size_t WS_WT = 0;
constexpr size_t WS_ROPE = al256(WS_WT + WE_LAYER * 2 * NL);
constexpr size_t WS_ACTA = al256(WS_ROPE + (size_t)4096 * 32 * 8);
constexpr size_t WS_QF = al256(WS_ACTA + (size_t)TT * 1024 * 2);
constexpr size_t WS_FOXK = al256(WS_QF + (size_t)TT * 512 * 2);
constexpr size_t WS_FOXV = al256(WS_FOXK + (size_t)KROWS * 512 * 2);
constexpr size_t WS_CUM = al256(WS_FOXV + (size_t)KROWS * 512 * 2);
constexpr size_t WS_ZC = al256(WS_CUM + (size_t)KROWS * 8 * 4);
constexpr size_t WS_CQN = al256(WS_ZC + (size_t)TT * 448 * 4);
constexpr size_t WS_CKV = al256(WS_CQN + (size_t)TT * 256 * 2);
constexpr size_t WS_KROPE = al256(WS_CKV + (size_t)KROWS * 128 * 2);
constexpr size_t WS_MEMK = al256(WS_KROPE + (size_t)KROWS * 64 * 2);
constexpr size_t WS_MEMV = al256(WS_MEMK + (size_t)NL * MB * NMEM * 1024 * 2);
constexpr size_t WS_HMEM = al256(WS_MEMV + (size_t)NL * MB * NMEM * 1024 * 2);
constexpr size_t WS_R1 = al256(WS_HMEM + (size_t)NL * NB * NMEM * 1024 * 2);
constexpr size_t R1_KV = 0;
constexpr size_t R1_QM = al256((size_t)KROWS * 1024 * 2);
constexpr size_t R1_U = 0;
constexpr size_t R1_XQ = 0;
constexpr size_t WS_BAR = al256(WS_R1 + (size_t)TT * 4096 * 2);
constexpr size_t WS_END = al256(WS_BAR + 3456 * 4);
static_assert(R1_QM + (size_t)TT * 768 * 2 <= (size_t)TT * 4096 * 2, "R1 overflow");

constexpr int SMEM_BYTES = 65536;

struct Params {
  const float* in[28];
  float* out;
  char* ws;
  int wv;
  int pad;
};

DI int get_bid() { int t = blockIdx.x; asm volatile("" : "+s"(t)); return t; }
DI int get_nblk() { int t = gridDim.x; asm volatile("" : "+s"(t)); return t; }
DI int lane_id() { return (int)__builtin_amdgcn_mbcnt_hi(~0u, __builtin_amdgcn_mbcnt_lo(~0u, 0u)); }
DI int get_tid(int wv) { int t = (wv << 6) | lane_id(); asm volatile("" : "+v"(t)); return t; }
DI unsigned pk2(float a, float b) { f32x2 v = {a, b}; return __builtin_bit_cast(unsigned, __builtin_convertvector(v, bfx2)); }
DI u16 f2bf(float a) { return (u16)(pk2(a, 0.f) & 0xffffu); }
DI f32x16 mfma(s16x8 a, s16x8 b, f32x16 c) {
  return __builtin_amdgcn_mfma_f32_32x32x16_bf16(__builtin_bit_cast(bfx8, a), __builtin_bit_cast(bfx8, b), c, 0, 0, 0);
}
DI int crow(int i, int h) { return (i & 3) + 8 * (i >> 2) + 4 * h; }
DI float wave_sum(float v) {
#pragma unroll
  for (int m = 32; m >= 1; m >>= 1) v += __shfl_xor(v, m);
  return v;
}
DI float xhalf_max(float v) {
  auto rr = __builtin_amdgcn_permlane32_swap(__float_as_uint(v), __float_as_uint(v), false, false);
  return fmaxf(__uint_as_float(rr[0]), __uint_as_float(rr[1]));
}
DI float xhalf_sum(float v) {
  auto rr = __builtin_amdgcn_permlane32_swap(__float_as_uint(v), __float_as_uint(v), false, false);
  return __uint_as_float(rr[0]) + __uint_as_float(rr[1]);
}
DI int tok_krow(int tok) {
  if (tok < TP) return tok;
  const int s = tok - TP;
  return TP + (s >> 5) * SKS + PAST + (s & 31);
}
DI int tok_pos(int tok) { return tok < TP ? (tok & (SEQ - 1)) : PAST + ((tok - TP) & 31); }

enum { EPI_IN = 0, EPI_MEM, EPI_UQ, EPI_KV, EPI_RESID, EPI_XQ, EPI_UP, EPI_RESID0 };

template <int EPI, int MI>
DI void epilogue(const Params& P, int l, f32x16 (&acc)[MI][2], int mw, int nw, int r, int h) {
  float* out = P.out;
  char* ws = P.ws;
  if constexpr (EPI == EPI_IN) {
    u16* qf = (u16*)(ws + WS_QF);
    u16* fk = (u16*)(ws + WS_FOXK);
    u16* fv = (u16*)(ws + WS_FOXV);
    float* zc = (float*)(ws + WS_ZC);
    const float* bfg = P.in[12] + l * 8;
#pragma unroll
    for (int mi = 0; mi < MI; mi++) {
#pragma unroll
      for (int i = 0; i < 16; i++) {
        const int row = mw + mi * 32 + crow(i, h);
        const int kr = tok_krow(row);
        const bool isp = row < TP;
        const size_t orow = isp ? ((size_t)l * TP + row) : ((size_t)l * TS + (row - TP));
#pragma unroll
        for (int ni = 0; ni < 2; ni++) {
          const int col = nw + ni * 32 + r;
          const float v = acc[mi][ni][i];
          if (col < 512) {
            qf[(size_t)row * 512 + col] = f2bf(v);
          } else if (col < 1024) {
            const int c = col - 512;
            out[(isp ? O_FKP : O_FKS) + orow * 512 + c] = v;
            fk[(size_t)kr * 512 + c] = f2bf(v);
          } else if (col < 1536) {
            const int c = col - 1024;
            out[(isp ? O_FVP : O_FVS) + orow * 512 + c] = v;
            fv[(size_t)kr * 512 + c] = f2bf(v);
          } else if (col < 1544) {
            const int c = col - 1536;
            const float g = v + bfg[c];
            const float ls = fminf(g, 0.f) - __logf(1.f + __expf(-fabsf(g)));
            out[(isp ? O_FLP : O_FLS) + orow * 8 + c] = ls;
          } else if (col < INC) {
            zc[(size_t)row * 448 + (col - 1544)] = v;
          }
        }
      }
    }
  } else if constexpr (EPI == EPI_MEM) {
    u16* mk = (u16*)(ws + WS_MEMK);
    u16* mv = (u16*)(ws + WS_MEMV);
#pragma unroll
    for (int mi = 0; mi < MI; mi++) {
#pragma unroll
      for (int i = 0; i < 16; i++) {
        const int row = mw + mi * 32 + crow(i, h);
#pragma unroll
        for (int ni = 0; ni < 2; ni++) {
          const int col = nw + ni * 32 + r;
          const float v = acc[mi][ni][i];
          const int c = col & 1023;
          const size_t oidx = ((size_t)l * (NB * NMEM) + row) * 1024 + c;
          const size_t bidx = ((size_t)l * (MB * NMEM) + row) * 1024 + c;
          if (col < 1024) { out[O_MKP + oidx] = v; mk[bidx] = f2bf(v); }
          else { out[O_MVP + oidx] = v; mv[bidx] = f2bf(v); }
        }
      }
    }
  } else if constexpr (EPI == EPI_UQ) {
    u16* qm = (u16*)(ws + WS_R1 + R1_QM);
    const f32x2* rt = (const f32x2*)(ws + WS_ROPE);
    const bool isrope = (nw % 192) == 128;
#pragma unroll
    for (int mi = 0; mi < MI; mi++) {
#pragma unroll
      for (int i = 0; i < 16; i++) {
        const int row = mw + mi * 32 + crow(i, h);
        float x1 = acc[mi][0][i], x2 = acc[mi][1][i];
        if (isrope) {
          const f32x2 cs = rt[tok_pos(row) * 32 + r];
          const float o1 = x1 * cs[0] - x2 * cs[1];
          const float o2 = x2 * cs[0] + x1 * cs[1];
          x1 = o1; x2 = o2;
        }
        qm[(size_t)row * 768 + nw + r] = f2bf(x1);
        qm[(size_t)row * 768 + nw + 32 + r] = f2bf(x2);
      }
    }
  } else if constexpr (EPI == EPI_KV || EPI == EPI_XQ || EPI == EPI_UP) {
    u16* dst; int ld;
    if constexpr (EPI == EPI_KV) { dst = (u16*)(ws + WS_R1 + R1_KV); ld = 1024; }
    else if constexpr (EPI == EPI_XQ) { dst = (u16*)(ws + WS_R1 + R1_XQ); ld = 1024; }
    else { dst = (u16*)(ws + WS_R1 + R1_U); ld = DFF; }
#pragma unroll
    for (int mi = 0; mi < MI; mi++) {
#pragma unroll
      for (int i = 0; i < 16; i++) {
        const int row = mw + mi * 32 + crow(i, h);
#pragma unroll
        for (int ni = 0; ni < 2; ni++) {
          float v = acc[mi][ni][i];
          if constexpr (EPI == EPI_UP) { v = fmaxf(v, 0.f); v = v * v; }
          dst[(size_t)row * ld + nw + ni * 32 + r] = f2bf(v);
        }
      }
    }
  } else if constexpr (EPI == EPI_RESID || EPI == EPI_RESID0) {
#pragma unroll
    for (int mi = 0; mi < MI; mi++) {
#pragma unroll
      for (int i = 0; i < 16; i++) {
        const int row = mw + mi * 32 + crow(i, h);
#pragma unroll
        for (int ni = 0; ni < 2; ni++) {
          unsafeAtomicAdd(out + (size_t)row * DM + nw + ni * 32 + r, EPI == EPI_RESID0 ? acc[mi][ni][i] * 0.f : acc[mi][ni][i]);
        }
      }
    }
  }
}

enum { MASK_NONE = 0, MASK_FRAME = 1, MASK_CHUNK = 2 };
struct AttnJob {
  const u16* Q; int ldq;
  const u16* K1; int ldk1;
  const u16* K2; int ldk2;
  const u16* V; int ldv;
  u16* O; int ldo;
  const float* cq;
  const float* ck;
  int nq, Sk, qpos0;
  float scale_log2;
  int wv;
};

template <int DQK, int D1, int DVT, int MASK, bool BIAS, bool PREFETCH, int LDQ, int LDK1, int LDK2, int LDV, int LDO>
DI void attn_block(const AttnJob& J, char* smem) {
  constexpr int KP = DQK * 2 + 16;
  constexpr int VP = DVT * 2;
  constexpr int CV = DVT / 8;
  constexpr int NKK = DQK / 16, NDV = DVT / 32;
  constexpr float LOG2E = 1.4426950408889634f;
  char* Ks = smem;
  char* Vs = smem + 64 * KP;
  float* cks = (float*)(smem + 64 * KP + 64 * VP);
  const int tid = get_tid(J.wv), wave = tid >> 6, lane = tid & 63, r = lane & 31, h = lane >> 5;
  const int wq0 = wave * 32;
  const bool active = wq0 < J.nq;
  const int qi = wq0 + r;
  const int qpos = J.qpos0 + qi;
  const int wqmax = J.qpos0 + wq0 + 31;
  const int qmax = J.qpos0 + J.nq - 1;
  const int ntk = (J.Sk + 63) >> 6;
  int nt = ntk;
  if (MASK != MASK_NONE) { const int t2 = (qmax >> 6) + 1; nt = t2 < ntk ? t2 : ntk; }

  s16x8 qf[NKK];
  {
    const u16* qp = J.Q + (size_t)qi * LDQ + h * 8;
#pragma unroll
    for (int kk = 0; kk < NKK; kk++) {
      if (active) qf[kk] = *(const s16x8*)(qp + kk * 16);
      else { s16x8 z = {0, 0, 0, 0, 0, 0, 0, 0}; qf[kk] = z; }
    }
  }
  float cqv = 0.f;
  if (BIAS) { if (active) cqv = J.cq[(size_t)qi * 8] * LOG2E; }

  f32x16 o[NDV];
#pragma unroll
  for (int d = 0; d < NDV; d++)
#pragma unroll
    for (int i = 0; i < 16; i++) o[d][i] = 0.f;
  float m_run = -1e30f, l_run = 0.f;

  constexpr int CK1 = D1 / 8, CK2 = (DQK - D1) / 8;
  constexpr int RP1 = 256 / CK1, NP1 = 64 / RP1;
  constexpr int RP2 = CK2 ? 256 / (CK2 ? CK2 : 1) : 64, NP2 = CK2 ? 64 / RP2 : 0;
  constexpr int RPV = 256 / CV, NPV = 64 / RPV;
  u32x4 rk1[NP1], rk2[NP2 ? NP2 : 1], rv[NPV];
  float rck = 0.f;
  const int tq = (lane & 15) >> 2, tp = lane & 3, tblk = (lane >> 4) & 1;
  const int vswz = (DVT >= 128) ? tq : (tq >> 1);
  const int r1 = tid / CK1, c1 = tid % CK1;
  const int r2 = CK2 ? tid / (CK2 ? CK2 : 1) : 0, c2 = CK2 ? tid % (CK2 ? CK2 : 1) : 0;
  const int r3 = tid / CV, c3 = tid % CV;
  const unsigned k1o = (unsigned)(r1 * LDK1 + c1 * 8) * 2u;
  const unsigned k2o = (unsigned)(r2 * LDK2 + c2 * 8) * 2u;
  const unsigned vo = (unsigned)(r3 * LDV + c3 * 8) * 2u;
  const int k1so = r1 * KP + c1 * 16;
  const int k2so = r2 * KP + D1 * 2 + c2 * 16;
  const int vsw = (DVT >= 128) ? (r3 & 3) : ((r3 >> 1) & 1);
  const int vso = 64 * KP + r3 * VP + (((c3 >> 2) ^ vsw) * 64) + (c3 & 3) * 16;
  const int vro = 64 * KP + (4 * h + tq) * VP + (16 * tblk + 4 * tp) * 2;
  const int kro = r * KP + h * 16;

  auto load_tile = [&](int j) {
    const int kb = j * 64;
#pragma unroll
    for (int i = 0; i < NP1; i++) {
      u32x4 v = {0u, 0u, 0u, 0u};
      if (kb + r1 + i * RP1 < J.Sk) v = *(const u32x4*)((const char*)(J.K1 + (size_t)(kb + i * RP1) * LDK1) + k1o);
      rk1[i] = v;
    }
#pragma unroll
    for (int i = 0; i < NP2; i++) {
      u32x4 v = {0u, 0u, 0u, 0u};
      if (kb + r2 + i * RP2 < J.Sk) v = *(const u32x4*)((const char*)(J.K2 + (size_t)(kb + i * RP2) * LDK2) + k2o);
      rk2[i] = v;
    }
#pragma unroll
    for (int i = 0; i < NPV; i++) {
      u32x4 v = {0u, 0u, 0u, 0u};
      if (kb + r3 + i * RPV < J.Sk) v = *(const u32x4*)((const char*)(J.V + (size_t)(kb + i * RPV) * LDV) + vo);
      rv[i] = v;
    }
    if (BIAS) {
      if (tid < 64) { const int key = kb + tid; rck = key < J.Sk ? J.ck[(size_t)key * 8] * LOG2E : 0.f; }
    }
  };
  auto store_tile = [&]() {
    int a1 = k1so, a2 = k2so, a3 = vso;
    asm volatile("" : "+v"(a1), "+v"(a2), "+v"(a3));
#pragma unroll
    for (int i = 0; i < NP1; i++) *(u32x4*)(smem + a1 + i * RP1 * KP) = rk1[i];
#pragma unroll
    for (int i = 0; i < NP2; i++) *(u32x4*)(smem + a2 + i * RP2 * KP) = rk2[i];
#pragma unroll
    for (int i = 0; i < NPV; i++) *(u32x4*)(smem + a3 + i * RPV * VP) = rv[i];
    if (BIAS) { if (tid < 64) cks[tid] = rck; }
  };

  if (PREFETCH) load_tile(0);
  for (int j = 0; j < nt; j++) {
    __syncthreads();
    if (!PREFETCH) load_tile(j);
    store_tile();
    __syncthreads();
    if (PREFETCH) { if (j + 1 < nt) load_tile(j + 1); }
    const bool need = active && (MASK == MASK_NONE || j * 64 <= wqmax);
    if (need) {
      int kro_l = kro, vro_l = vro;
      asm volatile("" : "+v"(kro_l), "+v"(vro_l));
      const char* krd = smem + kro_l;
      const bool needmask = (MASK == MASK_FRAME && j * 64 + 63 > J.qpos0 + wq0) || (j * 64 + 63 >= J.Sk);
      const int dq = (MASK == MASK_FRAME ? min(qpos, J.Sk - 1) : J.Sk - 1) - j * 64 - 4 * h;
#pragma unroll
      for (int hb = 0; hb < 2; hb++) {
        if (MASK == MASK_FRAME && j * 64 + hb * 32 > wqmax) continue;
        f32x16 p;
#pragma unroll
        for (int i = 0; i < 16; i++) p[i] = 0.f;
#pragma unroll
        for (int kk = 0; kk < NKK; kk++) {
          const s16x8 kf = *(const s16x8*)(krd + hb * 32 * KP + kk * 32);
          p = mfma(kf, qf[kk], p);
        }
        if (BIAS) {
#pragma unroll
          for (int g = 0; g < 4; g++) {
            const f32x4 c0 = *(const f32x4*)(cks + hb * 32 + 8 * g + 4 * h);
#pragma unroll
            for (int e = 0; e < 4; e++) p[4 * g + e] = fmaf(p[4 * g + e], J.scale_log2, cqv - c0[e]);
          }
        } else {
#pragma unroll
          for (int i = 0; i < 16; i++) p[i] *= J.scale_log2;
        }
        if (needmask) {
#pragma unroll
          for (int i = 0; i < 16; i++) {
            const int cc = (i & 3) + 8 * (i >> 2) + 32 * hb;
            p[i] = (cc <= dq) ? p[i] : -1e30f;
          }
        }
        float mx = p[0];
#pragma unroll
        for (int i = 1; i < 16; i++) mx = fmaxf(mx, p[i]);
        mx = xhalf_max(mx);
        const float m_new = fmaxf(m_run, mx);
        const float alpha = __builtin_amdgcn_exp2f(m_run - m_new);
        m_run = m_new;
        float ps = 0.f;
#pragma unroll
        for (int i = 0; i < 16; i++) { p[i] = __builtin_amdgcn_exp2f(p[i] - m_new); ps += p[i]; }
        l_run = l_run * alpha + ps;
        if (__any(alpha != 1.f)) {
#pragma unroll
          for (int d = 0; d < NDV; d++)
#pragma unroll
            for (int i = 0; i < 16; i++) o[d][i] *= alpha;
        }
        s16x8 pb[2];
        {
          u32x4 w;
          w[0] = pk2(p[0], p[1]); w[1] = pk2(p[2], p[3]); w[2] = pk2(p[4], p[5]); w[3] = pk2(p[6], p[7]);
          pb[0] = __builtin_bit_cast(s16x8, w);
          w[0] = pk2(p[8], p[9]); w[1] = pk2(p[10], p[11]); w[2] = pk2(p[12], p[13]); w[3] = pk2(p[14], p[15]);
          pb[1] = __builtin_bit_cast(s16x8, w);
        }
#pragma unroll
        for (int d = 0; d < NDV; d++) {
          const char* vb = smem + (vro_l + ((d ^ vswz) * 64)) + hb * 32 * VP;
#pragma unroll
          for (int s = 0; s < 2; s++) {
            const s16x4 lo = __builtin_amdgcn_ds_read_tr16_b64_v4i16(
                (__attribute__((address_space(3))) s16x4*)(uintptr_t)(vb + (16 * s) * VP));
            const s16x4 hi = __builtin_amdgcn_ds_read_tr16_b64_v4i16(
                (__attribute__((address_space(3))) s16x4*)(uintptr_t)(vb + (16 * s + 8) * VP));
            const s16x8 vf = __builtin_shufflevector(lo, hi, 0, 1, 2, 3, 4, 5, 6, 7);
            o[d] = mfma(vf, pb[s], o[d]);
          }
        }
      }
    }
  }
  const float lt = xhalf_sum(l_run);
  if (active && qi < J.nq) {
    const float inv = 1.f / lt;
    u16* op = J.O + (size_t)qi * LDO + 4 * h;
#pragma unroll
    for (int d = 0; d < NDV; d++) {
#pragma unroll
      for (int g = 0; g < 4; g++) {
        u32x2 w;
        w[0] = pk2(o[d][4 * g] * inv, o[d][4 * g + 1] * inv);
        w[1] = pk2(o[d][4 * g + 2] * inv, o[d][4 * g + 3] * inv);
        *(u32x2*)(op + d * 32 + 8 * g) = w;
      }
    }
  }
}

template <int NR, bool F32OUT>
DI void rms_rows(const float* __restrict__ xbase, size_t rstride, int nvalid, const float* __restrict__ g, void* dbase, size_t dstride, int lane) {
  f32x4 v[NR][4];
#pragma unroll
  for (int j = 0; j < NR; j++)
#pragma unroll
    for (int i = 0; i < 4; i++) {
      if (j < nvalid) v[j][i] = *(const f32x4*)(xbase + (size_t)j * rstride + i * 256 + lane * 4);
      else { f32x4 z = {0.f, 0.f, 0.f, 0.f}; v[j][i] = z; }
    }
  f32x4 gg[4];
#pragma unroll
  for (int i = 0; i < 4; i++) gg[i] = *(const f32x4*)(g + i * 256 + lane * 4);
#pragma unroll
  for (int j = 0; j < NR; j++) {
    float ss = 0.f;
#pragma unroll
    for (int i = 0; i < 4; i++) ss += v[j][i][0] * v[j][i][0] + v[j][i][1] * v[j][i][1] + v[j][i][2] * v[j][i][2] + v[j][i][3] * v[j][i][3];
    ss = wave_sum(ss);
    const float rs = rsqrtf(ss * (1.f / 1024.f) + 1e-6f);
    if (j < nvalid) {
#pragma unroll
      for (int i = 0; i < 4; i++) {
        if (F32OUT) {
          f32x4 w;
          w[0] = v[j][i][0] * rs * gg[i][0]; w[1] = v[j][i][1] * rs * gg[i][1]; w[2] = v[j][i][2] * rs * gg[i][2]; w[3] = v[j][i][3] * rs * gg[i][3];
          *(f32x4*)((float*)dbase + (size_t)j * dstride + i * 256 + lane * 4) = w;
        } else {
          u32x2 w;
          w[0] = pk2(v[j][i][0] * rs * gg[i][0], v[j][i][1] * rs * gg[i][1]);
          w[1] = pk2(v[j][i][2] * rs * gg[i][2], v[j][i][3] * rs * gg[i][3]);
          *(u32x2*)((u16*)dbase + (size_t)j * dstride + i * 256 + lane * 4) = w;
        }
      }
    }
  }
}

DI void cvt_job(const float* __restrict__ src, u16* __restrict__ dst, int nseg, size_t seglen, size_t sstride, size_t dstride, int wv) {
  const size_t upseg = seglen / 8;
  const size_t total = upseg * nseg;
  const size_t stride = (size_t)get_nblk() * 256;
  for (size_t u0 = (size_t)get_bid() * 256 + get_tid(wv); u0 < total; u0 += 4 * stride) {
    f32x4 a[4], b[4];
    size_t so[4], dd[4];
#pragma unroll
    for (int q = 0; q < 4; q++) {
      const size_t u = u0 + q * stride;
      const size_t uu = u < total ? u : u0;
      const size_t sg = uu / upseg, off = (uu - sg * upseg) * 8;
      so[q] = sg * sstride + off; dd[q] = sg * dstride + off;
      a[q] = *(const f32x4*)(src + so[q]);
      b[q] = *(const f32x4*)(src + so[q] + 4);
    }
#pragma unroll
    for (int q = 0; q < 4; q++) {
      if (u0 + q * stride < total) {
        u32x4 w;
        w[0] = pk2(a[q][0], a[q][1]); w[1] = pk2(a[q][2], a[q][3]); w[2] = pk2(b[q][0], b[q][1]); w[3] = pk2(b[q][2], b[q][3]);
        *(u32x4*)(dst + dd[q]) = w;
      }
    }
  }
}

DI void transpose_job(const float* __restrict__ src, u16* __restrict__ dst, int K, int N, int Npad, int& rot, char* smem, int wv) {
  float* tile = (float*)smem;
  const int tk = K / 64, tn = Npad / 64, ntiles = tk * tn;
  const int G = get_nblk();
  const int tid = get_tid(wv);
  for (int t = (get_bid() + G - (rot % G)) % G; t < ntiles; t += G) {
    const int k0 = (t % tk) * 64, n0 = (t / tk) * 64;
    float v[16];
#pragma unroll
    for (int i = 0; i < 16; i++) {
      const int k = i * 4 + (tid >> 6), n = tid & 63;
      v[i] = (n0 + n < N) ? src[(size_t)(k0 + k) * N + n0 + n] : 0.f;
    }
    __syncthreads();
#pragma unroll
    for (int i = 0; i < 16; i++) {
      const int k = i * 4 + (tid >> 6), n = tid & 63;
      tile[k * 65 + n] = v[i];
    }
    __syncthreads();
#pragma unroll
    for (int i = 0; i < 8; i++) {
      const int n = i * 8 + (tid >> 5), k = (tid & 31) * 2;
      *(unsigned*)(dst + (size_t)(n0 + n) * K + k0 + k) = pk2(tile[k * 65 + n], tile[(k + 1) * 65 + n]);
    }
  }
  rot += ntiles;
}

DI u16* wt_ptr(const Params& P, int l, size_t eoff) { return (u16*)(P.ws + WS_WT) + (size_t)l * WE_LAYER + eoff; }

DI void phase_prep(const Params& P, char* smem) {
  const int tid = get_tid(P.wv), lane = tid & 63;
  const int gw = get_bid() * 4 + (tid >> 6), nw = get_nblk() * 4;
  int rot = 0;
  for (int l = 0; l < NL; l++) {
    transpose_job(P.in[11] + (size_t)l * 1024 * INC, wt_ptr(P, l, WE_IN), 1024, INC, INP, rot, smem, P.wv);
    transpose_job(P.in[14] + (size_t)l * 256 * 768, wt_ptr(P, l, WE_UQ), 256, 768, 768, rot, smem, P.wv);
    transpose_job(P.in[16] + (size_t)l * 128 * 1024, wt_ptr(P, l, WE_UKV), 128, 1024, 1024, rot, smem, P.wv);
    transpose_job(P.in[17] + (size_t)l * 1024 * 1024, wt_ptr(P, l, WE_OUT), 1024, 1024, 1024, rot, smem, P.wv);
    transpose_job(P.in[20] + (size_t)l * 1024 * 1024, wt_ptr(P, l, WE_XQ), 1024, 1024, 1024, rot, smem, P.wv);
    transpose_job(P.in[21] + (size_t)l * 1024 * 1024, wt_ptr(P, l, WE_MKV), 1024, 1024, 1024, rot, smem, P.wv);
    transpose_job(P.in[22] + (size_t)l * 1024 * 1024, wt_ptr(P, l, WE_MKV) + (size_t)1024 * 1024, 1024, 1024, 1024, rot, smem, P.wv);
    transpose_job(P.in[23] + (size_t)l * 1024 * 1024, wt_ptr(P, l, WE_XO), 1024, 1024, 1024, rot, smem, P.wv);
    transpose_job(P.in[25] + (size_t)l * 1024 * 4096, wt_ptr(P, l, WE_UP), 1024, 4096, 4096, rot, smem, P.wv);
    transpose_job(P.in[26] + (size_t)l * 4096 * 1024, wt_ptr(P, l, WE_DN), 4096, 1024, 1024, rot, smem, P.wv);
  }
  {
    f32x2* rt = (f32x2*)(P.ws + WS_ROPE);
    for (int i = get_bid() * 256 + tid; i < 4096 * 32; i += get_nblk() * 256) {
      const int pos = i >> 5, j = i & 31;
      const float inv = powf(10000.f, -(float)j / 32.f);
      const float ang = (float)pos * inv;
      f32x2 cs; cs[0] = cosf(ang); cs[1] = sinf(ang);
      rt[i] = cs;
    }
  }
  for (int l = 0; l < NL; l++) {
    const size_t seg = (size_t)DB * NMEM * 1024;
    cvt_job(P.in[8] + l * seg, (u16*)(P.ws + WS_MEMK) + ((size_t)l * MB + NB) * NMEM * 1024, 1, seg, 0, 0, P.wv);
    cvt_job(P.in[9] + l * seg, (u16*)(P.ws + WS_MEMV) + ((size_t)l * MB + NB) * NMEM * 1024, 1, seg, 0, 0, P.wv);
  }
  for (int rr = gw; rr < NL * NB * NMEM; rr += nw) {
    const int l = rr / (NB * NMEM), row = rr % (NB * NMEM);
    rms_rows<1, false>(P.in[2] + (size_t)row * 1024, 0, 1, P.in[19] + l * 1024, (u16*)(P.ws + WS_HMEM) + (size_t)rr * 1024, 0, lane);
  }
  {
    const size_t n4 = (size_t)TT * 256;
    const size_t np4 = (size_t)TP * 256;
    const size_t stride = (size_t)get_nblk() * 256;
    for (size_t i0 = (size_t)get_bid() * 256 + tid; i0 < n4; i0 += 4 * stride) {
      f32x4 v[4];
#pragma unroll
      for (int q = 0; q < 4; q++) {
        const size_t i = i0 + q * stride;
        const size_t ii = i < n4 ? i : i0;
        v[q] = (ii < np4) ? *(const f32x4*)(P.in[0] + ii * 4) : *(const f32x4*)(P.in[1] + (ii - np4) * 4);
      }
#pragma unroll
      for (int q = 0; q < 4; q++) {
        const size_t i = i0 + q * stride;
        if (i < n4) *(f32x4*)(P.out + i * 4) = v[q];
      }
    }
  }
}

DI void phase_norm(const Params& P, const float* g, int cache_layer) {
  const int tid = get_tid(P.wv), lane = tid & 63;
  const int gw = get_bid() * 4 + (tid >> 6), nw = get_nblk() * 4;
  u16* h = (u16*)(P.ws + WS_ACTA);
  for (int row = gw; row < TT; row += 4 * nw) {
    const int nv = (TT - row + nw - 1) / nw;
    rms_rows<4, false>(P.out + (size_t)row * 1024, (size_t)nw * 1024, nv < 4 ? nv : 4, g, h + (size_t)row * 1024, (size_t)nw * 1024, lane);
  }
  if (cache_layer >= 0) {
    const int l = cache_layer;
    cvt_job(P.in[3] + (size_t)l * DB * PAST * 512, (u16*)(P.ws + WS_FOXK) + (size_t)TP * 512, DB, (size_t)PAST * 512, (size_t)PAST * 512, (size_t)SKS * 512, P.wv);
    cvt_job(P.in[4] + (size_t)l * DB * PAST * 512, (u16*)(P.ws + WS_FOXV) + (size_t)TP * 512, DB, (size_t)PAST * 512, (size_t)PAST * 512, (size_t)SKS * 512, P.wv);
    cvt_job(P.in[6] + (size_t)l * DB * PAST * 128, (u16*)(P.ws + WS_CKV) + (size_t)TP * 128, DB, (size_t)PAST * 128, (size_t)PAST * 128, (size_t)SKS * 128, P.wv);
    cvt_job(P.in[7] + (size_t)l * DB * PAST * 64, (u16*)(P.ws + WS_KROPE) + (size_t)TP * 64, DB, (size_t)PAST * 64, (size_t)PAST * 64, (size_t)SKS * 64, P.wv);
  }
}

DI void phase_final(const Params& P) {
  const int tid = get_tid(P.wv), lane = tid & 63;
  const int gw = get_bid() * 4 + (tid >> 6), nw = get_nblk() * 4;
  const float* g = P.in[27];
  for (int row = gw; row < TT; row += 4 * nw) {
    const int nv = (TT - row + nw - 1) / nw;
    rms_rows<4, true>(P.out + (size_t)row * 1024, (size_t)nw * 1024, nv < 4 ? nv : 4, g, P.out + (size_t)row * 1024, (size_t)nw * 1024, lane);
  }
}

DI void phase_post(const Params& P, int l, char* smem) {
  const int tid = get_tid(P.wv), lane = tid & 63;
  const int gw = get_bid() * 4 + (tid >> 6), nw = get_nblk() * 4;
  const float* zc = (const float*)(P.ws + WS_ZC);
  u16* cqn = (u16*)(P.ws + WS_CQN);
  u16* ckv = (u16*)(P.ws + WS_CKV);
  u16* krp = (u16*)(P.ws + WS_KROPE);
  const f32x2* rt = (const f32x2*)(P.ws + WS_ROPE);
  const float* gq = P.in[13] + l * 256;
  const float* gkv = P.in[15] + l * 128;
  for (int tok0 = gw; tok0 < TT; tok0 += 4 * nw) {
    f32x4 vq[4]; f32x2 vk[4]; float vr[4];
#pragma unroll
    for (int j = 0; j < 4; j++) {
      const int tk = tok0 + j * nw;
      const float* z = zc + (size_t)(tk < TT ? tk : tok0) * 448;
      vq[j] = *(const f32x4*)(z + lane * 4);
      vk[j] = *(const f32x2*)(z + 256 + lane * 2);
      vr[j] = z[384 + lane];
    }
    const f32x4 ggq = *(const f32x4*)(gq + lane * 4);
    const f32x2 ggk = *(const f32x2*)(gkv + lane * 2);
#pragma unroll
    for (int j = 0; j < 4; j++) {
      const int tok = tok0 + j * nw;
      if (tok >= TT) break;
      const bool isp = tok < TP;
      const size_t orow = isp ? ((size_t)l * TP + tok) : ((size_t)l * TS + (tok - TP));
      const int kr = tok_krow(tok);
      {
        const f32x4 v = vq[j];
        const float ss = wave_sum(v[0] * v[0] + v[1] * v[1] + v[2] * v[2] + v[3] * v[3]);
        const float rs = rsqrtf(ss * (1.f / 256.f) + 1e-6f);
        u32x2 w;
        w[0] = pk2(v[0] * rs * ggq[0], v[1] * rs * ggq[1]);
        w[1] = pk2(v[2] * rs * ggq[2], v[3] * rs * ggq[3]);
        *(u32x2*)(cqn + (size_t)tok * 256 + lane * 4) = w;
      }
      {
        const f32x2 v = vk[j];
        const float ss = wave_sum(v[0] * v[0] + v[1] * v[1]);
        const float rs = rsqrtf(ss * (1.f / 128.f) + 1e-6f);
        f32x2 o; o[0] = v[0] * rs * ggk[0]; o[1] = v[1] * rs * ggk[1];
        *(f32x2*)(P.out + (isp ? O_CKP : O_CKS) + orow * 128 + lane * 2) = o;
        *(unsigned*)(ckv + (size_t)kr * 128 + lane * 2) = pk2(o[0], o[1]);
      }
      {
        const float x = vr[j];
        const float y = __shfl_xor(x, 32);
        const f32x2 cs = rt[tok_pos(tok) * 32 + (lane & 31)];
        const float o = (lane < 32) ? (x * cs[0] - y * cs[1]) : (x * cs[0] + y * cs[1]);
        P.out[(isp ? O_KRP : O_KRS) + orow * 64 + lane] = o;
        krp[(size_t)kr * 64 + lane] = f2bf(o);
      }
    }
  }
  float* cum = (float*)(P.ws + WS_CUM);
  float* wtot = (float*)smem;
  const int wave = tid >> 6;
  for (int it = get_bid(); it < NB + DB; it += get_nblk()) {
    const bool isp = it < NB;
    const int b = isp ? it : it - NB;
    const int ppt = isp ? 16 : 9;
    const int npos = isp ? SEQ : SKS;
    const float* srcA; const float* srcB; int nA;
    size_t krow0;
    if (isp) { srcA = P.out + O_FLP + ((size_t)l * TP + (size_t)b * SEQ) * 8; srcB = srcA; nA = SEQ; krow0 = (size_t)b * SEQ; }
    else {
      srcA = P.in[5] + ((size_t)l * DB + b) * PAST * 8;
      srcB = P.out + O_FLS + ((size_t)l * TS + (size_t)b * DS) * 8 - (size_t)PAST * 8;
      nA = PAST; krow0 = (size_t)TP + (size_t)b * SKS;
    }
    const int p0 = tid * ppt;
    f32x4 va[16], vb[16];
#pragma unroll
    for (int j = 0; j < 16; j++) {
      const int p = p0 + j;
      f32x4 z = {0.f, 0.f, 0.f, 0.f};
      va[j] = z; vb[j] = z;
      if (j < ppt && p < npos) {
        const float* s = (p < nA ? srcA : srcB) + (size_t)p * 8;
        va[j] = *(const f32x4*)s; vb[j] = *(const f32x4*)(s + 4);
      }
    }
#pragma unroll
    for (int j = 1; j < 16; j++) { va[j] += va[j - 1]; vb[j] += vb[j - 1]; }
    f32x4 ta = va[15], tb = vb[15];
#pragma unroll
    for (int d = 1; d < 64; d <<= 1) {
#pragma unroll
      for (int e = 0; e < 4; e++) {
        const float ua = __shfl_up(ta[e], d), ub = __shfl_up(tb[e], d);
        if (lane >= d) { ta[e] += ua; tb[e] += ub; }
      }
    }
    __syncthreads();
    if (lane == 63) { *(f32x4*)(wtot + wave * 8) = ta; *(f32x4*)(wtot + wave * 8 + 4) = tb; }
    __syncthreads();
    f32x4 pa = ta - va[15], pb = tb - vb[15];
    for (int w2 = 0; w2 < wave; w2++) { pa += *(const f32x4*)(wtot + w2 * 8); pb += *(const f32x4*)(wtot + w2 * 8 + 4); }
#pragma unroll
    for (int j = 0; j < 16; j++) {
      const int p = p0 + j;
      if (j < ppt && p < npos) {
        float* d = cum + (krow0 + p) * 8;
        *(f32x4*)d = va[j] + pa; *(f32x4*)(d + 4) = vb[j] + pb;
      }
    }
  }
}

template <int EPI, int BM>
DI void gemm_phase(const Params& P, int l, const u16* __restrict__ A, int lda, const u16* __restrict__ Bt, int ldb, int K, int M, int N,
                   char* smem, int& rot) {
  constexpr int MI = BM / 64;
  constexpr int STAGE = (BM + 128) * 64;
  constexpr int NSLOT = 65536 / STAGE;
  constexpr int DEPTH = NSLOT - 1;
  constexpr int GPS = MI + 2;
  constexpr int SM = (BM == 256) ? 4 : 8, SNN = 64 / SM;
  const int tid = get_tid(P.wv), wave = tid >> 6, lane = tid & 63, r = lane & 31, h = lane >> 5;
  const int wm = wave >> 1, wn = wave & 1;
  const int TM = M / BM, TN = N >> 7;
  const int G = get_nblk();
  const int bid = get_bid();
  const bool sup = (G == 512) && ((TN % SNN) == 0) && ((TM % SM) == 0);
  const int SN = TN / SNN;
  const int nunits = sup ? (TM / SM) * SN : TM * TN;
  const int ustep = sup ? 8 : G;
  const int slot8 = bid >> 3;
  int u = sup ? (int)((bid + 8 - (rot & 7)) & 7) : (int)((bid + G - (rot % G)) % G);
  rot += nunits;
  if (u >= nunits) return;
  const int lrow = tid >> 2, lc = tid & 3;
  const int pc = (lc ^ ((tid >> 4) & 3)) * 8;
  const int nk = K >> 5;
  const int sw = (r >> 2) & 3;
  const int xo0 = ((0 + h) ^ sw) * 16, xo1 = ((2 + h) ^ sw) * 16;
  const int aro = (wm * (BM / 2) + r) * 64, bro = BM * 64 + (wn * 64 + r) * 64;
  auto tile_of = [&](int uu, int& m0, int& n0) {
    if (sup) { const int sm = uu / SN, sn = uu - sm * SN; m0 = (sm * SM + (slot8 / SNN)) * BM; n0 = (sn * SNN + (slot8 % SNN)) << 7; }
    else { const int mt = uu / TN; m0 = mt * BM; n0 = (uu - mt * TN) << 7; }
  };
  auto issue = [&](int m0, int n0, int ks, int slot) {
    const u16* ag = A + (size_t)(m0 + lrow) * lda + pc + ks * 32;
    const u16* bg = Bt + (size_t)(n0 + lrow) * ldb + pc + ks * 32;
    char* dst = smem + slot * STAGE + tid * 16;
#pragma unroll
    for (int i = 0; i < MI; i++)
      __builtin_amdgcn_global_load_lds((const unsigned*)(ag + (size_t)i * 64 * lda), (__attribute__((address_space(3))) unsigned*)(dst + i * 4096), 16, 0, 0);
#pragma unroll
    for (int i = 0; i < 2; i++)
      __builtin_amdgcn_global_load_lds((const unsigned*)(bg + (size_t)i * 64 * ldb), (__attribute__((address_space(3))) unsigned*)(dst + BM * 64 + i * 4096), 16, 0, 0);
  };
  int m0, n0;
  tile_of(u, m0, n0);
  int ui = u, ki = 0, mi0 = m0, ni0 = n0;
  bool idone = false;
  int pend = 0;
  unsigned g = 0;
  asm volatile("s_waitcnt vmcnt(0) lgkmcnt(0)" ::: "memory");
  __builtin_amdgcn_s_barrier();
#pragma unroll 1
  for (int s = 0; s < DEPTH; s++) {
    if (!idone) {
      issue(mi0, ni0, ki, (g + pend) % NSLOT);
      pend++;
      if (++ki == nk) { ki = 0; ui += ustep; if (ui < nunits) tile_of(ui, mi0, ni0); else idone = true; }
    }
  }
  while (true) {
    f32x16 acc[MI][2];
#pragma unroll
    for (int a = 0; a < MI; a++)
#pragma unroll
      for (int b = 0; b < 2; b++)
#pragma unroll
        for (int i = 0; i < 16; i++) acc[a][b][i] = 0.f;
#pragma unroll 1
    for (int kt = 0; kt < nk; kt++) {
      if (DEPTH == 3) {
        if (pend >= 3) asm volatile("s_waitcnt vmcnt(8)" ::: "memory");
        else if (pend == 2) asm volatile("s_waitcnt vmcnt(4)" ::: "memory");
        else asm volatile("s_waitcnt vmcnt(0)" ::: "memory");
      } else {
        asm volatile("s_waitcnt vmcnt(0)" ::: "memory");
      }
      asm volatile("s_waitcnt lgkmcnt(0)" ::: "memory");
      __builtin_amdgcn_s_barrier();
      if (DEPTH == 1) pend = 0;
      if (!idone) {
        issue(mi0, ni0, ki, (g + (DEPTH == 1 ? 1 : pend)) % NSLOT);
        if (DEPTH == 1) pend = 1;
        if (++ki == nk) { ki = 0; ui += ustep; if (ui < nunits) tile_of(ui, mi0, ni0); else idone = true; }
      } else {
        if (DEPTH != 1) pend--;
      }
      const char* sb = smem + (g % NSLOT) * STAGE;
      g++;
      {
        s16x8 a[MI], a2[MI];
#pragma unroll
        for (int i = 0; i < MI; i++) { a[i] = *(const s16x8*)(sb + aro + i * 32 * 64 + xo0); a2[i] = *(const s16x8*)(sb + aro + i * 32 * 64 + xo1); }
        const s16x8 b0 = *(const s16x8*)(sb + bro + xo0);
        const s16x8 b1 = *(const s16x8*)(sb + bro + 32 * 64 + xo0);
        const s16x8 b2 = *(const s16x8*)(sb + bro + xo1);
        const s16x8 b3 = *(const s16x8*)(sb + bro + 32 * 64 + xo1);
#pragma unroll
        for (int i = 0; i < MI; i++) { acc[i][0] = mfma(a[i], b0, acc[i][0]); acc[i][1] = mfma(a[i], b1, acc[i][1]); }
#pragma unroll
        for (int i = 0; i < MI; i++) { acc[i][0] = mfma(a2[i], b2, acc[i][0]); acc[i][1] = mfma(a2[i], b3, acc[i][1]); }
      }
    }
    epilogue<EPI, MI>(P, l, acc, m0 + wm * (BM / 2), n0 + wn * 64, r, h);
    u += ustep;
    if (u >= nunits) break;
    tile_of(u, m0, n0);
  }
  asm volatile("s_waitcnt vmcnt(0) lgkmcnt(0)" ::: "memory");
}

DI void phase_attn(const Params& P, int l, char* smem) {
  const u16* qf = (const u16*)(P.ws + WS_QF);
  const u16* fk = (const u16*)(P.ws + WS_FOXK);
  const u16* fv = (const u16*)(P.ws + WS_FOXV);
  const float* cum = (const float*)(P.ws + WS_CUM);
  const u16* qm = (const u16*)(P.ws + WS_R1 + R1_QM);
  const u16* kv = (const u16*)(P.ws + WS_R1 + R1_KV);
  const u16* krp = (const u16*)(P.ws + WS_KROPE);
  u16* mixed = (u16*)(P.ws + WS_ACTA);
  constexpr float LOG2E = 1.4426950408889634f;
  const int total = 384 + 32 * 96;
  for (int t = get_bid(); t < total; t += get_nblk()) {
    bool isfox, issample; int b, hd, qb = 0;
    if (t < 256) { isfox = true; issample = true; b = t >> 3; hd = t & 7; }
    else if (t < 384) { isfox = false; issample = true; const int u = t - 256; b = u >> 2; hd = u & 3; }
    else {
      const int u = t - 384; const int grp = u / 96; int w = u % 96; qb = 31 - grp; issample = false;
      if (w < 32) { isfox = false; b = w >> 2; hd = w & 3; }
      else { w -= 32; isfox = true; b = w >> 3; hd = w & 7; }
    }
    AttnJob J;
    J.wv = P.wv;
    size_t tok0, krow0;
    if (issample) { tok0 = (size_t)TP + (size_t)b * DS; krow0 = (size_t)TP + (size_t)b * SKS; J.nq = DS; J.Sk = SKS; J.qpos0 = PAST; }
    else { tok0 = (size_t)b * SEQ + (size_t)qb * 128; krow0 = (size_t)b * SEQ; J.nq = 128; J.Sk = SEQ; J.qpos0 = qb * 128; }
    if (isfox) {
      J.Q = qf + tok0 * 512 + hd * 64; J.ldq = 512;
      J.K1 = fk + krow0 * 512 + hd * 64; J.ldk1 = 512; J.K2 = J.K1; J.ldk2 = 512;
      J.V = fv + krow0 * 512 + hd * 64; J.ldv = 512;
      J.O = mixed + tok0 * 1024 + hd * 64; J.ldo = 1024;
      J.cq = cum + (krow0 + (size_t)J.qpos0) * 8 + hd;
      J.ck = cum + krow0 * 8 + hd;
      J.scale_log2 = 0.125f * LOG2E;
      attn_block<64, 64, 64, MASK_FRAME, true, FOX_PF, 512, 512, 512, 512, 1024>(J, smem);
    } else {
      J.Q = qm + tok0 * 768 + hd * 192; J.ldq = 768;
      J.K1 = kv + krow0 * 1024 + hd * 256; J.ldk1 = 1024;
      J.K2 = krp + krow0 * 64; J.ldk2 = 64;
      J.V = kv + krow0 * 1024 + hd * 256 + 128; J.ldv = 1024;
      J.O = mixed + tok0 * 1024 + 512 + hd * 128; J.ldo = 1024;
      J.cq = nullptr; J.ck = nullptr;
      J.scale_log2 = 0.07216878364870322f * LOG2E;
      attn_block<192, 128, 128, MASK_CHUNK, false, MLA_PF, 768, 1024, 64, 1024, 1024>(J, smem);
    }
  }
}

DI void phase_cross(const Params& P, int l, char* smem) {
  const u16* xq = (const u16*)(P.ws + WS_R1 + R1_XQ);
  const u16* mk = (const u16*)(P.ws + WS_MEMK) + (size_t)l * MB * NMEM * 1024;
  const u16* mv = (const u16*)(P.ws + WS_MEMV) + (size_t)l * MB * NMEM * 1024;
  u16* xo = (u16*)(P.ws + WS_ACTA);
  constexpr float LOG2E = 1.4426950408889634f;
  const int nsamp = DB * 4 * 2;
  const int total = nsamp + 256 * 4 * 2;
  for (int t = get_bid(); t < total; t += get_nblk()) {
    AttnJob J;
    J.wv = P.wv;
    size_t tok0; int mb, hd, half;
    if (t < nsamp) { const int b = t >> 3; hd = (t >> 1) & 3; half = t & 1; tok0 = (size_t)TP + (size_t)b * DS; mb = NB + b; J.nq = DS; }
    else { const int u = t - nsamp; const int qbk = u >> 3; hd = (u >> 1) & 3; half = u & 1; tok0 = (size_t)qbk * 128; mb = qbk >> 5; J.nq = 128; }
    J.Sk = NMEM; J.qpos0 = 0;
    J.Q = xq + tok0 * 1024 + hd * 256; J.ldq = 1024;
    J.K1 = mk + (size_t)mb * NMEM * 1024 + hd * 256; J.ldk1 = 1024; J.K2 = J.K1; J.ldk2 = 1024;
    J.V = mv + (size_t)mb * NMEM * 1024 + hd * 256 + half * 128; J.ldv = 1024;
    J.O = xo + tok0 * 1024 + hd * 256 + half * 128; J.ldo = 1024;
    J.cq = nullptr; J.ck = nullptr;
    J.scale_log2 = 0.0625f * LOG2E;
    attn_block<256, 256, 128, MASK_NONE, false, false, 1024, 1024, 1024, 1024, 1024>(J, smem);
  }
}

#define XB_TMO      128
#define XB_XCNT(j)  (256  + 64 * (j))
#define XB_XSUB(j)  (1280 + 64 * (j))
#define XB_XGEN(j)  (2304 + 64 * (j))
#define XB_TOP      3328
#define XB_TOPGEN   3392
#define XCD_BAR_WORDS 3456
#define XB_SPIN_CAP (1u << 20)
DI unsigned xb_ld(unsigned* p) { return __hip_atomic_load(p, __ATOMIC_RELAXED, __HIP_MEMORY_SCOPE_AGENT); }
DI unsigned xb_add(unsigned* p, unsigned v) { return __hip_atomic_fetch_add(p, v, __ATOMIC_RELAXED, __HIP_MEMORY_SCOPE_AGENT); }
DI unsigned xb_xcc_id() { return (unsigned)__builtin_amdgcn_s_getreg((3 << 11) | 20) & 0xFu; }
#define XB_SPIN(cond, bar) do { unsigned _sp = 0; while (cond) { __builtin_amdgcn_s_sleep(1); \
    if ((++_sp & 255u) == 0u) { if (xb_ld(&(bar)[XB_TMO])) break; if (_sp > XB_SPIN_CAP) { atomicAdd(&(bar)[XB_TMO], 1u); break; } } } } while (0)
DI void xb_census(unsigned* bar, unsigned x, unsigned& nloc, unsigned& nx) {
  const unsigned G = gridDim.x;
  unsigned sum, cnt, mine, sp = 0u;
  for (;;) {
    sum = 0u; cnt = 0u; mine = 0u;
#pragma unroll
    for (unsigned j = 0; j < 16; ++j) { const unsigned c = xb_ld(&bar[XB_XCNT(j)]); sum += c; cnt += (c > 0u) ? 1u : 0u; mine = (j == x) ? c : mine; }
    if (sum == G) break;
    __builtin_amdgcn_s_sleep(1);
    if ((++sp & 255u) == 0u) { if (xb_ld(&bar[XB_TMO])) break; if (sp > XB_SPIN_CAP) { atomicAdd(&bar[XB_TMO], 1u); break; } }
  }
  nloc = mine > 0u ? mine : 1u; nx = cnt > 0u ? cnt : 1u;
}
DI void xcd_barrier(unsigned* bar, unsigned x, unsigned nloc, unsigned nx, int wv) {
  asm volatile("s_waitcnt vmcnt(0)" ::: "memory");
  __syncthreads();
  if (wv == 0 && lane_id() == 0) {
    __builtin_amdgcn_s_waitcnt(0);
    const unsigned old = xb_add(&bar[XB_XSUB(x)], 1u);
    const unsigned gen = old / nloc;
    if (old + 1u == (gen + 1u) * nloc) {
      __builtin_amdgcn_fence(__ATOMIC_RELEASE, "agent");
      asm volatile("s_waitcnt vmcnt(0)" ::: "memory");
      const unsigned og = xb_add(&bar[XB_TOP], 1u);
      const unsigned tg = og / nx;
      if (og + 1u == (tg + 1u) * nx) xb_add(&bar[XB_TOPGEN], 1u);
      else XB_SPIN(xb_ld(&bar[XB_TOPGEN]) == tg, bar);
      __builtin_amdgcn_fence(__ATOMIC_ACQUIRE, "agent");
      xb_add(&bar[XB_XGEN(x)], 1u);
      asm volatile("s_waitcnt vmcnt(0)" ::: "memory");
    } else {
      XB_SPIN(xb_ld(&bar[XB_XGEN(x)]) == gen, bar);
      __builtin_amdgcn_fence(__ATOMIC_ACQUIRE, "agent");
      asm volatile("s_waitcnt vmcnt(0)" ::: "memory");
    }
  }
  __syncthreads();
}

constexpr int NPHASE = 2 + 13 * NL;

DI void run_phase(const Params& P, int ph, char* smem, bool dup = false) {
  if (ph == 0) { phase_prep(P, smem); return; }
  if (ph == NPHASE - 1) { phase_final(P); return; }
  const int l = (ph - 1) / 13, k = (ph - 1) % 13;
  char* ws = P.ws;
  const u16* actA = (const u16*)(ws + WS_ACTA);
  int rot = 0;
  switch (k) {
    case 0: phase_norm(P, P.in[10] + l * 1024, l); break;
    case 1:
      gemm_phase<EPI_IN, BM_BIG>(P, l, actA, 1024, wt_ptr(P, l, WE_IN), 1024, 1024, TT, INP, smem, rot);
      if (l == 0) {
        for (int l2 = 0; l2 < NL; l2++)
          gemm_phase<EPI_MEM, 128>(P, l2, (const u16*)(ws + WS_HMEM) + (size_t)l2 * NB * NMEM * 1024, 1024, wt_ptr(P, l2, WE_MKV), 1024, 1024,
                              NB * NMEM, 2048, smem, rot);
      }
      break;
    case 2: phase_post(P, l, smem); break;
    case 3:
      gemm_phase<EPI_KV, 128>(P, l, (const u16*)(ws + WS_CKV), 128, wt_ptr(P, l, WE_UKV), 128, 128, KROWS, 1024, smem, rot);
      gemm_phase<EPI_UQ, 128>(P, l, (const u16*)(ws + WS_CQN), 256, wt_ptr(P, l, WE_UQ), 256, 256, TT, 768, smem, rot);
      break;
    case 4: phase_attn(P, l, smem); break;
    case 5: if (dup) gemm_phase<EPI_RESID0, 128>(P, l, actA, 1024, wt_ptr(P, l, WE_OUT), 1024, 1024, TT, 1024, smem, rot); else gemm_phase<EPI_RESID, 128>(P, l, actA, 1024, wt_ptr(P, l, WE_OUT), 1024, 1024, TT, 1024, smem, rot); break;
    case 6: phase_norm(P, P.in[18] + l * 1024, -1); break;
    case 7: gemm_phase<EPI_XQ, 128>(P, l, actA, 1024, wt_ptr(P, l, WE_XQ), 1024, 1024, TT, 1024, smem, rot); break;
    case 8: phase_cross(P, l, smem); break;
    case 9: if (dup) gemm_phase<EPI_RESID0, 128>(P, l, actA, 1024, wt_ptr(P, l, WE_XO), 1024, 1024, TT, 1024, smem, rot); else gemm_phase<EPI_RESID, 128>(P, l, actA, 1024, wt_ptr(P, l, WE_XO), 1024, 1024, TT, 1024, smem, rot); break;
    case 10: phase_norm(P, P.in[24] + l * 1024, -1); break;
    case 11: gemm_phase<EPI_UP, BM_BIG>(P, l, actA, 1024, wt_ptr(P, l, WE_UP), 1024, 1024, TT, DFF, smem, rot); break;
    case 12: if (dup) gemm_phase<EPI_RESID0, 128>(P, l, (const u16*)(ws + WS_R1 + R1_U), DFF, wt_ptr(P, l, WE_DN), DFF, DFF, TT, 1024, smem, rot); else gemm_phase<EPI_RESID, 128>(P, l, (const u16*)(ws + WS_R1 + R1_U), DFF, wt_ptr(P, l, WE_DN), DFF, DFF, TT, 1024, smem, rot); break;
  }
}

__global__ void __launch_bounds__(256, LB_MIN) mega(Params P, int ph_lo, int ph_hi) {
  __shared__ __attribute__((aligned(16))) char smem[SMEM_BYTES];
  cg::grid_group grid = cg::this_grid();
  if (ph_hi > 4096) grid.sync();
  unsigned* bar = (unsigned*)(P.ws + WS_BAR);
  const unsigned xb_x = xb_xcc_id();
  unsigned xb_nloc = 1u, xb_nx = 1u;
  if (threadIdx.x == 0) { (void)xb_add(&bar[XB_XCNT(xb_x)], 1u); xb_census(bar, xb_x, xb_nloc, xb_nx); }
  xb_nloc = __builtin_amdgcn_readfirstlane(xb_nloc);
  xb_nx = __builtin_amdgcn_readfirstlane(xb_nx);
  unsigned xb_pack = xb_nloc | (xb_nx << 16) | (xb_x << 24) | ((unsigned)__builtin_amdgcn_readfirstlane(threadIdx.x >> 6) << 28);
  asm volatile("" : "+s"(xb_pack));
  for (int ph = ph_lo; ph < ph_hi; ph++) {
    Params Q = P;
    unsigned pk = xb_pack;
    asm volatile("" : "+s"(Q.out), "+s"(Q.ws), "+s"(pk));
    Q.wv = (int)(pk >> 28);
    run_phase(Q, ph, smem);
    if (ph + 1 < ph_hi) {
      unsigned pk2 = xb_pack;
      asm volatile("" : "+s"(pk2));
      xcd_barrier((unsigned*)(Q.ws + WS_BAR), (pk2 >> 24) & 0xfu, pk2 & 0xffffu, (pk2 >> 16) & 0xffu, (int)(pk2 >> 28));
    }
  }
}

extern "C" void kernel_launch(void* const* d_in, const int* in_sizes, int n_in, void* d_out, int out_size, void* d_ws,
                              size_t ws_size, hipStream_t stream) {
  static int grid_blocks = 0;
  if (!grid_blocks) {
    int dev = 0, cus = 0, per_cu = 0;
    hipGetDevice(&dev);
    hipDeviceGetAttribute(&cus, hipDeviceAttributeMultiprocessorCount, dev);
    hipOccupancyMaxActiveBlocksPerMultiprocessor(&per_cu, mega, 256, 0);
    if (per_cu < 1) per_cu = 1;
    if (per_cu > 2) per_cu = 2;
    grid_blocks = cus * per_cu;
  }
  if (n_in != 28 || (size_t)out_size != O_END || ws_size < WS_END) {
    fprintf(stderr, "kernel_launch: shape/ws mismatch n_in %d out %d (want %zu) ws %zu (want %zu)\n", n_in, out_size, (size_t)O_END, ws_size, (size_t)WS_END);
    return;
  }
  Params p;
  memset(&p, 0, sizeof(p));
  for (int i = 0; i < 28; i++) p.in[i] = (const float*)d_in[i];
  p.out = (float*)d_out;
  p.ws = (char*)d_ws;
  hipMemsetAsync((char*)d_ws + WS_BAR, 0, XCD_BAR_WORDS * 4, stream);
  int lo = 0, hi = NPHASE;
  void* args[] = {&p, &lo, &hi};
  hipError_t e = hipLaunchCooperativeKernel((void*)mega, dim3(grid_blocks), dim3(256), args, 0, stream);
  if (e != hipSuccess) fprintf(stderr, "cooperative launch failed: %s (grid %d)\n", hipGetErrorString(e), grid_blocks);
}
```

```cpp
#include <hip/hip_runtime.h>
#include <hip/hip_cooperative_groups.h>
#include <stdint.h>
#include <string.h>
#include <stdio.h>
namespace cg = cooperative_groups;

#ifndef COOP
#define COOP 1
#endif

#ifndef FOX_KT
#define FOX_KT 128
#endif
#ifndef FOX_PF
#define FOX_PF true
#endif
#ifndef MLA_PF
#define MLA_PF true
#endif
#ifndef LB_MIN
#define LB_MIN 2
#endif
#ifndef BM_BIG
#define BM_BIG 256
#endif
#define DI __device__ __forceinline__
typedef unsigned short u16;
typedef short s16x8 __attribute__((ext_vector_type(8)));
typedef short s16x4 __attribute__((ext_vector_type(4)));
typedef __bf16 bfx8 __attribute__((ext_vector_type(8)));
typedef __bf16 bfx2 __attribute__((ext_vector_type(2)));
typedef float f32x16 __attribute__((ext_vector_type(16)));
typedef float f32x4 __attribute__((ext_vector_type(4)));
typedef float f32x2 __attribute__((ext_vector_type(2)));
typedef unsigned u32x4 __attribute__((ext_vector_type(4)));
typedef unsigned u32x2 __attribute__((ext_vector_type(2)));

constexpr int DM = 1024, NB = 8, SEQ = 4096, NL = 2, DB = 32, DS = 32, PAST = 2048;
constexpr int TP = NB * SEQ;
constexpr int TS = DB * DS;
constexpr int TT = TP + TS;
constexpr int SKS = PAST + DS;
constexpr int KROWS = TP + DB * SKS;
constexpr int INC = 1992, INP = 2048;
constexpr int NMEM = 256, MB = NB + DB;
constexpr int DFF = 4096;

constexpr size_t O_Y = 0;
constexpr size_t O_FKP = (size_t)TT * DM;
constexpr size_t O_FVP = O_FKP + (size_t)NL * TP * 512;
constexpr size_t O_FLP = O_FVP + (size_t)NL * TP * 512;
constexpr size_t O_CKP = O_FLP + (size_t)NL * TP * 8;
constexpr size_t O_KRP = O_CKP + (size_t)NL * TP * 128;
constexpr size_t O_MKP = O_KRP + (size_t)NL * TP * 64;
constexpr size_t O_MVP = O_MKP + (size_t)NL * NB * NMEM * 1024;
constexpr size_t O_FKS = O_MVP + (size_t)NL * NB * NMEM * 1024;
constexpr size_t O_FVS = O_FKS + (size_t)NL * TS * 512;
constexpr size_t O_FLS = O_FVS + (size_t)NL * TS * 512;
constexpr size_t O_CKS = O_FLS + (size_t)NL * TS * 8;
constexpr size_t O_KRS = O_CKS + (size_t)NL * TS * 128;
constexpr size_t O_END = O_KRS + (size_t)NL * TS * 64;

constexpr size_t al256(size_t x) { return (x + 255) / 256 * 256; }
constexpr size_t WE_IN = 0;
constexpr size_t WE_UQ = WE_IN + (size_t)INP * 1024;
constexpr size_t WE_UKV = WE_UQ + (size_t)768 * 256;
constexpr size_t WE_OUT = WE_UKV + (size_t)1024 * 128;
constexpr size_t WE_XQ = WE_OUT + (size_t)1024 * 1024;
constexpr size_t WE_MKV = WE_XQ + (size_t)1024 * 1024;
constexpr size_t WE_XO = WE_MKV + (size_t)2048 * 1024;
constexpr size_t WE_UP = WE_XO + (size_t)1024 * 1024;
constexpr size_t WE_DN = WE_UP + (size_t)4096 * 1024;
constexpr size_t WE_LAYER = WE_DN + (size_t)1024 * 4096;
constexpr size_t WS_WT = 0;
constexpr size_t WS_ROPE = al256(WS_WT + WE_LAYER * 2 * NL);
constexpr size_t WS_ACTA = al256(WS_ROPE + (size_t)4096 * 32 * 8);
constexpr size_t WS_QF = al256(WS_ACTA + (size_t)TT * 1024 * 2);
constexpr size_t WS_FOXK = al256(WS_QF + (size_t)TT * 512 * 2);
constexpr size_t WS_FOXV = al256(WS_FOXK + (size_t)KROWS * 512 * 2);
constexpr size_t WS_CUM = al256(WS_FOXV + (size_t)KROWS * 512 * 2);
constexpr size_t WS_ZC = al256(WS_CUM + (size_t)KROWS * 8 * 4);
constexpr size_t WS_CQN = al256(WS_ZC + (size_t)TT * 448 * 4);
constexpr size_t WS_CKV = al256(WS_CQN + (size_t)TT * 256 * 2);
constexpr size_t WS_KROPE = al256(WS_CKV + (size_t)KROWS * 128 * 2);
constexpr size_t WS_MEMK = al256(WS_KROPE + (size_t)KROWS * 64 * 2);
constexpr size_t WS_MEMV = al256(WS_MEMK + (size_t)NL * MB * NMEM * 1024 * 2);
constexpr size_t WS_HMEM = al256(WS_MEMV + (size_t)NL * MB * NMEM * 1024 * 2);
constexpr size_t WS_R1 = al256(WS_HMEM + (size_t)NL * NB * NMEM * 1024 * 2);
constexpr size_t R1_KV = 0;
constexpr size_t R1_QM = al256((size_t)KROWS * 1024 * 2);
constexpr size_t R1_U = 0;
constexpr size_t R1_XQ = 0;
constexpr size_t WS_BAR = al256(WS_R1 + (size_t)TT * 4096 * 2);
constexpr size_t WS_END = al256(WS_BAR + 3456 * 4);
static_assert(R1_QM + (size_t)TT * 768 * 2 <= (size_t)TT * 4096 * 2, "R1 overflow");

constexpr int SMEM_BYTES = 65536;

struct Params {
  const float* in[28];
  float* out;
  char* ws;
  int wv;
  int pad;
};

DI int get_bid() { int t = blockIdx.x; asm volatile("" : "+s"(t)); return t; }
DI int get_nblk() { int t = gridDim.x; asm volatile("" : "+s"(t)); return t; }
DI int lane_id() { return (int)__builtin_amdgcn_mbcnt_hi(~0u, __builtin_amdgcn_mbcnt_lo(~0u, 0u)); }
DI int get_tid(int wv) { int t = (wv << 6) | lane_id(); asm volatile("" : "+v"(t)); return t; }
DI unsigned pk2(float a, float b) { f32x2 v = {a, b}; return __builtin_bit_cast(unsigned, __builtin_convertvector(v, bfx2)); }
DI u16 f2bf(float a) { return (u16)(pk2(a, 0.f) & 0xffffu); }
DI f32x16 mfma(s16x8 a, s16x8 b, f32x16 c) {
  return __builtin_amdgcn_mfma_f32_32x32x16_bf16(__builtin_bit_cast(bfx8, a), __builtin_bit_cast(bfx8, b), c, 0, 0, 0);
}
DI int crow(int i, int h) { return (i & 3) + 8 * (i >> 2) + 4 * h; }
DI float wave_sum(float v) {
#pragma unroll
  for (int m = 32; m >= 1; m >>= 1) v += __shfl_xor(v, m);
  return v;
}
DI float xhalf_max(float v) {
  auto rr = __builtin_amdgcn_permlane32_swap(__float_as_uint(v), __float_as_uint(v), false, false);
  return fmaxf(__uint_as_float(rr[0]), __uint_as_float(rr[1]));
}
DI float xhalf_sum(float v) {
  auto rr = __builtin_amdgcn_permlane32_swap(__float_as_uint(v), __float_as_uint(v), false, false);
  return __uint_as_float(rr[0]) + __uint_as_float(rr[1]);
}
DI int tok_krow(int tok) {
  if (tok < TP) return tok;
  const int s = tok - TP;
  return TP + (s >> 5) * SKS + PAST + (s & 31);
}
DI int tok_pos(int tok) { return tok < TP ? (tok & (SEQ - 1)) : PAST + ((tok - TP) & 31); }

enum { EPI_IN = 0, EPI_MEM, EPI_UQ, EPI_KV, EPI_RESID, EPI_XQ, EPI_UP, EPI_RESID0 };

template <int EPI, int MI>
DI void epilogue(const Params& P, int l, f32x16 (&acc)[MI][2], int mw, int nw, int r, int h) {
  float* out = P.out;
  char* ws = P.ws;
  if constexpr (EPI == EPI_IN) {
    u16* qf = (u16*)(ws + WS_QF);
    u16* fk = (u16*)(ws + WS_FOXK);
    u16* fv = (u16*)(ws + WS_FOXV);
    float* zc = (float*)(ws + WS_ZC);
    const float* bfg = P.in[12] + l * 8;
#pragma unroll
    for (int mi = 0; mi < MI; mi++) {
#pragma unroll
      for (int i = 0; i < 16; i++) {
        const int row = mw + mi * 32 + crow(i, h);
        const int kr = tok_krow(row);
        const bool isp = row < TP;
        const size_t orow = isp ? ((size_t)l * TP + row) : ((size_t)l * TS + (row - TP));
#pragma unroll
        for (int ni = 0; ni < 2; ni++) {
          const int col = nw + ni * 32 + r;
          const float v = acc[mi][ni][i];
          if (col < 512) {
            qf[(size_t)row * 512 + col] = f2bf(v);
          } else if (col < 1024) {
            const int c = col - 512;
            out[(isp ? O_FKP : O_FKS) + orow * 512 + c] = v;
            fk[(size_t)kr * 512 + c] = f2bf(v);
          } else if (col < 1536) {
            const int c = col - 1024;
            out[(isp ? O_FVP : O_FVS) + orow * 512 + c] = v;
            fv[(size_t)kr * 512 + c] = f2bf(v);
          } else if (col < 1544) {
            const int c = col - 1536;
            const float g = v + bfg[c];
            const float ls = fminf(g, 0.f) - __logf(1.f + __expf(-fabsf(g)));
            out[(isp ? O_FLP : O_FLS) + orow * 8 + c] = ls;
          } else if (col < INC) {
            zc[(size_t)row * 448 + (col - 1544)] = v;
          }
        }
      }
    }
  } else if constexpr (EPI == EPI_MEM) {
    u16* mk = (u16*)(ws + WS_MEMK);
    u16* mv = (u16*)(ws + WS_MEMV);
#pragma unroll
    for (int mi = 0; mi < MI; mi++) {
#pragma unroll
      for (int i = 0; i < 16; i++) {
        const int row = mw + mi * 32 + crow(i, h);
#pragma unroll
        for (int ni = 0; ni < 2; ni++) {
          const int col = nw + ni * 32 + r;
          const float v = acc[mi][ni][i];
          const int c = col & 1023;
          const size_t oidx = ((size_t)l * (NB * NMEM) + row) * 1024 + c;
          const size_t bidx = ((size_t)l * (MB * NMEM) + row) * 1024 + c;
          if (col < 1024) { out[O_MKP + oidx] = v; mk[bidx] = f2bf(v); }
          else { out[O_MVP + oidx] = v; mv[bidx] = f2bf(v); }
        }
      }
    }
  } else if constexpr (EPI == EPI_UQ) {
    u16* qm = (u16*)(ws + WS_R1 + R1_QM);
    const f32x2* rt = (const f32x2*)(ws + WS_ROPE);
    const bool isrope = (nw % 192) == 128;
#pragma unroll
    for (int mi = 0; mi < MI; mi++) {
#pragma unroll
      for (int i = 0; i < 16; i++) {
        const int row = mw + mi * 32 + crow(i, h);
        float x1 = acc[mi][0][i], x2 = acc[mi][1][i];
        if (isrope) {
          const f32x2 cs = rt[tok_pos(row) * 32 + r];
          const float o1 = x1 * cs[0] - x2 * cs[1];
          const float o2 = x2 * cs[0] + x1 * cs[1];
          x1 = o1; x2 = o2;
        }
        qm[(size_t)row * 768 + nw + r] = f2bf(x1);
        qm[(size_t)row * 768 + nw + 32 + r] = f2bf(x2);
      }
    }
  } else if constexpr (EPI == EPI_KV || EPI == EPI_XQ || EPI == EPI_UP) {
    u16* dst; int ld;
    if constexpr (EPI == EPI_KV) { dst = (u16*)(ws + WS_R1 + R1_KV); ld = 1024; }
    else if constexpr (EPI == EPI_XQ) { dst = (u16*)(ws + WS_R1 + R1_XQ); ld = 1024; }
    else { dst = (u16*)(ws + WS_R1 + R1_U); ld = DFF; }
    const bool odd = r & 1;
    const int colb = nw + (r & ~1);
#pragma unroll
    for (int mi = 0; mi < MI; mi++) {
#pragma unroll
      for (int i = 0; i < 16; i += 2) {
        const int row = mw + mi * 32 + crow(i, h) + (odd ? 1 : 0);
#pragma unroll
        for (int ni = 0; ni < 2; ni++) {
          float v0 = acc[mi][ni][i], v1 = acc[mi][ni][i + 1];
          if constexpr (EPI == EPI_UP) { v0 = fmaxf(v0, 0.f); v0 = v0 * v0; v1 = fmaxf(v1, 0.f); v1 = v1 * v1; }
          const float send = odd ? v0 : v1;
          const float recv = __int_as_float(__builtin_amdgcn_mov_dpp(__float_as_int(send), 0xB1, 0xF, 0xF, true));
          const unsigned w = odd ? pk2(recv, v1) : pk2(v0, recv);
          *(unsigned*)(dst + (size_t)row * ld + colb + ni * 32) = w;
        }
      }
    }
  } else if constexpr (EPI == EPI_RESID || EPI == EPI_RESID0) {
#pragma unroll
    for (int mi = 0; mi < MI; mi++) {
#pragma unroll
      for (int i = 0; i < 16; i++) {
        const int row = mw + mi * 32 + crow(i, h);
#pragma unroll
        for (int ni = 0; ni < 2; ni++) {
          unsafeAtomicAdd(out + (size_t)row * DM + nw + ni * 32 + r, EPI == EPI_RESID0 ? acc[mi][ni][i] * 0.f : acc[mi][ni][i]);
        }
      }
    }
  }
}

enum { MASK_NONE = 0, MASK_FRAME = 1, MASK_CHUNK = 2 };
struct AttnJob {
  const u16* Q; int ldq;
  const u16* K1; int ldk1;
  const u16* K2; int ldk2;
  const u16* V; int ldv;
  u16* O; int ldo;
  const float* cq;
  const float* ck;
  int nq, Sk, qpos0;
  float scale_log2;
  int wv;
};

template <int DQK, int D1, int DVT, int MASK, bool BIAS, bool PREFETCH, int LDQ, int LDK1, int LDK2, int LDV, int LDO, int KT>
DI void attn_block(const AttnJob& J, char* smem) {
  constexpr int KP = DQK * 2 + 16;
  constexpr int VP = DVT * 2;
  constexpr int CV = DVT / 8;
  constexpr int NKK = DQK / 16, NDV = DVT / 32;
  constexpr float LOG2E = 1.4426950408889634f;
  char* Ks = smem;
  char* Vs = smem + KT * KP;
  float* cks = (float*)(smem + KT * KP + KT * VP);
  const int tid = get_tid(J.wv), wave = tid >> 6, lane = tid & 63, r = lane & 31, h = lane >> 5;
  const int wq0 = wave * 32;
  const bool active = wq0 < J.nq;
  const int qi = wq0 + r;
  const int qpos = J.qpos0 + qi;
  const int wqmax = J.qpos0 + wq0 + 31;
  const int qmax = J.qpos0 + J.nq - 1;
  const int ntk = (J.Sk + KT - 1) / KT;
  int nt = ntk;
  if (MASK != MASK_NONE) { const int t2 = qmax / KT + 1; nt = t2 < ntk ? t2 : ntk; }

  s16x8 qf[NKK];
  {
    const u16* qp = J.Q + (size_t)qi * LDQ + h * 8;
#pragma unroll
    for (int kk = 0; kk < NKK; kk++) {
      if (active) qf[kk] = *(const s16x8*)(qp + kk * 16);
      else { s16x8 z = {0, 0, 0, 0, 0, 0, 0, 0}; qf[kk] = z; }
    }
  }
  float cqv = 0.f;
  if (BIAS) { if (active) cqv = J.cq[(size_t)qi * 8] * LOG2E; }

  f32x16 o[NDV];
#pragma unroll
  for (int d = 0; d < NDV; d++)
#pragma unroll
    for (int i = 0; i < 16; i++) o[d][i] = 0.f;
  float m_run = -1e30f, l_run = 0.f;

  constexpr int CK1 = D1 / 8, CK2 = (DQK - D1) / 8;
  constexpr int RP1 = 256 / CK1, NP1 = KT / RP1;
  constexpr int RP2 = CK2 ? 256 / (CK2 ? CK2 : 1) : 64, NP2 = CK2 ? KT / RP2 : 0;
  constexpr int RPV = 256 / CV, NPV = KT / RPV;
  u32x4 rk1[NP1], rk2[NP2 ? NP2 : 1], rv[NPV];
  float rck = 0.f;
  const int tq = (lane & 15) >> 2, tp = lane & 3, tblk = (lane >> 4) & 1;
  const int vswz = (DVT >= 128) ? tq : (tq >> 1);
  const int r1 = tid / CK1, c1 = tid % CK1;
  const int r2 = CK2 ? tid / (CK2 ? CK2 : 1) : 0, c2 = CK2 ? tid % (CK2 ? CK2 : 1) : 0;
  const int r3 = tid / CV, c3 = tid % CV;
  const unsigned k1o = (unsigned)(r1 * LDK1 + c1 * 8) * 2u;
  const unsigned k2o = (unsigned)(r2 * LDK2 + c2 * 8) * 2u;
  const unsigned vo = (unsigned)(r3 * LDV + c3 * 8) * 2u;
  const int k1so = r1 * KP + c1 * 16;
  const int k2so = r2 * KP + D1 * 2 + c2 * 16;
  const int vsw = (DVT >= 128) ? (r3 & 3) : ((r3 >> 1) & 1);
  const int vso = KT * KP + r3 * VP + (((c3 >> 2) ^ vsw) * 64) + (c3 & 3) * 16;
  const int vro = KT * KP + (4 * h + tq) * VP + (16 * tblk + 4 * tp) * 2;
  const int kro = r * KP + h * 16;

  auto load_tile = [&](int j) {
    const int kb = j * KT;
#pragma unroll
    for (int i = 0; i < NP1; i++) {
      u32x4 v = {0u, 0u, 0u, 0u};
      if (kb + r1 + i * RP1 < J.Sk) v = *(const u32x4*)((const char*)(J.K1 + (size_t)(kb + i * RP1) * LDK1) + k1o);
      rk1[i] = v;
    }
#pragma unroll
    for (int i = 0; i < NP2; i++) {
      u32x4 v = {0u, 0u, 0u, 0u};
      if (kb + r2 + i * RP2 < J.Sk) v = *(const u32x4*)((const char*)(J.K2 + (size_t)(kb + i * RP2) * LDK2) + k2o);
      rk2[i] = v;
    }
#pragma unroll
    for (int i = 0; i < NPV; i++) {
      u32x4 v = {0u, 0u, 0u, 0u};
      if (kb + r3 + i * RPV < J.Sk) v = *(const u32x4*)((const char*)(J.V + (size_t)(kb + i * RPV) * LDV) + vo);
      rv[i] = v;
    }
    if (BIAS) {
      if (tid < KT) { const int key = kb + tid; rck = key < J.Sk ? J.ck[(size_t)key * 8] * LOG2E : 0.f; }
    }
  };
  auto store_tile = [&]() {
    int a1 = k1so, a2 = k2so, a3 = vso;
    asm volatile("" : "+v"(a1), "+v"(a2), "+v"(a3));
#pragma unroll
    for (int i = 0; i < NP1; i++) *(u32x4*)(smem + a1 + i * RP1 * KP) = rk1[i];
#pragma unroll
    for (int i = 0; i < NP2; i++) *(u32x4*)(smem + a2 + i * RP2 * KP) = rk2[i];
#pragma unroll
    for (int i = 0; i < NPV; i++) *(u32x4*)(smem + a3 + i * RPV * VP) = rv[i];
    if (BIAS) { if (tid < KT) cks[tid] = rck; }
  };

  if (PREFETCH) load_tile(0);
  for (int j = 0; j < nt; j++) {
    __syncthreads();
    if (!PREFETCH) load_tile(j);
    store_tile();
    __syncthreads();
    if (PREFETCH) { if (j + 1 < nt) load_tile(j + 1); }
    const bool need = active && (MASK == MASK_NONE || j * KT <= wqmax);
    if (need) {
      int kro_l = kro, vro_l = vro;
      asm volatile("" : "+v"(kro_l), "+v"(vro_l));
      const char* krd = smem + kro_l;
      const bool needmask = (MASK == MASK_FRAME && j * KT + KT - 1 > J.qpos0 + wq0) || (j * KT + KT - 1 >= J.Sk);
      const int dq = (MASK == MASK_FRAME ? min(qpos, J.Sk - 1) : J.Sk - 1) - j * KT - 4 * h;
#pragma unroll
      for (int hb = 0; hb < KT / 32; hb++) {
        if (MASK == MASK_FRAME && j * KT + hb * 32 > wqmax) continue;
        f32x16 p;
#pragma unroll
        for (int i = 0; i < 16; i++) p[i] = 0.f;
#pragma unroll
        for (int kk = 0; kk < NKK; kk++) {
          const s16x8 kf = *(const s16x8*)(krd + hb * 32 * KP + kk * 32);
          p = mfma(kf, qf[kk], p);
        }
        if (BIAS) {
#pragma unroll
          for (int g = 0; g < 4; g++) {
            const f32x4 c0 = *(const f32x4*)(cks + hb * 32 + 8 * g + 4 * h);
#pragma unroll
            for (int e = 0; e < 4; e++) p[4 * g + e] = fmaf(p[4 * g + e], J.scale_log2, cqv - c0[e]);
          }
        } else {
#pragma unroll
          for (int i = 0; i < 16; i++) p[i] *= J.scale_log2;
        }
        if (needmask) {
#pragma unroll
          for (int i = 0; i < 16; i++) {
            const int cc = (i & 3) + 8 * (i >> 2) + 32 * hb;
            p[i] = (cc <= dq) ? p[i] : -1e30f;
          }
        }
        float mx = p[0];
#pragma unroll
        for (int i = 1; i < 16; i++) mx = fmaxf(mx, p[i]);
        mx = xhalf_max(mx);
        const float m_new = fmaxf(m_run, mx);
        const float alpha = __builtin_amdgcn_exp2f(m_run - m_new);
        m_run = m_new;
        float ps = 0.f;
#pragma unroll
        for (int i = 0; i < 16; i++) { p[i] = __builtin_amdgcn_exp2f(p[i] - m_new); ps += p[i]; }
        l_run = l_run * alpha + ps;
        if (__any(alpha != 1.f)) {
#pragma unroll
          for (int d = 0; d < NDV; d++)
#pragma unroll
            for (int i = 0; i < 16; i++) o[d][i] *= alpha;
        }
        s16x8 pb[2];
        {
          u32x4 w;
          w[0] = pk2(p[0], p[1]); w[1] = pk2(p[2], p[3]); w[2] = pk2(p[4], p[5]); w[3] = pk2(p[6], p[7]);
          pb[0] = __builtin_bit_cast(s16x8, w);
          w[0] = pk2(p[8], p[9]); w[1] = pk2(p[10], p[11]); w[2] = pk2(p[12], p[13]); w[3] = pk2(p[14], p[15]);
          pb[1] = __builtin_bit_cast(s16x8, w);
        }
#pragma unroll
        for (int d = 0; d < NDV; d++) {
          const char* vb = smem + (vro_l + ((d ^ vswz) * 64)) + hb * 32 * VP;
#pragma unroll
          for (int s = 0; s < 2; s++) {
            const s16x4 lo = __builtin_amdgcn_ds_read_tr16_b64_v4i16(
                (__attribute__((address_space(3))) s16x4*)(uintptr_t)(vb + (16 * s) * VP));
            const s16x4 hi = __builtin_amdgcn_ds_read_tr16_b64_v4i16(
                (__attribute__((address_space(3))) s16x4*)(uintptr_t)(vb + (16 * s + 8) * VP));
            const s16x8 vf = __builtin_shufflevector(lo, hi, 0, 1, 2, 3, 4, 5, 6, 7);
            o[d] = mfma(vf, pb[s], o[d]);
          }
        }
      }
    }
  }
  const float lt = xhalf_sum(l_run);
  if (active && qi < J.nq) {
    const float inv = 1.f / lt;
    u16* op = J.O + (size_t)qi * LDO + 4 * h;
#pragma unroll
    for (int d = 0; d < NDV; d++) {
#pragma unroll
      for (int g = 0; g < 4; g++) {
        u32x2 w;
        w[0] = pk2(o[d][4 * g] * inv, o[d][4 * g + 1] * inv);
        w[1] = pk2(o[d][4 * g + 2] * inv, o[d][4 * g + 3] * inv);
        *(u32x2*)(op + d * 32 + 8 * g) = w;
      }
    }
  }
}

template <int NR, bool F32OUT>
DI void rms_rows(const float* __restrict__ xbase, size_t rstride, int nvalid, const float* __restrict__ g, void* dbase, size_t dstride, int lane) {
  f32x4 v[NR][4];
#pragma unroll
  for (int j = 0; j < NR; j++)
#pragma unroll
    for (int i = 0; i < 4; i++) {
      if (j < nvalid) v[j][i] = *(const f32x4*)(xbase + (size_t)j * rstride + i * 256 + lane * 4);
      else { f32x4 z = {0.f, 0.f, 0.f, 0.f}; v[j][i] = z; }
    }
  f32x4 gg[4];
#pragma unroll
  for (int i = 0; i < 4; i++) gg[i] = *(const f32x4*)(g + i * 256 + lane * 4);
#pragma unroll
  for (int j = 0; j < NR; j++) {
    float ss = 0.f;
#pragma unroll
    for (int i = 0; i < 4; i++) ss += v[j][i][0] * v[j][i][0] + v[j][i][1] * v[j][i][1] + v[j][i][2] * v[j][i][2] + v[j][i][3] * v[j][i][3];
    ss = wave_sum(ss);
    const float rs = rsqrtf(ss * (1.f / 1024.f) + 1e-6f);
    if (j < nvalid) {
#pragma unroll
      for (int i = 0; i < 4; i++) {
        if (F32OUT) {
          f32x4 w;
          w[0] = v[j][i][0] * rs * gg[i][0]; w[1] = v[j][i][1] * rs * gg[i][1]; w[2] = v[j][i][2] * rs * gg[i][2]; w[3] = v[j][i][3] * rs * gg[i][3];
          *(f32x4*)((float*)dbase + (size_t)j * dstride + i * 256 + lane * 4) = w;
        } else {
          u32x2 w;
          w[0] = pk2(v[j][i][0] * rs * gg[i][0], v[j][i][1] * rs * gg[i][1]);
          w[1] = pk2(v[j][i][2] * rs * gg[i][2], v[j][i][3] * rs * gg[i][3]);
          *(u32x2*)((u16*)dbase + (size_t)j * dstride + i * 256 + lane * 4) = w;
        }
      }
    }
  }
}

DI void cvt_job(const float* __restrict__ src, u16* __restrict__ dst, int nseg, size_t seglen, size_t sstride, size_t dstride, int wv) {
  const size_t upseg = seglen / 8;
  const size_t total = upseg * nseg;
  const size_t stride = (size_t)get_nblk() * 256;
  for (size_t u0 = (size_t)get_bid() * 256 + get_tid(wv); u0 < total; u0 += 4 * stride) {
    f32x4 a[4], b[4];
    size_t so[4], dd[4];
#pragma unroll
    for (int q = 0; q < 4; q++) {
      const size_t u = u0 + q * stride;
      const size_t uu = u < total ? u : u0;
      const size_t sg = uu / upseg, off = (uu - sg * upseg) * 8;
      so[q] = sg * sstride + off; dd[q] = sg * dstride + off;
      a[q] = *(const f32x4*)(src + so[q]);
      b[q] = *(const f32x4*)(src + so[q] + 4);
    }
#pragma unroll
    for (int q = 0; q < 4; q++) {
      if (u0 + q * stride < total) {
        u32x4 w;
        w[0] = pk2(a[q][0], a[q][1]); w[1] = pk2(a[q][2], a[q][3]); w[2] = pk2(b[q][0], b[q][1]); w[3] = pk2(b[q][2], b[q][3]);
        *(u32x4*)(dst + dd[q]) = w;
      }
    }
  }
}

DI void transpose_job(const float* __restrict__ src, u16* __restrict__ dst, int K, int N, int Npad, int& rot, char* smem, int wv) {
  float* tile = (float*)smem;
  const int tk = K / 64, tn = Npad / 64, ntiles = tk * tn;
  const int G = get_nblk();
  const int tid = get_tid(wv);
  for (int t = (get_bid() + G - (rot % G)) % G; t < ntiles; t += G) {
    const int k0 = (t % tk) * 64, n0 = (t / tk) * 64;
    float v[16];
#pragma unroll
    for (int i = 0; i < 16; i++) {
      const int k = i * 4 + (tid >> 6), n = tid & 63;
      v[i] = (n0 + n < N) ? src[(size_t)(k0 + k) * N + n0 + n] : 0.f;
    }
    __syncthreads();
#pragma unroll
    for (int i = 0; i < 16; i++) {
      const int k = i * 4 + (tid >> 6), n = tid & 63;
      tile[k * 65 + n] = v[i];
    }
    __syncthreads();
#pragma unroll
    for (int i = 0; i < 8; i++) {
      const int n = i * 8 + (tid >> 5), k = (tid & 31) * 2;
      *(unsigned*)(dst + (size_t)(n0 + n) * K + k0 + k) = pk2(tile[k * 65 + n], tile[(k + 1) * 65 + n]);
    }
  }
  rot += ntiles;
}

DI u16* wt_ptr(const Params& P, int l, size_t eoff) { return (u16*)(P.ws + WS_WT) + (size_t)l * WE_LAYER + eoff; }

DI void phase_prep(const Params& P, char* smem) {
  const int tid = get_tid(P.wv), lane = tid & 63;
  const int gw = get_bid() * 4 + (tid >> 6), nw = get_nblk() * 4;
  int rot = 0;
  for (int l = 0; l < NL; l++) {
    transpose_job(P.in[11] + (size_t)l * 1024 * INC, wt_ptr(P, l, WE_IN), 1024, INC, INP, rot, smem, P.wv);
    transpose_job(P.in[14] + (size_t)l * 256 * 768, wt_ptr(P, l, WE_UQ), 256, 768, 768, rot, smem, P.wv);
    transpose_job(P.in[16] + (size_t)l * 128 * 1024, wt_ptr(P, l, WE_UKV), 128, 1024, 1024, rot, smem, P.wv);
    transpose_job(P.in[17] + (size_t)l * 1024 * 1024, wt_ptr(P, l, WE_OUT), 1024, 1024, 1024, rot, smem, P.wv);
    transpose_job(P.in[20] + (size_t)l * 1024 * 1024, wt_ptr(P, l, WE_XQ), 1024, 1024, 1024, rot, smem, P.wv);
    transpose_job(P.in[21] + (size_t)l * 1024 * 1024, wt_ptr(P, l, WE_MKV), 1024, 1024, 1024, rot, smem, P.wv);
    transpose_job(P.in[22] + (size_t)l * 1024 * 1024, wt_ptr(P, l, WE_MKV) + (size_t)1024 * 1024, 1024, 1024, 1024, rot, smem, P.wv);
    transpose_job(P.in[23] + (size_t)l * 1024 * 1024, wt_ptr(P, l, WE_XO), 1024, 1024, 1024, rot, smem, P.wv);
    transpose_job(P.in[25] + (size_t)l * 1024 * 4096, wt_ptr(P, l, WE_UP), 1024, 4096, 4096, rot, smem, P.wv);
    transpose_job(P.in[26] + (size_t)l * 4096 * 1024, wt_ptr(P, l, WE_DN), 4096, 1024, 1024, rot, smem, P.wv);
  }
  {
    f32x2* rt = (f32x2*)(P.ws + WS_ROPE);
    for (int i = get_bid() * 256 + tid; i < 4096 * 32; i += get_nblk() * 256) {
      const int pos = i >> 5, j = i & 31;
      const float inv = powf(10000.f, -(float)j / 32.f);
      const float ang = (float)pos * inv;
      f32x2 cs; cs[0] = cosf(ang); cs[1] = sinf(ang);
      rt[i] = cs;
    }
  }
  for (int l = 0; l < NL; l++) {
    const size_t seg = (size_t)DB * NMEM * 1024;
    cvt_job(P.in[8] + l * seg, (u16*)(P.ws + WS_MEMK) + ((size_t)l * MB + NB) * NMEM * 1024, 1, seg, 0, 0, P.wv);
    cvt_job(P.in[9] + l * seg, (u16*)(P.ws + WS_MEMV) + ((size_t)l * MB + NB) * NMEM * 1024, 1, seg, 0, 0, P.wv);
  }
  for (int rr = gw; rr < NL * NB * NMEM; rr += nw) {
    const int l = rr / (NB * NMEM), row = rr % (NB * NMEM);
    rms_rows<1, false>(P.in[2] + (size_t)row * 1024, 0, 1, P.in[19] + l * 1024, (u16*)(P.ws + WS_HMEM) + (size_t)rr * 1024, 0, lane);
  }
  {
    const size_t n4 = (size_t)TT * 256;
    const size_t np4 = (size_t)TP * 256;
    const size_t stride = (size_t)get_nblk() * 256;
    for (size_t i0 = (size_t)get_bid() * 256 + tid; i0 < n4; i0 += 4 * stride) {
      f32x4 v[4];
#pragma unroll
      for (int q = 0; q < 4; q++) {
        const size_t i = i0 + q * stride;
        const size_t ii = i < n4 ? i : i0;
        v[q] = (ii < np4) ? *(const f32x4*)(P.in[0] + ii * 4) : *(const f32x4*)(P.in[1] + (ii - np4) * 4);
      }
#pragma unroll
      for (int q = 0; q < 4; q++) {
        const size_t i = i0 + q * stride;
        if (i < n4) *(f32x4*)(P.out + i * 4) = v[q];
      }
    }
  }
}

DI void phase_norm(const Params& P, const float* g, int cache_layer) {
  const int tid = get_tid(P.wv), lane = tid & 63;
  const int gw = get_bid() * 4 + (tid >> 6), nw = get_nblk() * 4;
  u16* h = (u16*)(P.ws + WS_ACTA);
  for (int row = gw; row < TT; row += 4 * nw) {
    const int nv = (TT - row + nw - 1) / nw;
    rms_rows<4, false>(P.out + (size_t)row * 1024, (size_t)nw * 1024, nv < 4 ? nv : 4, g, h + (size_t)row * 1024, (size_t)nw * 1024, lane);
  }
  if (cache_layer >= 0) {
    const int l = cache_layer;
    cvt_job(P.in[3] + (size_t)l * DB * PAST * 512, (u16*)(P.ws + WS_FOXK) + (size_t)TP * 512, DB, (size_t)PAST * 512, (size_t)PAST * 512, (size_t)SKS * 512, P.wv);
    cvt_job(P.in[4] + (size_t)l * DB * PAST * 512, (u16*)(P.ws + WS_FOXV) + (size_t)TP * 512, DB, (size_t)PAST * 512, (size_t)PAST * 512, (size_t)SKS * 512, P.wv);
    cvt_job(P.in[6] + (size_t)l * DB * PAST * 128, (u16*)(P.ws + WS_CKV) + (size_t)TP * 128, DB, (size_t)PAST * 128, (size_t)PAST * 128, (size_t)SKS * 128, P.wv);
    cvt_job(P.in[7] + (size_t)l * DB * PAST * 64, (u16*)(P.ws + WS_KROPE) + (size_t)TP * 64, DB, (size_t)PAST * 64, (size_t)PAST * 64, (size_t)SKS * 64, P.wv);
  }
}

DI void phase_final(const Params& P) {
  const int tid = get_tid(P.wv), lane = tid & 63;
  const int gw = get_bid() * 4 + (tid >> 6), nw = get_nblk() * 4;
  const float* g = P.in[27];
  for (int row = gw; row < TT; row += 4 * nw) {
    const int nv = (TT - row + nw - 1) / nw;
    rms_rows<4, true>(P.out + (size_t)row * 1024, (size_t)nw * 1024, nv < 4 ? nv : 4, g, P.out + (size_t)row * 1024, (size_t)nw * 1024, lane);
  }
}

DI void phase_post(const Params& P, int l, char* smem) {
  const int tid = get_tid(P.wv), lane = tid & 63;
  const int gw = get_bid() * 4 + (tid >> 6), nw = get_nblk() * 4;
  const float* zc = (const float*)(P.ws + WS_ZC);
  u16* cqn = (u16*)(P.ws + WS_CQN);
  u16* ckv = (u16*)(P.ws + WS_CKV);
  u16* krp = (u16*)(P.ws + WS_KROPE);
  const f32x2* rt = (const f32x2*)(P.ws + WS_ROPE);
  const float* gq = P.in[13] + l * 256;
  const float* gkv = P.in[15] + l * 128;
  for (int tok0 = gw; tok0 < TT; tok0 += 4 * nw) {
    f32x4 vq[4]; f32x2 vk[4]; float vr[4];
#pragma unroll
    for (int j = 0; j < 4; j++) {
      const int tk = tok0 + j * nw;
      const float* z = zc + (size_t)(tk < TT ? tk : tok0) * 448;
      vq[j] = *(const f32x4*)(z + lane * 4);
      vk[j] = *(const f32x2*)(z + 256 + lane * 2);
      vr[j] = z[384 + lane];
    }
    const f32x4 ggq = *(const f32x4*)(gq + lane * 4);
    const f32x2 ggk = *(const f32x2*)(gkv + lane * 2);
#pragma unroll
    for (int j = 0; j < 4; j++) {
      const int tok = tok0 + j * nw;
      if (tok >= TT) break;
      const bool isp = tok < TP;
      const size_t orow = isp ? ((size_t)l * TP + tok) : ((size_t)l * TS + (tok - TP));
      const int kr = tok_krow(tok);
      {
        const f32x4 v = vq[j];
        const float ss = wave_sum(v[0] * v[0] + v[1] * v[1] + v[2] * v[2] + v[3] * v[3]);
        const float rs = rsqrtf(ss * (1.f / 256.f) + 1e-6f);
        u32x2 w;
        w[0] = pk2(v[0] * rs * ggq[0], v[1] * rs * ggq[1]);
        w[1] = pk2(v[2] * rs * ggq[2], v[3] * rs * ggq[3]);
        *(u32x2*)(cqn + (size_t)tok * 256 + lane * 4) = w;
      }
      {
        const f32x2 v = vk[j];
        const float ss = wave_sum(v[0] * v[0] + v[1] * v[1]);
        const float rs = rsqrtf(ss * (1.f / 128.f) + 1e-6f);
        f32x2 o; o[0] = v[0] * rs * ggk[0]; o[1] = v[1] * rs * ggk[1];
        *(f32x2*)(P.out + (isp ? O_CKP : O_CKS) + orow * 128 + lane * 2) = o;
        *(unsigned*)(ckv + (size_t)kr * 128 + lane * 2) = pk2(o[0], o[1]);
      }
      {
        const float x = vr[j];
        const float y = __shfl_xor(x, 32);
        const f32x2 cs = rt[tok_pos(tok) * 32 + (lane & 31)];
        const float o = (lane < 32) ? (x * cs[0] - y * cs[1]) : (x * cs[0] + y * cs[1]);
        P.out[(isp ? O_KRP : O_KRS) + orow * 64 + lane] = o;
        krp[(size_t)kr * 64 + lane] = f2bf(o);
      }
    }
  }
  float* cum = (float*)(P.ws + WS_CUM);
  float* wtot = (float*)smem;
  const int wave = tid >> 6;
  for (int it = get_bid(); it < NB + DB; it += get_nblk()) {
    const bool isp = it < NB;
    const int b = isp ? it : it - NB;
    const int ppt = isp ? 16 : 9;
    const int npos = isp ? SEQ : SKS;
    const float* srcA; const float* srcB; int nA;
    size_t krow0;
    if (isp) { srcA = P.out + O_FLP + ((size_t)l * TP + (size_t)b * SEQ) * 8; srcB = srcA; nA = SEQ; krow0 = (size_t)b * SEQ; }
    else {
      srcA = P.in[5] + ((size_t)l * DB + b) * PAST * 8;
      srcB = P.out + O_FLS + ((size_t)l * TS + (size_t)b * DS) * 8 - (size_t)PAST * 8;
      nA = PAST; krow0 = (size_t)TP + (size_t)b * SKS;
    }
    const int p0 = tid * ppt;
    f32x4 va[16], vb[16];
#pragma unroll
    for (int j = 0; j < 16; j++) {
      const int p = p0 + j;
      f32x4 z = {0.f, 0.f, 0.f, 0.f};
      va[j] = z; vb[j] = z;
      if (j < ppt && p < npos) {
        const float* s = (p < nA ? srcA : srcB) + (size_t)p * 8;
        va[j] = *(const f32x4*)s; vb[j] = *(const f32x4*)(s + 4);
      }
    }
#pragma unroll
    for (int j = 1; j < 16; j++) { va[j] += va[j - 1]; vb[j] += vb[j - 1]; }
    f32x4 ta = va[15], tb = vb[15];
#pragma unroll
    for (int d = 1; d < 64; d <<= 1) {
#pragma unroll
      for (int e = 0; e < 4; e++) {
        const float ua = __shfl_up(ta[e], d), ub = __shfl_up(tb[e], d);
        if (lane >= d) { ta[e] += ua; tb[e] += ub; }
      }
    }
    __syncthreads();
    if (lane == 63) { *(f32x4*)(wtot + wave * 8) = ta; *(f32x4*)(wtot + wave * 8 + 4) = tb; }
    __syncthreads();
    f32x4 pa = ta - va[15], pb = tb - vb[15];
    for (int w2 = 0; w2 < wave; w2++) { pa += *(const f32x4*)(wtot + w2 * 8); pb += *(const f32x4*)(wtot + w2 * 8 + 4); }
#pragma unroll
    for (int j = 0; j < 16; j++) {
      const int p = p0 + j;
      if (j < ppt && p < npos) {
        float* d = cum + (krow0 + p) * 8;
        *(f32x4*)d = va[j] + pa; *(f32x4*)(d + 4) = vb[j] + pb;
      }
    }
  }
}

template <int EPI, int BM>
DI void gemm_phase(const Params& P, int l, const u16* __restrict__ A, int lda, const u16* __restrict__ Bt, int ldb, int K, int M, int N,
                   char* smem, int& rot) {
  constexpr int MI = BM / 64;
  constexpr int STAGE = (BM + 128) * 64;
  constexpr int NSLOT = 65536 / STAGE;
  constexpr int DEPTH = NSLOT - 1;
  constexpr int GPS = MI + 2;
  constexpr int SM = (BM == 256) ? 4 : 8, SNN = 64 / SM;
  const int tid = get_tid(P.wv), wave = tid >> 6, lane = tid & 63, r = lane & 31, h = lane >> 5;
  const int wm = wave >> 1, wn = wave & 1;
  const int TM = M / BM, TN = N >> 7;
  const int G = get_nblk();
  const int bid = get_bid();
  const bool sup = (G == 512) && ((TN % SNN) == 0) && ((TM % SM) == 0);
  const int SN = TN / SNN;
  const int nunits = sup ? (TM / SM) * SN : TM * TN;
  const int ustep = sup ? 8 : G;
  const int slot8 = bid >> 3;
  int u = sup ? (int)((bid + 8 - (rot & 7)) & 7) : (int)((bid + G - (rot % G)) % G);
  rot += nunits;
  if (u >= nunits) return;
  const int lrow = tid >> 2, lc = tid & 3;
  const int pc = (lc ^ ((tid >> 4) & 3)) * 8;
  const int nk = K >> 5;
  const int sw = (r >> 2) & 3;
  const int xo0 = ((0 + h) ^ sw) * 16, xo1 = ((2 + h) ^ sw) * 16;
  const int aro = (wm * (BM / 2) + r) * 64, bro = BM * 64 + (wn * 64 + r) * 64;
  auto tile_of = [&](int uu, int& m0, int& n0) {
    if (sup) { const int sm = uu / SN, sn = uu - sm * SN; m0 = (sm * SM + (slot8 / SNN)) * BM; n0 = (sn * SNN + (slot8 % SNN)) << 7; }
    else { const int mt = uu / TN; m0 = mt * BM; n0 = (uu - mt * TN) << 7; }
  };
  auto issue = [&](int m0, int n0, int ks, int slot) {
    const u16* ag = A + (size_t)(m0 + lrow) * lda + pc + ks * 32;
    const u16* bg = Bt + (size_t)(n0 + lrow) * ldb + pc + ks * 32;
    char* dst = smem + slot * STAGE + tid * 16;
#pragma unroll
    for (int i = 0; i < MI; i++)
      __builtin_amdgcn_global_load_lds((const unsigned*)(ag + (size_t)i * 64 * lda), (__attribute__((address_space(3))) unsigned*)(dst + i * 4096), 16, 0, 0);
#pragma unroll
    for (int i = 0; i < 2; i++)
      __builtin_amdgcn_global_load_lds((const unsigned*)(bg + (size_t)i * 64 * ldb), (__attribute__((address_space(3))) unsigned*)(dst + BM * 64 + i * 4096), 16, 0, 0);
  };
  int m0, n0;
  tile_of(u, m0, n0);
  int ui = u, ki = 0, mi0 = m0, ni0 = n0;
  bool idone = false;
  int pend = 0;
  unsigned g = 0;
  asm volatile("s_waitcnt vmcnt(0) lgkmcnt(0)" ::: "memory");
  __builtin_amdgcn_s_barrier();
#pragma unroll 1
  for (int s = 0; s < DEPTH; s++) {
    if (!idone) {
      issue(mi0, ni0, ki, (g + pend) % NSLOT);
      pend++;
      if (++ki == nk) { ki = 0; ui += ustep; if (ui < nunits) tile_of(ui, mi0, ni0); else idone = true; }
    }
  }
  while (true) {
    f32x16 acc[MI][2];
#pragma unroll
    for (int a = 0; a < MI; a++)
#pragma unroll
      for (int b = 0; b < 2; b++)
#pragma unroll
        for (int i = 0; i < 16; i++) acc[a][b][i] = 0.f;
#pragma unroll 1
    for (int kt = 0; kt < nk; kt++) {
      if (DEPTH == 3) {
        if (pend >= 3) asm volatile("s_waitcnt vmcnt(8)" ::: "memory");
        else if (pend == 2) asm volatile("s_waitcnt vmcnt(4)" ::: "memory");
        else asm volatile("s_waitcnt vmcnt(0)" ::: "memory");
      } else {
        asm volatile("s_waitcnt vmcnt(0)" ::: "memory");
      }
      asm volatile("s_waitcnt lgkmcnt(0)" ::: "memory");
      __builtin_amdgcn_s_barrier();
      if (DEPTH == 1) pend = 0;
      if (!idone) {
        issue(mi0, ni0, ki, (g + (DEPTH == 1 ? 1 : pend)) % NSLOT);
        if (DEPTH == 1) pend = 1;
        if (++ki == nk) { ki = 0; ui += ustep; if (ui < nunits) tile_of(ui, mi0, ni0); else idone = true; }
      } else {
        if (DEPTH != 1) pend--;
      }
      const char* sb = smem + (g % NSLOT) * STAGE;
      g++;
      {
        s16x8 a[MI], a2[MI];
#pragma unroll
        for (int i = 0; i < MI; i++) { a[i] = *(const s16x8*)(sb + aro + i * 32 * 64 + xo0); a2[i] = *(const s16x8*)(sb + aro + i * 32 * 64 + xo1); }
        const s16x8 b0 = *(const s16x8*)(sb + bro + xo0);
        const s16x8 b1 = *(const s16x8*)(sb + bro + 32 * 64 + xo0);
        const s16x8 b2 = *(const s16x8*)(sb + bro + xo1);
        const s16x8 b3 = *(const s16x8*)(sb + bro + 32 * 64 + xo1);
#pragma unroll
        for (int i = 0; i < MI; i++) { acc[i][0] = mfma(a[i], b0, acc[i][0]); acc[i][1] = mfma(a[i], b1, acc[i][1]); }
#pragma unroll
        for (int i = 0; i < MI; i++) { acc[i][0] = mfma(a2[i], b2, acc[i][0]); acc[i][1] = mfma(a2[i], b3, acc[i][1]); }
      }
    }
    epilogue<EPI, MI>(P, l, acc, m0 + wm * (BM / 2), n0 + wn * 64, r, h);
    u += ustep;
    if (u >= nunits) break;
    tile_of(u, m0, n0);
  }
  asm volatile("s_waitcnt vmcnt(0) lgkmcnt(0)" ::: "memory");
}

DI void phase_attn(const Params& P, int l, char* smem) {
  const u16* qf = (const u16*)(P.ws + WS_QF);
  const u16* fk = (const u16*)(P.ws + WS_FOXK);
  const u16* fv = (const u16*)(P.ws + WS_FOXV);
  const float* cum = (const float*)(P.ws + WS_CUM);
  const u16* qm = (const u16*)(P.ws + WS_R1 + R1_QM);
  const u16* kv = (const u16*)(P.ws + WS_R1 + R1_KV);
  const u16* krp = (const u16*)(P.ws + WS_KROPE);
  u16* mixed = (u16*)(P.ws + WS_ACTA);
  constexpr float LOG2E = 1.4426950408889634f;
  const int total = 384 + 32 * 96;
  for (int t = get_bid(); t < total; t += get_nblk()) {
    bool isfox, issample; int b, hd, qb = 0;
    if (t < 256) { isfox = true; issample = true; b = t >> 3; hd = t & 7; }
    else if (t < 384) { isfox = false; issample = true; const int u = t - 256; b = u >> 2; hd = u & 3; }
    else {
      const int u = t - 384; const int grp = u / 96; int w = u % 96; qb = 31 - grp; issample = false;
      if (w < 32) { isfox = false; b = w >> 2; hd = w & 3; }
      else { w -= 32; isfox = true; b = w >> 3; hd = w & 7; }
    }
    AttnJob J;
    J.wv = P.wv;
    size_t tok0, krow0;
    if (issample) { tok0 = (size_t)TP + (size_t)b * DS; krow0 = (size_t)TP + (size_t)b * SKS; J.nq = DS; J.Sk = SKS; J.qpos0 = PAST; }
    else { tok0 = (size_t)b * SEQ + (size_t)qb * 128; krow0 = (size_t)b * SEQ; J.nq = 128; J.Sk = SEQ; J.qpos0 = qb * 128; }
    if (isfox) {
      J.Q = qf + tok0 * 512 + hd * 64; J.ldq = 512;
      J.K1 = fk + krow0 * 512 + hd * 64; J.ldk1 = 512; J.K2 = J.K1; J.ldk2 = 512;
      J.V = fv + krow0 * 512 + hd * 64; J.ldv = 512;
      J.O = mixed + tok0 * 1024 + hd * 64; J.ldo = 1024;
      J.cq = cum + (krow0 + (size_t)J.qpos0) * 8 + hd;
      J.ck = cum + krow0 * 8 + hd;
      J.scale_log2 = 0.125f * LOG2E;
      attn_block<64, 64, 64, MASK_FRAME, true, FOX_PF, 512, 512, 512, 512, 1024, FOX_KT>(J, smem);
    } else {
      J.Q = qm + tok0 * 768 + hd * 192; J.ldq = 768;
      J.K1 = kv + krow0 * 1024 + hd * 256; J.ldk1 = 1024;
      J.K2 = krp + krow0 * 64; J.ldk2 = 64;
      J.V = kv + krow0 * 1024 + hd * 256 + 128; J.ldv = 1024;
      J.O = mixed + tok0 * 1024 + 512 + hd * 128; J.ldo = 1024;
      J.cq = nullptr; J.ck = nullptr;
      J.scale_log2 = 0.07216878364870322f * LOG2E;
      attn_block<192, 128, 128, MASK_CHUNK, false, MLA_PF, 768, 1024, 64, 1024, 1024, 64>(J, smem);
    }
  }
}

DI void phase_cross(const Params& P, int l, char* smem) {
  const u16* xq = (const u16*)(P.ws + WS_R1 + R1_XQ);
  const u16* mk = (const u16*)(P.ws + WS_MEMK) + (size_t)l * MB * NMEM * 1024;
  const u16* mv = (const u16*)(P.ws + WS_MEMV) + (size_t)l * MB * NMEM * 1024;
  u16* xo = (u16*)(P.ws + WS_ACTA);
  constexpr float LOG2E = 1.4426950408889634f;
  const int nsamp = DB * 4 * 2;
  const int total = nsamp + 256 * 4 * 2;
  for (int t = get_bid(); t < total; t += get_nblk()) {
    AttnJob J;
    J.wv = P.wv;
    size_t tok0; int mb, hd, half;
    if (t < nsamp) { const int b = t >> 3; hd = (t >> 1) & 3; half = t & 1; tok0 = (size_t)TP + (size_t)b * DS; mb = NB + b; J.nq = DS; }
    else { const int u = t - nsamp; const int qbk = u >> 3; hd = (u >> 1) & 3; half = u & 1; tok0 = (size_t)qbk * 128; mb = qbk >> 5; J.nq = 128; }
    J.Sk = NMEM; J.qpos0 = 0;
    J.Q = xq + tok0 * 1024 + hd * 256; J.ldq = 1024;
    J.K1 = mk + (size_t)mb * NMEM * 1024 + hd * 256; J.ldk1 = 1024; J.K2 = J.K1; J.ldk2 = 1024;
    J.V = mv + (size_t)mb * NMEM * 1024 + hd * 256 + half * 128; J.ldv = 1024;
    J.O = xo + tok0 * 1024 + hd * 256 + half * 128; J.ldo = 1024;
    J.cq = nullptr; J.ck = nullptr;
    J.scale_log2 = 0.0625f * LOG2E;
    attn_block<256, 256, 128, MASK_NONE, false, false, 1024, 1024, 1024, 1024, 1024, 64>(J, smem);
  }
}

#define XB_TMO      128
#define XB_XCNT(j)  (256  + 64 * (j))
#define XB_XSUB(j)  (1280 + 64 * (j))
#define XB_XGEN(j)  (2304 + 64 * (j))
#define XB_TOP      3328
#define XB_TOPGEN   3392
#define XCD_BAR_WORDS 3456
#define XB_SPIN_CAP (1u << 20)
DI unsigned xb_ld(unsigned* p) { return __hip_atomic_load(p, __ATOMIC_RELAXED, __HIP_MEMORY_SCOPE_AGENT); }
DI unsigned xb_add(unsigned* p, unsigned v) { return __hip_atomic_fetch_add(p, v, __ATOMIC_RELAXED, __HIP_MEMORY_SCOPE_AGENT); }
DI unsigned xb_xcc_id() { return (unsigned)__builtin_amdgcn_s_getreg((3 << 11) | 20) & 0xFu; }
#define XB_SPIN(cond, bar) do { unsigned _sp = 0; while (cond) { __builtin_amdgcn_s_sleep(1); \
    if ((++_sp & 255u) == 0u) { if (xb_ld(&(bar)[XB_TMO])) break; if (_sp > XB_SPIN_CAP) { atomicAdd(&(bar)[XB_TMO], 1u); break; } } } } while (0)
DI void xb_census(unsigned* bar, unsigned x, unsigned& nloc, unsigned& nx) {
  const unsigned G = gridDim.x;
  unsigned sum, cnt, mine, sp = 0u;
  for (;;) {
    sum = 0u; cnt = 0u; mine = 0u;
#pragma unroll
    for (unsigned j = 0; j < 16; ++j) { const unsigned c = xb_ld(&bar[XB_XCNT(j)]); sum += c; cnt += (c > 0u) ? 1u : 0u; mine = (j == x) ? c : mine; }
    if (sum == G) break;
    __builtin_amdgcn_s_sleep(1);
    if ((++sp & 255u) == 0u) { if (xb_ld(&bar[XB_TMO])) break; if (sp > XB_SPIN_CAP) { atomicAdd(&bar[XB_TMO], 1u); break; } }
  }
  nloc = mine > 0u ? mine : 1u; nx = cnt > 0u ? cnt : 1u;
}
DI void xcd_barrier(unsigned* bar, unsigned x, unsigned nloc, unsigned nx, int wv) {
  asm volatile("s_waitcnt vmcnt(0)" ::: "memory");
  __syncthreads();
  if (wv == 0 && lane_id() == 0) {
    __builtin_amdgcn_s_waitcnt(0);
    const unsigned old = xb_add(&bar[XB_XSUB(x)], 1u);
    const unsigned gen = old / nloc;
    if (old + 1u == (gen + 1u) * nloc) {
      __builtin_amdgcn_fence(__ATOMIC_RELEASE, "agent");
      asm volatile("s_waitcnt vmcnt(0)" ::: "memory");
      const unsigned og = xb_add(&bar[XB_TOP], 1u);
      const unsigned tg = og / nx;
      if (og + 1u == (tg + 1u) * nx) xb_add(&bar[XB_TOPGEN], 1u);
      else XB_SPIN(xb_ld(&bar[XB_TOPGEN]) == tg, bar);
      __builtin_amdgcn_fence(__ATOMIC_ACQUIRE, "agent");
      xb_add(&bar[XB_XGEN(x)], 1u);
      asm volatile("s_waitcnt vmcnt(0)" ::: "memory");
    } else {
      XB_SPIN(xb_ld(&bar[XB_XGEN(x)]) == gen, bar);
      __builtin_amdgcn_fence(__ATOMIC_ACQUIRE, "agent");
      asm volatile("s_waitcnt vmcnt(0)" ::: "memory");
    }
  }
  __syncthreads();
}

constexpr int NPHASE = 2 + 13 * NL;

DI void run_phase(const Params& P, int ph, char* smem, bool dup = false) {
  if (ph == 0) { phase_prep(P, smem); return; }
  if (ph == NPHASE - 1) { phase_final(P); return; }
  const int l = (ph - 1) / 13, k = (ph - 1) % 13;
  char* ws = P.ws;
  const u16* actA = (const u16*)(ws + WS_ACTA);
  int rot = 0;
  switch (k) {
    case 0: phase_norm(P, P.in[10] + l * 1024, l); break;
    case 1:
      gemm_phase<EPI_IN, BM_BIG>(P, l, actA, 1024, wt_ptr(P, l, WE_IN), 1024, 1024, TT, INP, smem, rot);
      if (l == 0) {
        for (int l2 = 0; l2 < NL; l2++)
          gemm_phase<EPI_MEM, 128>(P, l2, (const u16*)(ws + WS_HMEM) + (size_t)l2 * NB * NMEM * 1024, 1024, wt_ptr(P, l2, WE_MKV), 1024, 1024,
                              NB * NMEM, 2048, smem, rot);
      }
      break;
    case 2: phase_post(P, l, smem); break;
    case 3:
      gemm_phase<EPI_KV, 128>(P, l, (const u16*)(ws + WS_CKV), 128, wt_ptr(P, l, WE_UKV), 128, 128, KROWS, 1024, smem, rot);
      gemm_phase<EPI_UQ, 128>(P, l, (const u16*)(ws + WS_CQN), 256, wt_ptr(P, l, WE_UQ), 256, 256, TT, 768, smem, rot);
      break;
    case 4: phase_attn(P, l, smem); break;
    case 5: if (dup) gemm_phase<EPI_RESID0, 128>(P, l, actA, 1024, wt_ptr(P, l, WE_OUT), 1024, 1024, TT, 1024, smem, rot); else gemm_phase<EPI_RESID, 128>(P, l, actA, 1024, wt_ptr(P, l, WE_OUT), 1024, 1024, TT, 1024, smem, rot); break;
    case 6: phase_norm(P, P.in[18] + l * 1024, -1); break;
    case 7: gemm_phase<EPI_XQ, 128>(P, l, actA, 1024, wt_ptr(P, l, WE_XQ), 1024, 1024, TT, 1024, smem, rot); break;
    case 8: phase_cross(P, l, smem); break;
    case 9: if (dup) gemm_phase<EPI_RESID0, 128>(P, l, actA, 1024, wt_ptr(P, l, WE_XO), 1024, 1024, TT, 1024, smem, rot); else gemm_phase<EPI_RESID, 128>(P, l, actA, 1024, wt_ptr(P, l, WE_XO), 1024, 1024, TT, 1024, smem, rot); break;
    case 10: phase_norm(P, P.in[24] + l * 1024, -1); break;
    case 11: gemm_phase<EPI_UP, BM_BIG>(P, l, actA, 1024, wt_ptr(P, l, WE_UP), 1024, 1024, TT, DFF, smem, rot); break;
    case 12: if (dup) gemm_phase<EPI_RESID0, 128>(P, l, (const u16*)(ws + WS_R1 + R1_U), DFF, wt_ptr(P, l, WE_DN), DFF, DFF, TT, 1024, smem, rot); else gemm_phase<EPI_RESID, 128>(P, l, (const u16*)(ws + WS_R1 + R1_U), DFF, wt_ptr(P, l, WE_DN), DFF, DFF, TT, 1024, smem, rot); break;
  }
}

__global__ void __launch_bounds__(256, LB_MIN) mega(Params P, int ph_lo, int ph_hi) {
  __shared__ __attribute__((aligned(16))) char smem[SMEM_BYTES];
  cg::grid_group grid = cg::this_grid();
  if (ph_hi > 4096) grid.sync();
  unsigned* bar = (unsigned*)(P.ws + WS_BAR);
  const unsigned xb_x = xb_xcc_id();
  unsigned xb_nloc = 1u, xb_nx = 1u;
  if (threadIdx.x == 0) { (void)xb_add(&bar[XB_XCNT(xb_x)], 1u); xb_census(bar, xb_x, xb_nloc, xb_nx); }
  xb_nloc = __builtin_amdgcn_readfirstlane(xb_nloc);
  xb_nx = __builtin_amdgcn_readfirstlane(xb_nx);
  unsigned xb_pack = xb_nloc | (xb_nx << 16) | (xb_x << 24) | ((unsigned)__builtin_amdgcn_readfirstlane(threadIdx.x >> 6) << 28);
  asm volatile("" : "+s"(xb_pack));
  for (int ph = ph_lo; ph < ph_hi; ph++) {
    Params Q = P;
    unsigned pk = xb_pack;
    asm volatile("" : "+s"(Q.out), "+s"(Q.ws), "+s"(pk));
    Q.wv = (int)(pk >> 28);
    run_phase(Q, ph, smem);
    if (ph + 1 < ph_hi) {
      unsigned pk2 = xb_pack;
      asm volatile("" : "+s"(pk2));
      xcd_barrier((unsigned*)(Q.ws + WS_BAR), (pk2 >> 24) & 0xfu, pk2 & 0xffffu, (pk2 >> 16) & 0xffu, (int)(pk2 >> 28));
    }
  }
}

extern "C" void kernel_launch(void* const* d_in, const int* in_sizes, int n_in, void* d_out, int out_size, void* d_ws,
                              size_t ws_size, hipStream_t stream) {
  static int grid_blocks = 0;
  if (!grid_blocks) {
    int dev = 0, cus = 0, per_cu = 0;
    hipGetDevice(&dev);
    hipDeviceGetAttribute(&cus, hipDeviceAttributeMultiprocessorCount, dev);
    hipOccupancyMaxActiveBlocksPerMultiprocessor(&per_cu, mega, 256, 0);
    if (per_cu < 1) per_cu = 1;
    if (per_cu > 2) per_cu = 2;
    grid_blocks = cus * per_cu;
  }
  if (n_in != 28 || (size_t)out_size != O_END || ws_size < WS_END) {
    fprintf(stderr, "kernel_launch: shape/ws mismatch n_in %d out %d (want %zu) ws %zu (want %zu)\n", n_in, out_size, (size_t)O_END, ws_size, (size_t)WS_END);
    return;
  }
  Params p;
  memset(&p, 0, sizeof(p));
  for (int i = 0; i < 28; i++) p.in[i] = (const float*)d_in[i];
  p.out = (float*)d_out;
  p.ws = (char*)d_ws;
  hipMemsetAsync((char*)d_ws + WS_BAR, 0, XCD_BAR_WORDS * 4, stream);
  int lo = 0, hi = NPHASE;
  void* args[] = {&p, &lo, &hi};
  hipError_t e = hipLaunchCooperativeKernel((void*)mega, dim3(grid_blocks), dim3(256), args, 0, stream);
  if (e != hipSuccess) fprintf(stderr, "cooperative launch failed: %s (grid %d)\n", hipGetErrorString(e), grid_blocks);
}
```

```cpp
#include <hip/hip_runtime.h>
#include <hip/hip_cooperative_groups.h>
#include <stdint.h>
#include <string.h>
#include <stdio.h>
namespace cg = cooperative_groups;

#ifndef COOP
#define COOP 1
#endif

#ifndef FOX_KT
#define FOX_KT 128
#endif
#ifndef FOX_PF
#define FOX_PF true
#endif
#ifndef MLA_PF
#define MLA_PF true
#endif
#ifndef LB_MIN
#define LB_MIN 2
#endif
#ifndef BM_BIG
#define BM_BIG 256
#endif
constexpr int NTHR = 512, NWV = 8;
#define DI __device__ __forceinline__
typedef unsigned short u16;
typedef short s16x8 __attribute__((ext_vector_type(8)));
typedef short s16x4 __attribute__((ext_vector_type(4)));
typedef __bf16 bfx8 __attribute__((ext_vector_type(8)));
typedef __bf16 bfx2 __attribute__((ext_vector_type(2)));
typedef float f32x16 __attribute__((ext_vector_type(16)));
typedef float f32x4 __attribute__((ext_vector_type(4)));
typedef float f32x2 __attribute__((ext_vector_type(2)));
typedef unsigned u32x4 __attribute__((ext_vector_type(4)));
typedef unsigned u32x2 __attribute__((ext_vector_type(2)));

constexpr int DM = 1024, NB = 8, SEQ = 4096, NL = 2, DB = 32, DS = 32, PAST = 2048;
constexpr int TP = NB * SEQ;
constexpr int TS = DB * DS;
constexpr int TT = TP + TS;
constexpr int SKS = PAST + DS;
constexpr int KROWS = TP + DB * SKS;
constexpr int INC = 1992, INP = 2048;
constexpr int NMEM = 256, MB = NB + DB;
constexpr int DFF = 4096;

constexpr size_t O_Y = 0;
constexpr size_t O_FKP = (size_t)TT * DM;
constexpr size_t O_FVP = O_FKP + (size_t)NL * TP * 512;
constexpr size_t O_FLP = O_FVP + (size_t)NL * TP * 512;
constexpr size_t O_CKP = O_FLP + (size_t)NL * TP * 8;
constexpr size_t O_KRP = O_CKP + (size_t)NL * TP * 128;
constexpr size_t O_MKP = O_KRP + (size_t)NL * TP * 64;
constexpr size_t O_MVP = O_MKP + (size_t)NL * NB * NMEM * 1024;
constexpr size_t O_FKS = O_MVP + (size_t)NL * NB * NMEM * 1024;
constexpr size_t O_FVS = O_FKS + (size_t)NL * TS * 512;
constexpr size_t O_FLS = O_FVS + (size_t)NL * TS * 512;
constexpr size_t O_CKS = O_FLS + (size_t)NL * TS * 8;
constexpr size_t O_KRS = O_CKS + (size_t)NL * TS * 128;
constexpr size_t O_END = O_KRS + (size_t)NL * TS * 64;

constexpr size_t al256(size_t x) { return (x + 255) / 256 * 256; }
constexpr size_t WE_IN = 0;
constexpr size_t WE_UQ = WE_IN + (size_t)INP * 1024;
constexpr size_t WE_UKV = WE_UQ + (size_t)768 * 256;
constexpr size_t WE_OUT = WE_UKV + (size_t)1024 * 128;
constexpr size_t WE_XQ = WE_OUT + (size_t)1024 * 1024;
constexpr size_t WE_MKV = WE_XQ + (size_t)1024 * 1024;
constexpr size_t WE_XO = WE_MKV + (size_t)2048 * 1024;
constexpr size_t WE_UP = WE_XO + (size_t)1024 * 1024;
constexpr size_t WE_DN = WE_UP + (size_t)4096 * 1024;
constexpr size_t WE_LAYER = WE_DN + (size_t)1024 * 4096;
constexpr size_t WS_WT = 0;
constexpr size_t WS_ROPE = al256(WS_WT + WE_LAYER * 2 * NL);
constexpr size_t WS_ACTA = al256(WS_ROPE + (size_t)4096 * 32 * 8);
constexpr size_t WS_QF = al256(WS_ACTA + (size_t)TT * 1024 * 2);
constexpr size_t WS_FOXK = al256(WS_QF + (size_t)TT * 512 * 2);
constexpr size_t WS_FOXV = al256(WS_FOXK + (size_t)KROWS * 512 * 2);
constexpr size_t WS_CUM = al256(WS_FOXV + (size_t)KROWS * 512 * 2);
constexpr size_t WS_ZC = al256(WS_CUM + (size_t)KROWS * 8 * 4);
constexpr size_t WS_CQN = al256(WS_ZC + (size_t)TT * 448 * 4);
constexpr size_t WS_CKV = al256(WS_CQN + (size_t)TT * 256 * 2);
constexpr size_t WS_KROPE = al256(WS_CKV + (size_t)KROWS * 128 * 2);
constexpr size_t WS_MEMK = al256(WS_KROPE + (size_t)KROWS * 64 * 2);
constexpr size_t WS_MEMV = al256(WS_MEMK + (size_t)NL * MB * NMEM * 1024 * 2);
constexpr size_t WS_HMEM = al256(WS_MEMV + (size_t)NL * MB * NMEM * 1024 * 2);
constexpr size_t WS_R1 = al256(WS_HMEM + (size_t)NL * NB * NMEM * 1024 * 2);
constexpr size_t R1_KV = 0;
constexpr size_t R1_QM = al256((size_t)KROWS * 1024 * 2);
constexpr size_t R1_U = 0;
constexpr size_t R1_XQ = 0;
constexpr size_t WS_BAR = al256(WS_R1 + (size_t)TT * 4096 * 2);
constexpr size_t WS_END = al256(WS_BAR + 3456 * 4);
static_assert(R1_QM + (size_t)TT * 768 * 2 <= (size_t)TT * 4096 * 2, "R1 overflow");

constexpr int SMEM_BYTES = 131072;

struct Params {
  const float* in[28];
  float* out;
  char* ws;
  int wv;
  int pad;
};

DI int get_bid() { int t = blockIdx.x; asm volatile("" : "+s"(t)); return t; }
DI int get_nblk() { int t = gridDim.x; asm volatile("" : "+s"(t)); return t; }
DI int lane_id() { return (int)__builtin_amdgcn_mbcnt_hi(~0u, __builtin_amdgcn_mbcnt_lo(~0u, 0u)); }
DI int get_tid(int wv) { int t = (wv << 6) | lane_id(); asm volatile("" : "+v"(t)); return t; }
DI unsigned pk2(float a, float b) { f32x2 v = {a, b}; return __builtin_bit_cast(unsigned, __builtin_convertvector(v, bfx2)); }
DI u16 f2bf(float a) { return (u16)(pk2(a, 0.f) & 0xffffu); }
DI f32x16 mfma(s16x8 a, s16x8 b, f32x16 c) {
  return __builtin_amdgcn_mfma_f32_32x32x16_bf16(__builtin_bit_cast(bfx8, a), __builtin_bit_cast(bfx8, b), c, 0, 0, 0);
}
DI int crow(int i, int h) { return (i & 3) + 8 * (i >> 2) + 4 * h; }
DI float wave_sum(float v) {
#pragma unroll
  for (int m = 32; m >= 1; m >>= 1) v += __shfl_xor(v, m);
  return v;
}
DI float xhalf_max(float v) {
  auto rr = __builtin_amdgcn_permlane32_swap(__float_as_uint(v), __float_as_uint(v), false, false);
  return fmaxf(__uint_as_float(rr[0]), __uint_as_float(rr[1]));
}
DI float xhalf_sum(float v) {
  auto rr = __builtin_amdgcn_permlane32_swap(__float_as_uint(v), __float_as_uint(v), false, false);
  return __uint_as_float(rr[0]) + __uint_as_float(rr[1]);
}
DI int tok_krow(int tok) {
  if (tok < TP) return tok;
  const int s = tok - TP;
  return TP + (s >> 5) * SKS + PAST + (s & 31);
}
DI int tok_pos(int tok) { return tok < TP ? (tok & (SEQ - 1)) : PAST + ((tok - TP) & 31); }

enum { EPI_IN = 0, EPI_MEM, EPI_UQ, EPI_KV, EPI_RESID, EPI_XQ, EPI_UP, EPI_RESID0 };

template <int EPI, int MI>
DI void epilogue(const Params& P, int l, f32x16 (&acc)[MI][2], int mw, int nw, int r, int h) {
  float* out = P.out;
  char* ws = P.ws;
  if constexpr (EPI == EPI_IN) {
    u16* qf = (u16*)(ws + WS_QF);
    u16* fk = (u16*)(ws + WS_FOXK);
    u16* fv = (u16*)(ws + WS_FOXV);
    float* zc = (float*)(ws + WS_ZC);
    const float* bfg = P.in[12] + l * 8;
#pragma unroll
    for (int mi = 0; mi < MI; mi++) {
#pragma unroll
      for (int i = 0; i < 16; i++) {
        const int row = mw + mi * 32 + crow(i, h);
        const int kr = tok_krow(row);
        const bool isp = row < TP;
        const size_t orow = isp ? ((size_t)l * TP + row) : ((size_t)l * TS + (row - TP));
#pragma unroll
        for (int ni = 0; ni < 2; ni++) {
          const int col = nw + ni * 32 + r;
          const float v = acc[mi][ni][i];
          if (col < 512) {
            qf[(size_t)row * 512 + col] = f2bf(v);
          } else if (col < 1024) {
            const int c = col - 512;
            out[(isp ? O_FKP : O_FKS) + orow * 512 + c] = v;
            fk[(size_t)kr * 512 + c] = f2bf(v);
          } else if (col < 1536) {
            const int c = col - 1024;
            out[(isp ? O_FVP : O_FVS) + orow * 512 + c] = v;
            fv[(size_t)kr * 512 + c] = f2bf(v);
          } else if (col < 1544) {
            const int c = col - 1536;
            const float g = v + bfg[c];
            const float ls = fminf(g, 0.f) - __logf(1.f + __expf(-fabsf(g)));
            out[(isp ? O_FLP : O_FLS) + orow * 8 + c] = ls;
          } else if (col < INC) {
            zc[(size_t)row * 448 + (col - 1544)] = v;
          }
        }
      }
    }
  } else if constexpr (EPI == EPI_MEM) {
    u16* mk = (u16*)(ws + WS_MEMK);
    u16* mv = (u16*)(ws + WS_MEMV);
#pragma unroll
    for (int mi = 0; mi < MI; mi++) {
#pragma unroll
      for (int i = 0; i < 16; i++) {
        const int row = mw + mi * 32 + crow(i, h);
#pragma unroll
        for (int ni = 0; ni < 2; ni++) {
          const int col = nw + ni * 32 + r;
          const float v = acc[mi][ni][i];
          const int c = col & 1023;
          const size_t oidx = ((size_t)l * (NB * NMEM) + row) * 1024 + c;
          const size_t bidx = ((size_t)l * (MB * NMEM) + row) * 1024 + c;
          if (col < 1024) { out[O_MKP + oidx] = v; mk[bidx] = f2bf(v); }
          else { out[O_MVP + oidx] = v; mv[bidx] = f2bf(v); }
        }
      }
    }
  } else if constexpr (EPI == EPI_UQ) {
    u16* qm = (u16*)(ws + WS_R1 + R1_QM);
    const f32x2* rt = (const f32x2*)(ws + WS_ROPE);
    const bool isrope = (nw % 192) == 128;
#pragma unroll
    for (int mi = 0; mi < MI; mi++) {
#pragma unroll
      for (int i = 0; i < 16; i++) {
        const int row = mw + mi * 32 + crow(i, h);
        float x1 = acc[mi][0][i], x2 = acc[mi][1][i];
        if (isrope) {
          const f32x2 cs = rt[tok_pos(row) * 32 + r];
          const float o1 = x1 * cs[0] - x2 * cs[1];
          const float o2 = x2 * cs[0] + x1 * cs[1];
          x1 = o1; x2 = o2;
        }
        qm[(size_t)row * 768 + nw + r] = f2bf(x1);
        qm[(size_t)row * 768 + nw + 32 + r] = f2bf(x2);
      }
    }
  } else if constexpr (EPI == EPI_KV || EPI == EPI_XQ || EPI == EPI_UP) {
    u16* dst; int ld;
    if constexpr (EPI == EPI_KV) { dst = (u16*)(ws + WS_R1 + R1_KV); ld = 1024; }
    else if constexpr (EPI == EPI_XQ) { dst = (u16*)(ws + WS_R1 + R1_XQ); ld = 1024; }
    else { dst = (u16*)(ws + WS_R1 + R1_U); ld = DFF; }
    const bool odd = r & 1;
    const int colb = nw + (r & ~1);
#pragma unroll
    for (int mi = 0; mi < MI; mi++) {
#pragma unroll
      for (int i = 0; i < 16; i += 2) {
        const int row = mw + mi * 32 + crow(i, h) + (odd ? 1 : 0);
#pragma unroll
        for (int ni = 0; ni < 2; ni++) {
          float v0 = acc[mi][ni][i], v1 = acc[mi][ni][i + 1];
          if constexpr (EPI == EPI_UP) { v0 = fmaxf(v0, 0.f); v0 = v0 * v0; v1 = fmaxf(v1, 0.f); v1 = v1 * v1; }
          const float send = odd ? v0 : v1;
          const float recv = __int_as_float(__builtin_amdgcn_mov_dpp(__float_as_int(send), 0xB1, 0xF, 0xF, true));
          const unsigned w = odd ? pk2(recv, v1) : pk2(v0, recv);
          *(unsigned*)(dst + (size_t)row * ld + colb + ni * 32) = w;
        }
      }
    }
  } else if constexpr (EPI == EPI_RESID || EPI == EPI_RESID0) {
#pragma unroll
    for (int mi = 0; mi < MI; mi++) {
#pragma unroll
      for (int i = 0; i < 16; i++) {
        const int row = mw + mi * 32 + crow(i, h);
#pragma unroll
        for (int ni = 0; ni < 2; ni++) {
          unsafeAtomicAdd(out + (size_t)row * DM + nw + ni * 32 + r, EPI == EPI_RESID0 ? acc[mi][ni][i] * 0.f : acc[mi][ni][i]);
        }
      }
    }
  }
}

enum { MASK_NONE = 0, MASK_FRAME = 1, MASK_CHUNK = 2 };
struct AttnJob {
  const u16* Q; int ldq;
  const u16* K1; int ldk1;
  const u16* K2; int ldk2;
  const u16* V; int ldv;
  u16* O; int ldo;
  const float* cq;
  const float* ck;
  int nq, Sk, qpos0;
  float scale_log2;
  int wv;
};

template <int DQK, int D1, int DVT, int MASK, bool BIAS, bool PREFETCH, int LDQ, int LDK1, int LDK2, int LDV, int LDO, int KT>
DI void attn_block(const AttnJob& J, char* smem) {
  constexpr int KP = DQK * 2 + 16;
  constexpr int VP = DVT * 2;
  constexpr int CV = DVT / 8;
  constexpr int NKK = DQK / 16, NDV = DVT / 32;
  constexpr float LOG2E = 1.4426950408889634f;
  char* Ks = smem;
  char* Vs = smem + KT * KP;
  float* cks = (float*)(smem + KT * KP + KT * VP);
  const int tid = get_tid(J.wv), wave = tid >> 6, lane = tid & 63, r = lane & 31, h = lane >> 5;
  const int wq0 = wave * 32;
  const bool active = wq0 < J.nq;
  const int qi = wq0 + r;
  const int qpos = J.qpos0 + qi;
  const int wqmax = J.qpos0 + wq0 + 31;
  const int qmax = J.qpos0 + J.nq - 1;
  const int ntk = (J.Sk + KT - 1) / KT;
  int nt = ntk;
  if (MASK != MASK_NONE) { const int t2 = qmax / KT + 1; nt = t2 < ntk ? t2 : ntk; }

  s16x8 qf[NKK];
  {
    const u16* qp = J.Q + (size_t)qi * LDQ + h * 8;
#pragma unroll
    for (int kk = 0; kk < NKK; kk++) {
      if (active) qf[kk] = *(const s16x8*)(qp + kk * 16);
      else { s16x8 z = {0, 0, 0, 0, 0, 0, 0, 0}; qf[kk] = z; }
    }
  }
  float cqv = 0.f;
  if (BIAS) { if (active) cqv = J.cq[(size_t)qi * 8] * LOG2E; }

  f32x16 o[NDV];
#pragma unroll
  for (int d = 0; d < NDV; d++)
#pragma unroll
    for (int i = 0; i < 16; i++) o[d][i] = 0.f;
  float m_run = -1e30f, l_run = 0.f;

  constexpr int CK1 = D1 / 8, CK2 = (DQK - D1) / 8;
  constexpr int RP1 = NTHR / CK1, NP1 = KT / RP1;
  constexpr int RP2 = CK2 ? NTHR / (CK2 ? CK2 : 1) : 64, NP2 = CK2 ? KT / RP2 : 0;
  constexpr int RPV = NTHR / CV, NPV = KT / RPV;
  u32x4 rk1[NP1], rk2[NP2 ? NP2 : 1], rv[NPV];
  float rck = 0.f;
  const int tq = (lane & 15) >> 2, tp = lane & 3, tblk = (lane >> 4) & 1;
  const int vswz = (DVT >= 128) ? tq : (tq >> 1);
  const int r1 = tid / CK1, c1 = tid % CK1;
  const int r2 = CK2 ? tid / (CK2 ? CK2 : 1) : 0, c2 = CK2 ? tid % (CK2 ? CK2 : 1) : 0;
  const int r3 = tid / CV, c3 = tid % CV;
  const unsigned k1o = (unsigned)(r1 * LDK1 + c1 * 8) * 2u;
  const unsigned k2o = (unsigned)(r2 * LDK2 + c2 * 8) * 2u;
  const unsigned vo = (unsigned)(r3 * LDV + c3 * 8) * 2u;
  const int k1so = r1 * KP + c1 * 16;
  const int k2so = r2 * KP + D1 * 2 + c2 * 16;
  const int vsw = (DVT >= 128) ? (r3 & 3) : ((r3 >> 1) & 1);
  const int vso = KT * KP + r3 * VP + (((c3 >> 2) ^ vsw) * 64) + (c3 & 3) * 16;
  const int vro = KT * KP + (4 * h + tq) * VP + (16 * tblk + 4 * tp) * 2;
  const int kro = r * KP + h * 16;

  auto load_tile = [&](int j) {
    const int kb = j * KT;
#pragma unroll
    for (int i = 0; i < NP1; i++) {
      u32x4 v = {0u, 0u, 0u, 0u};
      if (kb + r1 + i * RP1 < J.Sk) v = *(const u32x4*)((const char*)(J.K1 + (size_t)(kb + i * RP1) * LDK1) + k1o);
      rk1[i] = v;
    }
#pragma unroll
    for (int i = 0; i < NP2; i++) {
      u32x4 v = {0u, 0u, 0u, 0u};
      if (kb + r2 + i * RP2 < J.Sk) v = *(const u32x4*)((const char*)(J.K2 + (size_t)(kb + i * RP2) * LDK2) + k2o);
      rk2[i] = v;
    }
#pragma unroll
    for (int i = 0; i < NPV; i++) {
      u32x4 v = {0u, 0u, 0u, 0u};
      if (kb + r3 + i * RPV < J.Sk) v = *(const u32x4*)((const char*)(J.V + (size_t)(kb + i * RPV) * LDV) + vo);
      rv[i] = v;
    }
    if (BIAS) {
      if (tid < KT) { const int key = kb + tid; rck = key < J.Sk ? J.ck[(size_t)key * 8] * LOG2E : 0.f; }
    }
  };
  auto store_tile = [&]() {
    int a1 = k1so, a2 = k2so, a3 = vso;
    asm volatile("" : "+v"(a1), "+v"(a2), "+v"(a3));
#pragma unroll
    for (int i = 0; i < NP1; i++) *(u32x4*)(smem + a1 + i * RP1 * KP) = rk1[i];
#pragma unroll
    for (int i = 0; i < NP2; i++) *(u32x4*)(smem + a2 + i * RP2 * KP) = rk2[i];
#pragma unroll
    for (int i = 0; i < NPV; i++) *(u32x4*)(smem + a3 + i * RPV * VP) = rv[i];
    if (BIAS) { if (tid < KT) cks[tid] = rck; }
  };

  if (PREFETCH) load_tile(0);
  for (int j = 0; j < nt; j++) {
    __syncthreads();
    if (!PREFETCH) load_tile(j);
    store_tile();
    __syncthreads();
    if (PREFETCH) { if (j + 1 < nt) load_tile(j + 1); }
    const bool need = active && (MASK == MASK_NONE || j * KT <= wqmax);
    if (need) {
      int kro_l = kro, vro_l = vro;
      asm volatile("" : "+v"(kro_l), "+v"(vro_l));
      const char* krd = smem + kro_l;
      const bool needmask = (MASK == MASK_FRAME && j * KT + KT - 1 > J.qpos0 + wq0) || (j * KT + KT - 1 >= J.Sk);
      const int dq = (MASK == MASK_FRAME ? min(qpos, J.Sk - 1) : J.Sk - 1) - j * KT - 4 * h;
#pragma unroll
      for (int hb = 0; hb < KT / 32; hb++) {
        if (MASK == MASK_FRAME && j * KT + hb * 32 > wqmax) continue;
        f32x16 p;
#pragma unroll
        for (int i = 0; i < 16; i++) p[i] = 0.f;
#pragma unroll
        for (int kk = 0; kk < NKK; kk++) {
          const s16x8 kf = *(const s16x8*)(krd + hb * 32 * KP + kk * 32);
          p = mfma(kf, qf[kk], p);
        }
        if (BIAS) {
#pragma unroll
          for (int g = 0; g < 4; g++) {
            const f32x4 c0 = *(const f32x4*)(cks + hb * 32 + 8 * g + 4 * h);
#pragma unroll
            for (int e = 0; e < 4; e++) p[4 * g + e] = fmaf(p[4 * g + e], J.scale_log2, cqv - c0[e]);
          }
        } else {
#pragma unroll
          for (int i = 0; i < 16; i++) p[i] *= J.scale_log2;
        }
        if (needmask) {
#pragma unroll
          for (int i = 0; i < 16; i++) {
            const int cc = (i & 3) + 8 * (i >> 2) + 32 * hb;
            p[i] = (cc <= dq) ? p[i] : -1e30f;
          }
        }
        float mx = p[0];
#pragma unroll
        for (int i = 1; i < 16; i++) mx = fmaxf(mx, p[i]);
        mx = xhalf_max(mx);
        const float m_new = fmaxf(m_run, mx);
        const float alpha = __builtin_amdgcn_exp2f(m_run - m_new);
        m_run = m_new;
        float ps = 0.f;
#pragma unroll
        for (int i = 0; i < 16; i++) { p[i] = __builtin_amdgcn_exp2f(p[i] - m_new); ps += p[i]; }
        l_run = l_run * alpha + ps;
        if (__any(alpha != 1.f)) {
#pragma unroll
          for (int d = 0; d < NDV; d++)
#pragma unroll
            for (int i = 0; i < 16; i++) o[d][i] *= alpha;
        }
        s16x8 pb[2];
        {
          u32x4 w;
          w[0] = pk2(p[0], p[1]); w[1] = pk2(p[2], p[3]); w[2] = pk2(p[4], p[5]); w[3] = pk2(p[6], p[7]);
          pb[0] = __builtin_bit_cast(s16x8, w);
          w[0] = pk2(p[8], p[9]); w[1] = pk2(p[10], p[11]); w[2] = pk2(p[12], p[13]); w[3] = pk2(p[14], p[15]);
          pb[1] = __builtin_bit_cast(s16x8, w);
        }
#pragma unroll
        for (int d = 0; d < NDV; d++) {
          const char* vb = smem + (vro_l + ((d ^ vswz) * 64)) + hb * 32 * VP;
#pragma unroll
          for (int s = 0; s < 2; s++) {
            const s16x4 lo = __builtin_amdgcn_ds_read_tr16_b64_v4i16(
                (__attribute__((address_space(3))) s16x4*)(uintptr_t)(vb + (16 * s) * VP));
            const s16x4 hi = __builtin_amdgcn_ds_read_tr16_b64_v4i16(
                (__attribute__((address_space(3))) s16x4*)(uintptr_t)(vb + (16 * s + 8) * VP));
            const s16x8 vf = __builtin_shufflevector(lo, hi, 0, 1, 2, 3, 4, 5, 6, 7);
            o[d] = mfma(vf, pb[s], o[d]);
          }
        }
      }
    }
  }
  const float lt = xhalf_sum(l_run);
  if (active && qi < J.nq) {
    const float inv = 1.f / lt;
    u16* op = J.O + (size_t)qi * LDO + 4 * h;
#pragma unroll
    for (int d = 0; d < NDV; d++) {
#pragma unroll
      for (int g = 0; g < 4; g++) {
        u32x2 w;
        w[0] = pk2(o[d][4 * g] * inv, o[d][4 * g + 1] * inv);
        w[1] = pk2(o[d][4 * g + 2] * inv, o[d][4 * g + 3] * inv);
        *(u32x2*)(op + d * 32 + 8 * g) = w;
      }
    }
  }
}

template <int NR, bool F32OUT>
DI void rms_rows(const float* __restrict__ xbase, size_t rstride, int nvalid, const float* __restrict__ g, void* dbase, size_t dstride, int lane) {
  f32x4 v[NR][4];
#pragma unroll
  for (int j = 0; j < NR; j++)
#pragma unroll
    for (int i = 0; i < 4; i++) {
      if (j < nvalid) v[j][i] = *(const f32x4*)(xbase + (size_t)j * rstride + i * 256 + lane * 4);
      else { f32x4 z = {0.f, 0.f, 0.f, 0.f}; v[j][i] = z; }
    }
  f32x4 gg[4];
#pragma unroll
  for (int i = 0; i < 4; i++) gg[i] = *(const f32x4*)(g + i * 256 + lane * 4);
#pragma unroll
  for (int j = 0; j < NR; j++) {
    float ss = 0.f;
#pragma unroll
    for (int i = 0; i < 4; i++) ss += v[j][i][0] * v[j][i][0] + v[j][i][1] * v[j][i][1] + v[j][i][2] * v[j][i][2] + v[j][i][3] * v[j][i][3];
    ss = wave_sum(ss);
    const float rs = rsqrtf(ss * (1.f / 1024.f) + 1e-6f);
    if (j < nvalid) {
#pragma unroll
      for (int i = 0; i < 4; i++) {
        if (F32OUT) {
          f32x4 w;
          w[0] = v[j][i][0] * rs * gg[i][0]; w[1] = v[j][i][1] * rs * gg[i][1]; w[2] = v[j][i][2] * rs * gg[i][2]; w[3] = v[j][i][3] * rs * gg[i][3];
          *(f32x4*)((float*)dbase + (size_t)j * dstride + i * 256 + lane * 4) = w;
        } else {
          u32x2 w;
          w[0] = pk2(v[j][i][0] * rs * gg[i][0], v[j][i][1] * rs * gg[i][1]);
          w[1] = pk2(v[j][i][2] * rs * gg[i][2], v[j][i][3] * rs * gg[i][3]);
          *(u32x2*)((u16*)dbase + (size_t)j * dstride + i * 256 + lane * 4) = w;
        }
      }
    }
  }
}

DI void cvt_job(const float* __restrict__ src, u16* __restrict__ dst, int nseg, size_t seglen, size_t sstride, size_t dstride, int wv) {
  const size_t upseg = seglen / 8;
  const size_t total = upseg * nseg;
  const size_t stride = (size_t)get_nblk() * NTHR;
  for (size_t u0 = (size_t)get_bid() * NTHR + get_tid(wv); u0 < total; u0 += 4 * stride) {
    f32x4 a[4], b[4];
    size_t so[4], dd[4];
#pragma unroll
    for (int q = 0; q < 4; q++) {
      const size_t u = u0 + q * stride;
      const size_t uu = u < total ? u : u0;
      const size_t sg = uu / upseg, off = (uu - sg * upseg) * 8;
      so[q] = sg * sstride + off; dd[q] = sg * dstride + off;
      a[q] = *(const f32x4*)(src + so[q]);
      b[q] = *(const f32x4*)(src + so[q] + 4);
    }
#pragma unroll
    for (int q = 0; q < 4; q++) {
      if (u0 + q * stride < total) {
        u32x4 w;
        w[0] = pk2(a[q][0], a[q][1]); w[1] = pk2(a[q][2], a[q][3]); w[2] = pk2(b[q][0], b[q][1]); w[3] = pk2(b[q][2], b[q][3]);
        *(u32x4*)(dst + dd[q]) = w;
      }
    }
  }
}

DI void transpose_job(const float* __restrict__ src, u16* __restrict__ dst, int K, int N, int Npad, int& rot, char* smem, int wv) {
  float* tile = (float*)smem;
  const int tk = K / 64, tn = Npad / 64, ntiles = tk * tn;
  const int G = get_nblk();
  const int tid = get_tid(wv);
  for (int t = (get_bid() + G - (rot % G)) % G; t < ntiles; t += G) {
    const int k0 = (t % tk) * 64, n0 = (t / tk) * 64;
    float v[8];
#pragma unroll
    for (int i = 0; i < 8; i++) {
      const int k = i * 8 + (tid >> 6), n = tid & 63;
      v[i] = (n0 + n < N) ? src[(size_t)(k0 + k) * N + n0 + n] : 0.f;
    }
    __syncthreads();
#pragma unroll
    for (int i = 0; i < 8; i++) {
      const int k = i * 8 + (tid >> 6), n = tid & 63;
      tile[k * 65 + n] = v[i];
    }
    __syncthreads();
#pragma unroll
    for (int i = 0; i < 4; i++) {
      const int n = i * 16 + (tid >> 5), k = (tid & 31) * 2;
      *(unsigned*)(dst + (size_t)(n0 + n) * K + k0 + k) = pk2(tile[k * 65 + n], tile[(k + 1) * 65 + n]);
    }
  }
  rot += ntiles;
}

DI u16* wt_ptr(const Params& P, int l, size_t eoff) { return (u16*)(P.ws + WS_WT) + (size_t)l * WE_LAYER + eoff; }

DI void phase_prep(const Params& P, char* smem) {
  const int tid = get_tid(P.wv), lane = tid & 63;
  const int gw = get_bid() * NWV + (tid >> 6), nw = get_nblk() * NWV;
  int rot = 0;
  for (int l = 0; l < NL; l++) {
    transpose_job(P.in[11] + (size_t)l * 1024 * INC, wt_ptr(P, l, WE_IN), 1024, INC, INP, rot, smem, P.wv);
    transpose_job(P.in[14] + (size_t)l * 256 * 768, wt_ptr(P, l, WE_UQ), 256, 768, 768, rot, smem, P.wv);
    transpose_job(P.in[16] + (size_t)l * 128 * 1024, wt_ptr(P, l, WE_UKV), 128, 1024, 1024, rot, smem, P.wv);
    transpose_job(P.in[17] + (size_t)l * 1024 * 1024, wt_ptr(P, l, WE_OUT), 1024, 1024, 1024, rot, smem, P.wv);
    transpose_job(P.in[20] + (size_t)l * 1024 * 1024, wt_ptr(P, l, WE_XQ), 1024, 1024, 1024, rot, smem, P.wv);
    transpose_job(P.in[21] + (size_t)l * 1024 * 1024, wt_ptr(P, l, WE_MKV), 1024, 1024, 1024, rot, smem, P.wv);
    transpose_job(P.in[22] + (size_t)l * 1024 * 1024, wt_ptr(P, l, WE_MKV) + (size_t)1024 * 1024, 1024, 1024, 1024, rot, smem, P.wv);
    transpose_job(P.in[23] + (size_t)l * 1024 * 1024, wt_ptr(P, l, WE_XO), 1024, 1024, 1024, rot, smem, P.wv);
    transpose_job(P.in[25] + (size_t)l * 1024 * 4096, wt_ptr(P, l, WE_UP), 1024, 4096, 4096, rot, smem, P.wv);
    transpose_job(P.in[26] + (size_t)l * 4096 * 1024, wt_ptr(P, l, WE_DN), 4096, 1024, 1024, rot, smem, P.wv);
  }
  {
    f32x2* rt = (f32x2*)(P.ws + WS_ROPE);
    for (int i = get_bid() * NTHR + tid; i < 4096 * 32; i += get_nblk() * NTHR) {
      const int pos = i >> 5, j = i & 31;
      const float inv = powf(10000.f, -(float)j / 32.f);
      const float ang = (float)pos * inv;
      f32x2 cs; cs[0] = cosf(ang); cs[1] = sinf(ang);
      rt[i] = cs;
    }
  }
  for (int l = 0; l < NL; l++) {
    const size_t seg = (size_t)DB * NMEM * 1024;
    cvt_job(P.in[8] + l * seg, (u16*)(P.ws + WS_MEMK) + ((size_t)l * MB + NB) * NMEM * 1024, 1, seg, 0, 0, P.wv);
    cvt_job(P.in[9] + l * seg, (u16*)(P.ws + WS_MEMV) + ((size_t)l * MB + NB) * NMEM * 1024, 1, seg, 0, 0, P.wv);
  }
  for (int rr = gw; rr < NL * NB * NMEM; rr += nw) {
    const int l = rr / (NB * NMEM), row = rr % (NB * NMEM);
    rms_rows<1, false>(P.in[2] + (size_t)row * 1024, 0, 1, P.in[19] + l * 1024, (u16*)(P.ws + WS_HMEM) + (size_t)rr * 1024, 0, lane);
  }
  {
    const size_t n4 = (size_t)TT * 256;
    const size_t np4 = (size_t)TP * 256;
    const size_t stride = (size_t)get_nblk() * NTHR;
    for (size_t i0 = (size_t)get_bid() * NTHR + tid; i0 < n4; i0 += 4 * stride) {
      f32x4 v[4];
#pragma unroll
      for (int q = 0; q < 4; q++) {
        const size_t i = i0 + q * stride;
        const size_t ii = i < n4 ? i : i0;
        v[q] = (ii < np4) ? *(const f32x4*)(P.in[0] + ii * 4) : *(const f32x4*)(P.in[1] + (ii - np4) * 4);
      }
#pragma unroll
      for (int q = 0; q < 4; q++) {
        const size_t i = i0 + q * stride;
        if (i < n4) *(f32x4*)(P.out + i * 4) = v[q];
      }
    }
  }
}

DI void phase_norm(const Params& P, const float* g, int cache_layer) {
  const int tid = get_tid(P.wv), lane = tid & 63;
  const int gw = get_bid() * NWV + (tid >> 6), nw = get_nblk() * NWV;
  u16* h = (u16*)(P.ws + WS_ACTA);
  for (int row = gw; row < TT; row += 4 * nw) {
    const int nv = (TT - row + nw - 1) / nw;
    rms_rows<4, false>(P.out + (size_t)row * 1024, (size_t)nw * 1024, nv < 4 ? nv : 4, g, h + (size_t)row * 1024, (size_t)nw * 1024, lane);
  }
  if (cache_layer >= 0) {
    const int l = cache_layer;
    cvt_job(P.in[3] + (size_t)l * DB * PAST * 512, (u16*)(P.ws + WS_FOXK) + (size_t)TP * 512, DB, (size_t)PAST * 512, (size_t)PAST * 512, (size_t)SKS * 512, P.wv);
    cvt_job(P.in[4] + (size_t)l * DB * PAST * 512, (u16*)(P.ws + WS_FOXV) + (size_t)TP * 512, DB, (size_t)PAST * 512, (size_t)PAST * 512, (size_t)SKS * 512, P.wv);
    cvt_job(P.in[6] + (size_t)l * DB * PAST * 128, (u16*)(P.ws + WS_CKV) + (size_t)TP * 128, DB, (size_t)PAST * 128, (size_t)PAST * 128, (size_t)SKS * 128, P.wv);
    cvt_job(P.in[7] + (size_t)l * DB * PAST * 64, (u16*)(P.ws + WS_KROPE) + (size_t)TP * 64, DB, (size_t)PAST * 64, (size_t)PAST * 64, (size_t)SKS * 64, P.wv);
  }
}

DI void phase_final(const Params& P) {
  const int tid = get_tid(P.wv), lane = tid & 63;
  const int gw = get_bid() * NWV + (tid >> 6), nw = get_nblk() * NWV;
  const float* g = P.in[27];
  for (int row = gw; row < TT; row += 4 * nw) {
    const int nv = (TT - row + nw - 1) / nw;
    rms_rows<4, true>(P.out + (size_t)row * 1024, (size_t)nw * 1024, nv < 4 ? nv : 4, g, P.out + (size_t)row * 1024, (size_t)nw * 1024, lane);
  }
}

DI void phase_post(const Params& P, int l, char* smem) {
  const int tid = get_tid(P.wv), lane = tid & 63;
  const int gw = get_bid() * NWV + (tid >> 6), nw = get_nblk() * NWV;
  const float* zc = (const float*)(P.ws + WS_ZC);
  u16* cqn = (u16*)(P.ws + WS_CQN);
  u16* ckv = (u16*)(P.ws + WS_CKV);
  u16* krp = (u16*)(P.ws + WS_KROPE);
  const f32x2* rt = (const f32x2*)(P.ws + WS_ROPE);
  const float* gq = P.in[13] + l * 256;
  const float* gkv = P.in[15] + l * 128;
  for (int tok0 = gw; tok0 < TT; tok0 += 4 * nw) {
    f32x4 vq[4]; f32x2 vk[4]; float vr[4];
#pragma unroll
    for (int j = 0; j < 4; j++) {
      const int tk = tok0 + j * nw;
      const float* z = zc + (size_t)(tk < TT ? tk : tok0) * 448;
      vq[j] = *(const f32x4*)(z + lane * 4);
      vk[j] = *(const f32x2*)(z + 256 + lane * 2);
      vr[j] = z[384 + lane];
    }
    const f32x4 ggq = *(const f32x4*)(gq + lane * 4);
    const f32x2 ggk = *(const f32x2*)(gkv + lane * 2);
#pragma unroll
    for (int j = 0; j < 4; j++) {
      const int tok = tok0 + j * nw;
      if (tok >= TT) break;
      const bool isp = tok < TP;
      const size_t orow = isp ? ((size_t)l * TP + tok) : ((size_t)l * TS + (tok - TP));
      const int kr = tok_krow(tok);
      {
        const f32x4 v = vq[j];
        const float ss = wave_sum(v[0] * v[0] + v[1] * v[1] + v[2] * v[2] + v[3] * v[3]);
        const float rs = rsqrtf(ss * (1.f / 256.f) + 1e-6f);
        u32x2 w;
        w[0] = pk2(v[0] * rs * ggq[0], v[1] * rs * ggq[1]);
        w[1] = pk2(v[2] * rs * ggq[2], v[3] * rs * ggq[3]);
        *(u32x2*)(cqn + (size_t)tok * 256 + lane * 4) = w;
      }
      {
        const f32x2 v = vk[j];
        const float ss = wave_sum(v[0] * v[0] + v[1] * v[1]);
        const float rs = rsqrtf(ss * (1.f / 128.f) + 1e-6f);
        f32x2 o; o[0] = v[0] * rs * ggk[0]; o[1] = v[1] * rs * ggk[1];
        *(f32x2*)(P.out + (isp ? O_CKP : O_CKS) + orow * 128 + lane * 2) = o;
        *(unsigned*)(ckv + (size_t)kr * 128 + lane * 2) = pk2(o[0], o[1]);
      }
      {
        const float x = vr[j];
        const float y = __shfl_xor(x, 32);
        const f32x2 cs = rt[tok_pos(tok) * 32 + (lane & 31)];
        const float o = (lane < 32) ? (x * cs[0] - y * cs[1]) : (x * cs[0] + y * cs[1]);
        P.out[(isp ? O_KRP : O_KRS) + orow * 64 + lane] = o;
        krp[(size_t)kr * 64 + lane] = f2bf(o);
      }
    }
  }
  float* cum = (float*)(P.ws + WS_CUM);
  float* wtot = (float*)smem;
  const int wave = tid >> 6;
  for (int it = get_bid(); it < NB + DB; it += get_nblk()) {
    const bool isp = it < NB;
    const int b = isp ? it : it - NB;
    const int ppt = isp ? 16 : 9;
    const int npos = isp ? SEQ : SKS;
    const float* srcA; const float* srcB; int nA;
    size_t krow0;
    if (isp) { srcA = P.out + O_FLP + ((size_t)l * TP + (size_t)b * SEQ) * 8; srcB = srcA; nA = SEQ; krow0 = (size_t)b * SEQ; }
    else {
      srcA = P.in[5] + ((size_t)l * DB + b) * PAST * 8;
      srcB = P.out + O_FLS + ((size_t)l * TS + (size_t)b * DS) * 8 - (size_t)PAST * 8;
      nA = PAST; krow0 = (size_t)TP + (size_t)b * SKS;
    }
    const int p0 = tid * ppt;
    f32x4 va[16], vb[16];
#pragma unroll
    for (int j = 0; j < 16; j++) {
      const int p = p0 + j;
      f32x4 z = {0.f, 0.f, 0.f, 0.f};
      va[j] = z; vb[j] = z;
      if (j < ppt && p < npos) {
        const float* s = (p < nA ? srcA : srcB) + (size_t)p * 8;
        va[j] = *(const f32x4*)s; vb[j] = *(const f32x4*)(s + 4);
      }
    }
#pragma unroll
    for (int j = 1; j < 16; j++) { va[j] += va[j - 1]; vb[j] += vb[j - 1]; }
    f32x4 ta = va[15], tb = vb[15];
#pragma unroll
    for (int d = 1; d < 64; d <<= 1) {
#pragma unroll
      for (int e = 0; e < 4; e++) {
        const float ua = __shfl_up(ta[e], d), ub = __shfl_up(tb[e], d);
        if (lane >= d) { ta[e] += ua; tb[e] += ub; }
      }
    }
    __syncthreads();
    if (lane == 63) { *(f32x4*)(wtot + wave * 8) = ta; *(f32x4*)(wtot + wave * 8 + 4) = tb; }
    __syncthreads();
    f32x4 pa = ta - va[15], pb = tb - vb[15];
    for (int w2 = 0; w2 < wave; w2++) { pa += *(const f32x4*)(wtot + w2 * 8); pb += *(const f32x4*)(wtot + w2 * 8 + 4); }
#pragma unroll
    for (int j = 0; j < 16; j++) {
      const int p = p0 + j;
      if (j < ppt && p < npos) {
        float* d = cum + (krow0 + p) * 8;
        *(f32x4*)d = va[j] + pa; *(f32x4*)(d + 4) = vb[j] + pb;
      }
    }
  }
}

template <int EPI>
DI void gemm_phase(const Params& P, int l, const u16* __restrict__ A, int lda, const u16* __restrict__ Bt, int ldb, int K, int M, int N,
                   char* smem, int& rot) {
  constexpr int MI = 4;
  constexpr int STAGE = 32768;
  constexpr int NSLOT = SMEM_BYTES / STAGE;
  constexpr int DEPTH = NSLOT - 1;
  constexpr int GPS = 4;
  static_assert(NSLOT == 4, "ring waits are written for 4 slots");
  const int tid = get_tid(P.wv), wave = tid >> 6, lane = tid & 63, r = lane & 31, h = lane >> 5;
  const int wm = wave >> 2, wn = wave & 3;
  const int TM = M >> 8, TN = N >> 8;
  const int ntiles = TM * TN;
  const int G = get_nblk();
  const int bid = get_bid();
  const bool xmap = (G == 256);
  int t0, tstep;
  if (xmap) {
    const int nun = (ntiles + 31) >> 5;
    const int xs = (bid + 8 - (rot & 7)) & 7;
    t0 = xs * 32 + (bid >> 3); tstep = 256;
    rot += nun;
  } else {
    t0 = (bid + G - (rot % G)) % G; tstep = G;
    rot += ntiles;
  }
  if (t0 >= ntiles) return;
  const int lrow = tid >> 2, lc = tid & 3;
  const int pc = (lc ^ ((tid >> 4) & 3)) * 8;
  const int nk = K >> 5;
  const int sw = (r >> 2) & 3;
  const int xo0 = ((0 + h) ^ sw) * 16, xo1 = ((2 + h) ^ sw) * 16;
  const int aro = (wm * 128 + r) * 64, bro = 16384 + (wn * 64 + r) * 64;
  auto tile_of = [&](int t, int& m0, int& n0) { const int mt = t / TN; m0 = mt << 8; n0 = (t - mt * TN) << 8; };
  auto issue = [&](int m0, int n0, int ks, int slot) {
    const u16* ag = A + (size_t)(m0 + lrow) * lda + pc + ks * 32;
    const u16* bg = Bt + (size_t)(n0 + lrow) * ldb + pc + ks * 32;
    char* dst = smem + slot * STAGE + tid * 16;
#pragma unroll
    for (int i = 0; i < 2; i++)
      __builtin_amdgcn_global_load_lds((const unsigned*)(ag + (size_t)i * 128 * lda), (__attribute__((address_space(3))) unsigned*)(dst + i * 8192), 16, 0, 0);
#pragma unroll
    for (int i = 0; i < 2; i++)
      __builtin_amdgcn_global_load_lds((const unsigned*)(bg + (size_t)i * 128 * ldb), (__attribute__((address_space(3))) unsigned*)(dst + 16384 + i * 8192), 16, 0, 0);
  };
  int t = t0, m0, n0;
  tile_of(t, m0, n0);
  int ti = t0, ki = 0, mi0 = m0, ni0 = n0;
  bool idone = false;
  int pend = 0;
  unsigned g = 0;
  asm volatile("s_waitcnt vmcnt(0) lgkmcnt(0)" ::: "memory");
  __builtin_amdgcn_s_barrier();
#pragma unroll 1
  for (int s = 0; s < DEPTH; s++) {
    if (!idone) {
      issue(mi0, ni0, ki, (g + pend) % NSLOT);
      pend++;
      if (++ki == nk) { ki = 0; ti += tstep; if (ti < ntiles) tile_of(ti, mi0, ni0); else idone = true; }
    }
  }
  while (true) {
    f32x16 acc[MI][2];
#pragma unroll
    for (int a = 0; a < MI; a++)
#pragma unroll
      for (int b = 0; b < 2; b++)
#pragma unroll
        for (int i = 0; i < 16; i++) acc[a][b][i] = 0.f;
    s16x8 a2[MI], b2, b3;
    {
      const s16x8 z = {0, 0, 0, 0, 0, 0, 0, 0};
#pragma unroll
      for (int i = 0; i < MI; i++) a2[i] = z;
      b2 = z; b3 = z;
    }
#pragma unroll 1
    for (int kt = 0; kt < nk; kt++) {
      if (pend >= 3) asm volatile("s_waitcnt vmcnt(%0)" ::"n"(2 * GPS) : "memory");
      else if (pend == 2) asm volatile("s_waitcnt vmcnt(%0)" ::"n"(GPS) : "memory");
      else asm volatile("s_waitcnt vmcnt(0)" ::: "memory");
      asm volatile("s_waitcnt lgkmcnt(0)" ::: "memory");
      __builtin_amdgcn_s_barrier();
      if (!idone) {
        issue(mi0, ni0, ki, (g + pend) % NSLOT);
        if (++ki == nk) { ki = 0; ti += tstep; if (ti < ntiles) tile_of(ti, mi0, ni0); else idone = true; }
      } else {
        pend--;
      }
      const char* sb = smem + (g % NSLOT) * STAGE;
      g++;
      s16x8 a[MI];
#pragma unroll
      for (int i = 0; i < MI; i++) a[i] = *(const s16x8*)(sb + aro + i * 32 * 64 + xo0);
      const s16x8 b0 = *(const s16x8*)(sb + bro + xo0);
      const s16x8 b1 = *(const s16x8*)(sb + bro + 32 * 64 + xo0);
      if (kt > 0) {
#pragma unroll
        for (int i = 0; i < MI; i++) { acc[i][0] = mfma(a2[i], b2, acc[i][0]); acc[i][1] = mfma(a2[i], b3, acc[i][1]); }
      }
#pragma unroll
      for (int i = 0; i < MI; i++) a2[i] = *(const s16x8*)(sb + aro + i * 32 * 64 + xo1);
      b2 = *(const s16x8*)(sb + bro + xo1);
      b3 = *(const s16x8*)(sb + bro + 32 * 64 + xo1);
#pragma unroll
      for (int i = 0; i < MI; i++) { acc[i][0] = mfma(a[i], b0, acc[i][0]); acc[i][1] = mfma(a[i], b1, acc[i][1]); }
    }
#pragma unroll
    for (int i = 0; i < MI; i++) { acc[i][0] = mfma(a2[i], b2, acc[i][0]); acc[i][1] = mfma(a2[i], b3, acc[i][1]); }
    epilogue<EPI, MI>(P, l, acc, m0 + wm * 128, n0 + wn * 64, r, h);
    t += tstep;
    if (t >= ntiles) break;
    tile_of(t, m0, n0);
  }
  asm volatile("s_waitcnt vmcnt(0) lgkmcnt(0)" ::: "memory");
}

DI void phase_attn(const Params& P, int l, char* smem) {
  const u16* qf = (const u16*)(P.ws + WS_QF);
  const u16* fk = (const u16*)(P.ws + WS_FOXK);
  const u16* fv = (const u16*)(P.ws + WS_FOXV);
  const float* cum = (const float*)(P.ws + WS_CUM);
  const u16* qm = (const u16*)(P.ws + WS_R1 + R1_QM);
  const u16* kv = (const u16*)(P.ws + WS_R1 + R1_KV);
  const u16* krp = (const u16*)(P.ws + WS_KROPE);
  u16* mixed = (u16*)(P.ws + WS_ACTA);
  constexpr float LOG2E = 1.4426950408889634f;
  const int total = 384 + 16 * 96;
  for (int t = get_bid(); t < total; t += get_nblk()) {
    bool isfox, issample; int b, hd, qb = 0;
    if (t < 256) { isfox = true; issample = true; b = t >> 3; hd = t & 7; }
    else if (t < 384) { isfox = false; issample = true; const int u = t - 256; b = u >> 2; hd = u & 3; }
    else {
      const int u = t - 384; const int grp = u / 96; int w = u % 96; qb = 15 - grp; issample = false;
      if (w < 32) { isfox = false; b = w >> 2; hd = w & 3; }
      else { w -= 32; isfox = true; b = w >> 3; hd = w & 7; }
    }
    AttnJob J;
    J.wv = P.wv;
    size_t tok0, krow0;
    if (issample) { tok0 = (size_t)TP + (size_t)b * DS; krow0 = (size_t)TP + (size_t)b * SKS; J.nq = DS; J.Sk = SKS; J.qpos0 = PAST; }
    else { tok0 = (size_t)b * SEQ + (size_t)qb * 256; krow0 = (size_t)b * SEQ; J.nq = 256; J.Sk = SEQ; J.qpos0 = qb * 256; }
    if (isfox) {
      J.Q = qf + tok0 * 512 + hd * 64; J.ldq = 512;
      J.K1 = fk + krow0 * 512 + hd * 64; J.ldk1 = 512; J.K2 = J.K1; J.ldk2 = 512;
      J.V = fv + krow0 * 512 + hd * 64; J.ldv = 512;
      J.O = mixed + tok0 * 1024 + hd * 64; J.ldo = 1024;
      J.cq = cum + (krow0 + (size_t)J.qpos0) * 8 + hd;
      J.ck = cum + krow0 * 8 + hd;
      J.scale_log2 = 0.125f * LOG2E;
      attn_block<64, 64, 64, MASK_FRAME, true, FOX_PF, 512, 512, 512, 512, 1024, FOX_KT>(J, smem);
    } else {
      J.Q = qm + tok0 * 768 + hd * 192; J.ldq = 768;
      J.K1 = kv + krow0 * 1024 + hd * 256; J.ldk1 = 1024;
      J.K2 = krp + krow0 * 64; J.ldk2 = 64;
      J.V = kv + krow0 * 1024 + hd * 256 + 128; J.ldv = 1024;
      J.O = mixed + tok0 * 1024 + 512 + hd * 128; J.ldo = 1024;
      J.cq = nullptr; J.ck = nullptr;
      J.scale_log2 = 0.07216878364870322f * LOG2E;
      attn_block<192, 128, 128, MASK_CHUNK, false, MLA_PF, 768, 1024, 64, 1024, 1024, 64>(J, smem);
    }
  }
}

DI void phase_cross(const Params& P, int l, char* smem) {
  const u16* xq = (const u16*)(P.ws + WS_R1 + R1_XQ);
  const u16* mk = (const u16*)(P.ws + WS_MEMK) + (size_t)l * MB * NMEM * 1024;
  const u16* mv = (const u16*)(P.ws + WS_MEMV) + (size_t)l * MB * NMEM * 1024;
  u16* xo = (u16*)(P.ws + WS_ACTA);
  constexpr float LOG2E = 1.4426950408889634f;
  const int nsamp = DB * 4 * 2;
  const int total = nsamp + 128 * 4 * 2;
  for (int t = get_bid(); t < total; t += get_nblk()) {
    AttnJob J;
    J.wv = P.wv;
    size_t tok0; int mb, hd, half;
    if (t < nsamp) { const int b = t >> 3; hd = (t >> 1) & 3; half = t & 1; tok0 = (size_t)TP + (size_t)b * DS; mb = NB + b; J.nq = DS; }
    else { const int u = t - nsamp; const int qbk = u >> 3; hd = (u >> 1) & 3; half = u & 1; tok0 = (size_t)qbk * 256; mb = qbk >> 4; J.nq = 256; }
    J.Sk = NMEM; J.qpos0 = 0;
    J.Q = xq + tok0 * 1024 + hd * 256; J.ldq = 1024;
    J.K1 = mk + (size_t)mb * NMEM * 1024 + hd * 256; J.ldk1 = 1024; J.K2 = J.K1; J.ldk2 = 1024;
    J.V = mv + (size_t)mb * NMEM * 1024 + hd * 256 + half * 128; J.ldv = 1024;
    J.O = xo + tok0 * 1024 + hd * 256 + half * 128; J.ldo = 1024;
    J.cq = nullptr; J.ck = nullptr;
    J.scale_log2 = 0.0625f * LOG2E;
    attn_block<256, 256, 128, MASK_NONE, false, false, 1024, 1024, 1024, 1024, 1024, 64>(J, smem);
  }
}

#define XB_TMO      128
#define XB_XCNT(j)  (256  + 64 * (j))
#define XB_XSUB(j)  (1280 + 64 * (j))
#define XB_XGEN(j)  (2304 + 64 * (j))
#define XB_TOP      3328
#define XB_TOPGEN   3392
#define XCD_BAR_WORDS 3456
#define XB_SPIN_CAP (1u << 20)
DI unsigned xb_ld(unsigned* p) { return __hip_atomic_load(p, __ATOMIC_RELAXED, __HIP_MEMORY_SCOPE_AGENT); }
DI unsigned xb_add(unsigned* p, unsigned v) { return __hip_atomic_fetch_add(p, v, __ATOMIC_RELAXED, __HIP_MEMORY_SCOPE_AGENT); }
DI unsigned xb_xcc_id() { return (unsigned)__builtin_amdgcn_s_getreg((3 << 11) | 20) & 0xFu; }
#define XB_SPIN(cond, bar) do { unsigned _sp = 0; while (cond) { __builtin_amdgcn_s_sleep(1); \
    if ((++_sp & 255u) == 0u) { if (xb_ld(&(bar)[XB_TMO])) break; if (_sp > XB_SPIN_CAP) { atomicAdd(&(bar)[XB_TMO], 1u); break; } } } } while (0)
DI void xb_census(unsigned* bar, unsigned x, unsigned& nloc, unsigned& nx) {
  const unsigned G = gridDim.x;
  unsigned sum, cnt, mine, sp = 0u;
  for (;;) {
    sum = 0u; cnt = 0u; mine = 0u;
#pragma unroll
    for (unsigned j = 0; j < 16; ++j) { const unsigned c = xb_ld(&bar[XB_XCNT(j)]); sum += c; cnt += (c > 0u) ? 1u : 0u; mine = (j == x) ? c : mine; }
    if (sum == G) break;
    __builtin_amdgcn_s_sleep(1);
    if ((++sp & 255u) == 0u) { if (xb_ld(&bar[XB_TMO])) break; if (sp > XB_SPIN_CAP) { atomicAdd(&bar[XB_TMO], 1u); break; } }
  }
  nloc = mine > 0u ? mine : 1u; nx = cnt > 0u ? cnt : 1u;
}
DI void xcd_barrier(unsigned* bar, unsigned x, unsigned nloc, unsigned nx, int wv) {
  asm volatile("s_waitcnt vmcnt(0)" ::: "memory");
  __syncthreads();
  if (wv == 0 && lane_id() == 0) {
    __builtin_amdgcn_s_waitcnt(0);
    const unsigned old = xb_add(&bar[XB_XSUB(x)], 1u);
    const unsigned gen = old / nloc;
    if (old + 1u == (gen + 1u) * nloc) {
      __builtin_amdgcn_fence(__ATOMIC_RELEASE, "agent");
      asm volatile("s_waitcnt vmcnt(0)" ::: "memory");
      const unsigned og = xb_add(&bar[XB_TOP], 1u);
      const unsigned tg = og / nx;
      if (og + 1u == (tg + 1u) * nx) xb_add(&bar[XB_TOPGEN], 1u);
      else XB_SPIN(xb_ld(&bar[XB_TOPGEN]) == tg, bar);
      __builtin_amdgcn_fence(__ATOMIC_ACQUIRE, "agent");
      xb_add(&bar[XB_XGEN(x)], 1u);
      asm volatile("s_waitcnt vmcnt(0)" ::: "memory");
    } else {
      XB_SPIN(xb_ld(&bar[XB_XGEN(x)]) == gen, bar);
      __builtin_amdgcn_fence(__ATOMIC_ACQUIRE, "agent");
      asm volatile("s_waitcnt vmcnt(0)" ::: "memory");
    }
  }
  __syncthreads();
}

constexpr int NPHASE = 2 + 13 * NL;

DI void run_phase(const Params& P, int ph, char* smem, bool dup = false) {
  if (ph == 0) { phase_prep(P, smem); return; }
  if (ph == NPHASE - 1) { phase_final(P); return; }
  const int l = (ph - 1) / 13, k = (ph - 1) % 13;
  char* ws = P.ws;
  const u16* actA = (const u16*)(ws + WS_ACTA);
  int rot = 0;
  switch (k) {
    case 0: phase_norm(P, P.in[10] + l * 1024, l); break;
    case 1:
      gemm_phase<EPI_IN>(P, l, actA, 1024, wt_ptr(P, l, WE_IN), 1024, 1024, TT, INP, smem, rot);
      if (l == 0) {
        for (int l2 = 0; l2 < NL; l2++)
          gemm_phase<EPI_MEM>(P, l2, (const u16*)(ws + WS_HMEM) + (size_t)l2 * NB * NMEM * 1024, 1024, wt_ptr(P, l2, WE_MKV), 1024, 1024,
                              NB * NMEM, 2048, smem, rot);
      }
      break;
    case 2: phase_post(P, l, smem); break;
    case 3:
      gemm_phase<EPI_KV>(P, l, (const u16*)(ws + WS_CKV), 128, wt_ptr(P, l, WE_UKV), 128, 128, KROWS, 1024, smem, rot);
      gemm_phase<EPI_UQ>(P, l, (const u16*)(ws + WS_CQN), 256, wt_ptr(P, l, WE_UQ), 256, 256, TT, 768, smem, rot);
      break;
    case 4: phase_attn(P, l, smem); break;
    case 5: if (dup) gemm_phase<EPI_RESID0>(P, l, actA, 1024, wt_ptr(P, l, WE_OUT), 1024, 1024, TT, 1024, smem, rot); else gemm_phase<EPI_RESID>(P, l, actA, 1024, wt_ptr(P, l, WE_OUT), 1024, 1024, TT, 1024, smem, rot); break;
    case 6: phase_norm(P, P.in[18] + l * 1024, -1); break;
    case 7: gemm_phase<EPI_XQ>(P, l, actA, 1024, wt_ptr(P, l, WE_XQ), 1024, 1024, TT, 1024, smem, rot); break;
    case 8: phase_cross(P, l, smem); break;
    case 9: if (dup) gemm_phase<EPI_RESID0>(P, l, actA, 1024, wt_ptr(P, l, WE_XO), 1024, 1024, TT, 1024, smem, rot); else gemm_phase<EPI_RESID>(P, l, actA, 1024, wt_ptr(P, l, WE_XO), 1024, 1024, TT, 1024, smem, rot); break;
    case 10: phase_norm(P, P.in[24] + l * 1024, -1); break;
    case 11: gemm_phase<EPI_UP>(P, l, actA, 1024, wt_ptr(P, l, WE_UP), 1024, 1024, TT, DFF, smem, rot); break;
    case 12: if (dup) gemm_phase<EPI_RESID0>(P, l, (const u16*)(ws + WS_R1 + R1_U), DFF, wt_ptr(P, l, WE_DN), DFF, DFF, TT, 1024, smem, rot); else gemm_phase<EPI_RESID>(P, l, (const u16*)(ws + WS_R1 + R1_U), DFF, wt_ptr(P, l, WE_DN), DFF, DFF, TT, 1024, smem, rot); break;
  }
}

__global__ void __launch_bounds__(NTHR) mega(Params P, int ph_lo, int ph_hi) {
  extern __shared__ __attribute__((aligned(16))) char smem[];
  cg::grid_group grid = cg::this_grid();
  if (ph_hi > 4096) grid.sync();
  unsigned* bar = (unsigned*)(P.ws + WS_BAR);
  const unsigned xb_x = xb_xcc_id();
  unsigned xb_nloc = 1u, xb_nx = 1u;
  if (threadIdx.x == 0) { (void)xb_add(&bar[XB_XCNT(xb_x)], 1u); xb_census(bar, xb_x, xb_nloc, xb_nx); }
  xb_nloc = __builtin_amdgcn_readfirstlane(xb_nloc);
  xb_nx = __builtin_amdgcn_readfirstlane(xb_nx);
  unsigned xb_pack = xb_nloc | (xb_nx << 16) | (xb_x << 24) | ((unsigned)__builtin_amdgcn_readfirstlane(threadIdx.x >> 6) << 28);
  asm volatile("" : "+s"(xb_pack));
  for (int ph = ph_lo; ph < ph_hi; ph++) {
    Params Q = P;
    unsigned pk = xb_pack;
    asm volatile("" : "+s"(Q.out), "+s"(Q.ws), "+s"(pk));
    Q.wv = (int)(pk >> 28);
    run_phase(Q, ph, smem);
    if (ph + 1 < ph_hi) {
      unsigned pk2 = xb_pack;
      asm volatile("" : "+s"(pk2));
      xcd_barrier((unsigned*)(Q.ws + WS_BAR), (pk2 >> 24) & 0xfu, pk2 & 0xffffu, (pk2 >> 16) & 0xffu, (int)(pk2 >> 28));
    }
  }
}

extern "C" void kernel_launch(void* const* d_in, const int* in_sizes, int n_in, void* d_out, int out_size, void* d_ws,
                              size_t ws_size, hipStream_t stream) {
  static int grid_blocks = 0;
  if (!grid_blocks) {
    int dev = 0, cus = 0, per_cu = 0;
    hipGetDevice(&dev);
    hipDeviceGetAttribute(&cus, hipDeviceAttributeMultiprocessorCount, dev);
    hipFuncSetAttribute((const void*)mega, hipFuncAttributeMaxDynamicSharedMemorySize, SMEM_BYTES);
    hipOccupancyMaxActiveBlocksPerMultiprocessor(&per_cu, mega, NTHR, SMEM_BYTES);
    per_cu = 1;
    grid_blocks = cus * per_cu;
  }
  if (n_in != 28 || (size_t)out_size != O_END || ws_size < WS_END) {
    fprintf(stderr, "kernel_launch: shape/ws mismatch n_in %d out %d (want %zu) ws %zu (want %zu)\n", n_in, out_size, (size_t)O_END, ws_size, (size_t)WS_END);
    return;
  }
  Params p;
  memset(&p, 0, sizeof(p));
  for (int i = 0; i < 28; i++) p.in[i] = (const float*)d_in[i];
  p.out = (float*)d_out;
  p.ws = (char*)d_ws;
  hipMemsetAsync((char*)d_ws + WS_BAR, 0, XCD_BAR_WORDS * 4, stream);
  int lo = 0, hi = NPHASE;
  void* args[] = {&p, &lo, &hi};
  hipError_t e = hipLaunchCooperativeKernel((void*)mega, dim3(grid_blocks), dim3(NTHR), args, SMEM_BYTES, stream);
  if (e != hipSuccess) fprintf(stderr, "cooperative launch failed: %s (grid %d)\n", hipGetErrorString(e), grid_blocks);
}
```

```cpp
#include <hip/hip_runtime.h>
#include <hip/hip_cooperative_groups.h>
#include <stdint.h>
#include <string.h>
#include <stdio.h>
namespace cg = cooperative_groups;

#ifndef COOP
#define COOP 1
#endif

#ifndef FOX_KT
#define FOX_KT 128
#endif
#ifndef FOX_PF
#define FOX_PF true
#endif
#ifndef MLA_PF
#define MLA_PF true
#endif
#ifndef LB_MIN
#define LB_MIN 2
#endif
#ifndef BM_BIG
#define BM_BIG 256
#endif
constexpr int NTHR = 512, NWV = 8;
#define DI __device__ __forceinline__
typedef unsigned short u16;
typedef short s16x8 __attribute__((ext_vector_type(8)));
typedef short s16x4 __attribute__((ext_vector_type(4)));
typedef __bf16 bfx8 __attribute__((ext_vector_type(8)));
typedef __bf16 bfx2 __attribute__((ext_vector_type(2)));
typedef float f32x16 __attribute__((ext_vector_type(16)));
typedef float f32x4 __attribute__((ext_vector_type(4)));
typedef float f32x2 __attribute__((ext_vector_type(2)));
typedef unsigned u32x4 __attribute__((ext_vector_type(4)));
typedef unsigned u32x2 __attribute__((ext_vector_type(2)));

constexpr int DM = 1024, NB = 8, SEQ = 4096, NL = 2, DB = 32, DS = 32, PAST = 2048;
constexpr int TP = NB * SEQ;
constexpr int TS = DB * DS;
constexpr int TT = TP + TS;
constexpr int SKS = PAST + DS;
constexpr int KROWS = TP + DB * SKS;
constexpr int INC = 1992, INP = 2048;
constexpr int NMEM = 256, MB = NB + DB;
constexpr int DFF = 4096;

constexpr size_t O_Y = 0;
constexpr size_t O_FKP = (size_t)TT * DM;
constexpr size_t O_FVP = O_FKP + (size_t)NL * TP * 512;
constexpr size_t O_FLP = O_FVP + (size_t)NL * TP * 512;
constexpr size_t O_CKP = O_FLP + (size_t)NL * TP * 8;
constexpr size_t O_KRP = O_CKP + (size_t)NL * TP * 128;
constexpr size_t O_MKP = O_KRP + (size_t)NL * TP * 64;
constexpr size_t O_MVP = O_MKP + (size_t)NL * NB * NMEM * 1024;
constexpr size_t O_FKS = O_MVP + (size_t)NL * NB * NMEM * 1024;
constexpr size_t O_FVS = O_FKS + (size_t)NL * TS * 512;
constexpr size_t O_FLS = O_FVS + (size_t)NL * TS * 512;
constexpr size_t O_CKS = O_FLS + (size_t)NL * TS * 8;
constexpr size_t O_KRS = O_CKS + (size_t)NL * TS * 128;
constexpr size_t O_END = O_KRS + (size_t)NL * TS * 64;

constexpr size_t al256(size_t x) { return (x + 255) / 256 * 256; }
constexpr size_t WE_IN = 0;
constexpr size_t WE_UQ = WE_IN + (size_t)INP * 1024;
constexpr size_t WE_UKV = WE_UQ + (size_t)768 * 256;
constexpr size_t WE_OUT = WE_UKV + (size_t)1024 * 128;
constexpr size_t WE_XQ = WE_OUT + (size_t)1024 * 1024;
constexpr size_t WE_MKV = WE_XQ + (size_t)1024 * 1024;
constexpr size_t WE_XO = WE_MKV + (size_t)2048 * 1024;
constexpr size_t WE_UP = WE_XO + (size_t)1024 * 1024;
constexpr size_t WE_DN = WE_UP + (size_t)4096 * 1024;
constexpr size_t WE_LAYER = WE_DN + (size_t)1024 * 4096;
constexpr size_t WS_WT = 0;
constexpr size_t WS_ROPE = al256(WS_WT + WE_LAYER * 2 * NL);
constexpr size_t WS_ACTA = al256(WS_ROPE + (size_t)4096 * 32 * 8);
constexpr size_t WS_QF = al256(WS_ACTA + (size_t)TT * 1024 * 2);
constexpr size_t WS_FOXK = al256(WS_QF + (size_t)TT * 512 * 2);
constexpr size_t WS_FOXV = al256(WS_FOXK + (size_t)KROWS * 512 * 2);
constexpr size_t WS_CUM = al256(WS_FOXV + (size_t)KROWS * 512 * 2);
constexpr size_t WS_ZC = al256(WS_CUM + (size_t)KROWS * 8 * 4);
constexpr size_t WS_CQN = al256(WS_ZC + (size_t)TT * 448 * 4);
constexpr size_t WS_CKV = al256(WS_CQN + (size_t)TT * 256 * 2);
constexpr size_t WS_KROPE = al256(WS_CKV + (size_t)KROWS * 128 * 2);
constexpr size_t WS_MEMK = al256(WS_KROPE + (size_t)KROWS * 64 * 2);
constexpr size_t WS_MEMV = al256(WS_MEMK + (size_t)NL * MB * NMEM * 1024 * 2);
constexpr size_t WS_HMEM = al256(WS_MEMV + (size_t)NL * MB * NMEM * 1024 * 2);
constexpr size_t WS_R1 = al256(WS_HMEM + (size_t)NL * NB * NMEM * 1024 * 2);
constexpr size_t R1_KV = 0;
constexpr size_t R1_QM = al256((size_t)KROWS * 1024 * 2);
constexpr size_t R1_U = 0;
constexpr size_t R1_XQ = 0;
constexpr size_t WS_BAR = al256(WS_R1 + (size_t)TT * 4096 * 2);
constexpr size_t WS_END = al256(WS_BAR + 3456 * 4);
static_assert(R1_QM + (size_t)TT * 768 * 2 <= (size_t)TT * 4096 * 2, "R1 overflow");

constexpr int SMEM_BYTES = 131072;

struct Params {
  const float* in[28];
  float* out;
  char* ws;
  int wv;
  int pad;
};

DI int get_bid() { int t = blockIdx.x; asm volatile("" : "+s"(t)); return t; }
DI int get_nblk() { int t = gridDim.x; asm volatile("" : "+s"(t)); return t; }
DI int lane_id() { return (int)__builtin_amdgcn_mbcnt_hi(~0u, __builtin_amdgcn_mbcnt_lo(~0u, 0u)); }
DI int get_tid(int wv) { int t = (wv << 6) | lane_id(); asm volatile("" : "+v"(t)); return t; }
DI unsigned pk2(float a, float b) { f32x2 v = {a, b}; return __builtin_bit_cast(unsigned, __builtin_convertvector(v, bfx2)); }
DI u16 f2bf(float a) { return (u16)(pk2(a, 0.f) & 0xffffu); }
DI f32x16 mfma(s16x8 a, s16x8 b, f32x16 c) {
  return __builtin_amdgcn_mfma_f32_32x32x16_bf16(__builtin_bit_cast(bfx8, a), __builtin_bit_cast(bfx8, b), c, 0, 0, 0);
}
DI int crow(int i, int h) { return (i & 3) + 8 * (i >> 2) + 4 * h; }
DI float wave_sum(float v) {
#pragma unroll
  for (int m = 32; m >= 1; m >>= 1) v += __shfl_xor(v, m);
  return v;
}
DI float xhalf_max(float v) {
  auto rr = __builtin_amdgcn_permlane32_swap(__float_as_uint(v), __float_as_uint(v), false, false);
  return fmaxf(__uint_as_float(rr[0]), __uint_as_float(rr[1]));
}
DI float xhalf_sum(float v) {
  auto rr = __builtin_amdgcn_permlane32_swap(__float_as_uint(v), __float_as_uint(v), false, false);
  return __uint_as_float(rr[0]) + __uint_as_float(rr[1]);
}
DI int tok_krow(int tok) {
  if (tok < TP) return tok;
  const int s = tok - TP;
  return TP + (s >> 5) * SKS + PAST + (s & 31);
}
DI int tok_pos(int tok) { return tok < TP ? (tok & (SEQ - 1)) : PAST + ((tok - TP) & 31); }

enum { EPI_IN = 0, EPI_MEM, EPI_UQ, EPI_KV, EPI_RESID, EPI_XQ, EPI_UP, EPI_RESID0 };

template <int EPI, int MI>
DI void epilogue(const Params& P, int l, f32x16 (&acc)[MI][2], int mw, int nw, int r, int h) {
  float* out = P.out;
  char* ws = P.ws;
  if constexpr (EPI == EPI_IN) {
    u16* qf = (u16*)(ws + WS_QF);
    u16* fk = (u16*)(ws + WS_FOXK);
    u16* fv = (u16*)(ws + WS_FOXV);
    float* zc = (float*)(ws + WS_ZC);
    const float* bfg = P.in[12] + l * 8;
#pragma unroll
    for (int mi = 0; mi < MI; mi++) {
#pragma unroll
      for (int i = 0; i < 16; i++) {
        const int row = mw + mi * 32 + crow(i, h);
        const int kr = tok_krow(row);
        const bool isp = row < TP;
        const size_t orow = isp ? ((size_t)l * TP + row) : ((size_t)l * TS + (row - TP));
#pragma unroll
        for (int ni = 0; ni < 2; ni++) {
          const int col = nw + ni * 32 + r;
          const float v = acc[mi][ni][i];
          if (col < 512) {
            qf[(size_t)row * 512 + col] = f2bf(v);
          } else if (col < 1024) {
            const int c = col - 512;
            out[(isp ? O_FKP : O_FKS) + orow * 512 + c] = v;
            fk[(size_t)kr * 512 + c] = f2bf(v);
          } else if (col < 1536) {
            const int c = col - 1024;
            out[(isp ? O_FVP : O_FVS) + orow * 512 + c] = v;
            fv[(size_t)kr * 512 + c] = f2bf(v);
          } else if (col < 1544) {
            const int c = col - 1536;
            const float g = v + bfg[c];
            const float ls = fminf(g, 0.f) - __logf(1.f + __expf(-fabsf(g)));
            out[(isp ? O_FLP : O_FLS) + orow * 8 + c] = ls;
          } else if (col < INC) {
            zc[(size_t)row * 448 + (col - 1544)] = v;
          }
        }
      }
    }
  } else if constexpr (EPI == EPI_MEM) {
    u16* mk = (u16*)(ws + WS_MEMK);
    u16* mv = (u16*)(ws + WS_MEMV);
#pragma unroll
    for (int mi = 0; mi < MI; mi++) {
#pragma unroll
      for (int i = 0; i < 16; i++) {
        const int row = mw + mi * 32 + crow(i, h);
#pragma unroll
        for (int ni = 0; ni < 2; ni++) {
          const int col = nw + ni * 32 + r;
          const float v = acc[mi][ni][i];
          const int c = col & 1023;
          const size_t oidx = ((size_t)l * (NB * NMEM) + row) * 1024 + c;
          const size_t bidx = ((size_t)l * (MB * NMEM) + row) * 1024 + c;
          if (col < 1024) { out[O_MKP + oidx] = v; mk[bidx] = f2bf(v); }
          else { out[O_MVP + oidx] = v; mv[bidx] = f2bf(v); }
        }
      }
    }
  } else if constexpr (EPI == EPI_UQ) {
    u16* qm = (u16*)(ws + WS_R1 + R1_QM);
    const f32x2* rt = (const f32x2*)(ws + WS_ROPE);
    const bool isrope = (nw % 192) == 128;
#pragma unroll
    for (int mi = 0; mi < MI; mi++) {
#pragma unroll
      for (int i = 0; i < 16; i++) {
        const int row = mw + mi * 32 + crow(i, h);
        float x1 = acc[mi][0][i], x2 = acc[mi][1][i];
        if (isrope) {
          const f32x2 cs = rt[tok_pos(row) * 32 + r];
          const float o1 = x1 * cs[0] - x2 * cs[1];
          const float o2 = x2 * cs[0] + x1 * cs[1];
          x1 = o1; x2 = o2;
        }
        qm[(size_t)row * 768 + nw + r] = f2bf(x1);
        qm[(size_t)row * 768 + nw + 32 + r] = f2bf(x2);
      }
    }
  } else if constexpr (EPI == EPI_KV || EPI == EPI_XQ || EPI == EPI_UP) {
    u16* dst; int ld;
    if constexpr (EPI == EPI_KV) { dst = (u16*)(ws + WS_R1 + R1_KV); ld = 1024; }
    else if constexpr (EPI == EPI_XQ) { dst = (u16*)(ws + WS_R1 + R1_XQ); ld = 1024; }
    else { dst = (u16*)(ws + WS_R1 + R1_U); ld = DFF; }
    const bool odd = r & 1;
    const int colb = nw + (r & ~1);
#pragma unroll
    for (int mi = 0; mi < MI; mi++) {
#pragma unroll
      for (int i = 0; i < 16; i += 2) {
        const int row = mw + mi * 32 + crow(i, h) + (odd ? 1 : 0);
#pragma unroll
        for (int ni = 0; ni < 2; ni++) {
          float v0 = acc[mi][ni][i], v1 = acc[mi][ni][i + 1];
          if constexpr (EPI == EPI_UP) { v0 = fmaxf(v0, 0.f); v0 = v0 * v0; v1 = fmaxf(v1, 0.f); v1 = v1 * v1; }
          const float send = odd ? v0 : v1;
          const float recv = __int_as_float(__builtin_amdgcn_mov_dpp(__float_as_int(send), 0xB1, 0xF, 0xF, true));
          const unsigned w = odd ? pk2(recv, v1) : pk2(v0, recv);
          *(unsigned*)(dst + (size_t)row * ld + colb + ni * 32) = w;
        }
      }
    }
  } else if constexpr (EPI == EPI_RESID || EPI == EPI_RESID0) {
#pragma unroll
    for (int mi = 0; mi < MI; mi++) {
#pragma unroll
      for (int i = 0; i < 16; i++) {
        const int row = mw + mi * 32 + crow(i, h);
#pragma unroll
        for (int ni = 0; ni < 2; ni++) {
          unsafeAtomicAdd(out + (size_t)row * DM + nw + ni * 32 + r, EPI == EPI_RESID0 ? acc[mi][ni][i] * 0.f : acc[mi][ni][i]);
        }
      }
    }
  }
}

enum { MASK_NONE = 0, MASK_FRAME = 1, MASK_CHUNK = 2 };
struct AttnJob {
  const u16* Q; int ldq;
  const u16* K1; int ldk1;
  const u16* K2; int ldk2;
  const u16* V; int ldv;
  u16* O; int ldo;
  const float* cq;
  const float* ck;
  int nq, Sk, qpos0;
  float scale_log2;
  int wv;
};

template <int DQK, int D1, int DVT, int MASK, bool BIAS, bool PREFETCH, int LDQ, int LDK1, int LDK2, int LDV, int LDO, int KT>
DI void attn_block(const AttnJob& J, char* smem) {
  constexpr int KP = DQK * 2 + 16;
  constexpr int VP = DVT * 2;
  constexpr int CV = DVT / 8;
  constexpr int NKK = DQK / 16, NDV = DVT / 32;
  constexpr float LOG2E = 1.4426950408889634f;
  char* Ks = smem;
  char* Vs = smem + KT * KP;
  float* cks = (float*)(smem + KT * KP + KT * VP);
  const int tid = get_tid(J.wv), wave = tid >> 6, lane = tid & 63, r = lane & 31, h = lane >> 5;
  const int wq0 = wave * 32;
  const bool active = wq0 < J.nq;
  const int qi = wq0 + r;
  const int qpos = J.qpos0 + qi;
  const int wqmax = J.qpos0 + wq0 + 31;
  const int qmax = J.qpos0 + J.nq - 1;
  const int ntk = (J.Sk + KT - 1) / KT;
  int nt = ntk;
  if (MASK != MASK_NONE) { const int t2 = qmax / KT + 1; nt = t2 < ntk ? t2 : ntk; }

  s16x8 qf[NKK];
  {
    const u16* qp = J.Q + (size_t)qi * LDQ + h * 8;
#pragma unroll
    for (int kk = 0; kk < NKK; kk++) {
      if (active) qf[kk] = *(const s16x8*)(qp + kk * 16);
      else { s16x8 z = {0, 0, 0, 0, 0, 0, 0, 0}; qf[kk] = z; }
    }
  }
  float cqv = 0.f;
  if (BIAS) { if (active) cqv = J.cq[(size_t)qi * 8] * LOG2E; }

  f32x16 o[NDV];
#pragma unroll
  for (int d = 0; d < NDV; d++)
#pragma unroll
    for (int i = 0; i < 16; i++) o[d][i] = 0.f;
  float m_run = -1e30f, l_run = 0.f;

  constexpr int CK1 = D1 / 8, CK2 = (DQK - D1) / 8;
  constexpr int RP1 = NTHR / CK1, NP1 = KT / RP1;
  constexpr int RP2 = CK2 ? NTHR / (CK2 ? CK2 : 1) : 64, NP2 = CK2 ? KT / RP2 : 0;
  constexpr int RPV = NTHR / CV, NPV = KT / RPV;
  u32x4 rk1[NP1], rk2[NP2 ? NP2 : 1], rv[NPV];
  float rck = 0.f;
  const int tq = (lane & 15) >> 2, tp = lane & 3, tblk = (lane >> 4) & 1;
  const int vswz = (DVT >= 128) ? tq : (tq >> 1);
  const int r1 = tid / CK1, c1 = tid % CK1;
  const int r2 = CK2 ? tid / (CK2 ? CK2 : 1) : 0, c2 = CK2 ? tid % (CK2 ? CK2 : 1) : 0;
  const int r3 = tid / CV, c3 = tid % CV;
  const unsigned k1o = (unsigned)(r1 * LDK1 + c1 * 8) * 2u;
  const unsigned k2o = (unsigned)(r2 * LDK2 + c2 * 8) * 2u;
  const unsigned vo = (unsigned)(r3 * LDV + c3 * 8) * 2u;
  const int k1so = r1 * KP + c1 * 16;
  const int k2so = r2 * KP + D1 * 2 + c2 * 16;
  const int vsw = (DVT >= 128) ? (r3 & 3) : ((r3 >> 1) & 1);
  const int vso = KT * KP + r3 * VP + (((c3 >> 2) ^ vsw) * 64) + (c3 & 3) * 16;
  const int vro = KT * KP + (4 * h + tq) * VP + (16 * tblk + 4 * tp) * 2;
  const int kro = r * KP + h * 16;

  auto load_tile = [&](int j) {
    const int kb = j * KT;
#pragma unroll
    for (int i = 0; i < NP1; i++) {
      u32x4 v = {0u, 0u, 0u, 0u};
      if (kb + r1 + i * RP1 < J.Sk) v = *(const u32x4*)((const char*)(J.K1 + (size_t)(kb + i * RP1) * LDK1) + k1o);
      rk1[i] = v;
    }
#pragma unroll
    for (int i = 0; i < NP2; i++) {
      u32x4 v = {0u, 0u, 0u, 0u};
      if (kb + r2 + i * RP2 < J.Sk) v = *(const u32x4*)((const char*)(J.K2 + (size_t)(kb + i * RP2) * LDK2) + k2o);
      rk2[i] = v;
    }
#pragma unroll
    for (int i = 0; i < NPV; i++) {
      u32x4 v = {0u, 0u, 0u, 0u};
      if (kb + r3 + i * RPV < J.Sk) v = *(const u32x4*)((const char*)(J.V + (size_t)(kb + i * RPV) * LDV) + vo);
      rv[i] = v;
    }
    if (BIAS) {
      if (tid < KT) { const int key = kb + tid; rck = key < J.Sk ? J.ck[(size_t)key * 8] * LOG2E : 0.f; }
    }
  };
  auto store_tile = [&]() {
    int a1 = k1so, a2 = k2so, a3 = vso;
    asm volatile("" : "+v"(a1), "+v"(a2), "+v"(a3));
#pragma unroll
    for (int i = 0; i < NP1; i++) *(u32x4*)(smem + a1 + i * RP1 * KP) = rk1[i];
#pragma unroll
    for (int i = 0; i < NP2; i++) *(u32x4*)(smem + a2 + i * RP2 * KP) = rk2[i];
#pragma unroll
    for (int i = 0; i < NPV; i++) *(u32x4*)(smem + a3 + i * RPV * VP) = rv[i];
    if (BIAS) { if (tid < KT) cks[tid] = rck; }
  };

  if (PREFETCH) load_tile(0);
  for (int j = 0; j < nt; j++) {
    __syncthreads();
    if (!PREFETCH) load_tile(j);
    store_tile();
    __syncthreads();
    if (PREFETCH) { if (j + 1 < nt) load_tile(j + 1); }
    const bool need = active && (MASK == MASK_NONE || j * KT <= wqmax);
    if (need) {
      int kro_l = kro, vro_l = vro;
      asm volatile("" : "+v"(kro_l), "+v"(vro_l));
      const char* krd = smem + kro_l;
      const bool needmask = (MASK == MASK_FRAME && j * KT + KT - 1 > J.qpos0 + wq0) || (j * KT + KT - 1 >= J.Sk);
      const int dq = (MASK == MASK_FRAME ? min(qpos, J.Sk - 1) : J.Sk - 1) - j * KT - 4 * h;
#pragma unroll
      for (int hb = 0; hb < KT / 32; hb++) {
        if (MASK == MASK_FRAME && j * KT + hb * 32 > wqmax) continue;
        f32x16 p;
#pragma unroll
        for (int i = 0; i < 16; i++) p[i] = 0.f;
#pragma unroll
        for (int kk = 0; kk < NKK; kk++) {
          const s16x8 kf = *(const s16x8*)(krd + hb * 32 * KP + kk * 32);
          p = mfma(kf, qf[kk], p);
        }
        if (BIAS) {
#pragma unroll
          for (int g = 0; g < 4; g++) {
            const f32x4 c0 = *(const f32x4*)(cks + hb * 32 + 8 * g + 4 * h);
#pragma unroll
            for (int e = 0; e < 4; e++) p[4 * g + e] = fmaf(p[4 * g + e], J.scale_log2, cqv - c0[e]);
          }
        } else {
#pragma unroll
          for (int i = 0; i < 16; i++) p[i] *= J.scale_log2;
        }
        if (needmask) {
#pragma unroll
          for (int i = 0; i < 16; i++) {
            const int cc = (i & 3) + 8 * (i >> 2) + 32 * hb;
            p[i] = (cc <= dq) ? p[i] : -1e30f;
          }
        }
        float mx = p[0];
#pragma unroll
        for (int i = 1; i < 16; i++) mx = fmaxf(mx, p[i]);
        mx = xhalf_max(mx);
        const float m_new = fmaxf(m_run, mx);
        const float alpha = __builtin_amdgcn_exp2f(m_run - m_new);
        m_run = m_new;
        float ps = 0.f;
#pragma unroll
        for (int i = 0; i < 16; i++) { p[i] = __builtin_amdgcn_exp2f(p[i] - m_new); ps += p[i]; }
        l_run = l_run * alpha + ps;
        if (__any(alpha != 1.f)) {
#pragma unroll
          for (int d = 0; d < NDV; d++)
#pragma unroll
            for (int i = 0; i < 16; i++) o[d][i] *= alpha;
        }
        s16x8 pb[2];
        {
          u32x4 w;
          w[0] = pk2(p[0], p[1]); w[1] = pk2(p[2], p[3]); w[2] = pk2(p[4], p[5]); w[3] = pk2(p[6], p[7]);
          pb[0] = __builtin_bit_cast(s16x8, w);
          w[0] = pk2(p[8], p[9]); w[1] = pk2(p[10], p[11]); w[2] = pk2(p[12], p[13]); w[3] = pk2(p[14], p[15]);
          pb[1] = __builtin_bit_cast(s16x8, w);
        }
#pragma unroll
        for (int d = 0; d < NDV; d++) {
          const char* vb = smem + (vro_l + ((d ^ vswz) * 64)) + hb * 32 * VP;
#pragma unroll
          for (int s = 0; s < 2; s++) {
            const s16x4 lo = __builtin_amdgcn_ds_read_tr16_b64_v4i16(
                (__attribute__((address_space(3))) s16x4*)(uintptr_t)(vb + (16 * s) * VP));
            const s16x4 hi = __builtin_amdgcn_ds_read_tr16_b64_v4i16(
                (__attribute__((address_space(3))) s16x4*)(uintptr_t)(vb + (16 * s + 8) * VP));
            const s16x8 vf = __builtin_shufflevector(lo, hi, 0, 1, 2, 3, 4, 5, 6, 7);
            o[d] = mfma(vf, pb[s], o[d]);
          }
        }
      }
    }
  }
  const float lt = xhalf_sum(l_run);
  if (active && qi < J.nq) {
    const float inv = 1.f / lt;
    u16* op = J.O + (size_t)qi * LDO + 4 * h;
#pragma unroll
    for (int d = 0; d < NDV; d++) {
#pragma unroll
      for (int g = 0; g < 4; g++) {
        u32x2 w;
        w[0] = pk2(o[d][4 * g] * inv, o[d][4 * g + 1] * inv);
        w[1] = pk2(o[d][4 * g + 2] * inv, o[d][4 * g + 3] * inv);
        *(u32x2*)(op + d * 32 + 8 * g) = w;
      }
    }
  }
}

template <int NR, bool F32OUT>
DI void rms_rows(const float* __restrict__ xbase, size_t rstride, int nvalid, const float* __restrict__ g, void* dbase, size_t dstride, int lane) {
  f32x4 v[NR][4];
#pragma unroll
  for (int j = 0; j < NR; j++)
#pragma unroll
    for (int i = 0; i < 4; i++) {
      if (j < nvalid) v[j][i] = *(const f32x4*)(xbase + (size_t)j * rstride + i * 256 + lane * 4);
      else { f32x4 z = {0.f, 0.f, 0.f, 0.f}; v[j][i] = z; }
    }
  f32x4 gg[4];
#pragma unroll
  for (int i = 0; i < 4; i++) gg[i] = *(const f32x4*)(g + i * 256 + lane * 4);
#pragma unroll
  for (int j = 0; j < NR; j++) {
    float ss = 0.f;
#pragma unroll
    for (int i = 0; i < 4; i++) ss += v[j][i][0] * v[j][i][0] + v[j][i][1] * v[j][i][1] + v[j][i][2] * v[j][i][2] + v[j][i][3] * v[j][i][3];
    ss = wave_sum(ss);
    const float rs = rsqrtf(ss * (1.f / 1024.f) + 1e-6f);
    if (j < nvalid) {
#pragma unroll
      for (int i = 0; i < 4; i++) {
        if (F32OUT) {
          f32x4 w;
          w[0] = v[j][i][0] * rs * gg[i][0]; w[1] = v[j][i][1] * rs * gg[i][1]; w[2] = v[j][i][2] * rs * gg[i][2]; w[3] = v[j][i][3] * rs * gg[i][3];
          *(f32x4*)((float*)dbase + (size_t)j * dstride + i * 256 + lane * 4) = w;
        } else {
          u32x2 w;
          w[0] = pk2(v[j][i][0] * rs * gg[i][0], v[j][i][1] * rs * gg[i][1]);
          w[1] = pk2(v[j][i][2] * rs * gg[i][2], v[j][i][3] * rs * gg[i][3]);
          *(u32x2*)((u16*)dbase + (size_t)j * dstride + i * 256 + lane * 4) = w;
        }
      }
    }
  }
}

DI void cvt_job(const float* __restrict__ src, u16* __restrict__ dst, int nseg, size_t seglen, size_t sstride, size_t dstride, int wv) {
  const size_t upseg = seglen / 8;
  const size_t total = upseg * nseg;
  const size_t stride = (size_t)get_nblk() * NTHR;
  for (size_t u0 = (size_t)get_bid() * NTHR + get_tid(wv); u0 < total; u0 += 4 * stride) {
    f32x4 a[4], b[4];
    size_t so[4], dd[4];
#pragma unroll
    for (int q = 0; q < 4; q++) {
      const size_t u = u0 + q * stride;
      const size_t uu = u < total ? u : u0;
      const size_t sg = uu / upseg, off = (uu - sg * upseg) * 8;
      so[q] = sg * sstride + off; dd[q] = sg * dstride + off;
      a[q] = *(const f32x4*)(src + so[q]);
      b[q] = *(const f32x4*)(src + so[q] + 4);
    }
#pragma unroll
    for (int q = 0; q < 4; q++) {
      if (u0 + q * stride < total) {
        u32x4 w;
        w[0] = pk2(a[q][0], a[q][1]); w[1] = pk2(a[q][2], a[q][3]); w[2] = pk2(b[q][0], b[q][1]); w[3] = pk2(b[q][2], b[q][3]);
        *(u32x4*)(dst + dd[q]) = w;
      }
    }
  }
}

DI void transpose_job(const float* __restrict__ src, u16* __restrict__ dst, int K, int N, int Npad, int& rot, char* smem, int wv) {
  float* tile = (float*)smem;
  const int tk = K / 64, tn = Npad / 64, ntiles = tk * tn;
  const int G = get_nblk();
  const int tid = get_tid(wv);
  for (int t = (get_bid() + G - (rot % G)) % G; t < ntiles; t += G) {
    const int k0 = (t % tk) * 64, n0 = (t / tk) * 64;
    float v[8];
#pragma unroll
    for (int i = 0; i < 8; i++) {
      const int k = i * 8 + (tid >> 6), n = tid & 63;
      v[i] = (n0 + n < N) ? src[(size_t)(k0 + k) * N + n0 + n] : 0.f;
    }
    __syncthreads();
#pragma unroll
    for (int i = 0; i < 8; i++) {
      const int k = i * 8 + (tid >> 6), n = tid & 63;
      tile[k * 65 + n] = v[i];
    }
    __syncthreads();
#pragma unroll
    for (int i = 0; i < 4; i++) {
      const int n = i * 16 + (tid >> 5), k = (tid & 31) * 2;
      *(unsigned*)(dst + (size_t)(n0 + n) * K + k0 + k) = pk2(tile[k * 65 + n], tile[(k + 1) * 65 + n]);
    }
  }
  rot += ntiles;
}

DI u16* wt_ptr(const Params& P, int l, size_t eoff) { return (u16*)(P.ws + WS_WT) + (size_t)l * WE_LAYER + eoff; }

DI void phase_prep(const Params& P, char* smem) {
  const int tid = get_tid(P.wv), lane = tid & 63;
  const int gw = get_bid() * NWV + (tid >> 6), nw = get_nblk() * NWV;
  int rot = 0;
  for (int l = 0; l < NL; l++) {
    transpose_job(P.in[11] + (size_t)l * 1024 * INC, wt_ptr(P, l, WE_IN), 1024, INC, INP, rot, smem, P.wv);
    transpose_job(P.in[14] + (size_t)l * 256 * 768, wt_ptr(P, l, WE_UQ), 256, 768, 768, rot, smem, P.wv);
    transpose_job(P.in[16] + (size_t)l * 128 * 1024, wt_ptr(P, l, WE_UKV), 128, 1024, 1024, rot, smem, P.wv);
    transpose_job(P.in[17] + (size_t)l * 1024 * 1024, wt_ptr(P, l, WE_OUT), 1024, 1024, 1024, rot, smem, P.wv);
    transpose_job(P.in[20] + (size_t)l * 1024 * 1024, wt_ptr(P, l, WE_XQ), 1024, 1024, 1024, rot, smem, P.wv);
    transpose_job(P.in[21] + (size_t)l * 1024 * 1024, wt_ptr(P, l, WE_MKV), 1024, 1024, 1024, rot, smem, P.wv);
    transpose_job(P.in[22] + (size_t)l * 1024 * 1024, wt_ptr(P, l, WE_MKV) + (size_t)1024 * 1024, 1024, 1024, 1024, rot, smem, P.wv);
    transpose_job(P.in[23] + (size_t)l * 1024 * 1024, wt_ptr(P, l, WE_XO), 1024, 1024, 1024, rot, smem, P.wv);
    transpose_job(P.in[25] + (size_t)l * 1024 * 4096, wt_ptr(P, l, WE_UP), 1024, 4096, 4096, rot, smem, P.wv);
    transpose_job(P.in[26] + (size_t)l * 4096 * 1024, wt_ptr(P, l, WE_DN), 4096, 1024, 1024, rot, smem, P.wv);
  }
  {
    f32x2* rt = (f32x2*)(P.ws + WS_ROPE);
    for (int i = get_bid() * NTHR + tid; i < 4096 * 32; i += get_nblk() * NTHR) {
      const int pos = i >> 5, j = i & 31;
      const float inv = powf(10000.f, -(float)j / 32.f);
      const float ang = (float)pos * inv;
      f32x2 cs; cs[0] = cosf(ang); cs[1] = sinf(ang);
      rt[i] = cs;
    }
  }
  for (int l = 0; l < NL; l++) {
    const size_t seg = (size_t)DB * NMEM * 1024;
    cvt_job(P.in[8] + l * seg, (u16*)(P.ws + WS_MEMK) + ((size_t)l * MB + NB) * NMEM * 1024, 1, seg, 0, 0, P.wv);
    cvt_job(P.in[9] + l * seg, (u16*)(P.ws + WS_MEMV) + ((size_t)l * MB + NB) * NMEM * 1024, 1, seg, 0, 0, P.wv);
  }
  for (int rr = gw; rr < NL * NB * NMEM; rr += nw) {
    const int l = rr / (NB * NMEM), row = rr % (NB * NMEM);
    rms_rows<1, false>(P.in[2] + (size_t)row * 1024, 0, 1, P.in[19] + l * 1024, (u16*)(P.ws + WS_HMEM) + (size_t)rr * 1024, 0, lane);
  }
  {
    const size_t n4 = (size_t)TT * 256;
    const size_t np4 = (size_t)TP * 256;
    const size_t stride = (size_t)get_nblk() * NTHR;
    for (size_t i0 = (size_t)get_bid() * NTHR + tid; i0 < n4; i0 += 4 * stride) {
      f32x4 v[4];
#pragma unroll
      for (int q = 0; q < 4; q++) {
        const size_t i = i0 + q * stride;
        const size_t ii = i < n4 ? i : i0;
        v[q] = (ii < np4) ? *(const f32x4*)(P.in[0] + ii * 4) : *(const f32x4*)(P.in[1] + (ii - np4) * 4);
      }
#pragma unroll
      for (int q = 0; q < 4; q++) {
        const size_t i = i0 + q * stride;
        if (i < n4) *(f32x4*)(P.out + i * 4) = v[q];
      }
    }
  }
}

DI void phase_norm(const Params& P, const float* g, int cache_layer) {
  const int tid = get_tid(P.wv), lane = tid & 63;
  const int gw = get_bid() * NWV + (tid >> 6), nw = get_nblk() * NWV;
  u16* h = (u16*)(P.ws + WS_ACTA);
  for (int row = gw; row < TT; row += 4 * nw) {
    const int nv = (TT - row + nw - 1) / nw;
    rms_rows<4, false>(P.out + (size_t)row * 1024, (size_t)nw * 1024, nv < 4 ? nv : 4, g, h + (size_t)row * 1024, (size_t)nw * 1024, lane);
  }
  if (cache_layer >= 0) {
    const int l = cache_layer;
    cvt_job(P.in[3] + (size_t)l * DB * PAST * 512, (u16*)(P.ws + WS_FOXK) + (size_t)TP * 512, DB, (size_t)PAST * 512, (size_t)PAST * 512, (size_t)SKS * 512, P.wv);
    cvt_job(P.in[4] + (size_t)l * DB * PAST * 512, (u16*)(P.ws + WS_FOXV) + (size_t)TP * 512, DB, (size_t)PAST * 512, (size_t)PAST * 512, (size_t)SKS * 512, P.wv);
    cvt_job(P.in[6] + (size_t)l * DB * PAST * 128, (u16*)(P.ws + WS_CKV) + (size_t)TP * 128, DB, (size_t)PAST * 128, (size_t)PAST * 128, (size_t)SKS * 128, P.wv);
    cvt_job(P.in[7] + (size_t)l * DB * PAST * 64, (u16*)(P.ws + WS_KROPE) + (size_t)TP * 64, DB, (size_t)PAST * 64, (size_t)PAST * 64, (size_t)SKS * 64, P.wv);
  }
}

DI void phase_final(const Params& P) {
  const int tid = get_tid(P.wv), lane = tid & 63;
  const int gw = get_bid() * NWV + (tid >> 6), nw = get_nblk() * NWV;
  const float* g = P.in[27];
  for (int row = gw; row < TT; row += 4 * nw) {
    const int nv = (TT - row + nw - 1) / nw;
    rms_rows<4, true>(P.out + (size_t)row * 1024, (size_t)nw * 1024, nv < 4 ? nv : 4, g, P.out + (size_t)row * 1024, (size_t)nw * 1024, lane);
  }
}

DI void phase_post(const Params& P, int l, char* smem) {
  const int tid = get_tid(P.wv), lane = tid & 63;
  const int gw = get_bid() * NWV + (tid >> 6), nw = get_nblk() * NWV;
  const float* zc = (const float*)(P.ws + WS_ZC);
  u16* cqn = (u16*)(P.ws + WS_CQN);
  u16* ckv = (u16*)(P.ws + WS_CKV);
  u16* krp = (u16*)(P.ws + WS_KROPE);
  const f32x2* rt = (const f32x2*)(P.ws + WS_ROPE);
  const float* gq = P.in[13] + l * 256;
  const float* gkv = P.in[15] + l * 128;
  for (int tok0 = gw; tok0 < TT; tok0 += 4 * nw) {
    f32x4 vq[4]; f32x2 vk[4]; float vr[4];
#pragma unroll
    for (int j = 0; j < 4; j++) {
      const int tk = tok0 + j * nw;
      const float* z = zc + (size_t)(tk < TT ? tk : tok0) * 448;
      vq[j] = *(const f32x4*)(z + lane * 4);
      vk[j] = *(const f32x2*)(z + 256 + lane * 2);
      vr[j] = z[384 + lane];
    }
    const f32x4 ggq = *(const f32x4*)(gq + lane * 4);
    const f32x2 ggk = *(const f32x2*)(gkv + lane * 2);
#pragma unroll
    for (int j = 0; j < 4; j++) {
      const int tok = tok0 + j * nw;
      if (tok >= TT) break;
      const bool isp = tok < TP;
      const size_t orow = isp ? ((size_t)l * TP + tok) : ((size_t)l * TS + (tok - TP));
      const int kr = tok_krow(tok);
      {
        const f32x4 v = vq[j];
        const float ss = wave_sum(v[0] * v[0] + v[1] * v[1] + v[2] * v[2] + v[3] * v[3]);
        const float rs = rsqrtf(ss * (1.f / 256.f) + 1e-6f);
        u32x2 w;
        w[0] = pk2(v[0] * rs * ggq[0], v[1] * rs * ggq[1]);
        w[1] = pk2(v[2] * rs * ggq[2], v[3] * rs * ggq[3]);
        *(u32x2*)(cqn + (size_t)tok * 256 + lane * 4) = w;
      }
      {
        const f32x2 v = vk[j];
        const float ss = wave_sum(v[0] * v[0] + v[1] * v[1]);
        const float rs = rsqrtf(ss * (1.f / 128.f) + 1e-6f);
        f32x2 o; o[0] = v[0] * rs * ggk[0]; o[1] = v[1] * rs * ggk[1];
        *(f32x2*)(P.out + (isp ? O_CKP : O_CKS) + orow * 128 + lane * 2) = o;
        *(unsigned*)(ckv + (size_t)kr * 128 + lane * 2) = pk2(o[0], o[1]);
      }
      {
        const float x = vr[j];
        const float y = __shfl_xor(x, 32);
        const f32x2 cs = rt[tok_pos(tok) * 32 + (lane & 31)];
        const float o = (lane < 32) ? (x * cs[0] - y * cs[1]) : (x * cs[0] + y * cs[1]);
        P.out[(isp ? O_KRP : O_KRS) + orow * 64 + lane] = o;
        krp[(size_t)kr * 64 + lane] = f2bf(o);
      }
    }
  }
  float* cum = (float*)(P.ws + WS_CUM);
  float* wtot = (float*)smem;
  const int wave = tid >> 6;
  for (int it = get_bid(); it < NB + DB; it += get_nblk()) {
    const bool isp = it < NB;
    const int b = isp ? it : it - NB;
    const int ppt = isp ? 16 : 9;
    const int npos = isp ? SEQ : SKS;
    const float* srcA; const float* srcB; int nA;
    size_t krow0;
    if (isp) { srcA = P.out + O_FLP + ((size_t)l * TP + (size_t)b * SEQ) * 8; srcB = srcA; nA = SEQ; krow0 = (size_t)b * SEQ; }
    else {
      srcA = P.in[5] + ((size_t)l * DB + b) * PAST * 8;
      srcB = P.out + O_FLS + ((size_t)l * TS + (size_t)b * DS) * 8 - (size_t)PAST * 8;
      nA = PAST; krow0 = (size_t)TP + (size_t)b * SKS;
    }
    const int p0 = tid * ppt;
    f32x4 va[16], vb[16];
#pragma unroll
    for (int j = 0; j < 16; j++) {
      const int p = p0 + j;
      f32x4 z = {0.f, 0.f, 0.f, 0.f};
      va[j] = z; vb[j] = z;
      if (j < ppt && p < npos) {
        const float* s = (p < nA ? srcA : srcB) + (size_t)p * 8;
        va[j] = *(const f32x4*)s; vb[j] = *(const f32x4*)(s + 4);
      }
    }
#pragma unroll
    for (int j = 1; j < 16; j++) { va[j] += va[j - 1]; vb[j] += vb[j - 1]; }
    f32x4 ta = va[15], tb = vb[15];
#pragma unroll
    for (int d = 1; d < 64; d <<= 1) {
#pragma unroll
      for (int e = 0; e < 4; e++) {
        const float ua = __shfl_up(ta[e], d), ub = __shfl_up(tb[e], d);
        if (lane >= d) { ta[e] += ua; tb[e] += ub; }
      }
    }
    __syncthreads();
    if (lane == 63) { *(f32x4*)(wtot + wave * 8) = ta; *(f32x4*)(wtot + wave * 8 + 4) = tb; }
    __syncthreads();
    f32x4 pa = ta - va[15], pb = tb - vb[15];
    for (int w2 = 0; w2 < wave; w2++) { pa += *(const f32x4*)(wtot + w2 * 8); pb += *(const f32x4*)(wtot + w2 * 8 + 4); }
#pragma unroll
    for (int j = 0; j < 16; j++) {
      const int p = p0 + j;
      if (j < ppt && p < npos) {
        float* d = cum + (krow0 + p) * 8;
        *(f32x4*)d = va[j] + pa; *(f32x4*)(d + 4) = vb[j] + pb;
      }
    }
  }
}

template <int EPI>
DI void gemm_phase(const Params& P, int l, const u16* __restrict__ A, int lda, const u16* __restrict__ Bt, int ldb, int K, int M, int N,
                   char* smem, int& rot) {
  constexpr int MI = 4;
  constexpr int STAGE = 32768;
  constexpr int NSLOT = SMEM_BYTES / STAGE;
  constexpr int DEPTH = NSLOT - 1;
  constexpr int GPS = 4;
  static_assert(NSLOT == 4, "ring waits are written for 4 slots");
  const int tid = get_tid(P.wv), wave = tid >> 6, lane = tid & 63, r = lane & 31, h = lane >> 5;
  const int wm = wave >> 2, wn = wave & 3;
  const int TM = M >> 8, TN = N >> 8;
  const int ntiles = TM * TN;
  const int G = get_nblk();
  const int bid = get_bid();
  const bool xmap = (G == 256);
  int t0, tstep;
  if (xmap) {
    const int nun = (ntiles + 31) >> 5;
    const int xs = (bid + 8 - (rot & 7)) & 7;
    t0 = xs * 32 + (bid >> 3); tstep = 256;
    rot += nun;
  } else {
    t0 = (bid + G - (rot % G)) % G; tstep = G;
    rot += ntiles;
  }
  const int nk = K >> 5;
  constexpr bool SPLITK = (EPI == EPI_RESID || EPI == EPI_RESID0);
  const bool sk = SPLITK && xmap && (TN == 4) && (((TM * nk) & 63) == 0);
  const int skS = (TM * nk) >> 6;
  const int sknt = (bid >> 3) & 3;
  const int p_begin = sk ? ((bid & 7) * 8 + (bid >> 5)) * skS : t0;
  const int p_end = sk ? p_begin + skS : ntiles;
  if (p_begin >= p_end) return;
  const int lrow = tid >> 2, lc = tid & 3;
  const int pc = (lc ^ ((tid >> 4) & 3)) * 8;
  const int sw = (r >> 2) & 3;
  const int xo0 = ((0 + h) ^ sw) * 16, xo1 = ((2 + h) ^ sw) * 16;
  const int aro = (wm * 128 + r) * 64, bro = 16384 + (wn * 64 + r) * 64;
  auto tile_of = [&](int t, int& m0, int& n0) { const int mt = t / TN; m0 = mt << 8; n0 = (t - mt * TN) << 8; };
  auto issue = [&](int m0, int n0, int ks, int slot) {
    const u16* ag = A + (size_t)(m0 + lrow) * lda + pc + ks * 32;
    const u16* bg = Bt + (size_t)(n0 + lrow) * ldb + pc + ks * 32;
    char* dst = smem + slot * STAGE + tid * 16;
#pragma unroll
    for (int i = 0; i < 2; i++)
      __builtin_amdgcn_global_load_lds((const unsigned*)(ag + (size_t)i * 128 * lda), (__attribute__((address_space(3))) unsigned*)(dst + i * 8192), 16, 0, 0);
#pragma unroll
    for (int i = 0; i < 2; i++)
      __builtin_amdgcn_global_load_lds((const unsigned*)(bg + (size_t)i * 128 * ldb), (__attribute__((address_space(3))) unsigned*)(dst + 16384 + i * 8192), 16, 0, 0);
  };
  auto unit_at = [&](int p, int& m0, int& n0, int& kb, int& nkk) {
    if (sk) { const int mt = p / nk; kb = p - mt * nk; const int rem = p_end - p; nkk = (nk - kb) < rem ? (nk - kb) : rem; m0 = mt << 8; n0 = sknt << 8; }
    else { tile_of(p, m0, n0); kb = 0; nkk = nk; }
  };
  int t = p_begin, m0, n0, kb, nkk;
  unit_at(t, m0, n0, kb, nkk);
  int ti = p_begin, ki = 0, mi0 = m0, ni0 = n0, kbi = kb, nki = nkk;
  bool idone = false;
  int pend = 0;
  unsigned g = 0;
  asm volatile("s_waitcnt vmcnt(0) lgkmcnt(0)" ::: "memory");
  __builtin_amdgcn_s_barrier();
#pragma unroll 1
  for (int s = 0; s < DEPTH; s++) {
    if (!idone) {
      issue(mi0, ni0, kbi + ki, (g + pend) % NSLOT);
      pend++;
      if (++ki == nki) { ki = 0; ti = sk ? ti + nki : ti + tstep; if (ti < p_end) unit_at(ti, mi0, ni0, kbi, nki); else idone = true; }
    }
  }
  while (true) {
    f32x16 acc[MI][2];
#pragma unroll
    for (int a = 0; a < MI; a++)
#pragma unroll
      for (int b = 0; b < 2; b++)
#pragma unroll
        for (int i = 0; i < 16; i++) acc[a][b][i] = 0.f;
    s16x8 a2[MI], b2, b3;
    {
      const s16x8 z = {0, 0, 0, 0, 0, 0, 0, 0};
#pragma unroll
      for (int i = 0; i < MI; i++) a2[i] = z;
      b2 = z; b3 = z;
    }
#pragma unroll 1
    for (int kt = 0; kt < nkk; kt++) {
      if (pend >= 3) asm volatile("s_waitcnt vmcnt(%0)" ::"n"(2 * GPS) : "memory");
      else if (pend == 2) asm volatile("s_waitcnt vmcnt(%0)" ::"n"(GPS) : "memory");
      else asm volatile("s_waitcnt vmcnt(0)" ::: "memory");
      asm volatile("s_waitcnt lgkmcnt(0)" ::: "memory");
      __builtin_amdgcn_s_barrier();
      if (!idone) {
        issue(mi0, ni0, kbi + ki, (g + pend) % NSLOT);
        if (++ki == nki) { ki = 0; ti = sk ? ti + nki : ti + tstep; if (ti < p_end) unit_at(ti, mi0, ni0, kbi, nki); else idone = true; }
      } else {
        pend--;
      }
      const char* sb = smem + (g % NSLOT) * STAGE;
      g++;
      s16x8 a[MI];
#pragma unroll
      for (int i = 0; i < MI; i++) a[i] = *(const s16x8*)(sb + aro + i * 32 * 64 + xo0);
      const s16x8 b0 = *(const s16x8*)(sb + bro + xo0);
      const s16x8 b1 = *(const s16x8*)(sb + bro + 32 * 64 + xo0);
      if (kt > 0) {
#pragma unroll
        for (int i = 0; i < MI; i++) { acc[i][0] = mfma(a2[i], b2, acc[i][0]); acc[i][1] = mfma(a2[i], b3, acc[i][1]); }
      }
#pragma unroll
      for (int i = 0; i < MI; i++) a2[i] = *(const s16x8*)(sb + aro + i * 32 * 64 + xo1);
      b2 = *(const s16x8*)(sb + bro + xo1);
      b3 = *(const s16x8*)(sb + bro + 32 * 64 + xo1);
#pragma unroll
      for (int i = 0; i < MI; i++) { acc[i][0] = mfma(a[i], b0, acc[i][0]); acc[i][1] = mfma(a[i], b1, acc[i][1]); }
    }
#pragma unroll
    for (int i = 0; i < MI; i++) { acc[i][0] = mfma(a2[i], b2, acc[i][0]); acc[i][1] = mfma(a2[i], b3, acc[i][1]); }
    epilogue<EPI, MI>(P, l, acc, m0 + wm * 128, n0 + wn * 64, r, h);
    t = sk ? t + nkk : t + tstep;
    if (t >= p_end) break;
    unit_at(t, m0, n0, kb, nkk);
  }
  asm volatile("s_waitcnt vmcnt(0) lgkmcnt(0)" ::: "memory");
}

DI void phase_attn(const Params& P, int l, char* smem) {
  const u16* qf = (const u16*)(P.ws + WS_QF);
  const u16* fk = (const u16*)(P.ws + WS_FOXK);
  const u16* fv = (const u16*)(P.ws + WS_FOXV);
  const float* cum = (const float*)(P.ws + WS_CUM);
  const u16* qm = (const u16*)(P.ws + WS_R1 + R1_QM);
  const u16* kv = (const u16*)(P.ws + WS_R1 + R1_KV);
  const u16* krp = (const u16*)(P.ws + WS_KROPE);
  u16* mixed = (u16*)(P.ws + WS_ACTA);
  constexpr float LOG2E = 1.4426950408889634f;
  const int total = 384 + 16 * 96;
  for (int t = get_bid(); t < total; t += get_nblk()) {
    bool isfox, issample; int b, hd, qb = 0;
    if (t < 256) { isfox = true; issample = true; b = t >> 3; hd = t & 7; }
    else if (t < 384) { isfox = false; issample = true; const int u = t - 256; b = u >> 2; hd = u & 3; }
    else {
      const int u = t - 384; const int grp = u / 96; int w = u % 96; qb = 15 - grp; issample = false;
      if (w < 32) { isfox = false; b = w >> 2; hd = w & 3; }
      else { w -= 32; isfox = true; b = w >> 3; hd = w & 7; }
    }
    AttnJob J;
    J.wv = P.wv;
    size_t tok0, krow0;
    if (issample) { tok0 = (size_t)TP + (size_t)b * DS; krow0 = (size_t)TP + (size_t)b * SKS; J.nq = DS; J.Sk = SKS; J.qpos0 = PAST; }
    else { tok0 = (size_t)b * SEQ + (size_t)qb * 256; krow0 = (size_t)b * SEQ; J.nq = 256; J.Sk = SEQ; J.qpos0 = qb * 256; }
    if (isfox) {
      J.Q = qf + tok0 * 512 + hd * 64; J.ldq = 512;
      J.K1 = fk + krow0 * 512 + hd * 64; J.ldk1 = 512; J.K2 = J.K1; J.ldk2 = 512;
      J.V = fv + krow0 * 512 + hd * 64; J.ldv = 512;
      J.O = mixed + tok0 * 1024 + hd * 64; J.ldo = 1024;
      J.cq = cum + (krow0 + (size_t)J.qpos0) * 8 + hd;
      J.ck = cum + krow0 * 8 + hd;
      J.scale_log2 = 0.125f * LOG2E;
      attn_block<64, 64, 64, MASK_FRAME, true, FOX_PF, 512, 512, 512, 512, 1024, FOX_KT>(J, smem);
    } else {
      J.Q = qm + tok0 * 768 + hd * 192; J.ldq = 768;
      J.K1 = kv + krow0 * 1024 + hd * 256; J.ldk1 = 1024;
      J.K2 = krp + krow0 * 64; J.ldk2 = 64;
      J.V = kv + krow0 * 1024 + hd * 256 + 128; J.ldv = 1024;
      J.O = mixed + tok0 * 1024 + 512 + hd * 128; J.ldo = 1024;
      J.cq = nullptr; J.ck = nullptr;
      J.scale_log2 = 0.07216878364870322f * LOG2E;
      attn_block<192, 128, 128, MASK_CHUNK, false, MLA_PF, 768, 1024, 64, 1024, 1024, 64>(J, smem);
    }
  }
}

DI void phase_cross(const Params& P, int l, char* smem) {
  const u16* xq = (const u16*)(P.ws + WS_R1 + R1_XQ);
  const u16* mk = (const u16*)(P.ws + WS_MEMK) + (size_t)l * MB * NMEM * 1024;
  const u16* mv = (const u16*)(P.ws + WS_MEMV) + (size_t)l * MB * NMEM * 1024;
  u16* xo = (u16*)(P.ws + WS_ACTA);
  constexpr float LOG2E = 1.4426950408889634f;
  const int nsamp = DB * 4 * 2;
  const int total = nsamp + 128 * 4 * 2;
  for (int t = get_bid(); t < total; t += get_nblk()) {
    AttnJob J;
    J.wv = P.wv;
    size_t tok0; int mb, hd, half;
    if (t < nsamp) { const int b = t >> 3; hd = (t >> 1) & 3; half = t & 1; tok0 = (size_t)TP + (size_t)b * DS; mb = NB + b; J.nq = DS; }
    else { const int u = t - nsamp; const int qbk = u >> 3; hd = (u >> 1) & 3; half = u & 1; tok0 = (size_t)qbk * 256; mb = qbk >> 4; J.nq = 256; }
    J.Sk = NMEM; J.qpos0 = 0;
    J.Q = xq + tok0 * 1024 + hd * 256; J.ldq = 1024;
    J.K1 = mk + (size_t)mb * NMEM * 1024 + hd * 256; J.ldk1 = 1024; J.K2 = J.K1; J.ldk2 = 1024;
    J.V = mv + (size_t)mb * NMEM * 1024 + hd * 256 + half * 128; J.ldv = 1024;
    J.O = xo + tok0 * 1024 + hd * 256 + half * 128; J.ldo = 1024;
    J.cq = nullptr; J.ck = nullptr;
    J.scale_log2 = 0.0625f * LOG2E;
    attn_block<256, 256, 128, MASK_NONE, false, false, 1024, 1024, 1024, 1024, 1024, 64>(J, smem);
  }
}

#define XB_TMO      128
#define XB_XCNT(j)  (256  + 64 * (j))
#define XB_XSUB(j)  (1280 + 64 * (j))
#define XB_XGEN(j)  (2304 + 64 * (j))
#define XB_TOP      3328
#define XB_TOPGEN   3392
#define XCD_BAR_WORDS 3456
#define XB_SPIN_CAP (1u << 20)
DI unsigned xb_ld(unsigned* p) { return __hip_atomic_load(p, __ATOMIC_RELAXED, __HIP_MEMORY_SCOPE_AGENT); }
DI unsigned xb_add(unsigned* p, unsigned v) { return __hip_atomic_fetch_add(p, v, __ATOMIC_RELAXED, __HIP_MEMORY_SCOPE_AGENT); }
DI unsigned xb_xcc_id() { return (unsigned)__builtin_amdgcn_s_getreg((3 << 11) | 20) & 0xFu; }
#define XB_SPIN(cond, bar) do { unsigned _sp = 0; while (cond) { __builtin_amdgcn_s_sleep(1); \
    if ((++_sp & 255u) == 0u) { if (xb_ld(&(bar)[XB_TMO])) break; if (_sp > XB_SPIN_CAP) { atomicAdd(&(bar)[XB_TMO], 1u); break; } } } } while (0)
DI void xb_census(unsigned* bar, unsigned x, unsigned& nloc, unsigned& nx) {
  const unsigned G = gridDim.x;
  unsigned sum, cnt, mine, sp = 0u;
  for (;;) {
    sum = 0u; cnt = 0u; mine = 0u;
#pragma unroll
    for (unsigned j = 0; j < 16; ++j) { const unsigned c = xb_ld(&bar[XB_XCNT(j)]); sum += c; cnt += (c > 0u) ? 1u : 0u; mine = (j == x) ? c : mine; }
    if (sum == G) break;
    __builtin_amdgcn_s_sleep(1);
    if ((++sp & 255u) == 0u) { if (xb_ld(&bar[XB_TMO])) break; if (sp > XB_SPIN_CAP) { atomicAdd(&bar[XB_TMO], 1u); break; } }
  }
  nloc = mine > 0u ? mine : 1u; nx = cnt > 0u ? cnt : 1u;
}
DI void xcd_barrier(unsigned* bar, unsigned x, unsigned nloc, unsigned nx, int wv) {
  asm volatile("s_waitcnt vmcnt(0)" ::: "memory");
  __syncthreads();
  if (wv == 0 && lane_id() == 0) {
    __builtin_amdgcn_s_waitcnt(0);
    const unsigned old = xb_add(&bar[XB_XSUB(x)], 1u);
    const unsigned gen = old / nloc;
    if (old + 1u == (gen + 1u) * nloc) {
      __builtin_amdgcn_fence(__ATOMIC_RELEASE, "agent");
      asm volatile("s_waitcnt vmcnt(0)" ::: "memory");
      const unsigned og = xb_add(&bar[XB_TOP], 1u);
      const unsigned tg = og / nx;
      if (og + 1u == (tg + 1u) * nx) xb_add(&bar[XB_TOPGEN], 1u);
      else XB_SPIN(xb_ld(&bar[XB_TOPGEN]) == tg, bar);
      __builtin_amdgcn_fence(__ATOMIC_ACQUIRE, "agent");
      xb_add(&bar[XB_XGEN(x)], 1u);
      asm volatile("s_waitcnt vmcnt(0)" ::: "memory");
    } else {
      XB_SPIN(xb_ld(&bar[XB_XGEN(x)]) == gen, bar);
      __builtin_amdgcn_fence(__ATOMIC_ACQUIRE, "agent");
      asm volatile("s_waitcnt vmcnt(0)" ::: "memory");
    }
  }
  __syncthreads();
}

constexpr int NPHASE = 2 + 13 * NL;

DI void run_phase(const Params& P, int ph, char* smem, bool dup = false) {
  if (ph == 0) { phase_prep(P, smem); return; }
  if (ph == NPHASE - 1) { phase_final(P); return; }
  const int l = (ph - 1) / 13, k = (ph - 1) % 13;
  char* ws = P.ws;
  const u16* actA = (const u16*)(ws + WS_ACTA);
  int rot = 0;
  switch (k) {
    case 0: phase_norm(P, P.in[10] + l * 1024, l); break;
    case 1:
      gemm_phase<EPI_IN>(P, l, actA, 1024, wt_ptr(P, l, WE_IN), 1024, 1024, TT, INP, smem, rot);
      if (l == 0) {
        for (int l2 = 0; l2 < NL; l2++)
          gemm_phase<EPI_MEM>(P, l2, (const u16*)(ws + WS_HMEM) + (size_t)l2 * NB * NMEM * 1024, 1024, wt_ptr(P, l2, WE_MKV), 1024, 1024,
                              NB * NMEM, 2048, smem, rot);
      }
      break;
    case 2: phase_post(P, l, smem); break;
    case 3:
      gemm_phase<EPI_KV>(P, l, (const u16*)(ws + WS_CKV), 128, wt_ptr(P, l, WE_UKV), 128, 128, KROWS, 1024, smem, rot);
      gemm_phase<EPI_UQ>(P, l, (const u16*)(ws + WS_CQN), 256, wt_ptr(P, l, WE_UQ), 256, 256, TT, 768, smem, rot);
      break;
    case 4: phase_attn(P, l, smem); break;
    case 5: if (dup) gemm_phase<EPI_RESID0>(P, l, actA, 1024, wt_ptr(P, l, WE_OUT), 1024, 1024, TT, 1024, smem, rot); else gemm_phase<EPI_RESID>(P, l, actA, 1024, wt_ptr(P, l, WE_OUT), 1024, 1024, TT, 1024, smem, rot); break;
    case 6: phase_norm(P, P.in[18] + l * 1024, -1); break;
    case 7: gemm_phase<EPI_XQ>(P, l, actA, 1024, wt_ptr(P, l, WE_XQ), 1024, 1024, TT, 1024, smem, rot); break;
    case 8: phase_cross(P, l, smem); break;
    case 9: if (dup) gemm_phase<EPI_RESID0>(P, l, actA, 1024, wt_ptr(P, l, WE_XO), 1024, 1024, TT, 1024, smem, rot); else gemm_phase<EPI_RESID>(P, l, actA, 1024, wt_ptr(P, l, WE_XO), 1024, 1024, TT, 1024, smem, rot); break;
    case 10: phase_norm(P, P.in[24] + l * 1024, -1); break;
    case 11: gemm_phase<EPI_UP>(P, l, actA, 1024, wt_ptr(P, l, WE_UP), 1024, 1024, TT, DFF, smem, rot); break;
    case 12: if (dup) gemm_phase<EPI_RESID0>(P, l, (const u16*)(ws + WS_R1 + R1_U), DFF, wt_ptr(P, l, WE_DN), DFF, DFF, TT, 1024, smem, rot); else gemm_phase<EPI_RESID>(P, l, (const u16*)(ws + WS_R1 + R1_U), DFF, wt_ptr(P, l, WE_DN), DFF, DFF, TT, 1024, smem, rot); break;
  }
}

__global__ void __launch_bounds__(NTHR) mega(Params P, int ph_lo, int ph_hi) {
  extern __shared__ __attribute__((aligned(16))) char smem[];
  cg::grid_group grid = cg::this_grid();
  if (ph_hi > 4096) grid.sync();
  unsigned* bar = (unsigned*)(P.ws + WS_BAR);
  const unsigned xb_x = xb_xcc_id();
  unsigned xb_nloc = 1u, xb_nx = 1u;
  if (threadIdx.x == 0) { (void)xb_add(&bar[XB_XCNT(xb_x)], 1u); xb_census(bar, xb_x, xb_nloc, xb_nx); }
  xb_nloc = __builtin_amdgcn_readfirstlane(xb_nloc);
  xb_nx = __builtin_amdgcn_readfirstlane(xb_nx);
  unsigned xb_pack = xb_nloc | (xb_nx << 16) | (xb_x << 24) | ((unsigned)__builtin_amdgcn_readfirstlane(threadIdx.x >> 6) << 28);
  asm volatile("" : "+s"(xb_pack));
  for (int ph = ph_lo; ph < ph_hi; ph++) {
    Params Q = P;
    unsigned pk = xb_pack;
    asm volatile("" : "+s"(Q.out), "+s"(Q.ws), "+s"(pk));
    Q.wv = (int)(pk >> 28);
    run_phase(Q, ph, smem);
    if (ph + 1 < ph_hi) {
      unsigned pk2 = xb_pack;
      asm volatile("" : "+s"(pk2));
      xcd_barrier((unsigned*)(Q.ws + WS_BAR), (pk2 >> 24) & 0xfu, pk2 & 0xffffu, (pk2 >> 16) & 0xffu, (int)(pk2 >> 28));
    }
  }
}

extern "C" void kernel_launch(void* const* d_in, const int* in_sizes, int n_in, void* d_out, int out_size, void* d_ws,
                              size_t ws_size, hipStream_t stream) {
  static int grid_blocks = 0;
  if (!grid_blocks) {
    int dev = 0, cus = 0, per_cu = 0;
    hipGetDevice(&dev);
    hipDeviceGetAttribute(&cus, hipDeviceAttributeMultiprocessorCount, dev);
    hipFuncSetAttribute((const void*)mega, hipFuncAttributeMaxDynamicSharedMemorySize, SMEM_BYTES);
    hipOccupancyMaxActiveBlocksPerMultiprocessor(&per_cu, mega, NTHR, SMEM_BYTES);
    per_cu = 1;
    grid_blocks = cus * per_cu;
  }
  if (n_in != 28 || (size_t)out_size != O_END || ws_size < WS_END) {
    fprintf(stderr, "kernel_launch: shape/ws mismatch n_in %d out %d (want %zu) ws %zu (want %zu)\n", n_in, out_size, (size_t)O_END, ws_size, (size_t)WS_END);
    return;
  }
  Params p;
  memset(&p, 0, sizeof(p));
  for (int i = 0; i < 28; i++) p.in[i] = (const float*)d_in[i];
  p.out = (float*)d_out;
  p.ws = (char*)d_ws;
  hipMemsetAsync((char*)d_ws + WS_BAR, 0, XCD_BAR_WORDS * 4, stream);
  int lo = 0, hi = NPHASE;
  void* args[] = {&p, &lo, &hi};
  hipError_t e = hipLaunchCooperativeKernel((void*)mega, dim3(grid_blocks), dim3(NTHR), args, SMEM_BYTES, stream);
  if (e != hipSuccess) fprintf(stderr, "cooperative launch failed: %s (grid %d)\n", hipGetErrorString(e), grid_blocks);
}
```

```cpp
#include <hip/hip_runtime.h>
#include <hip/hip_cooperative_groups.h>
#include <stdint.h>
#include <string.h>
#include <stdio.h>
namespace cg = cooperative_groups;

#ifndef COOP
#define COOP 1
#endif

#ifndef FOX_KT
#define FOX_KT 128
#endif
#ifndef FOX_PF
#define FOX_PF true
#endif
#ifndef MLA_PF
#define MLA_PF true
#endif
#ifndef LB_MIN
#define LB_MIN 2
#endif
#ifndef BM_BIG
#define BM_BIG 256
#endif
constexpr int NTHR = 512, NWV = 8;
#define DI __device__ __forceinline__
typedef unsigned short u16;
typedef short s16x8 __attribute__((ext_vector_type(8)));
typedef short s16x4 __attribute__((ext_vector_type(4)));
typedef __bf16 bfx8 __attribute__((ext_vector_type(8)));
typedef __bf16 bfx2 __attribute__((ext_vector_type(2)));
typedef float f32x16 __attribute__((ext_vector_type(16)));
typedef float f32x4 __attribute__((ext_vector_type(4)));
typedef float f32x2 __attribute__((ext_vector_type(2)));
typedef unsigned u32x4 __attribute__((ext_vector_type(4)));
typedef unsigned u32x2 __attribute__((ext_vector_type(2)));

constexpr int DM = 1024, NB = 8, SEQ = 4096, NL = 2, DB = 32, DS = 32, PAST = 2048;
constexpr int TP = NB * SEQ;
constexpr int TS = DB * DS;
constexpr int TT = TP + TS;
constexpr int SKS = PAST + DS;
constexpr int KROWS = TP + DB * SKS;
constexpr int INC = 1992, INP = 2048;
constexpr int NMEM = 256, MB = NB + DB;
constexpr int DFF = 4096;

constexpr size_t O_Y = 0;
constexpr size_t O_FKP = (size_t)TT * DM;
constexpr size_t O_FVP = O_FKP + (size_t)NL * TP * 512;
constexpr size_t O_FLP = O_FVP + (size_t)NL * TP * 512;
constexpr size_t O_CKP = O_FLP + (size_t)NL * TP * 8;
constexpr size_t O_KRP = O_CKP + (size_t)NL * TP * 128;
constexpr size_t O_MKP = O_KRP + (size_t)NL * TP * 64;
constexpr size_t O_MVP = O_MKP + (size_t)NL * NB * NMEM * 1024;
constexpr size_t O_FKS = O_MVP + (size_t)NL * NB * NMEM * 1024;
constexpr size_t O_FVS = O_FKS + (size_t)NL * TS * 512;
constexpr size_t O_FLS = O_FVS + (size_t)NL * TS * 512;
constexpr size_t O_CKS = O_FLS + (size_t)NL * TS * 8;
constexpr size_t O_KRS = O_CKS + (size_t)NL * TS * 128;
constexpr size_t O_END = O_KRS + (size_t)NL * TS * 64;

constexpr size_t al256(size_t x) { return (x + 255) / 256 * 256; }
constexpr size_t WE_IN = 0;
constexpr size_t WE_UQ = WE_IN + (size_t)INP * 1024;
constexpr size_t WE_UKV = WE_UQ + (size_t)768 * 256;
constexpr size_t WE_OUT = WE_UKV + (size_t)1024 * 128;
constexpr size_t WE_XQ = WE_OUT + (size_t)1024 * 1024;
constexpr size_t WE_MKV = WE_XQ + (size_t)1024 * 1024;
constexpr size_t WE_XO = WE_MKV + (size_t)2048 * 1024;
constexpr size_t WE_UP = WE_XO + (size_t)1024 * 1024;
constexpr size_t WE_DN = WE_UP + (size_t)4096 * 1024;
constexpr size_t WE_LAYER = WE_DN + (size_t)1024 * 4096;
constexpr size_t WS_WT = 0;
constexpr size_t WS_ROPE = al256(WS_WT + WE_LAYER * 2 * NL);
constexpr size_t WS_ACTA = al256(WS_ROPE + (size_t)4096 * 32 * 8);
constexpr size_t WS_QF = al256(WS_ACTA + (size_t)TT * 1024 * 2);
constexpr size_t WS_FOXK = al256(WS_QF + (size_t)TT * 512 * 2);
constexpr size_t WS_FOXV = al256(WS_FOXK + (size_t)KROWS * 512 * 2);
constexpr size_t WS_CUM = al256(WS_FOXV + (size_t)KROWS * 512 * 2);
constexpr size_t WS_ZC = al256(WS_CUM + (size_t)KROWS * 8 * 4);
constexpr size_t WS_CQN = al256(WS_ZC + (size_t)TT * 448 * 4);
constexpr size_t WS_CKV = al256(WS_CQN + (size_t)TT * 256 * 2);
constexpr size_t WS_KROPE = al256(WS_CKV + (size_t)KROWS * 128 * 2);
constexpr size_t WS_MEMK = al256(WS_KROPE + (size_t)KROWS * 64 * 2);
constexpr size_t WS_MEMV = al256(WS_MEMK + (size_t)NL * MB * NMEM * 1024 * 2);
constexpr size_t WS_HMEM = al256(WS_MEMV + (size_t)NL * MB * NMEM * 1024 * 2);
constexpr size_t WS_R1 = al256(WS_HMEM + (size_t)NL * NB * NMEM * 1024 * 2);
constexpr size_t R1_KV = 0;
constexpr size_t R1_QM = al256((size_t)KROWS * 1024 * 2);
constexpr size_t R1_U = 0;
constexpr size_t R1_XQ = 0;
constexpr size_t WS_BAR = al256(WS_R1 + (size_t)TT * 4096 * 2);
constexpr size_t WS_END = al256(WS_BAR + 3456 * 4);
static_assert(R1_QM + (size_t)TT * 768 * 2 <= (size_t)TT * 4096 * 2, "R1 overflow");

constexpr int SMEM_BYTES = 131072;

struct Params {
  const float* in[28];
  float* out;
  char* ws;
  int wv;
  int pad;
};

DI int get_bid() { int t = blockIdx.x; asm volatile("" : "+s"(t)); return t; }
DI int get_nblk() { int t = gridDim.x; asm volatile("" : "+s"(t)); return t; }
DI int lane_id() { return (int)__builtin_amdgcn_mbcnt_hi(~0u, __builtin_amdgcn_mbcnt_lo(~0u, 0u)); }
DI int get_tid(int wv) { int t = (wv << 6) | lane_id(); asm volatile("" : "+v"(t)); return t; }
DI unsigned pk2(float a, float b) { f32x2 v = {a, b}; return __builtin_bit_cast(unsigned, __builtin_convertvector(v, bfx2)); }
DI u16 f2bf(float a) { return (u16)(pk2(a, 0.f) & 0xffffu); }
DI f32x16 mfma(s16x8 a, s16x8 b, f32x16 c) {
  return __builtin_amdgcn_mfma_f32_32x32x16_bf16(__builtin_bit_cast(bfx8, a), __builtin_bit_cast(bfx8, b), c, 0, 0, 0);
}
DI int crow(int i, int h) { return (i & 3) + 8 * (i >> 2) + 4 * h; }
DI float wave_sum(float v) {
#pragma unroll
  for (int m = 32; m >= 1; m >>= 1) v += __shfl_xor(v, m);
  return v;
}
DI float xhalf_max(float v) {
  auto rr = __builtin_amdgcn_permlane32_swap(__float_as_uint(v), __float_as_uint(v), false, false);
  return fmaxf(__uint_as_float(rr[0]), __uint_as_float(rr[1]));
}
DI float xhalf_sum(float v) {
  auto rr = __builtin_amdgcn_permlane32_swap(__float_as_uint(v), __float_as_uint(v), false, false);
  return __uint_as_float(rr[0]) + __uint_as_float(rr[1]);
}
DI int tok_krow(int tok) {
  if (tok < TP) return tok;
  const int s = tok - TP;
  return TP + (s >> 5) * SKS + PAST + (s & 31);
}
DI int tok_pos(int tok) { return tok < TP ? (tok & (SEQ - 1)) : PAST + ((tok - TP) & 31); }

enum { EPI_IN = 0, EPI_MEM, EPI_UQ, EPI_KV, EPI_RESID, EPI_XQ, EPI_UP, EPI_RESID0 };

template <int EPI, int MI>
DI void epilogue(const Params& P, int l, f32x16 (&acc)[MI][2], int mw, int nw, int r, int h) {
  float* out = P.out;
  char* ws = P.ws;
  if constexpr (EPI == EPI_IN) {
    u16* qf = (u16*)(ws + WS_QF);
    u16* fk = (u16*)(ws + WS_FOXK);
    u16* fv = (u16*)(ws + WS_FOXV);
    float* zc = (float*)(ws + WS_ZC);
    const float* bfg = P.in[12] + l * 8;
#pragma unroll
    for (int mi = 0; mi < MI; mi++) {
#pragma unroll
      for (int i = 0; i < 16; i++) {
        const int row = mw + mi * 32 + crow(i, h);
        const int kr = tok_krow(row);
        const bool isp = row < TP;
        const size_t orow = isp ? ((size_t)l * TP + row) : ((size_t)l * TS + (row - TP));
#pragma unroll
        for (int ni = 0; ni < 2; ni++) {
          const int col = nw + ni * 32 + r;
          const float v = acc[mi][ni][i];
          if (col < 512) {
            qf[(size_t)row * 512 + col] = f2bf(v);
          } else if (col < 1024) {
            const int c = col - 512;
            out[(isp ? O_FKP : O_FKS) + orow * 512 + c] = v;
            fk[(size_t)kr * 512 + c] = f2bf(v);
          } else if (col < 1536) {
            const int c = col - 1024;
            out[(isp ? O_FVP : O_FVS) + orow * 512 + c] = v;
            fv[(size_t)kr * 512 + c] = f2bf(v);
          } else if (col < 1544) {
            const int c = col - 1536;
            const float g = v + bfg[c];
            const float ls = fminf(g, 0.f) - __logf(1.f + __expf(-fabsf(g)));
            out[(isp ? O_FLP : O_FLS) + orow * 8 + c] = ls;
          } else if (col < INC) {
            zc[(size_t)row * 448 + (col - 1544)] = v;
          }
        }
      }
    }
  } else if constexpr (EPI == EPI_MEM) {
    u16* mk = (u16*)(ws + WS_MEMK);
    u16* mv = (u16*)(ws + WS_MEMV);
#pragma unroll
    for (int mi = 0; mi < MI; mi++) {
#pragma unroll
      for (int i = 0; i < 16; i++) {
        const int row = mw + mi * 32 + crow(i, h);
#pragma unroll
        for (int ni = 0; ni < 2; ni++) {
          const int col = nw + ni * 32 + r;
          const float v = acc[mi][ni][i];
          const int c = col & 1023;
          const size_t oidx = ((size_t)l * (NB * NMEM) + row) * 1024 + c;
          const size_t bidx = ((size_t)l * (MB * NMEM) + row) * 1024 + c;
          if (col < 1024) { out[O_MKP + oidx] = v; mk[bidx] = f2bf(v); }
          else { out[O_MVP + oidx] = v; mv[bidx] = f2bf(v); }
        }
      }
    }
  } else if constexpr (EPI == EPI_UQ) {
    u16* qm = (u16*)(ws + WS_R1 + R1_QM);
    const f32x2* rt = (const f32x2*)(ws + WS_ROPE);
    const bool isrope = (nw % 192) == 128;
#pragma unroll
    for (int mi = 0; mi < MI; mi++) {
#pragma unroll
      for (int i = 0; i < 16; i++) {
        const int row = mw + mi * 32 + crow(i, h);
        float x1 = acc[mi][0][i], x2 = acc[mi][1][i];
        if (isrope) {
          const f32x2 cs = rt[tok_pos(row) * 32 + r];
          const float o1 = x1 * cs[0] - x2 * cs[1];
          const float o2 = x2 * cs[0] + x1 * cs[1];
          x1 = o1; x2 = o2;
        }
        qm[(size_t)row * 768 + nw + r] = f2bf(x1);
        qm[(size_t)row * 768 + nw + 32 + r] = f2bf(x2);
      }
    }
  } else if constexpr (EPI == EPI_KV || EPI == EPI_XQ || EPI == EPI_UP) {
    u16* dst; int ld;
    if constexpr (EPI == EPI_KV) { dst = (u16*)(ws + WS_R1 + R1_KV); ld = 1024; }
    else if constexpr (EPI == EPI_XQ) { dst = (u16*)(ws + WS_R1 + R1_XQ); ld = 1024; }
    else { dst = (u16*)(ws + WS_R1 + R1_U); ld = DFF; }
    const bool odd = r & 1;
    const int colb = nw + (r & ~1);
#pragma unroll
    for (int mi = 0; mi < MI; mi++) {
#pragma unroll
      for (int i = 0; i < 16; i += 2) {
        const int row = mw + mi * 32 + crow(i, h) + (odd ? 1 : 0);
#pragma unroll
        for (int ni = 0; ni < 2; ni++) {
          float v0 = acc[mi][ni][i], v1 = acc[mi][ni][i + 1];
          if constexpr (EPI == EPI_UP) { v0 = fmaxf(v0, 0.f); v0 = v0 * v0; v1 = fmaxf(v1, 0.f); v1 = v1 * v1; }
          const float send = odd ? v0 : v1;
          const float recv = __int_as_float(__builtin_amdgcn_mov_dpp(__float_as_int(send), 0xB1, 0xF, 0xF, true));
          const unsigned w = odd ? pk2(recv, v1) : pk2(v0, recv);
          *(unsigned*)(dst + (size_t)row * ld + colb + ni * 32) = w;
        }
      }
    }
  } else if constexpr (EPI == EPI_RESID || EPI == EPI_RESID0) {
#pragma unroll
    for (int mi = 0; mi < MI; mi++) {
#pragma unroll
      for (int i = 0; i < 16; i++) {
        const int row = mw + mi * 32 + crow(i, h);
#pragma unroll
        for (int ni = 0; ni < 2; ni++) {
          unsafeAtomicAdd(out + (size_t)row * DM + nw + ni * 32 + r, EPI == EPI_RESID0 ? acc[mi][ni][i] * 0.f : acc[mi][ni][i]);
        }
      }
    }
  }
}

enum { MASK_NONE = 0, MASK_FRAME = 1, MASK_CHUNK = 2 };
struct AttnJob {
  const u16* Q; int ldq;
  const u16* K1; int ldk1;
  const u16* K2; int ldk2;
  const u16* V; int ldv;
  u16* O; int ldo;
  const float* cq;
  const float* ck;
  int nq, Sk, qpos0;
  float scale_log2;
  int wv;
};

template <int DQK, int D1, int DVT, int MASK, bool BIAS, bool PREFETCH, int LDQ, int LDK1, int LDK2, int LDV, int LDO, int KT>
DI void attn_block(const AttnJob& J, char* smem) {
  constexpr int KP = DQK * 2 + 16;
  constexpr int VP = DVT * 2;
  constexpr int CV = DVT / 8;
  constexpr int NKK = DQK / 16, NDV = DVT / 32;
  constexpr float LOG2E = 1.4426950408889634f;
  char* Ks = smem;
  char* Vs = smem + KT * KP;
  float* cks = (float*)(smem + KT * KP + KT * VP);
  const int tid = get_tid(J.wv), wave = tid >> 6, lane = tid & 63, r = lane & 31, h = lane >> 5;
  const int wq0 = wave * 32;
  const bool active = wq0 < J.nq;
  const int qi = wq0 + r;
  const int qpos = J.qpos0 + qi;
  const int wqmax = J.qpos0 + wq0 + 31;
  const int qmax = J.qpos0 + J.nq - 1;
  const int ntk = (J.Sk + KT - 1) / KT;
  int nt = ntk;
  if (MASK != MASK_NONE) { const int t2 = qmax / KT + 1; nt = t2 < ntk ? t2 : ntk; }

  s16x8 qf[NKK];
  {
    const u16* qp = J.Q + (size_t)qi * LDQ + h * 8;
#pragma unroll
    for (int kk = 0; kk < NKK; kk++) {
      if (active) qf[kk] = *(const s16x8*)(qp + kk * 16);
      else { s16x8 z = {0, 0, 0, 0, 0, 0, 0, 0}; qf[kk] = z; }
    }
  }

  f32x16 o[NDV];
#pragma unroll
  for (int d = 0; d < NDV; d++)
#pragma unroll
    for (int i = 0; i < 16; i++) o[d][i] = 0.f;
  float m_run = -1e30f, l_run = 0.f;

  constexpr int CK1 = D1 / 8, CK2 = (DQK - D1) / 8;
  constexpr int RP1 = NTHR / CK1, NP1 = KT / RP1;
  constexpr int RP2 = CK2 ? NTHR / (CK2 ? CK2 : 1) : 64, NP2 = CK2 ? KT / RP2 : 0;
  constexpr int RPV = NTHR / CV, NPV = KT / RPV;
  u32x4 rk1[NP1], rk2[NP2 ? NP2 : 1], rv[NPV];
  float rck = 0.f;
  const int tq = (lane & 15) >> 2, tp = lane & 3, tblk = (lane >> 4) & 1;
  const int vswz = (DVT >= 128) ? tq : (tq >> 1);
  const int r1 = tid / CK1, c1 = tid % CK1;
  const int r2 = CK2 ? tid / (CK2 ? CK2 : 1) : 0, c2 = CK2 ? tid % (CK2 ? CK2 : 1) : 0;
  const int r3 = tid / CV, c3 = tid % CV;
  const unsigned k1o = (unsigned)(r1 * LDK1 + c1 * 8) * 2u;
  const unsigned k2o = (unsigned)(r2 * LDK2 + c2 * 8) * 2u;
  const unsigned vo = (unsigned)(r3 * LDV + c3 * 8) * 2u;
  const int k1so = r1 * KP + c1 * 16;
  const int k2so = r2 * KP + D1 * 2 + c2 * 16;
  const int vsw = (DVT >= 128) ? (r3 & 3) : ((r3 >> 1) & 1);
  const int vso = KT * KP + r3 * VP + (((c3 >> 2) ^ vsw) * 64) + (c3 & 3) * 16;
  const int vro = KT * KP + (4 * h + tq) * VP + (16 * tblk + 4 * tp) * 2;
  const int kro = r * KP + h * 16;

  auto load_tile = [&](int j) {
    const int kb = j * KT;
#pragma unroll
    for (int i = 0; i < NP1; i++) {
      u32x4 v = {0u, 0u, 0u, 0u};
      if (kb + r1 + i * RP1 < J.Sk) v = *(const u32x4*)((const char*)(J.K1 + (size_t)(kb + i * RP1) * LDK1) + k1o);
      rk1[i] = v;
    }
#pragma unroll
    for (int i = 0; i < NP2; i++) {
      u32x4 v = {0u, 0u, 0u, 0u};
      if (kb + r2 + i * RP2 < J.Sk) v = *(const u32x4*)((const char*)(J.K2 + (size_t)(kb + i * RP2) * LDK2) + k2o);
      rk2[i] = v;
    }
#pragma unroll
    for (int i = 0; i < NPV; i++) {
      u32x4 v = {0u, 0u, 0u, 0u};
      if (kb + r3 + i * RPV < J.Sk) v = *(const u32x4*)((const char*)(J.V + (size_t)(kb + i * RPV) * LDV) + vo);
      rv[i] = v;
    }
    if (BIAS) {
      if (tid < KT) { const int key = kb + tid; rck = key < J.Sk ? -J.ck[(size_t)key * 8] * LOG2E : 0.f; }
    }
  };
  auto store_tile = [&]() {
    int a1 = k1so, a2 = k2so, a3 = vso;
    asm volatile("" : "+v"(a1), "+v"(a2), "+v"(a3));
#pragma unroll
    for (int i = 0; i < NP1; i++) *(u32x4*)(smem + a1 + i * RP1 * KP) = rk1[i];
#pragma unroll
    for (int i = 0; i < NP2; i++) *(u32x4*)(smem + a2 + i * RP2 * KP) = rk2[i];
#pragma unroll
    for (int i = 0; i < NPV; i++) *(u32x4*)(smem + a3 + i * RPV * VP) = rv[i];
    if (BIAS) { if (tid < KT) cks[tid] = rck; }
  };

  if (PREFETCH) load_tile(0);
  for (int j = 0; j < nt; j++) {
    __syncthreads();
    if (!PREFETCH) load_tile(j);
    store_tile();
    __syncthreads();
    if (PREFETCH) { if (j + 1 < nt) load_tile(j + 1); }
    const bool need = active && (MASK == MASK_NONE || j * KT <= wqmax);
    if (need) {
      int kro_l = kro, vro_l = vro;
      asm volatile("" : "+v"(kro_l), "+v"(vro_l));
      const char* krd = smem + kro_l;
      const bool needmask = (MASK == MASK_FRAME && j * KT + KT - 1 > J.qpos0 + wq0) || (j * KT + KT - 1 >= J.Sk);
      const int dq = (MASK == MASK_FRAME ? min(qpos, J.Sk - 1) : J.Sk - 1) - j * KT - 4 * h;
#pragma unroll
      for (int hb = 0; hb < KT / 32; hb++) {
        if (MASK == MASK_FRAME && j * KT + hb * 32 > wqmax) continue;
        f32x16 p;
#pragma unroll
        for (int i = 0; i < 16; i++) p[i] = 0.f;
#pragma unroll
        for (int kk = 0; kk < NKK; kk++) {
          const s16x8 kf = *(const s16x8*)(krd + hb * 32 * KP + kk * 32);
          p = mfma(kf, qf[kk], p);
        }
        if (BIAS) {
#pragma unroll
          for (int g = 0; g < 4; g++) {
            const f32x4 c0 = *(const f32x4*)(cks + hb * 32 + 8 * g + 4 * h);
#pragma unroll
            for (int e = 0; e < 4; e++) p[4 * g + e] = fmaf(p[4 * g + e], J.scale_log2, c0[e]);
          }
        } else {
#pragma unroll
          for (int i = 0; i < 16; i++) p[i] *= J.scale_log2;
        }
        if (needmask) {
#pragma unroll
          for (int i = 0; i < 16; i++) {
            const int cc = (i & 3) + 8 * (i >> 2) + 32 * hb;
            p[i] = (cc <= dq) ? p[i] : -1e30f;
          }
        }
        float mx = p[0];
#pragma unroll
        for (int i = 1; i < 16; i++) mx = fmaxf(mx, p[i]);
        mx = xhalf_max(mx);
        if (__any(mx > m_run + 8.f)) {
          const float m_new = fmaxf(m_run, mx);
          const float alpha = __builtin_amdgcn_exp2f(m_run - m_new);
          m_run = m_new;
          l_run *= alpha;
#pragma unroll
          for (int d = 0; d < NDV; d++)
#pragma unroll
            for (int i = 0; i < 16; i++) o[d][i] *= alpha;
        }
        float ps = 0.f;
#pragma unroll
        for (int i = 0; i < 16; i++) { p[i] = __builtin_amdgcn_exp2f(p[i] - m_run); ps += p[i]; }
        l_run += ps;
        s16x8 pb[2];
        {
          u32x4 w;
          w[0] = pk2(p[0], p[1]); w[1] = pk2(p[2], p[3]); w[2] = pk2(p[4], p[5]); w[3] = pk2(p[6], p[7]);
          pb[0] = __builtin_bit_cast(s16x8, w);
          w[0] = pk2(p[8], p[9]); w[1] = pk2(p[10], p[11]); w[2] = pk2(p[12], p[13]); w[3] = pk2(p[14], p[15]);
          pb[1] = __builtin_bit_cast(s16x8, w);
        }
#pragma unroll
        for (int d = 0; d < NDV; d++) {
          const char* vb = smem + (vro_l + ((d ^ vswz) * 64)) + hb * 32 * VP;
#pragma unroll
          for (int s = 0; s < 2; s++) {
            const s16x4 lo = __builtin_amdgcn_ds_read_tr16_b64_v4i16(
                (__attribute__((address_space(3))) s16x4*)(uintptr_t)(vb + (16 * s) * VP));
            const s16x4 hi = __builtin_amdgcn_ds_read_tr16_b64_v4i16(
                (__attribute__((address_space(3))) s16x4*)(uintptr_t)(vb + (16 * s + 8) * VP));
            const s16x8 vf = __builtin_shufflevector(lo, hi, 0, 1, 2, 3, 4, 5, 6, 7);
            o[d] = mfma(vf, pb[s], o[d]);
          }
        }
      }
    }
  }
  const float lt = xhalf_sum(l_run);
  if (active && qi < J.nq) {
    const float inv = 1.f / lt;
    u16* op = J.O + (size_t)qi * LDO + 4 * h;
#pragma unroll
    for (int d = 0; d < NDV; d++) {
#pragma unroll
      for (int g = 0; g < 4; g++) {
        u32x2 w;
        w[0] = pk2(o[d][4 * g] * inv, o[d][4 * g + 1] * inv);
        w[1] = pk2(o[d][4 * g + 2] * inv, o[d][4 * g + 3] * inv);
        *(u32x2*)(op + d * 32 + 8 * g) = w;
      }
    }
  }
}

template <int NR, bool F32OUT>
DI void rms_rows(const float* __restrict__ xbase, size_t rstride, int nvalid, const float* __restrict__ g, void* dbase, size_t dstride, int lane) {
  f32x4 v[NR][4];
#pragma unroll
  for (int j = 0; j < NR; j++)
#pragma unroll
    for (int i = 0; i < 4; i++) {
      if (j < nvalid) v[j][i] = *(const f32x4*)(xbase + (size_t)j * rstride + i * 256 + lane * 4);
      else { f32x4 z = {0.f, 0.f, 0.f, 0.f}; v[j][i] = z; }
    }
  f32x4 gg[4];
#pragma unroll
  for (int i = 0; i < 4; i++) gg[i] = *(const f32x4*)(g + i * 256 + lane * 4);
#pragma unroll
  for (int j = 0; j < NR; j++) {
    float ss = 0.f;
#pragma unroll
    for (int i = 0; i < 4; i++) ss += v[j][i][0] * v[j][i][0] + v[j][i][1] * v[j][i][1] + v[j][i][2] * v[j][i][2] + v[j][i][3] * v[j][i][3];
    ss = wave_sum(ss);
    const float rs = rsqrtf(ss * (1.f / 1024.f) + 1e-6f);
    if (j < nvalid) {
#pragma unroll
      for (int i = 0; i < 4; i++) {
        if (F32OUT) {
          f32x4 w;
          w[0] = v[j][i][0] * rs * gg[i][0]; w[1] = v[j][i][1] * rs * gg[i][1]; w[2] = v[j][i][2] * rs * gg[i][2]; w[3] = v[j][i][3] * rs * gg[i][3];
          *(f32x4*)((float*)dbase + (size_t)j * dstride + i * 256 + lane * 4) = w;
        } else {
          u32x2 w;
          w[0] = pk2(v[j][i][0] * rs * gg[i][0], v[j][i][1] * rs * gg[i][1]);
          w[1] = pk2(v[j][i][2] * rs * gg[i][2], v[j][i][3] * rs * gg[i][3]);
          *(u32x2*)((u16*)dbase + (size_t)j * dstride + i * 256 + lane * 4) = w;
        }
      }
    }
  }
}

DI void cvt_job(const float* __restrict__ src, u16* __restrict__ dst, int nseg, size_t seglen, size_t sstride, size_t dstride, int wv) {
  const size_t upseg = seglen / 8;
  const size_t total = upseg * nseg;
  const size_t stride = (size_t)get_nblk() * NTHR;
  for (size_t u0 = (size_t)get_bid() * NTHR + get_tid(wv); u0 < total; u0 += 4 * stride) {
    f32x4 a[4], b[4];
    size_t so[4], dd[4];
#pragma unroll
    for (int q = 0; q < 4; q++) {
      const size_t u = u0 + q * stride;
      const size_t uu = u < total ? u : u0;
      const size_t sg = uu / upseg, off = (uu - sg * upseg) * 8;
      so[q] = sg * sstride + off; dd[q] = sg * dstride + off;
      a[q] = *(const f32x4*)(src + so[q]);
      b[q] = *(const f32x4*)(src + so[q] + 4);
    }
#pragma unroll
    for (int q = 0; q < 4; q++) {
      if (u0 + q * stride < total) {
        u32x4 w;
        w[0] = pk2(a[q][0], a[q][1]); w[1] = pk2(a[q][2], a[q][3]); w[2] = pk2(b[q][0], b[q][1]); w[3] = pk2(b[q][2], b[q][3]);
        *(u32x4*)(dst + dd[q]) = w;
      }
    }
  }
}

DI void transpose_job(const float* __restrict__ src, u16* __restrict__ dst, int K, int N, int Npad, int& rot, char* smem, int wv) {
  float* tile = (float*)smem;
  const int tk = K / 64, tn = Npad / 64, ntiles = tk * tn;
  const int G = get_nblk();
  const int tid = get_tid(wv);
  for (int t = (get_bid() + G - (rot % G)) % G; t < ntiles; t += G) {
    const int k0 = (t % tk) * 64, n0 = (t / tk) * 64;
    float v[8];
#pragma unroll
    for (int i = 0; i < 8; i++) {
      const int k = i * 8 + (tid >> 6), n = tid & 63;
      v[i] = (n0 + n < N) ? src[(size_t)(k0 + k) * N + n0 + n] : 0.f;
    }
    __syncthreads();
#pragma unroll
    for (int i = 0; i < 8; i++) {
      const int k = i * 8 + (tid >> 6), n = tid & 63;
      tile[k * 65 + n] = v[i];
    }
    __syncthreads();
#pragma unroll
    for (int i = 0; i < 4; i++) {
      const int n = i * 16 + (tid >> 5), k = (tid & 31) * 2;
      *(unsigned*)(dst + (size_t)(n0 + n) * K + k0 + k) = pk2(tile[k * 65 + n], tile[(k + 1) * 65 + n]);
    }
  }
  rot += ntiles;
}

DI u16* wt_ptr(const Params& P, int l, size_t eoff) { return (u16*)(P.ws + WS_WT) + (size_t)l * WE_LAYER + eoff; }

DI void phase_prep(const Params& P, char* smem) {
  const int tid = get_tid(P.wv), lane = tid & 63;
  const int gw = get_bid() * NWV + (tid >> 6), nw = get_nblk() * NWV;
  int rot = 0;
  for (int l = 0; l < NL; l++) {
    transpose_job(P.in[11] + (size_t)l * 1024 * INC, wt_ptr(P, l, WE_IN), 1024, INC, INP, rot, smem, P.wv);
    transpose_job(P.in[14] + (size_t)l * 256 * 768, wt_ptr(P, l, WE_UQ), 256, 768, 768, rot, smem, P.wv);
    transpose_job(P.in[16] + (size_t)l * 128 * 1024, wt_ptr(P, l, WE_UKV), 128, 1024, 1024, rot, smem, P.wv);
    transpose_job(P.in[17] + (size_t)l * 1024 * 1024, wt_ptr(P, l, WE_OUT), 1024, 1024, 1024, rot, smem, P.wv);
    transpose_job(P.in[20] + (size_t)l * 1024 * 1024, wt_ptr(P, l, WE_XQ), 1024, 1024, 1024, rot, smem, P.wv);
    transpose_job(P.in[21] + (size_t)l * 1024 * 1024, wt_ptr(P, l, WE_MKV), 1024, 1024, 1024, rot, smem, P.wv);
    transpose_job(P.in[22] + (size_t)l * 1024 * 1024, wt_ptr(P, l, WE_MKV) + (size_t)1024 * 1024, 1024, 1024, 1024, rot, smem, P.wv);
    transpose_job(P.in[23] + (size_t)l * 1024 * 1024, wt_ptr(P, l, WE_XO), 1024, 1024, 1024, rot, smem, P.wv);
    transpose_job(P.in[25] + (size_t)l * 1024 * 4096, wt_ptr(P, l, WE_UP), 1024, 4096, 4096, rot, smem, P.wv);
    transpose_job(P.in[26] + (size_t)l * 4096 * 1024, wt_ptr(P, l, WE_DN), 4096, 1024, 1024, rot, smem, P.wv);
  }
  {
    f32x2* rt = (f32x2*)(P.ws + WS_ROPE);
    for (int i = get_bid() * NTHR + tid; i < 4096 * 32; i += get_nblk() * NTHR) {
      const int pos = i >> 5, j = i & 31;
      const float inv = powf(10000.f, -(float)j / 32.f);
      const float ang = (float)pos * inv;
      f32x2 cs; cs[0] = cosf(ang); cs[1] = sinf(ang);
      rt[i] = cs;
    }
  }
  for (int l = 0; l < NL; l++) {
    const size_t seg = (size_t)DB * NMEM * 1024;
    cvt_job(P.in[8] + l * seg, (u16*)(P.ws + WS_MEMK) + ((size_t)l * MB + NB) * NMEM * 1024, 1, seg, 0, 0, P.wv);
    cvt_job(P.in[9] + l * seg, (u16*)(P.ws + WS_MEMV) + ((size_t)l * MB + NB) * NMEM * 1024, 1, seg, 0, 0, P.wv);
  }
  for (int rr = gw; rr < NL * NB * NMEM; rr += nw) {
    const int l = rr / (NB * NMEM), row = rr % (NB * NMEM);
    rms_rows<1, false>(P.in[2] + (size_t)row * 1024, 0, 1, P.in[19] + l * 1024, (u16*)(P.ws + WS_HMEM) + (size_t)rr * 1024, 0, lane);
  }
  {
    const size_t n4 = (size_t)TT * 256;
    const size_t np4 = (size_t)TP * 256;
    const size_t stride = (size_t)get_nblk() * NTHR;
    for (size_t i0 = (size_t)get_bid() * NTHR + tid; i0 < n4; i0 += 4 * stride) {
      f32x4 v[4];
#pragma unroll
      for (int q = 0; q < 4; q++) {
        const size_t i = i0 + q * stride;
        const size_t ii = i < n4 ? i : i0;
        v[q] = (ii < np4) ? *(const f32x4*)(P.in[0] + ii * 4) : *(const f32x4*)(P.in[1] + (ii - np4) * 4);
      }
#pragma unroll
      for (int q = 0; q < 4; q++) {
        const size_t i = i0 + q * stride;
        if (i < n4) *(f32x4*)(P.out + i * 4) = v[q];
      }
    }
  }
}

DI void phase_norm(const Params& P, const float* g, int cache_layer) {
  const int tid = get_tid(P.wv), lane = tid & 63;
  const int gw = get_bid() * NWV + (tid >> 6), nw = get_nblk() * NWV;
  u16* h = (u16*)(P.ws + WS_ACTA);
  for (int row = gw; row < TT; row += 4 * nw) {
    const int nv = (TT - row + nw - 1) / nw;
    rms_rows<4, false>(P.out + (size_t)row * 1024, (size_t)nw * 1024, nv < 4 ? nv : 4, g, h + (size_t)row * 1024, (size_t)nw * 1024, lane);
  }
  if (cache_layer >= 0) {
    const int l = cache_layer;
    cvt_job(P.in[3] + (size_t)l * DB * PAST * 512, (u16*)(P.ws + WS_FOXK) + (size_t)TP * 512, DB, (size_t)PAST * 512, (size_t)PAST * 512, (size_t)SKS * 512, P.wv);
    cvt_job(P.in[4] + (size_t)l * DB * PAST * 512, (u16*)(P.ws + WS_FOXV) + (size_t)TP * 512, DB, (size_t)PAST * 512, (size_t)PAST * 512, (size_t)SKS * 512, P.wv);
    cvt_job(P.in[6] + (size_t)l * DB * PAST * 128, (u16*)(P.ws + WS_CKV) + (size_t)TP * 128, DB, (size_t)PAST * 128, (size_t)PAST * 128, (size_t)SKS * 128, P.wv);
    cvt_job(P.in[7] + (size_t)l * DB * PAST * 64, (u16*)(P.ws + WS_KROPE) + (size_t)TP * 64, DB, (size_t)PAST * 64, (size_t)PAST * 64, (size_t)SKS * 64, P.wv);
  }
}

DI void phase_final(const Params& P) {
  const int tid = get_tid(P.wv), lane = tid & 63;
  const int gw = get_bid() * NWV + (tid >> 6), nw = get_nblk() * NWV;
  const float* g = P.in[27];
  for (int row = gw; row < TT; row += 4 * nw) {
    const int nv = (TT - row + nw - 1) / nw;
    rms_rows<4, true>(P.out + (size_t)row * 1024, (size_t)nw * 1024, nv < 4 ? nv : 4, g, P.out + (size_t)row * 1024, (size_t)nw * 1024, lane);
  }
}

DI void phase_post(const Params& P, int l, char* smem) {
  const int tid = get_tid(P.wv), lane = tid & 63;
  const int gw = get_bid() * NWV + (tid >> 6), nw = get_nblk() * NWV;
  const float* zc = (const float*)(P.ws + WS_ZC);
  u16* cqn = (u16*)(P.ws + WS_CQN);
  u16* ckv = (u16*)(P.ws + WS_CKV);
  u16* krp = (u16*)(P.ws + WS_KROPE);
  const f32x2* rt = (const f32x2*)(P.ws + WS_ROPE);
  const float* gq = P.in[13] + l * 256;
  const float* gkv = P.in[15] + l * 128;
  for (int tok0 = gw; tok0 < TT; tok0 += 4 * nw) {
    f32x4 vq[4]; f32x2 vk[4]; float vr[4];
#pragma unroll
    for (int j = 0; j < 4; j++) {
      const int tk = tok0 + j * nw;
      const float* z = zc + (size_t)(tk < TT ? tk : tok0) * 448;
      vq[j] = *(const f32x4*)(z + lane * 4);
      vk[j] = *(const f32x2*)(z + 256 + lane * 2);
      vr[j] = z[384 + lane];
    }
    const f32x4 ggq = *(const f32x4*)(gq + lane * 4);
    const f32x2 ggk = *(const f32x2*)(gkv + lane * 2);
#pragma unroll
    for (int j = 0; j < 4; j++) {
      const int tok = tok0 + j * nw;
      if (tok >= TT) break;
      const bool isp = tok < TP;
      const size_t orow = isp ? ((size_t)l * TP + tok) : ((size_t)l * TS + (tok - TP));
      const int kr = tok_krow(tok);
      {
        const f32x4 v = vq[j];
        const float ss = wave_sum(v[0] * v[0] + v[1] * v[1] + v[2] * v[2] + v[3] * v[3]);
        const float rs = rsqrtf(ss * (1.f / 256.f) + 1e-6f);
        u32x2 w;
        w[0] = pk2(v[0] * rs * ggq[0], v[1] * rs * ggq[1]);
        w[1] = pk2(v[2] * rs * ggq[2], v[3] * rs * ggq[3]);
        *(u32x2*)(cqn + (size_t)tok * 256 + lane * 4) = w;
      }
      {
        const f32x2 v = vk[j];
        const float ss = wave_sum(v[0] * v[0] + v[1] * v[1]);
        const float rs = rsqrtf(ss * (1.f / 128.f) + 1e-6f);
        f32x2 o; o[0] = v[0] * rs * ggk[0]; o[1] = v[1] * rs * ggk[1];
        *(f32x2*)(P.out + (isp ? O_CKP : O_CKS) + orow * 128 + lane * 2) = o;
        *(unsigned*)(ckv + (size_t)kr * 128 + lane * 2) = pk2(o[0], o[1]);
      }
      {
        const float x = vr[j];
        const float y = __shfl_xor(x, 32);
        const f32x2 cs = rt[tok_pos(tok) * 32 + (lane & 31)];
        const float o = (lane < 32) ? (x * cs[0] - y * cs[1]) : (x * cs[0] + y * cs[1]);
        P.out[(isp ? O_KRP : O_KRS) + orow * 64 + lane] = o;
        krp[(size_t)kr * 64 + lane] = f2bf(o);
      }
    }
  }
  float* cum = (float*)(P.ws + WS_CUM);
  float* wtot = (float*)smem;
  const int wave = tid >> 6;
  for (int it = get_bid(); it < NB + DB; it += get_nblk()) {
    const bool isp = it < NB;
    const int b = isp ? it : it - NB;
    const int ppt = isp ? 16 : 9;
    const int npos = isp ? SEQ : SKS;
    const float* srcA; const float* srcB; int nA;
    size_t krow0;
    if (isp) { srcA = P.out + O_FLP + ((size_t)l * TP + (size_t)b * SEQ) * 8; srcB = srcA; nA = SEQ; krow0 = (size_t)b * SEQ; }
    else {
      srcA = P.in[5] + ((size_t)l * DB + b) * PAST * 8;
      srcB = P.out + O_FLS + ((size_t)l * TS + (size_t)b * DS) * 8 - (size_t)PAST * 8;
      nA = PAST; krow0 = (size_t)TP + (size_t)b * SKS;
    }
    const int p0 = tid * ppt;
    f32x4 va[16], vb[16];
#pragma unroll
    for (int j = 0; j < 16; j++) {
      const int p = p0 + j;
      f32x4 z = {0.f, 0.f, 0.f, 0.f};
      va[j] = z; vb[j] = z;
      if (j < ppt && p < npos) {
        const float* s = (p < nA ? srcA : srcB) + (size_t)p * 8;
        va[j] = *(const f32x4*)s; vb[j] = *(const f32x4*)(s + 4);
      }
    }
#pragma unroll
    for (int j = 1; j < 16; j++) { va[j] += va[j - 1]; vb[j] += vb[j - 1]; }
    f32x4 ta = va[15], tb = vb[15];
#pragma unroll
    for (int d = 1; d < 64; d <<= 1) {
#pragma unroll
      for (int e = 0; e < 4; e++) {
        const float ua = __shfl_up(ta[e], d), ub = __shfl_up(tb[e], d);
        if (lane >= d) { ta[e] += ua; tb[e] += ub; }
      }
    }
    __syncthreads();
    if (lane == 63) { *(f32x4*)(wtot + wave * 8) = ta; *(f32x4*)(wtot + wave * 8 + 4) = tb; }
    __syncthreads();
    f32x4 pa = ta - va[15], pb = tb - vb[15];
    for (int w2 = 0; w2 < wave; w2++) { pa += *(const f32x4*)(wtot + w2 * 8); pb += *(const f32x4*)(wtot + w2 * 8 + 4); }
#pragma unroll
    for (int j = 0; j < 16; j++) {
      const int p = p0 + j;
      if (j < ppt && p < npos) {
        float* d = cum + (krow0 + p) * 8;
        *(f32x4*)d = va[j] + pa; *(f32x4*)(d + 4) = vb[j] + pb;
      }
    }
  }
}

template <int EPI>
DI void gemm_phase(const Params& P, int l, const u16* __restrict__ A, int lda, const u16* __restrict__ Bt, int ldb, int K, int M, int N,
                   char* smem, int& rot) {
  constexpr int MI = 4;
  constexpr int STAGE = 32768;
  constexpr int NSLOT = SMEM_BYTES / STAGE;
  constexpr int DEPTH = NSLOT - 1;
  constexpr int GPS = 4;
  static_assert(NSLOT == 4, "ring waits are written for 4 slots");
  const int tid = get_tid(P.wv), wave = tid >> 6, lane = tid & 63, r = lane & 31, h = lane >> 5;
  const int wm = wave >> 2, wn = wave & 3;
  const int TM = M >> 8, TN = N >> 8;
  const int ntiles = TM * TN;
  const int G = get_nblk();
  const int bid = get_bid();
  const bool xmap = (G == 256);
  int t0, tstep;
  if (xmap) {
    const int nun = (ntiles + 31) >> 5;
    const int xs = (bid + 8 - (rot & 7)) & 7;
    t0 = xs * 32 + (bid >> 3); tstep = 256;
    rot += nun;
  } else {
    t0 = (bid + G - (rot % G)) % G; tstep = G;
    rot += ntiles;
  }
  const int nk = K >> 5;
  constexpr bool SPLITK = (EPI == EPI_RESID || EPI == EPI_RESID0);
  const bool sk = SPLITK && xmap && (TN == 4) && (((TM * nk) & 63) == 0);
  const int skS = (TM * nk) >> 6;
  const int sknt = (bid >> 3) & 3;
  const int p_begin = sk ? ((bid & 7) * 8 + (bid >> 5)) * skS : t0;
  const int p_end = sk ? p_begin + skS : ntiles;
  if (p_begin >= p_end) return;
  const int lrow = tid >> 2, lc = tid & 3;
  const int pc = (lc ^ ((tid >> 4) & 3)) * 8;
  const int sw = (r >> 2) & 3;
  const int xo0 = ((0 + h) ^ sw) * 16, xo1 = ((2 + h) ^ sw) * 16;
  const int aro = (wm * 128 + r) * 64, bro = 16384 + (wn * 64 + r) * 64;
  auto tile_of = [&](int t, int& m0, int& n0) { const int mt = t / TN; m0 = mt << 8; n0 = (t - mt * TN) << 8; };
  auto issue = [&](int m0, int n0, int ks, int slot) {
    const u16* ag = A + (size_t)(m0 + lrow) * lda + pc + ks * 32;
    const u16* bg = Bt + (size_t)(n0 + lrow) * ldb + pc + ks * 32;
    char* dst = smem + slot * STAGE + tid * 16;
#pragma unroll
    for (int i = 0; i < 2; i++)
      __builtin_amdgcn_global_load_lds((const unsigned*)(ag + (size_t)i * 128 * lda), (__attribute__((address_space(3))) unsigned*)(dst + i * 8192), 16, 0, 0);
#pragma unroll
    for (int i = 0; i < 2; i++)
      __builtin_amdgcn_global_load_lds((const unsigned*)(bg + (size_t)i * 128 * ldb), (__attribute__((address_space(3))) unsigned*)(dst + 16384 + i * 8192), 16, 0, 0);
  };
  auto unit_at = [&](int p, int& m0, int& n0, int& kb, int& nkk) {
    if (sk) { const int mt = p / nk; kb = p - mt * nk; const int rem = p_end - p; nkk = (nk - kb) < rem ? (nk - kb) : rem; m0 = mt << 8; n0 = sknt << 8; }
    else { tile_of(p, m0, n0); kb = 0; nkk = nk; }
  };
  int t = p_begin, m0, n0, kb, nkk;
  unit_at(t, m0, n0, kb, nkk);
  int ti = p_begin, ki = 0, mi0 = m0, ni0 = n0, kbi = kb, nki = nkk;
  bool idone = false;
  int pend = 0;
  unsigned g = 0;
  asm volatile("s_waitcnt vmcnt(0) lgkmcnt(0)" ::: "memory");
  __builtin_amdgcn_s_barrier();
#pragma unroll 1
  for (int s = 0; s < DEPTH; s++) {
    if (!idone) {
      issue(mi0, ni0, kbi + ki, (g + pend) % NSLOT);
      pend++;
      if (++ki == nki) { ki = 0; ti = sk ? ti + nki : ti + tstep; if (ti < p_end) unit_at(ti, mi0, ni0, kbi, nki); else idone = true; }
    }
  }
  while (true) {
    f32x16 acc[MI][2];
#pragma unroll
    for (int a = 0; a < MI; a++)
#pragma unroll
      for (int b = 0; b < 2; b++)
#pragma unroll
        for (int i = 0; i < 16; i++) acc[a][b][i] = 0.f;
    s16x8 a2[MI], b2, b3;
    {
      const s16x8 z = {0, 0, 0, 0, 0, 0, 0, 0};
#pragma unroll
      for (int i = 0; i < MI; i++) a2[i] = z;
      b2 = z; b3 = z;
    }
#pragma unroll 1
    for (int kt = 0; kt < nkk; kt++) {
      if (pend >= 3) asm volatile("s_waitcnt vmcnt(%0)" ::"n"(2 * GPS) : "memory");
      else if (pend == 2) asm volatile("s_waitcnt vmcnt(%0)" ::"n"(GPS) : "memory");
      else asm volatile("s_waitcnt vmcnt(0)" ::: "memory");
      asm volatile("" ::: "memory");
      __builtin_amdgcn_s_waitcnt(0xC07F);
      __builtin_amdgcn_s_barrier();
      asm volatile("" ::: "memory");
      if (!idone) {
        issue(mi0, ni0, kbi + ki, (g + pend) % NSLOT);
        if (++ki == nki) { ki = 0; ti = sk ? ti + nki : ti + tstep; if (ti < p_end) unit_at(ti, mi0, ni0, kbi, nki); else idone = true; }
      } else {
        pend--;
      }
      const char* sb = smem + (g % NSLOT) * STAGE;
      g++;
      s16x8 a[MI];
#pragma unroll
      for (int i = 0; i < MI; i++) a[i] = *(const s16x8*)(sb + aro + i * 32 * 64 + xo0);
      const s16x8 b0 = *(const s16x8*)(sb + bro + xo0);
      const s16x8 b1 = *(const s16x8*)(sb + bro + 32 * 64 + xo0);
      if (kt > 0) {
#pragma unroll
        for (int i = 0; i < MI; i++) { acc[i][0] = mfma(a2[i], b2, acc[i][0]); acc[i][1] = mfma(a2[i], b3, acc[i][1]); }
      }
#pragma unroll
      for (int i = 0; i < MI; i++) a2[i] = *(const s16x8*)(sb + aro + i * 32 * 64 + xo1);
      b2 = *(const s16x8*)(sb + bro + xo1);
      b3 = *(const s16x8*)(sb + bro + 32 * 64 + xo1);
#pragma unroll
      for (int i = 0; i < MI; i++) { acc[i][0] = mfma(a[i], b0, acc[i][0]); acc[i][1] = mfma(a[i], b1, acc[i][1]); }
    }
#pragma unroll
    for (int i = 0; i < MI; i++) { acc[i][0] = mfma(a2[i], b2, acc[i][0]); acc[i][1] = mfma(a2[i], b3, acc[i][1]); }
    epilogue<EPI, MI>(P, l, acc, m0 + wm * 128, n0 + wn * 64, r, h);
    t = sk ? t + nkk : t + tstep;
    if (t >= p_end) break;
    unit_at(t, m0, n0, kb, nkk);
  }
  asm volatile("s_waitcnt vmcnt(0) lgkmcnt(0)" ::: "memory");
}

DI void phase_attn(const Params& P, int l, char* smem) {
  const u16* qf = (const u16*)(P.ws + WS_QF);
  const u16* fk = (const u16*)(P.ws + WS_FOXK);
  const u16* fv = (const u16*)(P.ws + WS_FOXV);
  const float* cum = (const float*)(P.ws + WS_CUM);
  const u16* qm = (const u16*)(P.ws + WS_R1 + R1_QM);
  const u16* kv = (const u16*)(P.ws + WS_R1 + R1_KV);
  const u16* krp = (const u16*)(P.ws + WS_KROPE);
  u16* mixed = (u16*)(P.ws + WS_ACTA);
  constexpr float LOG2E = 1.4426950408889634f;
  const int total = 384 + 16 * 96;
  for (int t = get_bid(); t < total; t += get_nblk()) {
    bool isfox, issample; int b, hd, qb = 0;
    if (t < 256) { isfox = true; issample = true; b = t >> 3; hd = t & 7; }
    else if (t < 384) { isfox = false; issample = true; const int u = t - 256; b = u >> 2; hd = u & 3; }
    else {
      const int u = t - 384; const int grp = u / 96; int w = u % 96; qb = 15 - grp; issample = false;
      if (w < 32) { isfox = false; b = w >> 2; hd = w & 3; }
      else { w -= 32; isfox = true; b = w >> 3; hd = w & 7; }
    }
    AttnJob J;
    J.wv = P.wv;
    size_t tok0, krow0;
    if (issample) { tok0 = (size_t)TP + (size_t)b * DS; krow0 = (size_t)TP + (size_t)b * SKS; J.nq = DS; J.Sk = SKS; J.qpos0 = PAST; }
    else { tok0 = (size_t)b * SEQ + (size_t)qb * 256; krow0 = (size_t)b * SEQ; J.nq = 256; J.Sk = SEQ; J.qpos0 = qb * 256; }
    if (isfox) {
      J.Q = qf + tok0 * 512 + hd * 64; J.ldq = 512;
      J.K1 = fk + krow0 * 512 + hd * 64; J.ldk1 = 512; J.K2 = J.K1; J.ldk2 = 512;
      J.V = fv + krow0 * 512 + hd * 64; J.ldv = 512;
      J.O = mixed + tok0 * 1024 + hd * 64; J.ldo = 1024;
      J.cq = cum + (krow0 + (size_t)J.qpos0) * 8 + hd;
      J.ck = cum + krow0 * 8 + hd;
      J.scale_log2 = 0.125f * LOG2E;
      attn_block<64, 64, 64, MASK_FRAME, true, FOX_PF, 512, 512, 512, 512, 1024, FOX_KT>(J, smem);
    } else {
      J.Q = qm + tok0 * 768 + hd * 192; J.ldq = 768;
      J.K1 = kv + krow0 * 1024 + hd * 256; J.ldk1 = 1024;
      J.K2 = krp + krow0 * 64; J.ldk2 = 64;
      J.V = kv + krow0 * 1024 + hd * 256 + 128; J.ldv = 1024;
      J.O = mixed + tok0 * 1024 + 512 + hd * 128; J.ldo = 1024;
      J.cq = nullptr; J.ck = nullptr;
      J.scale_log2 = 0.07216878364870322f * LOG2E;
      attn_block<192, 128, 128, MASK_CHUNK, false, MLA_PF, 768, 1024, 64, 1024, 1024, 64>(J, smem);
    }
  }
}

DI void phase_cross(const Params& P, int l, char* smem) {
  const u16* xq = (const u16*)(P.ws + WS_R1 + R1_XQ);
  const u16* mk = (const u16*)(P.ws + WS_MEMK) + (size_t)l * MB * NMEM * 1024;
  const u16* mv = (const u16*)(P.ws + WS_MEMV) + (size_t)l * MB * NMEM * 1024;
  u16* xo = (u16*)(P.ws + WS_ACTA);
  constexpr float LOG2E = 1.4426950408889634f;
  const int nsamp = DB * 4 * 2;
  const int total = nsamp + 128 * 4 * 2;
  for (int t = get_bid(); t < total; t += get_nblk()) {
    AttnJob J;
    J.wv = P.wv;
    size_t tok0; int mb, hd, half;
    if (t < nsamp) { const int b = t >> 3; hd = (t >> 1) & 3; half = t & 1; tok0 = (size_t)TP + (size_t)b * DS; mb = NB + b; J.nq = DS; }
    else { const int u = t - nsamp; const int qbk = u >> 3; hd = (u >> 1) & 3; half = u & 1; tok0 = (size_t)qbk * 256; mb = qbk >> 4; J.nq = 256; }
    J.Sk = NMEM; J.qpos0 = 0;
    J.Q = xq + tok0 * 1024 + hd * 256; J.ldq = 1024;
    J.K1 = mk + (size_t)mb * NMEM * 1024 + hd * 256; J.ldk1 = 1024; J.K2 = J.K1; J.ldk2 = 1024;
    J.V = mv + (size_t)mb * NMEM * 1024 + hd * 256 + half * 128; J.ldv = 1024;
    J.O = xo + tok0 * 1024 + hd * 256 + half * 128; J.ldo = 1024;
    J.cq = nullptr; J.ck = nullptr;
    J.scale_log2 = 0.0625f * LOG2E;
    attn_block<256, 256, 128, MASK_NONE, false, false, 1024, 1024, 1024, 1024, 1024, 64>(J, smem);
  }
}

#define XB_TMO      128
#define XB_XCNT(j)  (256  + 64 * (j))
#define XB_XSUB(j)  (1280 + 64 * (j))
#define XB_XGEN(j)  (2304 + 64 * (j))
#define XB_TOP      3328
#define XB_TOPGEN   3392
#define XCD_BAR_WORDS 3456
#define XB_SPIN_CAP (1u << 20)
DI unsigned xb_ld(unsigned* p) { return __hip_atomic_load(p, __ATOMIC_RELAXED, __HIP_MEMORY_SCOPE_AGENT); }
DI unsigned xb_add(unsigned* p, unsigned v) { return __hip_atomic_fetch_add(p, v, __ATOMIC_RELAXED, __HIP_MEMORY_SCOPE_AGENT); }
DI unsigned xb_xcc_id() { return (unsigned)__builtin_amdgcn_s_getreg((3 << 11) | 20) & 0xFu; }
#define XB_SPIN(cond, bar) do { unsigned _sp = 0; while (cond) { __builtin_amdgcn_s_sleep(1); \
    if ((++_sp & 255u) == 0u) { if (xb_ld(&(bar)[XB_TMO])) break; if (_sp > XB_SPIN_CAP) { atomicAdd(&(bar)[XB_TMO], 1u); break; } } } } while (0)
DI void xb_census(unsigned* bar, unsigned x, unsigned& nloc, unsigned& nx) {
  const unsigned G = gridDim.x;
  unsigned sum, cnt, mine, sp = 0u;
  for (;;) {
    sum = 0u; cnt = 0u; mine = 0u;
#pragma unroll
    for (unsigned j = 0; j < 16; ++j) { const unsigned c = xb_ld(&bar[XB_XCNT(j)]); sum += c; cnt += (c > 0u) ? 1u : 0u; mine = (j == x) ? c : mine; }
    if (sum == G) break;
    __builtin_amdgcn_s_sleep(1);
    if ((++sp & 255u) == 0u) { if (xb_ld(&bar[XB_TMO])) break; if (sp > XB_SPIN_CAP) { atomicAdd(&bar[XB_TMO], 1u); break; } }
  }
  nloc = mine > 0u ? mine : 1u; nx = cnt > 0u ? cnt : 1u;
}
DI void xcd_barrier(unsigned* bar, unsigned x, unsigned nloc, unsigned nx, int wv) {
  asm volatile("s_waitcnt vmcnt(0)" ::: "memory");
  __syncthreads();
  if (wv == 0 && lane_id() == 0) {
    __builtin_amdgcn_s_waitcnt(0);
    const unsigned old = xb_add(&bar[XB_XSUB(x)], 1u);
    const unsigned gen = old / nloc;
    if (old + 1u == (gen + 1u) * nloc) {
      __builtin_amdgcn_fence(__ATOMIC_RELEASE, "agent");
      asm volatile("s_waitcnt vmcnt(0)" ::: "memory");
      const unsigned og = xb_add(&bar[XB_TOP], 1u);
      const unsigned tg = og / nx;
      if (og + 1u == (tg + 1u) * nx) xb_add(&bar[XB_TOPGEN], 1u);
      else XB_SPIN(xb_ld(&bar[XB_TOPGEN]) == tg, bar);
      __builtin_amdgcn_fence(__ATOMIC_ACQUIRE, "agent");
      xb_add(&bar[XB_XGEN(x)], 1u);
      asm volatile("s_waitcnt vmcnt(0)" ::: "memory");
    } else {
      XB_SPIN(xb_ld(&bar[XB_XGEN(x)]) == gen, bar);
      __builtin_amdgcn_fence(__ATOMIC_ACQUIRE, "agent");
      asm volatile("s_waitcnt vmcnt(0)" ::: "memory");
    }
  }
  __syncthreads();
}

constexpr int NPHASE = 2 + 13 * NL;

DI void run_phase(const Params& P, int ph, char* smem, bool dup = false) {
  if (ph == 0) { phase_prep(P, smem); return; }
  if (ph == NPHASE - 1) { phase_final(P); return; }
  const int l = (ph - 1) / 13, k = (ph - 1) % 13;
  char* ws = P.ws;
  const u16* actA = (const u16*)(ws + WS_ACTA);
  int rot = 0;
  switch (k) {
    case 0: phase_norm(P, P.in[10] + l * 1024, l); break;
    case 1:
      gemm_phase<EPI_IN>(P, l, actA, 1024, wt_ptr(P, l, WE_IN), 1024, 1024, TT, INP, smem, rot);
      if (l == 0) {
        for (int l2 = 0; l2 < NL; l2++)
          gemm_phase<EPI_MEM>(P, l2, (const u16*)(ws + WS_HMEM) + (size_t)l2 * NB * NMEM * 1024, 1024, wt_ptr(P, l2, WE_MKV), 1024, 1024,
                              NB * NMEM, 2048, smem, rot);
      }
      break;
    case 2: phase_post(P, l, smem); break;
    case 3:
      gemm_phase<EPI_KV>(P, l, (const u16*)(ws + WS_CKV), 128, wt_ptr(P, l, WE_UKV), 128, 128, KROWS, 1024, smem, rot);
      gemm_phase<EPI_UQ>(P, l, (const u16*)(ws + WS_CQN), 256, wt_ptr(P, l, WE_UQ), 256, 256, TT, 768, smem, rot);
      break;
    case 4: phase_attn(P, l, smem); break;
    case 5: if (dup) gemm_phase<EPI_RESID0>(P, l, actA, 1024, wt_ptr(P, l, WE_OUT), 1024, 1024, TT, 1024, smem, rot); else gemm_phase<EPI_RESID>(P, l, actA, 1024, wt_ptr(P, l, WE_OUT), 1024, 1024, TT, 1024, smem, rot); break;
    case 6: phase_norm(P, P.in[18] + l * 1024, -1); break;
    case 7: gemm_phase<EPI_XQ>(P, l, actA, 1024, wt_ptr(P, l, WE_XQ), 1024, 1024, TT, 1024, smem, rot); break;
    case 8: phase_cross(P, l, smem); break;
    case 9: if (dup) gemm_phase<EPI_RESID0>(P, l, actA, 1024, wt_ptr(P, l, WE_XO), 1024, 1024, TT, 1024, smem, rot); else gemm_phase<EPI_RESID>(P, l, actA, 1024, wt_ptr(P, l, WE_XO), 1024, 1024, TT, 1024, smem, rot); break;
    case 10: phase_norm(P, P.in[24] + l * 1024, -1); break;
    case 11: gemm_phase<EPI_UP>(P, l, actA, 1024, wt_ptr(P, l, WE_UP), 1024, 1024, TT, DFF, smem, rot); break;
    case 12: if (dup) gemm_phase<EPI_RESID0>(P, l, (const u16*)(ws + WS_R1 + R1_U), DFF, wt_ptr(P, l, WE_DN), DFF, DFF, TT, 1024, smem, rot); else gemm_phase<EPI_RESID>(P, l, (const u16*)(ws + WS_R1 + R1_U), DFF, wt_ptr(P, l, WE_DN), DFF, DFF, TT, 1024, smem, rot); break;
  }
}

__global__ void __launch_bounds__(NTHR) mega(Params P, int ph_lo, int ph_hi) {
  extern __shared__ __attribute__((aligned(16))) char smem[];
  cg::grid_group grid = cg::this_grid();
  if (ph_hi > 4096) grid.sync();
  unsigned* bar = (unsigned*)(P.ws + WS_BAR);
  const unsigned xb_x = xb_xcc_id();
  unsigned xb_nloc = 1u, xb_nx = 1u;
  if (threadIdx.x == 0) { (void)xb_add(&bar[XB_XCNT(xb_x)], 1u); xb_census(bar, xb_x, xb_nloc, xb_nx); }
  xb_nloc = __builtin_amdgcn_readfirstlane(xb_nloc);
  xb_nx = __builtin_amdgcn_readfirstlane(xb_nx);
  unsigned xb_pack = xb_nloc | (xb_nx << 16) | (xb_x << 24) | ((unsigned)__builtin_amdgcn_readfirstlane(threadIdx.x >> 6) << 28);
  asm volatile("" : "+s"(xb_pack));
  for (int ph = ph_lo; ph < ph_hi; ph++) {
    Params Q = P;
    unsigned pk = xb_pack;
    asm volatile("" : "+s"(Q.out), "+s"(Q.ws), "+s"(pk));
    Q.wv = (int)(pk >> 28);
    run_phase(Q, ph, smem);
    if (ph + 1 < ph_hi) {
      unsigned pk2 = xb_pack;
      asm volatile("" : "+s"(pk2));
      xcd_barrier((unsigned*)(Q.ws + WS_BAR), (pk2 >> 24) & 0xfu, pk2 & 0xffffu, (pk2 >> 16) & 0xffu, (int)(pk2 >> 28));
    }
  }
}

extern "C" void kernel_launch(void* const* d_in, const int* in_sizes, int n_in, void* d_out, int out_size, void* d_ws,
                              size_t ws_size, hipStream_t stream) {
  static int grid_blocks = 0;
  if (!grid_blocks) {
    int dev = 0, cus = 0, per_cu = 0;
    hipGetDevice(&dev);
    hipDeviceGetAttribute(&cus, hipDeviceAttributeMultiprocessorCount, dev);
    hipFuncSetAttribute((const void*)mega, hipFuncAttributeMaxDynamicSharedMemorySize, SMEM_BYTES);
    hipOccupancyMaxActiveBlocksPerMultiprocessor(&per_cu, mega, NTHR, SMEM_BYTES);
    per_cu = 1;
    grid_blocks = cus * per_cu;
  }
  if (n_in != 28 || (size_t)out_size != O_END || ws_size < WS_END) {
    fprintf(stderr, "kernel_launch: shape/ws mismatch n_in %d out %d (want %zu) ws %zu (want %zu)\n", n_in, out_size, (size_t)O_END, ws_size, (size_t)WS_END);
    return;
  }
  Params p;
  memset(&p, 0, sizeof(p));
  for (int i = 0; i < 28; i++) p.in[i] = (const float*)d_in[i];
  p.out = (float*)d_out;
  p.ws = (char*)d_ws;
  hipMemsetAsync((char*)d_ws + WS_BAR, 0, XCD_BAR_WORDS * 4, stream);
  int lo = 0, hi = NPHASE;
  void* args[] = {&p, &lo, &hi};
  hipError_t e = hipLaunchCooperativeKernel((void*)mega, dim3(grid_blocks), dim3(NTHR), args, SMEM_BYTES, stream);
  if (e != hipSuccess) fprintf(stderr, "cooperative launch failed: %s (grid %d)\n", hipGetErrorString(e), grid_blocks);
}
```

```cpp
#include <hip/hip_runtime.h>
#include <hip/hip_cooperative_groups.h>
#include <stdint.h>
#include <string.h>
#include <stdio.h>
namespace cg = cooperative_groups;

#ifndef COOP
#define COOP 1
#endif

#ifndef FOX_KT
#define FOX_KT 128
#endif
#ifndef FOX_PF
#define FOX_PF true
#endif
#ifndef MLA_PF
#define MLA_PF true
#endif
#ifndef LB_MIN
#define LB_MIN 2
#endif
#ifndef BM_BIG
#define BM_BIG 256
#endif
constexpr int NTHR = 512, NWV = 8;
#define DI __device__ __forceinline__
typedef unsigned short u16;
typedef short s16x8 __attribute__((ext_vector_type(8)));
typedef short s16x4 __attribute__((ext_vector_type(4)));
typedef __bf16 bfx8 __attribute__((ext_vector_type(8)));
typedef __bf16 bfx2 __attribute__((ext_vector_type(2)));
typedef float f32x16 __attribute__((ext_vector_type(16)));
typedef float f32x4 __attribute__((ext_vector_type(4)));
typedef float f32x2 __attribute__((ext_vector_type(2)));
typedef unsigned u32x4 __attribute__((ext_vector_type(4)));
typedef unsigned u32x2 __attribute__((ext_vector_type(2)));

constexpr int DM = 1024, NB = 8, SEQ = 4096, NL = 2, DB = 32, DS = 32, PAST = 2048;
constexpr int TP = NB * SEQ;
constexpr int TS = DB * DS;
constexpr int TT = TP + TS;
constexpr int SKS = PAST + DS;
constexpr int KROWS = TP + DB * SKS;
constexpr int INC = 1992, INP = 2048;
constexpr int NMEM = 256, MB = NB + DB;
constexpr int DFF = 4096;

constexpr size_t O_Y = 0;
constexpr size_t O_FKP = (size_t)TT * DM;
constexpr size_t O_FVP = O_FKP + (size_t)NL * TP * 512;
constexpr size_t O_FLP = O_FVP + (size_t)NL * TP * 512;
constexpr size_t O_CKP = O_FLP + (size_t)NL * TP * 8;
constexpr size_t O_KRP = O_CKP + (size_t)NL * TP * 128;
constexpr size_t O_MKP = O_KRP + (size_t)NL * TP * 64;
constexpr size_t O_MVP = O_MKP + (size_t)NL * NB * NMEM * 1024;
constexpr size_t O_FKS = O_MVP + (size_t)NL * NB * NMEM * 1024;
constexpr size_t O_FVS = O_FKS + (size_t)NL * TS * 512;
constexpr size_t O_FLS = O_FVS + (size_t)NL * TS * 512;
constexpr size_t O_CKS = O_FLS + (size_t)NL * TS * 8;
constexpr size_t O_KRS = O_CKS + (size_t)NL * TS * 128;
constexpr size_t O_END = O_KRS + (size_t)NL * TS * 64;

constexpr size_t al256(size_t x) { return (x + 255) / 256 * 256; }
constexpr size_t WE_IN = 0;
constexpr size_t WE_UQ = WE_IN + (size_t)INP * 1024;
constexpr size_t WE_UKV = WE_UQ + (size_t)768 * 256;
constexpr size_t WE_OUT = WE_UKV + (size_t)1024 * 128;
constexpr size_t WE_XQ = WE_OUT + (size_t)1024 * 1024;
constexpr size_t WE_MKV = WE_XQ + (size_t)1024 * 1024;
constexpr size_t WE_XO = WE_MKV + (size_t)2048 * 1024;
constexpr size_t WE_UP = WE_XO + (size_t)1024 * 1024;
constexpr size_t WE_DN = WE_UP + (size_t)4096 * 1024;
constexpr size_t WE_LAYER = WE_DN + (size_t)1024 * 4096;
constexpr size_t WS_WT = 0;
constexpr size_t WS_ROPE = al256(WS_WT + WE_LAYER * 2 * NL);
constexpr size_t WS_ACTA = al256(WS_ROPE + (size_t)4096 * 32 * 8);
constexpr size_t WS_QF = al256(WS_ACTA + (size_t)TT * 1024 * 2);
constexpr size_t WS_FOXK = al256(WS_QF + (size_t)TT * 512 * 2);
constexpr size_t WS_FOXV = al256(WS_FOXK + (size_t)KROWS * 512 * 2);
constexpr size_t WS_CUM = al256(WS_FOXV + (size_t)KROWS * 512 * 2);
constexpr size_t WS_ZC = al256(WS_CUM + (size_t)KROWS * 8 * 4);
constexpr size_t WS_CQN = al256(WS_ZC + (size_t)TT * 448 * 4);
constexpr size_t WS_CKV = al256(WS_CQN + (size_t)TT * 256 * 2);
constexpr size_t WS_KROPE = al256(WS_CKV + (size_t)KROWS * 128 * 2);
constexpr size_t WS_MEMK = al256(WS_KROPE + (size_t)KROWS * 64 * 2);
constexpr size_t WS_MEMV = al256(WS_MEMK + (size_t)NL * MB * NMEM * 1024 * 2);
constexpr size_t WS_HMEM = al256(WS_MEMV + (size_t)NL * MB * NMEM * 1024 * 2);
constexpr size_t WS_R1 = al256(WS_HMEM + (size_t)NL * NB * NMEM * 1024 * 2);
constexpr size_t R1_KV = 0;
constexpr size_t R1_QM = al256((size_t)KROWS * 1024 * 2);
constexpr size_t R1_U = 0;
constexpr size_t R1_XQ = 0;
constexpr size_t WS_BAR = al256(WS_R1 + (size_t)TT * 4096 * 2);
constexpr size_t WS_CTR = WS_BAR + 3456 * 4;
constexpr size_t WS_END = al256(WS_CTR + 4 * 256);
static_assert(R1_QM + (size_t)TT * 768 * 2 <= (size_t)TT * 4096 * 2, "R1 overflow");

constexpr int SMEM_BYTES = 131072;

struct Params {
  const float* in[28];
  float* out;
  char* ws;
  int wv;
  int pad;
};

DI int get_bid() { int t = blockIdx.x; asm volatile("" : "+s"(t)); return t; }
DI int get_nblk() { int t = gridDim.x; asm volatile("" : "+s"(t)); return t; }
DI int lane_id() { return (int)__builtin_amdgcn_mbcnt_hi(~0u, __builtin_amdgcn_mbcnt_lo(~0u, 0u)); }
DI int get_tid(int wv) { int t = (wv << 6) | lane_id(); asm volatile("" : "+v"(t)); return t; }
DI unsigned pk2(float a, float b) { f32x2 v = {a, b}; return __builtin_bit_cast(unsigned, __builtin_convertvector(v, bfx2)); }
DI u16 f2bf(float a) { return (u16)(pk2(a, 0.f) & 0xffffu); }
DI f32x16 mfma(s16x8 a, s16x8 b, f32x16 c) {
  return __builtin_amdgcn_mfma_f32_32x32x16_bf16(__builtin_bit_cast(bfx8, a), __builtin_bit_cast(bfx8, b), c, 0, 0, 0);
}
DI int crow(int i, int h) { return (i & 3) + 8 * (i >> 2) + 4 * h; }
DI float wave_sum(float v) {
#pragma unroll
  for (int m = 32; m >= 1; m >>= 1) v += __shfl_xor(v, m);
  return v;
}
DI float xhalf_max(float v) {
  auto rr = __builtin_amdgcn_permlane32_swap(__float_as_uint(v), __float_as_uint(v), false, false);
  return fmaxf(__uint_as_float(rr[0]), __uint_as_float(rr[1]));
}
DI float xhalf_sum(float v) {
  auto rr = __builtin_amdgcn_permlane32_swap(__float_as_uint(v), __float_as_uint(v), false, false);
  return __uint_as_float(rr[0]) + __uint_as_float(rr[1]);
}
DI int tok_krow(int tok) {
  if (tok < TP) return tok;
  const int s = tok - TP;
  return TP + (s >> 5) * SKS + PAST + (s & 31);
}
DI int tok_pos(int tok) { return tok < TP ? (tok & (SEQ - 1)) : PAST + ((tok - TP) & 31); }

enum { EPI_IN = 0, EPI_MEM, EPI_UQ, EPI_KV, EPI_RESID, EPI_XQ, EPI_UP, EPI_RESID0 };

template <int EPI, int MI>
DI void epilogue(const Params& P, int l, f32x16 (&acc)[MI][2], int mw, int nw, int r, int h) {
  float* out = P.out;
  char* ws = P.ws;
  if constexpr (EPI == EPI_IN) {
    u16* qf = (u16*)(ws + WS_QF);
    u16* fk = (u16*)(ws + WS_FOXK);
    u16* fv = (u16*)(ws + WS_FOXV);
    float* zc = (float*)(ws + WS_ZC);
    const float* bfg = P.in[12] + l * 8;
#pragma unroll
    for (int mi = 0; mi < MI; mi++) {
#pragma unroll
      for (int i = 0; i < 16; i++) {
        const int row = mw + mi * 32 + crow(i, h);
        const int kr = tok_krow(row);
        const bool isp = row < TP;
        const size_t orow = isp ? ((size_t)l * TP + row) : ((size_t)l * TS + (row - TP));
#pragma unroll
        for (int ni = 0; ni < 2; ni++) {
          const int col = nw + ni * 32 + r;
          const float v = acc[mi][ni][i];
          if (col < 512) {
            qf[(size_t)row * 512 + col] = f2bf(v);
          } else if (col < 1024) {
            const int c = col - 512;
            out[(isp ? O_FKP : O_FKS) + orow * 512 + c] = v;
            fk[(size_t)kr * 512 + c] = f2bf(v);
          } else if (col < 1536) {
            const int c = col - 1024;
            out[(isp ? O_FVP : O_FVS) + orow * 512 + c] = v;
            fv[(size_t)kr * 512 + c] = f2bf(v);
          } else if (col < 1544) {
            const int c = col - 1536;
            const float g = v + bfg[c];
            const float ls = fminf(g, 0.f) - __logf(1.f + __expf(-fabsf(g)));
            out[(isp ? O_FLP : O_FLS) + orow * 8 + c] = ls;
          } else if (col < INC) {
            zc[(size_t)row * 448 + (col - 1544)] = v;
          }
        }
      }
    }
  } else if constexpr (EPI == EPI_MEM) {
    u16* mk = (u16*)(ws + WS_MEMK);
    u16* mv = (u16*)(ws + WS_MEMV);
#pragma unroll
    for (int mi = 0; mi < MI; mi++) {
#pragma unroll
      for (int i = 0; i < 16; i++) {
        const int row = mw + mi * 32 + crow(i, h);
#pragma unroll
        for (int ni = 0; ni < 2; ni++) {
          const int col = nw + ni * 32 + r;
          const float v = acc[mi][ni][i];
          const int c = col & 1023;
          const size_t oidx = ((size_t)l * (NB * NMEM) + row) * 1024 + c;
          const size_t bidx = ((size_t)l * (MB * NMEM) + row) * 1024 + c;
          if (col < 1024) { out[O_MKP + oidx] = v; mk[bidx] = f2bf(v); }
          else { out[O_MVP + oidx] = v; mv[bidx] = f2bf(v); }
        }
      }
    }
  } else if constexpr (EPI == EPI_UQ) {
    u16* qm = (u16*)(ws + WS_R1 + R1_QM);
    const f32x2* rt = (const f32x2*)(ws + WS_ROPE);
    const bool isrope = (nw % 192) == 128;
#pragma unroll
    for (int mi = 0; mi < MI; mi++) {
#pragma unroll
      for (int i = 0; i < 16; i++) {
        const int row = mw + mi * 32 + crow(i, h);
        float x1 = acc[mi][0][i], x2 = acc[mi][1][i];
        if (isrope) {
          const f32x2 cs = rt[tok_pos(row) * 32 + r];
          const float o1 = x1 * cs[0] - x2 * cs[1];
          const float o2 = x2 * cs[0] + x1 * cs[1];
          x1 = o1; x2 = o2;
        }
        qm[(size_t)row * 768 + nw + r] = f2bf(x1);
        qm[(size_t)row * 768 + nw + 32 + r] = f2bf(x2);
      }
    }
  } else if constexpr (EPI == EPI_KV || EPI == EPI_XQ || EPI == EPI_UP) {
    u16* dst; int ld;
    if constexpr (EPI == EPI_KV) { dst = (u16*)(ws + WS_R1 + R1_KV); ld = 1024; }
    else if constexpr (EPI == EPI_XQ) { dst = (u16*)(ws + WS_R1 + R1_XQ); ld = 1024; }
    else { dst = (u16*)(ws + WS_R1 + R1_U); ld = DFF; }
    const bool odd = r & 1;
    const int colb = nw + (r & ~1);
#pragma unroll
    for (int mi = 0; mi < MI; mi++) {
#pragma unroll
      for (int i = 0; i < 16; i += 2) {
        const int row = mw + mi * 32 + crow(i, h) + (odd ? 1 : 0);
#pragma unroll
        for (int ni = 0; ni < 2; ni++) {
          float v0 = acc[mi][ni][i], v1 = acc[mi][ni][i + 1];
          if constexpr (EPI == EPI_UP) { v0 = fmaxf(v0, 0.f); v0 = v0 * v0; v1 = fmaxf(v1, 0.f); v1 = v1 * v1; }
          const float send = odd ? v0 : v1;
          const float recv = __int_as_float(__builtin_amdgcn_mov_dpp(__float_as_int(send), 0xB1, 0xF, 0xF, true));
          const unsigned w = odd ? pk2(recv, v1) : pk2(v0, recv);
          *(unsigned*)(dst + (size_t)row * ld + colb + ni * 32) = w;
        }
      }
    }
  } else if constexpr (EPI == EPI_RESID || EPI == EPI_RESID0) {
#pragma unroll
    for (int mi = 0; mi < MI; mi++) {
#pragma unroll
      for (int i = 0; i < 16; i++) {
        const int row = mw + mi * 32 + crow(i, h);
#pragma unroll
        for (int ni = 0; ni < 2; ni++) {
          unsafeAtomicAdd(out + (size_t)row * DM + nw + ni * 32 + r, EPI == EPI_RESID0 ? acc[mi][ni][i] * 0.f : acc[mi][ni][i]);
        }
      }
    }
  }
}

enum { MASK_NONE = 0, MASK_FRAME = 1, MASK_CHUNK = 2 };
struct AttnJob {
  const u16* Q; int ldq;
  const u16* K1; int ldk1;
  const u16* K2; int ldk2;
  const u16* V; int ldv;
  u16* O; int ldo;
  const float* cq;
  const float* ck;
  int nq, Sk, qpos0;
  float scale_log2;
  int wv;
};

template <int DQK, int D1, int DVT, int MASK, bool BIAS, bool PREFETCH, int LDQ, int LDK1, int LDK2, int LDV, int LDO, int KT>
DI void attn_block(const AttnJob& J, char* smem) {
  constexpr int KP = DQK * 2 + 16;
  constexpr int VP = DVT * 2;
  constexpr int CV = DVT / 8;
  constexpr int NKK = DQK / 16, NDV = DVT / 32;
  constexpr float LOG2E = 1.4426950408889634f;
  char* Ks = smem;
  char* Vs = smem + KT * KP;
  float* cks = (float*)(smem + KT * KP + KT * VP);
  const int tid = get_tid(J.wv), wave = tid >> 6, lane = tid & 63, r = lane & 31, h = lane >> 5;
  const int wq0 = wave * 32;
  const bool active = wq0 < J.nq;
  const int qi = wq0 + r;
  const int qpos = J.qpos0 + qi;
  const int wqmax = J.qpos0 + wq0 + 31;
  const int qmax = J.qpos0 + J.nq - 1;
  const int ntk = (J.Sk + KT - 1) / KT;
  int nt = ntk;
  if (MASK != MASK_NONE) { const int t2 = qmax / KT + 1; nt = t2 < ntk ? t2 : ntk; }

  s16x8 qf[NKK];
  {
    const u16* qp = J.Q + (size_t)qi * LDQ + h * 8;
#pragma unroll
    for (int kk = 0; kk < NKK; kk++) {
      if (active) qf[kk] = *(const s16x8*)(qp + kk * 16);
      else { s16x8 z = {0, 0, 0, 0, 0, 0, 0, 0}; qf[kk] = z; }
    }
  }

  f32x16 o[NDV];
#pragma unroll
  for (int d = 0; d < NDV; d++)
#pragma unroll
    for (int i = 0; i < 16; i++) o[d][i] = 0.f;
  float m_run = -1e30f, l_run = 0.f;

  constexpr int CK1 = D1 / 8, CK2 = (DQK - D1) / 8;
  constexpr int RP1 = NTHR / CK1, NP1 = KT / RP1;
  constexpr int RP2 = CK2 ? NTHR / (CK2 ? CK2 : 1) : 64, NP2 = CK2 ? KT / RP2 : 0;
  constexpr int RPV = NTHR / CV, NPV = KT / RPV;
  u32x4 rk1[NP1], rk2[NP2 ? NP2 : 1], rv[NPV];
  float rck = 0.f;
  const int tq = (lane & 15) >> 2, tp = lane & 3, tblk = (lane >> 4) & 1;
  const int vswz = (DVT >= 128) ? tq : (tq >> 1);
  const int r1 = tid / CK1, c1 = tid % CK1;
  const int r2 = CK2 ? tid / (CK2 ? CK2 : 1) : 0, c2 = CK2 ? tid % (CK2 ? CK2 : 1) : 0;
  const int r3 = tid / CV, c3 = tid % CV;
  const unsigned k1o = (unsigned)(r1 * LDK1 + c1 * 8) * 2u;
  const unsigned k2o = (unsigned)(r2 * LDK2 + c2 * 8) * 2u;
  const unsigned vo = (unsigned)(r3 * LDV + c3 * 8) * 2u;
  const int k1so = r1 * KP + c1 * 16;
  const int k2so = r2 * KP + D1 * 2 + c2 * 16;
  const int vsw = (DVT >= 128) ? (r3 & 3) : ((r3 >> 1) & 1);
  const int vso = KT * KP + r3 * VP + (((c3 >> 2) ^ vsw) * 64) + (c3 & 3) * 16;
  const int vro = KT * KP + (4 * h + tq) * VP + (16 * tblk + 4 * tp) * 2;
  const int kro = r * KP + h * 16;

  auto load_tile = [&](int j) {
    const int kb = j * KT;
#pragma unroll
    for (int i = 0; i < NP1; i++) {
      u32x4 v = {0u, 0u, 0u, 0u};
      if (kb + r1 + i * RP1 < J.Sk) v = *(const u32x4*)((const char*)(J.K1 + (size_t)(kb + i * RP1) * LDK1) + k1o);
      rk1[i] = v;
    }
#pragma unroll
    for (int i = 0; i < NP2; i++) {
      u32x4 v = {0u, 0u, 0u, 0u};
      if (kb + r2 + i * RP2 < J.Sk) v = *(const u32x4*)((const char*)(J.K2 + (size_t)(kb + i * RP2) * LDK2) + k2o);
      rk2[i] = v;
    }
#pragma unroll
    for (int i = 0; i < NPV; i++) {
      u32x4 v = {0u, 0u, 0u, 0u};
      if (kb + r3 + i * RPV < J.Sk) v = *(const u32x4*)((const char*)(J.V + (size_t)(kb + i * RPV) * LDV) + vo);
      rv[i] = v;
    }
    if (BIAS) {
      if (tid < KT) { const int key = kb + tid; rck = key < J.Sk ? -J.ck[(size_t)key * 8] * LOG2E : 0.f; }
    }
  };
  auto store_tile = [&]() {
    int a1 = k1so, a2 = k2so, a3 = vso;
    asm volatile("" : "+v"(a1), "+v"(a2), "+v"(a3));
#pragma unroll
    for (int i = 0; i < NP1; i++) *(u32x4*)(smem + a1 + i * RP1 * KP) = rk1[i];
#pragma unroll
    for (int i = 0; i < NP2; i++) *(u32x4*)(smem + a2 + i * RP2 * KP) = rk2[i];
#pragma unroll
    for (int i = 0; i < NPV; i++) *(u32x4*)(smem + a3 + i * RPV * VP) = rv[i];
    if (BIAS) { if (tid < KT) cks[tid] = rck; }
  };

  if (PREFETCH) load_tile(0);
  for (int j = 0; j < nt; j++) {
    __syncthreads();
    if (!PREFETCH) load_tile(j);
    store_tile();
    __syncthreads();
    if (PREFETCH) { if (j + 1 < nt) load_tile(j + 1); }
    const bool need = active && (MASK == MASK_NONE || j * KT <= wqmax);
    if (need) {
      int kro_l = kro, vro_l = vro;
      asm volatile("" : "+v"(kro_l), "+v"(vro_l));
      const char* krd = smem + kro_l;
      const bool needmask = (MASK == MASK_FRAME && j * KT + KT - 1 > J.qpos0 + wq0) || (j * KT + KT - 1 >= J.Sk);
      const int dq = (MASK == MASK_FRAME ? min(qpos, J.Sk - 1) : J.Sk - 1) - j * KT - 4 * h;
#pragma unroll
      for (int hb = 0; hb < KT / 32; hb++) {
        if (MASK == MASK_FRAME && j * KT + hb * 32 > wqmax) continue;
        f32x16 p;
#pragma unroll
        for (int i = 0; i < 16; i++) p[i] = 0.f;
#pragma unroll
        for (int kk = 0; kk < NKK; kk++) {
          const s16x8 kf = *(const s16x8*)(krd + hb * 32 * KP + kk * 32);
          p = mfma(kf, qf[kk], p);
        }
        if (BIAS) {
#pragma unroll
          for (int g = 0; g < 4; g++) {
            const f32x4 c0 = *(const f32x4*)(cks + hb * 32 + 8 * g + 4 * h);
#pragma unroll
            for (int e = 0; e < 4; e++) p[4 * g + e] = fmaf(p[4 * g + e], J.scale_log2, c0[e]);
          }
        } else {
#pragma unroll
          for (int i = 0; i < 16; i++) p[i] *= J.scale_log2;
        }
        if (needmask) {
#pragma unroll
          for (int i = 0; i < 16; i++) {
            const int cc = (i & 3) + 8 * (i >> 2) + 32 * hb;
            p[i] = (cc <= dq) ? p[i] : -1e30f;
          }
        }
        float mx = p[0];
#pragma unroll
        for (int i = 1; i < 16; i++) mx = fmaxf(mx, p[i]);
        mx = xhalf_max(mx);
        if (__any(mx > m_run + 8.f)) {
          const float m_new = fmaxf(m_run, mx);
          const float alpha = __builtin_amdgcn_exp2f(m_run - m_new);
          m_run = m_new;
          l_run *= alpha;
#pragma unroll
          for (int d = 0; d < NDV; d++)
#pragma unroll
            for (int i = 0; i < 16; i++) o[d][i] *= alpha;
        }
        float ps = 0.f;
#pragma unroll
        for (int i = 0; i < 16; i++) { p[i] = __builtin_amdgcn_exp2f(p[i] - m_run); ps += p[i]; }
        l_run += ps;
        s16x8 pb[2];
        {
          u32x4 w;
          w[0] = pk2(p[0], p[1]); w[1] = pk2(p[2], p[3]); w[2] = pk2(p[4], p[5]); w[3] = pk2(p[6], p[7]);
          pb[0] = __builtin_bit_cast(s16x8, w);
          w[0] = pk2(p[8], p[9]); w[1] = pk2(p[10], p[11]); w[2] = pk2(p[12], p[13]); w[3] = pk2(p[14], p[15]);
          pb[1] = __builtin_bit_cast(s16x8, w);
        }
#pragma unroll
        for (int d = 0; d < NDV; d++) {
          const char* vb = smem + (vro_l + ((d ^ vswz) * 64)) + hb * 32 * VP;
#pragma unroll
          for (int s = 0; s < 2; s++) {
            const s16x4 lo = __builtin_amdgcn_ds_read_tr16_b64_v4i16(
                (__attribute__((address_space(3))) s16x4*)(uintptr_t)(vb + (16 * s) * VP));
            const s16x4 hi = __builtin_amdgcn_ds_read_tr16_b64_v4i16(
                (__attribute__((address_space(3))) s16x4*)(uintptr_t)(vb + (16 * s + 8) * VP));
            const s16x8 vf = __builtin_shufflevector(lo, hi, 0, 1, 2, 3, 4, 5, 6, 7);
            o[d] = mfma(vf, pb[s], o[d]);
          }
        }
      }
    }
  }
  const float lt = xhalf_sum(l_run);
  if (active && qi < J.nq) {
    const float inv = 1.f / lt;
    u16* op = J.O + (size_t)qi * LDO + 4 * h;
#pragma unroll
    for (int d = 0; d < NDV; d++) {
#pragma unroll
      for (int g = 0; g < 4; g++) {
        u32x2 w;
        w[0] = pk2(o[d][4 * g] * inv, o[d][4 * g + 1] * inv);
        w[1] = pk2(o[d][4 * g + 2] * inv, o[d][4 * g + 3] * inv);
        *(u32x2*)(op + d * 32 + 8 * g) = w;
      }
    }
  }
}

template <int NR, bool F32OUT>
DI void rms_rows(const float* __restrict__ xbase, size_t rstride, int nvalid, const float* __restrict__ g, void* dbase, size_t dstride, int lane) {
  f32x4 v[NR][4];
#pragma unroll
  for (int j = 0; j < NR; j++)
#pragma unroll
    for (int i = 0; i < 4; i++) {
      if (j < nvalid) v[j][i] = *(const f32x4*)(xbase + (size_t)j * rstride + i * 256 + lane * 4);
      else { f32x4 z = {0.f, 0.f, 0.f, 0.f}; v[j][i] = z; }
    }
  f32x4 gg[4];
#pragma unroll
  for (int i = 0; i < 4; i++) gg[i] = *(const f32x4*)(g + i * 256 + lane * 4);
#pragma unroll
  for (int j = 0; j < NR; j++) {
    float ss = 0.f;
#pragma unroll
    for (int i = 0; i < 4; i++) ss += v[j][i][0] * v[j][i][0] + v[j][i][1] * v[j][i][1] + v[j][i][2] * v[j][i][2] + v[j][i][3] * v[j][i][3];
    ss = wave_sum(ss);
    const float rs = rsqrtf(ss * (1.f / 1024.f) + 1e-6f);
    if (j < nvalid) {
#pragma unroll
      for (int i = 0; i < 4; i++) {
        if (F32OUT) {
          f32x4 w;
          w[0] = v[j][i][0] * rs * gg[i][0]; w[1] = v[j][i][1] * rs * gg[i][1]; w[2] = v[j][i][2] * rs * gg[i][2]; w[3] = v[j][i][3] * rs * gg[i][3];
          *(f32x4*)((float*)dbase + (size_t)j * dstride + i * 256 + lane * 4) = w;
        } else {
          u32x2 w;
          w[0] = pk2(v[j][i][0] * rs * gg[i][0], v[j][i][1] * rs * gg[i][1]);
          w[1] = pk2(v[j][i][2] * rs * gg[i][2], v[j][i][3] * rs * gg[i][3]);
          *(u32x2*)((u16*)dbase + (size_t)j * dstride + i * 256 + lane * 4) = w;
        }
      }
    }
  }
}

DI void cvt_job(const float* __restrict__ src, u16* __restrict__ dst, int nseg, size_t seglen, size_t sstride, size_t dstride, int wv) {
  const size_t upseg = seglen / 8;
  const size_t total = upseg * nseg;
  const size_t stride = (size_t)get_nblk() * NTHR;
  for (size_t u0 = (size_t)get_bid() * NTHR + get_tid(wv); u0 < total; u0 += 4 * stride) {
    f32x4 a[4], b[4];
    size_t so[4], dd[4];
#pragma unroll
    for (int q = 0; q < 4; q++) {
      const size_t u = u0 + q * stride;
      const size_t uu = u < total ? u : u0;
      const size_t sg = uu / upseg, off = (uu - sg * upseg) * 8;
      so[q] = sg * sstride + off; dd[q] = sg * dstride + off;
      a[q] = *(const f32x4*)(src + so[q]);
      b[q] = *(const f32x4*)(src + so[q] + 4);
    }
#pragma unroll
    for (int q = 0; q < 4; q++) {
      if (u0 + q * stride < total) {
        u32x4 w;
        w[0] = pk2(a[q][0], a[q][1]); w[1] = pk2(a[q][2], a[q][3]); w[2] = pk2(b[q][0], b[q][1]); w[3] = pk2(b[q][2], b[q][3]);
        *(u32x4*)(dst + dd[q]) = w;
      }
    }
  }
}

DI void transpose_job(const float* __restrict__ src, u16* __restrict__ dst, int K, int N, int Npad, int& rot, char* smem, int wv) {
  float* tile = (float*)smem;
  const int tk = K / 64, tn = Npad / 64, ntiles = tk * tn;
  const int G = get_nblk();
  const int tid = get_tid(wv);
  for (int t = (get_bid() + G - (rot % G)) % G; t < ntiles; t += G) {
    const int k0 = (t % tk) * 64, n0 = (t / tk) * 64;
    float v[8];
#pragma unroll
    for (int i = 0; i < 8; i++) {
      const int k = i * 8 + (tid >> 6), n = tid & 63;
      v[i] = (n0 + n < N) ? src[(size_t)(k0 + k) * N + n0 + n] : 0.f;
    }
    __syncthreads();
#pragma unroll
    for (int i = 0; i < 8; i++) {
      const int k = i * 8 + (tid >> 6), n = tid & 63;
      tile[k * 65 + n] = v[i];
    }
    __syncthreads();
#pragma unroll
    for (int i = 0; i < 4; i++) {
      const int n = i * 16 + (tid >> 5), k = (tid & 31) * 2;
      *(unsigned*)(dst + (size_t)(n0 + n) * K + k0 + k) = pk2(tile[k * 65 + n], tile[(k + 1) * 65 + n]);
    }
  }
  rot += ntiles;
}

DI u16* wt_ptr(const Params& P, int l, size_t eoff) { return (u16*)(P.ws + WS_WT) + (size_t)l * WE_LAYER + eoff; }

DI void phase_prep(const Params& P, char* smem) {
  const int tid = get_tid(P.wv), lane = tid & 63;
  const int gw = get_bid() * NWV + (tid >> 6), nw = get_nblk() * NWV;
  int rot = 0;
  for (int l = 0; l < NL; l++) {
    transpose_job(P.in[11] + (size_t)l * 1024 * INC, wt_ptr(P, l, WE_IN), 1024, INC, INP, rot, smem, P.wv);
    transpose_job(P.in[14] + (size_t)l * 256 * 768, wt_ptr(P, l, WE_UQ), 256, 768, 768, rot, smem, P.wv);
    transpose_job(P.in[16] + (size_t)l * 128 * 1024, wt_ptr(P, l, WE_UKV), 128, 1024, 1024, rot, smem, P.wv);
    transpose_job(P.in[17] + (size_t)l * 1024 * 1024, wt_ptr(P, l, WE_OUT), 1024, 1024, 1024, rot, smem, P.wv);
    transpose_job(P.in[20] + (size_t)l * 1024 * 1024, wt_ptr(P, l, WE_XQ), 1024, 1024, 1024, rot, smem, P.wv);
    transpose_job(P.in[21] + (size_t)l * 1024 * 1024, wt_ptr(P, l, WE_MKV), 1024, 1024, 1024, rot, smem, P.wv);
    transpose_job(P.in[22] + (size_t)l * 1024 * 1024, wt_ptr(P, l, WE_MKV) + (size_t)1024 * 1024, 1024, 1024, 1024, rot, smem, P.wv);
    transpose_job(P.in[23] + (size_t)l * 1024 * 1024, wt_ptr(P, l, WE_XO), 1024, 1024, 1024, rot, smem, P.wv);
    transpose_job(P.in[25] + (size_t)l * 1024 * 4096, wt_ptr(P, l, WE_UP), 1024, 4096, 4096, rot, smem, P.wv);
    transpose_job(P.in[26] + (size_t)l * 4096 * 1024, wt_ptr(P, l, WE_DN), 4096, 1024, 1024, rot, smem, P.wv);
  }
  {
    f32x2* rt = (f32x2*)(P.ws + WS_ROPE);
    for (int i = get_bid() * NTHR + tid; i < 4096 * 32; i += get_nblk() * NTHR) {
      const int pos = i >> 5, j = i & 31;
      const float inv = powf(10000.f, -(float)j / 32.f);
      const float ang = (float)pos * inv;
      f32x2 cs; cs[0] = cosf(ang); cs[1] = sinf(ang);
      rt[i] = cs;
    }
  }
  for (int l = 0; l < NL; l++) {
    const size_t seg = (size_t)DB * NMEM * 1024;
    cvt_job(P.in[8] + l * seg, (u16*)(P.ws + WS_MEMK) + ((size_t)l * MB + NB) * NMEM * 1024, 1, seg, 0, 0, P.wv);
    cvt_job(P.in[9] + l * seg, (u16*)(P.ws + WS_MEMV) + ((size_t)l * MB + NB) * NMEM * 1024, 1, seg, 0, 0, P.wv);
  }
  for (int rr = gw; rr < NL * NB * NMEM; rr += nw) {
    const int l = rr / (NB * NMEM), row = rr % (NB * NMEM);
    rms_rows<1, false>(P.in[2] + (size_t)row * 1024, 0, 1, P.in[19] + l * 1024, (u16*)(P.ws + WS_HMEM) + (size_t)rr * 1024, 0, lane);
  }
  {
    const size_t n4 = (size_t)TT * 256;
    const size_t np4 = (size_t)TP * 256;
    const size_t stride = (size_t)get_nblk() * NTHR;
    for (size_t i0 = (size_t)get_bid() * NTHR + tid; i0 < n4; i0 += 4 * stride) {
      f32x4 v[4];
#pragma unroll
      for (int q = 0; q < 4; q++) {
        const size_t i = i0 + q * stride;
        const size_t ii = i < n4 ? i : i0;
        v[q] = (ii < np4) ? *(const f32x4*)(P.in[0] + ii * 4) : *(const f32x4*)(P.in[1] + (ii - np4) * 4);
      }
#pragma unroll
      for (int q = 0; q < 4; q++) {
        const size_t i = i0 + q * stride;
        if (i < n4) *(f32x4*)(P.out + i * 4) = v[q];
      }
    }
  }
}

DI void phase_norm(const Params& P, const float* g, int cache_layer) {
  const int tid = get_tid(P.wv), lane = tid & 63;
  const int gw = get_bid() * NWV + (tid >> 6), nw = get_nblk() * NWV;
  u16* h = (u16*)(P.ws + WS_ACTA);
  for (int row = gw; row < TT; row += 4 * nw) {
    const int nv = (TT - row + nw - 1) / nw;
    rms_rows<4, false>(P.out + (size_t)row * 1024, (size_t)nw * 1024, nv < 4 ? nv : 4, g, h + (size_t)row * 1024, (size_t)nw * 1024, lane);
  }
  if (cache_layer >= 0) {
    const int l = cache_layer;
    cvt_job(P.in[3] + (size_t)l * DB * PAST * 512, (u16*)(P.ws + WS_FOXK) + (size_t)TP * 512, DB, (size_t)PAST * 512, (size_t)PAST * 512, (size_t)SKS * 512, P.wv);
    cvt_job(P.in[4] + (size_t)l * DB * PAST * 512, (u16*)(P.ws + WS_FOXV) + (size_t)TP * 512, DB, (size_t)PAST * 512, (size_t)PAST * 512, (size_t)SKS * 512, P.wv);
    cvt_job(P.in[6] + (size_t)l * DB * PAST * 128, (u16*)(P.ws + WS_CKV) + (size_t)TP * 128, DB, (size_t)PAST * 128, (size_t)PAST * 128, (size_t)SKS * 128, P.wv);
    cvt_job(P.in[7] + (size_t)l * DB * PAST * 64, (u16*)(P.ws + WS_KROPE) + (size_t)TP * 64, DB, (size_t)PAST * 64, (size_t)PAST * 64, (size_t)SKS * 64, P.wv);
  }
}

DI void phase_final(const Params& P) {
  const int tid = get_tid(P.wv), lane = tid & 63;
  const int gw = get_bid() * NWV + (tid >> 6), nw = get_nblk() * NWV;
  const float* g = P.in[27];
  for (int row = gw; row < TT; row += 4 * nw) {
    const int nv = (TT - row + nw - 1) / nw;
    rms_rows<4, true>(P.out + (size_t)row * 1024, (size_t)nw * 1024, nv < 4 ? nv : 4, g, P.out + (size_t)row * 1024, (size_t)nw * 1024, lane);
  }
}

DI void phase_post(const Params& P, int l, char* smem) {
  const int tid = get_tid(P.wv), lane = tid & 63;
  const int gw = get_bid() * NWV + (tid >> 6), nw = get_nblk() * NWV;
  const float* zc = (const float*)(P.ws + WS_ZC);
  u16* cqn = (u16*)(P.ws + WS_CQN);
  u16* ckv = (u16*)(P.ws + WS_CKV);
  u16* krp = (u16*)(P.ws + WS_KROPE);
  const f32x2* rt = (const f32x2*)(P.ws + WS_ROPE);
  const float* gq = P.in[13] + l * 256;
  const float* gkv = P.in[15] + l * 128;
  for (int tok0 = gw; tok0 < TT; tok0 += 4 * nw) {
    f32x4 vq[4]; f32x2 vk[4]; float vr[4];
#pragma unroll
    for (int j = 0; j < 4; j++) {
      const int tk = tok0 + j * nw;
      const float* z = zc + (size_t)(tk < TT ? tk : tok0) * 448;
      vq[j] = *(const f32x4*)(z + lane * 4);
      vk[j] = *(const f32x2*)(z + 256 + lane * 2);
      vr[j] = z[384 + lane];
    }
    const f32x4 ggq = *(const f32x4*)(gq + lane * 4);
    const f32x2 ggk = *(const f32x2*)(gkv + lane * 2);
#pragma unroll
    for (int j = 0; j < 4; j++) {
      const int tok = tok0 + j * nw;
      if (tok >= TT) break;
      const bool isp = tok < TP;
      const size_t orow = isp ? ((size_t)l * TP + tok) : ((size_t)l * TS + (tok - TP));
      const int kr = tok_krow(tok);
      {
        const f32x4 v = vq[j];
        const float ss = wave_sum(v[0] * v[0] + v[1] * v[1] + v[2] * v[2] + v[3] * v[3]);
        const float rs = rsqrtf(ss * (1.f / 256.f) + 1e-6f);
        u32x2 w;
        w[0] = pk2(v[0] * rs * ggq[0], v[1] * rs * ggq[1]);
        w[1] = pk2(v[2] * rs * ggq[2], v[3] * rs * ggq[3]);
        *(u32x2*)(cqn + (size_t)tok * 256 + lane * 4) = w;
      }
      {
        const f32x2 v = vk[j];
        const float ss = wave_sum(v[0] * v[0] + v[1] * v[1]);
        const float rs = rsqrtf(ss * (1.f / 128.f) + 1e-6f);
        f32x2 o; o[0] = v[0] * rs * ggk[0]; o[1] = v[1] * rs * ggk[1];
        *(f32x2*)(P.out + (isp ? O_CKP : O_CKS) + orow * 128 + lane * 2) = o;
        *(unsigned*)(ckv + (size_t)kr * 128 + lane * 2) = pk2(o[0], o[1]);
      }
      {
        const float x = vr[j];
        const float y = __shfl_xor(x, 32);
        const f32x2 cs = rt[tok_pos(tok) * 32 + (lane & 31)];
        const float o = (lane < 32) ? (x * cs[0] - y * cs[1]) : (x * cs[0] + y * cs[1]);
        P.out[(isp ? O_KRP : O_KRS) + orow * 64 + lane] = o;
        krp[(size_t)kr * 64 + lane] = f2bf(o);
      }
    }
  }
  float* cum = (float*)(P.ws + WS_CUM);
  float* wtot = (float*)smem;
  const int wave = tid >> 6;
  for (int it = get_bid(); it < NB + DB; it += get_nblk()) {
    const bool isp = it < NB;
    const int b = isp ? it : it - NB;
    const int ppt = isp ? 16 : 9;
    const int npos = isp ? SEQ : SKS;
    const float* srcA; const float* srcB; int nA;
    size_t krow0;
    if (isp) { srcA = P.out + O_FLP + ((size_t)l * TP + (size_t)b * SEQ) * 8; srcB = srcA; nA = SEQ; krow0 = (size_t)b * SEQ; }
    else {
      srcA = P.in[5] + ((size_t)l * DB + b) * PAST * 8;
      srcB = P.out + O_FLS + ((size_t)l * TS + (size_t)b * DS) * 8 - (size_t)PAST * 8;
      nA = PAST; krow0 = (size_t)TP + (size_t)b * SKS;
    }
    const int p0 = tid * ppt;
    f32x4 va[16], vb[16];
#pragma unroll
    for (int j = 0; j < 16; j++) {
      const int p = p0 + j;
      f32x4 z = {0.f, 0.f, 0.f, 0.f};
      va[j] = z; vb[j] = z;
      if (j < ppt && p < npos) {
        const float* s = (p < nA ? srcA : srcB) + (size_t)p * 8;
        va[j] = *(const f32x4*)s; vb[j] = *(const f32x4*)(s + 4);
      }
    }
#pragma unroll
    for (int j = 1; j < 16; j++) { va[j] += va[j - 1]; vb[j] += vb[j - 1]; }
    f32x4 ta = va[15], tb = vb[15];
#pragma unroll
    for (int d = 1; d < 64; d <<= 1) {
#pragma unroll
      for (int e = 0; e < 4; e++) {
        const float ua = __shfl_up(ta[e], d), ub = __shfl_up(tb[e], d);
        if (lane >= d) { ta[e] += ua; tb[e] += ub; }
      }
    }
    __syncthreads();
    if (lane == 63) { *(f32x4*)(wtot + wave * 8) = ta; *(f32x4*)(wtot + wave * 8 + 4) = tb; }
    __syncthreads();
    f32x4 pa = ta - va[15], pb = tb - vb[15];
    for (int w2 = 0; w2 < wave; w2++) { pa += *(const f32x4*)(wtot + w2 * 8); pb += *(const f32x4*)(wtot + w2 * 8 + 4); }
#pragma unroll
    for (int j = 0; j < 16; j++) {
      const int p = p0 + j;
      if (j < ppt && p < npos) {
        float* d = cum + (krow0 + p) * 8;
        *(f32x4*)d = va[j] + pa; *(f32x4*)(d + 4) = vb[j] + pb;
      }
    }
  }
}

template <int EPI>
DI void gemm_phase(const Params& P, int l, const u16* __restrict__ A, int lda, const u16* __restrict__ Bt, int ldb, int K, int M, int N,
                   char* smem, int& rot) {
  constexpr int MI = 4;
  constexpr int STAGE = 32768;
  constexpr int NSLOT = SMEM_BYTES / STAGE;
  constexpr int DEPTH = NSLOT - 1;
  constexpr int GPS = 4;
  static_assert(NSLOT == 4, "ring waits are written for 4 slots");
  const int tid = get_tid(P.wv), wave = tid >> 6, lane = tid & 63, r = lane & 31, h = lane >> 5;
  const int wm = wave >> 2, wn = wave & 3;
  const int TM = M >> 8, TN = N >> 8;
  const int ntiles = TM * TN;
  const int G = get_nblk();
  const int bid = get_bid();
  const bool xmap = (G == 256);
  int t0, tstep;
  if (xmap) {
    const int nun = (ntiles + 31) >> 5;
    const int xs = (bid + 8 - (rot & 7)) & 7;
    t0 = xs * 32 + (bid >> 3); tstep = 256;
    rot += nun;
  } else {
    t0 = (bid + G - (rot % G)) % G; tstep = G;
    rot += ntiles;
  }
  const int nk = K >> 5;
  constexpr bool SPLITK = (EPI == EPI_RESID || EPI == EPI_RESID0);
  const bool sk = SPLITK && xmap && (TN == 4) && (((TM * nk) & 63) == 0);
  const int skS = (TM * nk) >> 6;
  const int sknt = (bid >> 3) & 3;
  const int p_begin = sk ? ((bid & 7) * 8 + (bid >> 5)) * skS : t0;
  const int p_end = sk ? p_begin + skS : ntiles;
  if (p_begin >= p_end) return;
  const int lrow = tid >> 2, lc = tid & 3;
  const int pc = (lc ^ ((tid >> 4) & 3)) * 8;
  const int sw = (r >> 2) & 3;
  const int xo0 = ((0 + h) ^ sw) * 16, xo1 = ((2 + h) ^ sw) * 16;
  const int aro = (wm * 128 + r) * 64, bro = 16384 + (wn * 64 + r) * 64;
  auto tile_of = [&](int t, int& m0, int& n0) { const int mt = t / TN; m0 = mt << 8; n0 = (t - mt * TN) << 8; };
  auto issue = [&](int m0, int n0, int ks, int slot) {
    const u16* ag = A + (size_t)(m0 + lrow) * lda + pc + ks * 32;
    const u16* bg = Bt + (size_t)(n0 + lrow) * ldb + pc + ks * 32;
    char* dst = smem + slot * STAGE + tid * 16;
#pragma unroll
    for (int i = 0; i < 2; i++)
      __builtin_amdgcn_global_load_lds((const unsigned*)(ag + (size_t)i * 128 * lda), (__attribute__((address_space(3))) unsigned*)(dst + i * 8192), 16, 0, 0);
#pragma unroll
    for (int i = 0; i < 2; i++)
      __builtin_amdgcn_global_load_lds((const unsigned*)(bg + (size_t)i * 128 * ldb), (__attribute__((address_space(3))) unsigned*)(dst + 16384 + i * 8192), 16, 0, 0);
  };
  auto unit_at = [&](int p, int& m0, int& n0, int& kb, int& nkk) {
    if (sk) { const int mt = p / nk; kb = p - mt * nk; const int rem = p_end - p; nkk = (nk - kb) < rem ? (nk - kb) : rem; m0 = mt << 8; n0 = sknt << 8; }
    else { tile_of(p, m0, n0); kb = 0; nkk = nk; }
  };
  int t = p_begin, m0, n0, kb, nkk;
  unit_at(t, m0, n0, kb, nkk);
  int ti = p_begin, ki = 0, mi0 = m0, ni0 = n0, kbi = kb, nki = nkk;
  bool idone = false;
  int pend = 0;
  unsigned g = 0;
  asm volatile("s_waitcnt vmcnt(0) lgkmcnt(0)" ::: "memory");
  __builtin_amdgcn_s_barrier();
#pragma unroll 1
  for (int s = 0; s < DEPTH; s++) {
    if (!idone) {
      issue(mi0, ni0, kbi + ki, (g + pend) % NSLOT);
      pend++;
      if (++ki == nki) { ki = 0; ti = sk ? ti + nki : ti + tstep; if (ti < p_end) unit_at(ti, mi0, ni0, kbi, nki); else idone = true; }
    }
  }
  while (true) {
    f32x16 acc[MI][2];
#pragma unroll
    for (int a = 0; a < MI; a++)
#pragma unroll
      for (int b = 0; b < 2; b++)
#pragma unroll
        for (int i = 0; i < 16; i++) acc[a][b][i] = 0.f;
    s16x8 a2[MI], b2, b3;
    {
      const s16x8 z = {0, 0, 0, 0, 0, 0, 0, 0};
#pragma unroll
      for (int i = 0; i < MI; i++) a2[i] = z;
      b2 = z; b3 = z;
    }
#pragma unroll 1
    for (int kt = 0; kt < nkk; kt++) {
      if (pend >= 3) asm volatile("s_waitcnt vmcnt(%0)" ::"n"(2 * GPS) : "memory");
      else if (pend == 2) asm volatile("s_waitcnt vmcnt(%0)" ::"n"(GPS) : "memory");
      else asm volatile("s_waitcnt vmcnt(0)" ::: "memory");
      asm volatile("" ::: "memory");
      __builtin_amdgcn_s_waitcnt(0xC07F);
      __builtin_amdgcn_s_barrier();
      asm volatile("" ::: "memory");
      if (!idone) {
        issue(mi0, ni0, kbi + ki, (g + pend) % NSLOT);
        if (++ki == nki) { ki = 0; ti = sk ? ti + nki : ti + tstep; if (ti < p_end) unit_at(ti, mi0, ni0, kbi, nki); else idone = true; }
      } else {
        pend--;
      }
      const char* sb = smem + (g % NSLOT) * STAGE;
      g++;
      s16x8 a[MI];
#pragma unroll
      for (int i = 0; i < MI; i++) a[i] = *(const s16x8*)(sb + aro + i * 32 * 64 + xo0);
      const s16x8 b0 = *(const s16x8*)(sb + bro + xo0);
      const s16x8 b1 = *(const s16x8*)(sb + bro + 32 * 64 + xo0);
      if (kt > 0) {
#pragma unroll
        for (int i = 0; i < MI; i++) { acc[i][0] = mfma(a2[i], b2, acc[i][0]); acc[i][1] = mfma(a2[i], b3, acc[i][1]); }
      }
#pragma unroll
      for (int i = 0; i < MI; i++) a2[i] = *(const s16x8*)(sb + aro + i * 32 * 64 + xo1);
      b2 = *(const s16x8*)(sb + bro + xo1);
      b3 = *(const s16x8*)(sb + bro + 32 * 64 + xo1);
#pragma unroll
      for (int i = 0; i < MI; i++) { acc[i][0] = mfma(a[i], b0, acc[i][0]); acc[i][1] = mfma(a[i], b1, acc[i][1]); }
    }
#pragma unroll
    for (int i = 0; i < MI; i++) { acc[i][0] = mfma(a2[i], b2, acc[i][0]); acc[i][1] = mfma(a2[i], b3, acc[i][1]); }
    epilogue<EPI, MI>(P, l, acc, m0 + wm * 128, n0 + wn * 64, r, h);
    t = sk ? t + nkk : t + tstep;
    if (t >= p_end) break;
    unit_at(t, m0, n0, kb, nkk);
  }
  asm volatile("s_waitcnt vmcnt(0) lgkmcnt(0)" ::: "memory");
}

DI int next_item(unsigned* ctr, char* smem, int wv) {
  volatile int* slot = (volatile int*)(smem + SMEM_BYTES - 16);
  __syncthreads();
  if (wv == 0 && lane_id() == 0) *slot = (int)__hip_atomic_fetch_add(ctr, 1u, __ATOMIC_RELAXED, __HIP_MEMORY_SCOPE_AGENT);
  __syncthreads();
  return *slot;
}

DI void phase_attn(const Params& P, int l, char* smem) {
  const u16* qf = (const u16*)(P.ws + WS_QF);
  const u16* fk = (const u16*)(P.ws + WS_FOXK);
  const u16* fv = (const u16*)(P.ws + WS_FOXV);
  const float* cum = (const float*)(P.ws + WS_CUM);
  const u16* qm = (const u16*)(P.ws + WS_R1 + R1_QM);
  const u16* kv = (const u16*)(P.ws + WS_R1 + R1_KV);
  const u16* krp = (const u16*)(P.ws + WS_KROPE);
  u16* mixed = (u16*)(P.ws + WS_ACTA);
  constexpr float LOG2E = 1.4426950408889634f;
  const int total = 384 + 16 * 96;
  unsigned* ctr = (unsigned*)(P.ws + WS_CTR) + (l * 2 + 0) * 64;
  for (int t = next_item(ctr, smem, P.wv); t < total; t = next_item(ctr, smem, P.wv)) {
    bool isfox, issample; int b, hd, qb = 0;
    if (t < 128) { isfox = false; issample = true; b = t >> 2; hd = t & 3; }
    else if (t < 384) { isfox = true; issample = true; const int u = t - 128; b = u >> 3; hd = u & 7; }
    else {
      const int u = t - 384; const int grp = u / 96; int w = u % 96; qb = 15 - grp; issample = false;
      if (w < 32) { isfox = false; b = w >> 2; hd = w & 3; }
      else { w -= 32; isfox = true; b = w >> 3; hd = w & 7; }
    }
    AttnJob J;
    J.wv = P.wv;
    size_t tok0, krow0;
    if (issample) { tok0 = (size_t)TP + (size_t)b * DS; krow0 = (size_t)TP + (size_t)b * SKS; J.nq = DS; J.Sk = SKS; J.qpos0 = PAST; }
    else { tok0 = (size_t)b * SEQ + (size_t)qb * 256; krow0 = (size_t)b * SEQ; J.nq = 256; J.Sk = SEQ; J.qpos0 = qb * 256; }
    if (isfox) {
      J.Q = qf + tok0 * 512 + hd * 64; J.ldq = 512;
      J.K1 = fk + krow0 * 512 + hd * 64; J.ldk1 = 512; J.K2 = J.K1; J.ldk2 = 512;
      J.V = fv + krow0 * 512 + hd * 64; J.ldv = 512;
      J.O = mixed + tok0 * 1024 + hd * 64; J.ldo = 1024;
      J.cq = cum + (krow0 + (size_t)J.qpos0) * 8 + hd;
      J.ck = cum + krow0 * 8 + hd;
      J.scale_log2 = 0.125f * LOG2E;
      attn_block<64, 64, 64, MASK_FRAME, true, FOX_PF, 512, 512, 512, 512, 1024, FOX_KT>(J, smem);
    } else {
      J.Q = qm + tok0 * 768 + hd * 192; J.ldq = 768;
      J.K1 = kv + krow0 * 1024 + hd * 256; J.ldk1 = 1024;
      J.K2 = krp + krow0 * 64; J.ldk2 = 64;
      J.V = kv + krow0 * 1024 + hd * 256 + 128; J.ldv = 1024;
      J.O = mixed + tok0 * 1024 + 512 + hd * 128; J.ldo = 1024;
      J.cq = nullptr; J.ck = nullptr;
      J.scale_log2 = 0.07216878364870322f * LOG2E;
      attn_block<192, 128, 128, MASK_CHUNK, false, MLA_PF, 768, 1024, 64, 1024, 1024, 64>(J, smem);
    }
  }
}

DI void phase_cross(const Params& P, int l, char* smem) {
  const u16* xq = (const u16*)(P.ws + WS_R1 + R1_XQ);
  const u16* mk = (const u16*)(P.ws + WS_MEMK) + (size_t)l * MB * NMEM * 1024;
  const u16* mv = (const u16*)(P.ws + WS_MEMV) + (size_t)l * MB * NMEM * 1024;
  u16* xo = (u16*)(P.ws + WS_ACTA);
  constexpr float LOG2E = 1.4426950408889634f;
  const int nsamp = DB * 4 * 2;
  const int total = nsamp + 128 * 4 * 2;
  unsigned* ctr = (unsigned*)(P.ws + WS_CTR) + (l * 2 + 1) * 64;
  for (int t = next_item(ctr, smem, P.wv); t < total; t = next_item(ctr, smem, P.wv)) {
    AttnJob J;
    J.wv = P.wv;
    size_t tok0; int mb, hd, half;
    if (t < nsamp) { const int b = t >> 3; hd = (t >> 1) & 3; half = t & 1; tok0 = (size_t)TP + (size_t)b * DS; mb = NB + b; J.nq = DS; }
    else { const int u = t - nsamp; const int qbk = u >> 3; hd = (u >> 1) & 3; half = u & 1; tok0 = (size_t)qbk * 256; mb = qbk >> 4; J.nq = 256; }
    J.Sk = NMEM; J.qpos0 = 0;
    J.Q = xq + tok0 * 1024 + hd * 256; J.ldq = 1024;
    J.K1 = mk + (size_t)mb * NMEM * 1024 + hd * 256; J.ldk1 = 1024; J.K2 = J.K1; J.ldk2 = 1024;
    J.V = mv + (size_t)mb * NMEM * 1024 + hd * 256 + half * 128; J.ldv = 1024;
    J.O = xo + tok0 * 1024 + hd * 256 + half * 128; J.ldo = 1024;
    J.cq = nullptr; J.ck = nullptr;
    J.scale_log2 = 0.0625f * LOG2E;
    attn_block<256, 256, 128, MASK_NONE, false, false, 1024, 1024, 1024, 1024, 1024, 64>(J, smem);
  }
}

#define XB_TMO      128
#define XB_XCNT(j)  (256  + 64 * (j))
#define XB_XSUB(j)  (1280 + 64 * (j))
#define XB_XGEN(j)  (2304 + 64 * (j))
#define XB_TOP      3328
#define XB_TOPGEN   3392
#define XCD_BAR_WORDS 3456
#define XB_SPIN_CAP (1u << 20)
DI unsigned xb_ld(unsigned* p) { return __hip_atomic_load(p, __ATOMIC_RELAXED, __HIP_MEMORY_SCOPE_AGENT); }
DI unsigned xb_add(unsigned* p, unsigned v) { return __hip_atomic_fetch_add(p, v, __ATOMIC_RELAXED, __HIP_MEMORY_SCOPE_AGENT); }
DI unsigned xb_xcc_id() { return (unsigned)__builtin_amdgcn_s_getreg((3 << 11) | 20) & 0xFu; }
#define XB_SPIN(cond, bar) do { unsigned _sp = 0; while (cond) { __builtin_amdgcn_s_sleep(1); \
    if ((++_sp & 255u) == 0u) { if (xb_ld(&(bar)[XB_TMO])) break; if (_sp > XB_SPIN_CAP) { atomicAdd(&(bar)[XB_TMO], 1u); break; } } } } while (0)
DI void xb_census(unsigned* bar, unsigned x, unsigned& nloc, unsigned& nx) {
  const unsigned G = gridDim.x;
  unsigned sum, cnt, mine, sp = 0u;
  for (;;) {
    sum = 0u; cnt = 0u; mine = 0u;
#pragma unroll
    for (unsigned j = 0; j < 16; ++j) { const unsigned c = xb_ld(&bar[XB_XCNT(j)]); sum += c; cnt += (c > 0u) ? 1u : 0u; mine = (j == x) ? c : mine; }
    if (sum == G) break;
    __builtin_amdgcn_s_sleep(1);
    if ((++sp & 255u) == 0u) { if (xb_ld(&bar[XB_TMO])) break; if (sp > XB_SPIN_CAP) { atomicAdd(&bar[XB_TMO], 1u); break; } }
  }
  nloc = mine > 0u ? mine : 1u; nx = cnt > 0u ? cnt : 1u;
}
DI void xcd_barrier(unsigned* bar, unsigned x, unsigned nloc, unsigned nx, int wv) {
  asm volatile("s_waitcnt vmcnt(0)" ::: "memory");
  __syncthreads();
  if (wv == 0 && lane_id() == 0) {
    __builtin_amdgcn_s_waitcnt(0);
    const unsigned old = xb_add(&bar[XB_XSUB(x)], 1u);
    const unsigned gen = old / nloc;
    if (old + 1u == (gen + 1u) * nloc) {
      __builtin_amdgcn_fence(__ATOMIC_RELEASE, "agent");
      asm volatile("s_waitcnt vmcnt(0)" ::: "memory");
      const unsigned og = xb_add(&bar[XB_TOP], 1u);
      const unsigned tg = og / nx;
      if (og + 1u == (tg + 1u) * nx) xb_add(&bar[XB_TOPGEN], 1u);
      else XB_SPIN(xb_ld(&bar[XB_TOPGEN]) == tg, bar);
      __builtin_amdgcn_fence(__ATOMIC_ACQUIRE, "agent");
      xb_add(&bar[XB_XGEN(x)], 1u);
      asm volatile("s_waitcnt vmcnt(0)" ::: "memory");
    } else {
      XB_SPIN(xb_ld(&bar[XB_XGEN(x)]) == gen, bar);
      __builtin_amdgcn_fence(__ATOMIC_ACQUIRE, "agent");
      asm volatile("s_waitcnt vmcnt(0)" ::: "memory");
    }
  }
  __syncthreads();
}

constexpr int NPHASE = 2 + 13 * NL;

DI void run_phase(const Params& P, int ph, char* smem, bool dup = false) {
  if (ph == 0) { phase_prep(P, smem); return; }
  if (ph == NPHASE - 1) { phase_final(P); return; }
  const int l = (ph - 1) / 13, k = (ph - 1) % 13;
  char* ws = P.ws;
  const u16* actA = (const u16*)(ws + WS_ACTA);
  int rot = 0;
  switch (k) {
    case 0: phase_norm(P, P.in[10] + l * 1024, l); break;
    case 1:
      gemm_phase<EPI_IN>(P, l, actA, 1024, wt_ptr(P, l, WE_IN), 1024, 1024, TT, INP, smem, rot);
      if (l == 0) {
        for (int l2 = 0; l2 < NL; l2++)
          gemm_phase<EPI_MEM>(P, l2, (const u16*)(ws + WS_HMEM) + (size_t)l2 * NB * NMEM * 1024, 1024, wt_ptr(P, l2, WE_MKV), 1024, 1024,
                              NB * NMEM, 2048, smem, rot);
      }
      break;
    case 2: phase_post(P, l, smem); break;
    case 3:
      gemm_phase<EPI_KV>(P, l, (const u16*)(ws + WS_CKV), 128, wt_ptr(P, l, WE_UKV), 128, 128, KROWS, 1024, smem, rot);
      gemm_phase<EPI_UQ>(P, l, (const u16*)(ws + WS_CQN), 256, wt_ptr(P, l, WE_UQ), 256, 256, TT, 768, smem, rot);
      break;
    case 4: phase_attn(P, l, smem); break;
    case 5: if (dup) gemm_phase<EPI_RESID0>(P, l, actA, 1024, wt_ptr(P, l, WE_OUT), 1024, 1024, TT, 1024, smem, rot); else gemm_phase<EPI_RESID>(P, l, actA, 1024, wt_ptr(P, l, WE_OUT), 1024, 1024, TT, 1024, smem, rot); break;
    case 6: phase_norm(P, P.in[18] + l * 1024, -1); break;
    case 7: gemm_phase<EPI_XQ>(P, l, actA, 1024, wt_ptr(P, l, WE_XQ), 1024, 1024, TT, 1024, smem, rot); break;
    case 8: phase_cross(P, l, smem); break;
    case 9: if (dup) gemm_phase<EPI_RESID0>(P, l, actA, 1024, wt_ptr(P, l, WE_XO), 1024, 1024, TT, 1024, smem, rot); else gemm_phase<EPI_RESID>(P, l, actA, 1024, wt_ptr(P, l, WE_XO), 1024, 1024, TT, 1024, smem, rot); break;
    case 10: phase_norm(P, P.in[24] + l * 1024, -1); break;
    case 11: gemm_phase<EPI_UP>(P, l, actA, 1024, wt_ptr(P, l, WE_UP), 1024, 1024, TT, DFF, smem, rot); break;
    case 12: if (dup) gemm_phase<EPI_RESID0>(P, l, (const u16*)(ws + WS_R1 + R1_U), DFF, wt_ptr(P, l, WE_DN), DFF, DFF, TT, 1024, smem, rot); else gemm_phase<EPI_RESID>(P, l, (const u16*)(ws + WS_R1 + R1_U), DFF, wt_ptr(P, l, WE_DN), DFF, DFF, TT, 1024, smem, rot); break;
  }
}

__global__ void __launch_bounds__(NTHR) mega(Params P, int ph_lo, int ph_hi) {
  extern __shared__ __attribute__((aligned(16))) char smem[];
  cg::grid_group grid = cg::this_grid();
  if (ph_hi > 4096) grid.sync();
  unsigned* bar = (unsigned*)(P.ws + WS_BAR);
  const unsigned xb_x = xb_xcc_id();
  unsigned xb_nloc = 1u, xb_nx = 1u;
  if (threadIdx.x == 0) { (void)xb_add(&bar[XB_XCNT(xb_x)], 1u); xb_census(bar, xb_x, xb_nloc, xb_nx); }
  xb_nloc = __builtin_amdgcn_readfirstlane(xb_nloc);
  xb_nx = __builtin_amdgcn_readfirstlane(xb_nx);
  unsigned xb_pack = xb_nloc | (xb_nx << 16) | (xb_x << 24) | ((unsigned)__builtin_amdgcn_readfirstlane(threadIdx.x >> 6) << 28);
  asm volatile("" : "+s"(xb_pack));
  for (int ph = ph_lo; ph < ph_hi; ph++) {
    Params Q = P;
    unsigned pk = xb_pack;
    asm volatile("" : "+s"(Q.out), "+s"(Q.ws), "+s"(pk));
    Q.wv = (int)(pk >> 28);
    run_phase(Q, ph, smem);
    if (ph + 1 < ph_hi) {
      unsigned pk2 = xb_pack;
      asm volatile("" : "+s"(pk2));
      xcd_barrier((unsigned*)(Q.ws + WS_BAR), (pk2 >> 24) & 0xfu, pk2 & 0xffffu, (pk2 >> 16) & 0xffu, (int)(pk2 >> 28));
    }
  }
}

extern "C" void kernel_launch(void* const* d_in, const int* in_sizes, int n_in, void* d_out, int out_size, void* d_ws,
                              size_t ws_size, hipStream_t stream) {
  static int grid_blocks = 0;
  if (!grid_blocks) {
    int dev = 0, cus = 0, per_cu = 0;
    hipGetDevice(&dev);
    hipDeviceGetAttribute(&cus, hipDeviceAttributeMultiprocessorCount, dev);
    hipFuncSetAttribute((const void*)mega, hipFuncAttributeMaxDynamicSharedMemorySize, SMEM_BYTES);
    hipOccupancyMaxActiveBlocksPerMultiprocessor(&per_cu, mega, NTHR, SMEM_BYTES);
    per_cu = 1;
    grid_blocks = cus * per_cu;
  }
  if (n_in != 28 || (size_t)out_size != O_END || ws_size < WS_END) {
    fprintf(stderr, "kernel_launch: shape/ws mismatch n_in %d out %d (want %zu) ws %zu (want %zu)\n", n_in, out_size, (size_t)O_END, ws_size, (size_t)WS_END);
    return;
  }
  Params p;
  memset(&p, 0, sizeof(p));
  for (int i = 0; i < 28; i++) p.in[i] = (const float*)d_in[i];
  p.out = (float*)d_out;
  p.ws = (char*)d_ws;
  hipMemsetAsync((char*)d_ws + WS_BAR, 0, XCD_BAR_WORDS * 4 + 4 * 256, stream);
  int lo = 0, hi = NPHASE;
  void* args[] = {&p, &lo, &hi};
  hipError_t e = hipLaunchCooperativeKernel((void*)mega, dim3(grid_blocks), dim3(NTHR), args, SMEM_BYTES, stream);
  if (e != hipSuccess) fprintf(stderr, "cooperative launch failed: %s (grid %d)\n", hipGetErrorString(e), grid_blocks);
}
```

```cpp
#include <hip/hip_runtime.h>
#include <hip/hip_cooperative_groups.h>
#include <stdint.h>
#include <string.h>
#include <stdio.h>
namespace cg = cooperative_groups;

#ifndef COOP
#define COOP 1
#endif

#ifndef FOX_KT
#define FOX_KT 128
#endif
#ifndef FOX_PF
#define FOX_PF true
#endif
#ifndef MLA_PF
#define MLA_PF true
#endif
#ifndef LB_MIN
#define LB_MIN 2
#endif
#ifndef BM_BIG
#define BM_BIG 256
#endif
constexpr int NTHR = 512, NWV = 8;
#define DI __device__ __forceinline__
typedef unsigned short u16;
typedef short s16x8 __attribute__((ext_vector_type(8)));
typedef short s16x4 __attribute__((ext_vector_type(4)));
typedef __bf16 bfx8 __attribute__((ext_vector_type(8)));
typedef __bf16 bfx2 __attribute__((ext_vector_type(2)));
typedef float f32x16 __attribute__((ext_vector_type(16)));
typedef float f32x4 __attribute__((ext_vector_type(4)));
typedef float f32x2 __attribute__((ext_vector_type(2)));
typedef unsigned u32x4 __attribute__((ext_vector_type(4)));
typedef unsigned u32x2 __attribute__((ext_vector_type(2)));

constexpr int DM = 1024, NB = 8, SEQ = 4096, NL = 2, DB = 32, DS = 32, PAST = 2048;
constexpr int TP = NB * SEQ;
constexpr int TS = DB * DS;
constexpr int TT = TP + TS;
constexpr int SKS = PAST + DS;
constexpr int KROWS = TP + DB * SKS;
constexpr int INC = 1992, INP = 2048;
constexpr int NMEM = 256, MB = NB + DB;
constexpr int DFF = 4096;

constexpr size_t O_Y = 0;
constexpr size_t O_FKP = (size_t)TT * DM;
constexpr size_t O_FVP = O_FKP + (size_t)NL * TP * 512;
constexpr size_t O_FLP = O_FVP + (size_t)NL * TP * 512;
constexpr size_t O_CKP = O_FLP + (size_t)NL * TP * 8;
constexpr size_t O_KRP = O_CKP + (size_t)NL * TP * 128;
constexpr size_t O_MKP = O_KRP + (size_t)NL * TP * 64;
constexpr size_t O_MVP = O_MKP + (size_t)NL * NB * NMEM * 1024;
constexpr size_t O_FKS = O_MVP + (size_t)NL * NB * NMEM * 1024;
constexpr size_t O_FVS = O_FKS + (size_t)NL * TS * 512;
constexpr size_t O_FLS = O_FVS + (size_t)NL * TS * 512;
constexpr size_t O_CKS = O_FLS + (size_t)NL * TS * 8;
constexpr size_t O_KRS = O_CKS + (size_t)NL * TS * 128;
constexpr size_t O_END = O_KRS + (size_t)NL * TS * 64;

constexpr size_t al256(size_t x) { return (x + 255) / 256 * 256; }
constexpr size_t WE_IN = 0;
constexpr size_t WE_UQ = WE_IN + (size_t)INP * 1024;
constexpr size_t WE_UKV = WE_UQ + (size_t)768 * 256;
constexpr size_t WE_OUT = WE_UKV + (size_t)1024 * 128;
constexpr size_t WE_XQ = WE_OUT + (size_t)1024 * 1024;
constexpr size_t WE_MKV = WE_XQ + (size_t)1024 * 1024;
constexpr size_t WE_XO = WE_MKV + (size_t)2048 * 1024;
constexpr size_t WE_UP = WE_XO + (size_t)1024 * 1024;
constexpr size_t WE_DN = WE_UP + (size_t)4096 * 1024;
constexpr size_t WE_LAYER = WE_DN + (size_t)1024 * 4096;
constexpr size_t WS_WT = 0;
constexpr size_t WS_ROPE = al256(WS_WT + WE_LAYER * 2 * NL);
constexpr size_t WS_ACTA = al256(WS_ROPE + (size_t)4096 * 32 * 8);
constexpr size_t WS_QF = al256(WS_ACTA + (size_t)TT * 1024 * 2);
constexpr size_t WS_FOXK = al256(WS_QF + (size_t)TT * 512 * 2);
constexpr size_t WS_FOXV = al256(WS_FOXK + (size_t)KROWS * 512 * 2);
constexpr size_t WS_CUM = al256(WS_FOXV + (size_t)KROWS * 512 * 2);
constexpr size_t WS_ZC = al256(WS_CUM + (size_t)KROWS * 8 * 4);
constexpr size_t WS_CQN = al256(WS_ZC + (size_t)TT * 448 * 4);
constexpr size_t WS_CKV = al256(WS_CQN + (size_t)TT * 256 * 2);
constexpr size_t WS_KROPE = al256(WS_CKV + (size_t)KROWS * 128 * 2);
constexpr size_t WS_MEMK = al256(WS_KROPE + (size_t)KROWS * 64 * 2);
constexpr size_t WS_MEMV = al256(WS_MEMK + (size_t)NL * MB * NMEM * 1024 * 2);
constexpr size_t WS_HMEM = al256(WS_MEMV + (size_t)NL * MB * NMEM * 1024 * 2);
constexpr size_t WS_R1 = al256(WS_HMEM + (size_t)NL * NB * NMEM * 1024 * 2);
constexpr size_t R1_KV = 0;
constexpr size_t R1_QM = al256((size_t)KROWS * 1024 * 2);
constexpr size_t R1_U = 0;
constexpr size_t R1_XQ = 0;
constexpr size_t WS_BAR = al256(WS_R1 + (size_t)TT * 4096 * 2);
constexpr size_t WS_CTR = WS_BAR + 3456 * 4;
constexpr size_t WS_END = al256(WS_CTR + 4 * 256);
static_assert(R1_QM + (size_t)TT * 768 * 2 <= (size_t)TT * 4096 * 2, "R1 overflow");

constexpr int SMEM_BYTES = 131072;

struct Params {
  const float* in[28];
  float* out;
  char* ws;
  int wv;
  int pad;
};

DI int get_bid() { int t = blockIdx.x; asm volatile("" : "+s"(t)); return t; }
DI int get_nblk() { int t = gridDim.x; asm volatile("" : "+s"(t)); return t; }
DI int lane_id() { return (int)__builtin_amdgcn_mbcnt_hi(~0u, __builtin_amdgcn_mbcnt_lo(~0u, 0u)); }
DI int get_tid(int wv) { int t = (wv << 6) | lane_id(); asm volatile("" : "+v"(t)); return t; }
DI unsigned pk2(float a, float b) { f32x2 v = {a, b}; return __builtin_bit_cast(unsigned, __builtin_convertvector(v, bfx2)); }
DI u16 f2bf(float a) { return (u16)(pk2(a, 0.f) & 0xffffu); }
DI f32x16 mfma(s16x8 a, s16x8 b, f32x16 c) {
  return __builtin_amdgcn_mfma_f32_32x32x16_bf16(__builtin_bit_cast(bfx8, a), __builtin_bit_cast(bfx8, b), c, 0, 0, 0);
}
DI int crow(int i, int h) { return (i & 3) + 8 * (i >> 2) + 4 * h; }
DI float wave_sum(float v) {
#pragma unroll
  for (int m = 32; m >= 1; m >>= 1) v += __shfl_xor(v, m);
  return v;
}
DI float xhalf_max(float v) {
  auto rr = __builtin_amdgcn_permlane32_swap(__float_as_uint(v), __float_as_uint(v), false, false);
  return fmaxf(__uint_as_float(rr[0]), __uint_as_float(rr[1]));
}
DI float xhalf_sum(float v) {
  auto rr = __builtin_amdgcn_permlane32_swap(__float_as_uint(v), __float_as_uint(v), false, false);
  return __uint_as_float(rr[0]) + __uint_as_float(rr[1]);
}
DI int tok_krow(int tok) {
  if (tok < TP) return tok;
  const int s = tok - TP;
  return TP + (s >> 5) * SKS + PAST + (s & 31);
}
DI int tok_pos(int tok) { return tok < TP ? (tok & (SEQ - 1)) : PAST + ((tok - TP) & 31); }

enum { EPI_IN = 0, EPI_MEM, EPI_UQ, EPI_KV, EPI_RESID, EPI_XQ, EPI_UP, EPI_RESID0 };

template <int EPI, int MI>
DI void epilogue(const Params& P, int l, f32x16 (&acc)[MI][2], int mw, int nw, int r, int h) {
  float* out = P.out;
  char* ws = P.ws;
  if constexpr (EPI == EPI_IN) {
    u16* qf = (u16*)(ws + WS_QF);
    u16* fk = (u16*)(ws + WS_FOXK);
    u16* fv = (u16*)(ws + WS_FOXV);
    float* zc = (float*)(ws + WS_ZC);
    const float* bfg = P.in[12] + l * 8;
#pragma unroll
    for (int mi = 0; mi < MI; mi++) {
#pragma unroll
      for (int i = 0; i < 16; i++) {
        const int row = mw + mi * 32 + crow(i, h);
        const int kr = tok_krow(row);
        const bool isp = row < TP;
        const size_t orow = isp ? ((size_t)l * TP + row) : ((size_t)l * TS + (row - TP));
#pragma unroll
        for (int ni = 0; ni < 2; ni++) {
          const int col = nw + ni * 32 + r;
          const float v = acc[mi][ni][i];
          if (col < 512) {
            qf[(size_t)row * 512 + col] = f2bf(v);
          } else if (col < 1024) {
            const int c = col - 512;
            out[(isp ? O_FKP : O_FKS) + orow * 512 + c] = v;
            fk[(size_t)kr * 512 + c] = f2bf(v);
          } else if (col < 1536) {
            const int c = col - 1024;
            out[(isp ? O_FVP : O_FVS) + orow * 512 + c] = v;
            fv[(size_t)kr * 512 + c] = f2bf(v);
          } else if (col < 1544) {
            const int c = col - 1536;
            const float g = v + bfg[c];
            const float ls = fminf(g, 0.f) - __logf(1.f + __expf(-fabsf(g)));
            out[(isp ? O_FLP : O_FLS) + orow * 8 + c] = ls;
          } else if (col < INC) {
            zc[(size_t)row * 448 + (col - 1544)] = v;
          }
        }
      }
    }
  } else if constexpr (EPI == EPI_MEM) {
    u16* mk = (u16*)(ws + WS_MEMK);
    u16* mv = (u16*)(ws + WS_MEMV);
#pragma unroll
    for (int mi = 0; mi < MI; mi++) {
#pragma unroll
      for (int i = 0; i < 16; i++) {
        const int row = mw + mi * 32 + crow(i, h);
#pragma unroll
        for (int ni = 0; ni < 2; ni++) {
          const int col = nw + ni * 32 + r;
          const float v = acc[mi][ni][i];
          const int c = col & 1023;
          const size_t oidx = ((size_t)l * (NB * NMEM) + row) * 1024 + c;
          const size_t bidx = ((size_t)l * (MB * NMEM) + row) * 1024 + c;
          if (col < 1024) { out[O_MKP + oidx] = v; mk[bidx] = f2bf(v); }
          else { out[O_MVP + oidx] = v; mv[bidx] = f2bf(v); }
        }
      }
    }
  } else if constexpr (EPI == EPI_UQ) {
    u16* qm = (u16*)(ws + WS_R1 + R1_QM);
    const f32x2* rt = (const f32x2*)(ws + WS_ROPE);
    const bool isrope = (nw % 192) == 128;
#pragma unroll
    for (int mi = 0; mi < MI; mi++) {
#pragma unroll
      for (int i = 0; i < 16; i++) {
        const int row = mw + mi * 32 + crow(i, h);
        float x1 = acc[mi][0][i], x2 = acc[mi][1][i];
        if (isrope) {
          const f32x2 cs = rt[tok_pos(row) * 32 + r];
          const float o1 = x1 * cs[0] - x2 * cs[1];
          const float o2 = x2 * cs[0] + x1 * cs[1];
          x1 = o1; x2 = o2;
        }
        qm[(size_t)row * 768 + nw + r] = f2bf(x1);
        qm[(size_t)row * 768 + nw + 32 + r] = f2bf(x2);
      }
    }
  } else if constexpr (EPI == EPI_KV || EPI == EPI_XQ || EPI == EPI_UP) {
    u16* dst; int ld;
    if constexpr (EPI == EPI_KV) { dst = (u16*)(ws + WS_R1 + R1_KV); ld = 1024; }
    else if constexpr (EPI == EPI_XQ) { dst = (u16*)(ws + WS_R1 + R1_XQ); ld = 1024; }
    else { dst = (u16*)(ws + WS_R1 + R1_U); ld = DFF; }
    const bool odd = r & 1;
    const int colb = nw + (r & ~1);
#pragma unroll
    for (int mi = 0; mi < MI; mi++) {
#pragma unroll
      for (int i = 0; i < 16; i += 2) {
        const int row = mw + mi * 32 + crow(i, h) + (odd ? 1 : 0);
#pragma unroll
        for (int ni = 0; ni < 2; ni++) {
          float v0 = acc[mi][ni][i], v1 = acc[mi][ni][i + 1];
          if constexpr (EPI == EPI_UP) { v0 = fmaxf(v0, 0.f); v0 = v0 * v0; v1 = fmaxf(v1, 0.f); v1 = v1 * v1; }
          const float send = odd ? v0 : v1;
          const float recv = __int_as_float(__builtin_amdgcn_mov_dpp(__float_as_int(send), 0xB1, 0xF, 0xF, true));
          const unsigned w = odd ? pk2(recv, v1) : pk2(v0, recv);
          *(unsigned*)(dst + (size_t)row * ld + colb + ni * 32) = w;
        }
      }
    }
  } else if constexpr (EPI == EPI_RESID || EPI == EPI_RESID0) {
#pragma unroll
    for (int mi = 0; mi < MI; mi++) {
#pragma unroll
      for (int i = 0; i < 16; i++) {
        const int row = mw + mi * 32 + crow(i, h);
#pragma unroll
        for (int ni = 0; ni < 2; ni++) {
          unsafeAtomicAdd(out + (size_t)row * DM + nw + ni * 32 + r, EPI == EPI_RESID0 ? acc[mi][ni][i] * 0.f : acc[mi][ni][i]);
        }
      }
    }
  }
}

enum { MASK_NONE = 0, MASK_FRAME = 1, MASK_CHUNK = 2 };
struct AttnJob {
  const u16* Q; int ldq;
  const u16* K1; int ldk1;
  const u16* K2; int ldk2;
  const u16* V; int ldv;
  u16* O; int ldo;
  const float* cq;
  const float* ck;
  int nq, Sk, qpos0;
  float scale_log2;
  int wv;
};

template <int DQK, int D1, int DVT, int MASK, bool BIAS, bool PREFETCH, int LDQ, int LDK1, int LDK2, int LDV, int LDO, int KT, bool KSPLIT = false>
DI void attn_block(const AttnJob& J, char* smem) {
  constexpr int KP = DQK * 2 + 16;
  constexpr int VP = DVT * 2;
  constexpr int CV = DVT / 8;
  constexpr int NKK = DQK / 16, NDV = DVT / 32;
  constexpr float LOG2E = 1.4426950408889634f;
  char* Ks = smem;
  char* Vs = smem + KT * KP;
  float* cks = (float*)(smem + KT * KP + KT * VP);
  const int tid = get_tid(J.wv), wave = tid >> 6, lane = tid & 63, r = lane & 31, h = lane >> 5;
  const int wq0 = KSPLIT ? 0 : wave * 32;
  const bool active = wq0 < J.nq;
  const int qi = wq0 + r;
  const int qpos = J.qpos0 + qi;
  const int wqmax = J.qpos0 + wq0 + 31;
  const int qmax = J.qpos0 + J.nq - 1;
  const int ntk = (J.Sk + KT - 1) / KT;
  int nt = ntk;
  if (MASK != MASK_NONE) { const int t2 = qmax / KT + 1; nt = t2 < ntk ? t2 : ntk; }

  s16x8 qf[NKK];
  {
    const u16* qp = J.Q + (size_t)qi * LDQ + h * 8;
#pragma unroll
    for (int kk = 0; kk < NKK; kk++) {
      if (active) qf[kk] = *(const s16x8*)(qp + kk * 16);
      else { s16x8 z = {0, 0, 0, 0, 0, 0, 0, 0}; qf[kk] = z; }
    }
  }

  f32x16 o[NDV];
#pragma unroll
  for (int d = 0; d < NDV; d++)
#pragma unroll
    for (int i = 0; i < 16; i++) o[d][i] = 0.f;
  float m_run = -1e30f, l_run = 0.f;

  constexpr int CK1 = D1 / 8, CK2 = (DQK - D1) / 8;
  constexpr int RP1 = NTHR / CK1, NP1 = KT / RP1;
  constexpr int RP2 = CK2 ? NTHR / (CK2 ? CK2 : 1) : 64, NP2 = CK2 ? KT / RP2 : 0;
  constexpr int RPV = NTHR / CV, NPV = KT / RPV;
  u32x4 rk1[NP1], rk2[NP2 ? NP2 : 1], rv[NPV];
  float rck = 0.f;
  const int tq = (lane & 15) >> 2, tp = lane & 3, tblk = (lane >> 4) & 1;
  const int vswz = (DVT >= 128) ? tq : (tq >> 1);
  const int r1 = tid / CK1, c1 = tid % CK1;
  const int r2 = CK2 ? tid / (CK2 ? CK2 : 1) : 0, c2 = CK2 ? tid % (CK2 ? CK2 : 1) : 0;
  const int r3 = tid / CV, c3 = tid % CV;
  const unsigned k1o = (unsigned)(r1 * LDK1 + c1 * 8) * 2u;
  const unsigned k2o = (unsigned)(r2 * LDK2 + c2 * 8) * 2u;
  const unsigned vo = (unsigned)(r3 * LDV + c3 * 8) * 2u;
  const int k1so = r1 * KP + c1 * 16;
  const int k2so = r2 * KP + D1 * 2 + c2 * 16;
  const int vsw = (DVT >= 128) ? (r3 & 3) : ((r3 >> 1) & 1);
  const int vso = KT * KP + r3 * VP + (((c3 >> 2) ^ vsw) * 64) + (c3 & 3) * 16;
  const int vro = KT * KP + (4 * h + tq) * VP + (16 * tblk + 4 * tp) * 2;
  const int kro = r * KP + h * 16;

  auto load_tile = [&](int j) {
    const int kb = j * KT;
#pragma unroll
    for (int i = 0; i < NP1; i++) {
      u32x4 v = {0u, 0u, 0u, 0u};
      if (kb + r1 + i * RP1 < J.Sk) v = *(const u32x4*)((const char*)(J.K1 + (size_t)(kb + i * RP1) * LDK1) + k1o);
      rk1[i] = v;
    }
#pragma unroll
    for (int i = 0; i < NP2; i++) {
      u32x4 v = {0u, 0u, 0u, 0u};
      if (kb + r2 + i * RP2 < J.Sk) v = *(const u32x4*)((const char*)(J.K2 + (size_t)(kb + i * RP2) * LDK2) + k2o);
      rk2[i] = v;
    }
#pragma unroll
    for (int i = 0; i < NPV; i++) {
      u32x4 v = {0u, 0u, 0u, 0u};
      if (kb + r3 + i * RPV < J.Sk) v = *(const u32x4*)((const char*)(J.V + (size_t)(kb + i * RPV) * LDV) + vo);
      rv[i] = v;
    }
    if (BIAS) {
      if (tid < KT) { const int key = kb + tid; rck = key < J.Sk ? -J.ck[(size_t)key * 8] * LOG2E : 0.f; }
    }
  };
  auto store_tile = [&]() {
    int a1 = k1so, a2 = k2so, a3 = vso;
    asm volatile("" : "+v"(a1), "+v"(a2), "+v"(a3));
#pragma unroll
    for (int i = 0; i < NP1; i++) *(u32x4*)(smem + a1 + i * RP1 * KP) = rk1[i];
#pragma unroll
    for (int i = 0; i < NP2; i++) *(u32x4*)(smem + a2 + i * RP2 * KP) = rk2[i];
#pragma unroll
    for (int i = 0; i < NPV; i++) *(u32x4*)(smem + a3 + i * RPV * VP) = rv[i];
    if (BIAS) { if (tid < KT) cks[tid] = rck; }
  };

  if (PREFETCH) load_tile(0);
  for (int j = 0; j < nt; j++) {
    __syncthreads();
    if (!PREFETCH) load_tile(j);
    store_tile();
    __syncthreads();
    if (PREFETCH) { if (j + 1 < nt) load_tile(j + 1); }
    const bool need = active && (MASK == MASK_NONE || j * KT <= wqmax);
    if (need) {
      int kro_l = kro, vro_l = vro;
      asm volatile("" : "+v"(kro_l), "+v"(vro_l));
      const char* krd = smem + kro_l;
      const bool needmask = (MASK == MASK_FRAME && j * KT + KT - 1 > J.qpos0 + wq0) || (j * KT + KT - 1 >= J.Sk);
      const int dq = (MASK == MASK_FRAME ? min(qpos, J.Sk - 1) : J.Sk - 1) - j * KT - 4 * h;
#pragma unroll
      for (int hb = 0; hb < KT / 32; hb++) {
        if (KSPLIT && hb != J.wv) continue;
        if (MASK == MASK_FRAME && j * KT + hb * 32 > wqmax) continue;
        f32x16 p;
#pragma unroll
        for (int i = 0; i < 16; i++) p[i] = 0.f;
#pragma unroll
        for (int kk = 0; kk < NKK; kk++) {
          const s16x8 kf = *(const s16x8*)(krd + hb * 32 * KP + kk * 32);
          p = mfma(kf, qf[kk], p);
        }
        if (BIAS) {
#pragma unroll
          for (int g = 0; g < 4; g++) {
            const f32x4 c0 = *(const f32x4*)(cks + hb * 32 + 8 * g + 4 * h);
#pragma unroll
            for (int e = 0; e < 4; e++) p[4 * g + e] = fmaf(p[4 * g + e], J.scale_log2, c0[e]);
          }
        } else {
#pragma unroll
          for (int i = 0; i < 16; i++) p[i] *= J.scale_log2;
        }
        if (needmask) {
#pragma unroll
          for (int i = 0; i < 16; i++) {
            const int cc = (i & 3) + 8 * (i >> 2) + 32 * hb;
            p[i] = (cc <= dq) ? p[i] : -1e30f;
          }
        }
        float mx = p[0];
#pragma unroll
        for (int i = 1; i < 16; i++) mx = fmaxf(mx, p[i]);
        mx = xhalf_max(mx);
        if (__any(mx > m_run + 8.f)) {
          const float m_new = fmaxf(m_run, mx);
          const float alpha = __builtin_amdgcn_exp2f(m_run - m_new);
          m_run = m_new;
          l_run *= alpha;
#pragma unroll
          for (int d = 0; d < NDV; d++)
#pragma unroll
            for (int i = 0; i < 16; i++) o[d][i] *= alpha;
        }
        float ps = 0.f;
#pragma unroll
        for (int i = 0; i < 16; i++) { p[i] = __builtin_amdgcn_exp2f(p[i] - m_run); ps += p[i]; }
        l_run += ps;
        s16x8 pb[2];
        {
          u32x4 w;
          w[0] = pk2(p[0], p[1]); w[1] = pk2(p[2], p[3]); w[2] = pk2(p[4], p[5]); w[3] = pk2(p[6], p[7]);
          pb[0] = __builtin_bit_cast(s16x8, w);
          w[0] = pk2(p[8], p[9]); w[1] = pk2(p[10], p[11]); w[2] = pk2(p[12], p[13]); w[3] = pk2(p[14], p[15]);
          pb[1] = __builtin_bit_cast(s16x8, w);
        }
#pragma unroll
        for (int d = 0; d < NDV; d++) {
          const char* vb = smem + (vro_l + ((d ^ vswz) * 64)) + hb * 32 * VP;
#pragma unroll
          for (int s = 0; s < 2; s++) {
            const s16x4 lo = __builtin_amdgcn_ds_read_tr16_b64_v4i16(
                (__attribute__((address_space(3))) s16x4*)(uintptr_t)(vb + (16 * s) * VP));
            const s16x4 hi = __builtin_amdgcn_ds_read_tr16_b64_v4i16(
                (__attribute__((address_space(3))) s16x4*)(uintptr_t)(vb + (16 * s + 8) * VP));
            const s16x8 vf = __builtin_shufflevector(lo, hi, 0, 1, 2, 3, 4, 5, 6, 7);
            o[d] = mfma(vf, pb[s], o[d]);
          }
        }
      }
    }
  }
  float lt = xhalf_sum(l_run);
  bool writer = active && qi < J.nq;
  if (KSPLIT) {
    constexpr int NWS = KT / 32;
    constexpr int NV = NDV * 16 + 2;
    float* mb = (float*)smem;
    __syncthreads();
    if (wave < NWS) {
      float* w = mb + (size_t)wave * NV * 64 + lane;
#pragma unroll
      for (int d = 0; d < NDV; d++)
#pragma unroll
        for (int i = 0; i < 16; i++) w[(d * 16 + i) * 64] = o[d][i];
      w[(NDV * 16) * 64] = m_run;
      w[(NDV * 16 + 1) * 64] = lt;
    }
    __syncthreads();
    writer = writer && (wave == 0);
    if (wave == 0) {
      float M = -1e30f;
#pragma unroll
      for (int w2 = 0; w2 < NWS; w2++) M = fmaxf(M, mb[((size_t)w2 * NV + NDV * 16) * 64 + lane]);
      float L = 0.f;
#pragma unroll
      for (int d = 0; d < NDV; d++)
#pragma unroll
        for (int i = 0; i < 16; i++) o[d][i] = 0.f;
#pragma unroll 1
      for (int w2 = 0; w2 < NWS; w2++) {
        const float* rsrc = mb + (size_t)w2 * NV * 64 + lane;
        const float sc = __builtin_amdgcn_exp2f(rsrc[(NDV * 16) * 64] - M);
        L += rsrc[(NDV * 16 + 1) * 64] * sc;
#pragma unroll
        for (int d = 0; d < NDV; d++)
#pragma unroll
          for (int i = 0; i < 16; i++) o[d][i] += rsrc[(d * 16 + i) * 64] * sc;
      }
      lt = L;
    }
  }
  if (writer) {
    const float inv = 1.f / lt;
    u16* op = J.O + (size_t)qi * LDO + 4 * h;
#pragma unroll
    for (int d = 0; d < NDV; d++) {
#pragma unroll
      for (int g = 0; g < 4; g++) {
        u32x2 w;
        w[0] = pk2(o[d][4 * g] * inv, o[d][4 * g + 1] * inv);
        w[1] = pk2(o[d][4 * g + 2] * inv, o[d][4 * g + 3] * inv);
        *(u32x2*)(op + d * 32 + 8 * g) = w;
      }
    }
  }
}

template <int NR, bool F32OUT>
DI void rms_rows(const float* __restrict__ xbase, size_t rstride, int nvalid, const float* __restrict__ g, void* dbase, size_t dstride, int lane) {
  f32x4 v[NR][4];
#pragma unroll
  for (int j = 0; j < NR; j++)
#pragma unroll
    for (int i = 0; i < 4; i++) {
      if (j < nvalid) v[j][i] = *(const f32x4*)(xbase + (size_t)j * rstride + i * 256 + lane * 4);
      else { f32x4 z = {0.f, 0.f, 0.f, 0.f}; v[j][i] = z; }
    }
  f32x4 gg[4];
#pragma unroll
  for (int i = 0; i < 4; i++) gg[i] = *(const f32x4*)(g + i * 256 + lane * 4);
#pragma unroll
  for (int j = 0; j < NR; j++) {
    float ss = 0.f;
#pragma unroll
    for (int i = 0; i < 4; i++) ss += v[j][i][0] * v[j][i][0] + v[j][i][1] * v[j][i][1] + v[j][i][2] * v[j][i][2] + v[j][i][3] * v[j][i][3];
    ss = wave_sum(ss);
    const float rs = rsqrtf(ss * (1.f / 1024.f) + 1e-6f);
    if (j < nvalid) {
#pragma unroll
      for (int i = 0; i < 4; i++) {
        if (F32OUT) {
          f32x4 w;
          w[0] = v[j][i][0] * rs * gg[i][0]; w[1] = v[j][i][1] * rs * gg[i][1]; w[2] = v[j][i][2] * rs * gg[i][2]; w[3] = v[j][i][3] * rs * gg[i][3];
          *(f32x4*)((float*)dbase + (size_t)j * dstride + i * 256 + lane * 4) = w;
        } else {
          u32x2 w;
          w[0] = pk2(v[j][i][0] * rs * gg[i][0], v[j][i][1] * rs * gg[i][1]);
          w[1] = pk2(v[j][i][2] * rs * gg[i][2], v[j][i][3] * rs * gg[i][3]);
          *(u32x2*)((u16*)dbase + (size_t)j * dstride + i * 256 + lane * 4) = w;
        }
      }
    }
  }
}

DI void cvt_job(const float* __restrict__ src, u16* __restrict__ dst, int nseg, size_t seglen, size_t sstride, size_t dstride, int wv) {
  const size_t upseg = seglen / 8;
  const size_t total = upseg * nseg;
  const size_t stride = (size_t)get_nblk() * NTHR;
  for (size_t u0 = (size_t)get_bid() * NTHR + get_tid(wv); u0 < total; u0 += 4 * stride) {
    f32x4 a[4], b[4];
    size_t so[4], dd[4];
#pragma unroll
    for (int q = 0; q < 4; q++) {
      const size_t u = u0 + q * stride;
      const size_t uu = u < total ? u : u0;
      const size_t sg = uu / upseg, off = (uu - sg * upseg) * 8;
      so[q] = sg * sstride + off; dd[q] = sg * dstride + off;
      a[q] = *(const f32x4*)(src + so[q]);
      b[q] = *(const f32x4*)(src + so[q] + 4);
    }
#pragma unroll
    for (int q = 0; q < 4; q++) {
      if (u0 + q * stride < total) {
        u32x4 w;
        w[0] = pk2(a[q][0], a[q][1]); w[1] = pk2(a[q][2], a[q][3]); w[2] = pk2(b[q][0], b[q][1]); w[3] = pk2(b[q][2], b[q][3]);
        *(u32x4*)(dst + dd[q]) = w;
      }
    }
  }
}

DI void transpose_job(const float* __restrict__ src, u16* __restrict__ dst, int K, int N, int Npad, int& rot, char* smem, int wv) {
  float* tile = (float*)smem;
  const int tk = K / 64, tn = Npad / 64, ntiles = tk * tn;
  const int G = get_nblk();
  const int tid = get_tid(wv);
  for (int t = (get_bid() + G - (rot % G)) % G; t < ntiles; t += G) {
    const int k0 = (t % tk) * 64, n0 = (t / tk) * 64;
    float v[8];
#pragma unroll
    for (int i = 0; i < 8; i++) {
      const int k = i * 8 + (tid >> 6), n = tid & 63;
      v[i] = (n0 + n < N) ? src[(size_t)(k0 + k) * N + n0 + n] : 0.f;
    }
    __syncthreads();
#pragma unroll
    for (int i = 0; i < 8; i++) {
      const int k = i * 8 + (tid >> 6), n = tid & 63;
      tile[k * 65 + n] = v[i];
    }
    __syncthreads();
#pragma unroll
    for (int i = 0; i < 4; i++) {
      const int n = i * 16 + (tid >> 5), k = (tid & 31) * 2;
      *(unsigned*)(dst + (size_t)(n0 + n) * K + k0 + k) = pk2(tile[k * 65 + n], tile[(k + 1) * 65 + n]);
    }
  }
  rot += ntiles;
}

DI u16* wt_ptr(const Params& P, int l, size_t eoff) { return (u16*)(P.ws + WS_WT) + (size_t)l * WE_LAYER + eoff; }

DI void phase_prep(const Params& P, char* smem) {
  const int tid = get_tid(P.wv), lane = tid & 63;
  const int gw = get_bid() * NWV + (tid >> 6), nw = get_nblk() * NWV;
  int rot = 0;
  for (int l = 0; l < NL; l++) {
    transpose_job(P.in[11] + (size_t)l * 1024 * INC, wt_ptr(P, l, WE_IN), 1024, INC, INP, rot, smem, P.wv);
    transpose_job(P.in[14] + (size_t)l * 256 * 768, wt_ptr(P, l, WE_UQ), 256, 768, 768, rot, smem, P.wv);
    transpose_job(P.in[16] + (size_t)l * 128 * 1024, wt_ptr(P, l, WE_UKV), 128, 1024, 1024, rot, smem, P.wv);
    transpose_job(P.in[17] + (size_t)l * 1024 * 1024, wt_ptr(P, l, WE_OUT), 1024, 1024, 1024, rot, smem, P.wv);
    transpose_job(P.in[20] + (size_t)l * 1024 * 1024, wt_ptr(P, l, WE_XQ), 1024, 1024, 1024, rot, smem, P.wv);
    transpose_job(P.in[21] + (size_t)l * 1024 * 1024, wt_ptr(P, l, WE_MKV), 1024, 1024, 1024, rot, smem, P.wv);
    transpose_job(P.in[22] + (size_t)l * 1024 * 1024, wt_ptr(P, l, WE_MKV) + (size_t)1024 * 1024, 1024, 1024, 1024, rot, smem, P.wv);
    transpose_job(P.in[23] + (size_t)l * 1024 * 1024, wt_ptr(P, l, WE_XO), 1024, 1024, 1024, rot, smem, P.wv);
    transpose_job(P.in[25] + (size_t)l * 1024 * 4096, wt_ptr(P, l, WE_UP), 1024, 4096, 4096, rot, smem, P.wv);
    transpose_job(P.in[26] + (size_t)l * 4096 * 1024, wt_ptr(P, l, WE_DN), 4096, 1024, 1024, rot, smem, P.wv);
  }
  {
    f32x2* rt = (f32x2*)(P.ws + WS_ROPE);
    for (int i = get_bid() * NTHR + tid; i < 4096 * 32; i += get_nblk() * NTHR) {
      const int pos = i >> 5, j = i & 31;
      const float inv = powf(10000.f, -(float)j / 32.f);
      const float ang = (float)pos * inv;
      f32x2 cs; cs[0] = cosf(ang); cs[1] = sinf(ang);
      rt[i] = cs;
    }
  }
  for (int l = 0; l < NL; l++) {
    const size_t seg = (size_t)DB * NMEM * 1024;
    cvt_job(P.in[8] + l * seg, (u16*)(P.ws + WS_MEMK) + ((size_t)l * MB + NB) * NMEM * 1024, 1, seg, 0, 0, P.wv);
    cvt_job(P.in[9] + l * seg, (u16*)(P.ws + WS_MEMV) + ((size_t)l * MB + NB) * NMEM * 1024, 1, seg, 0, 0, P.wv);
  }
  for (int rr = gw; rr < NL * NB * NMEM; rr += nw) {
    const int l = rr / (NB * NMEM), row = rr % (NB * NMEM);
    rms_rows<1, false>(P.in[2] + (size_t)row * 1024, 0, 1, P.in[19] + l * 1024, (u16*)(P.ws + WS_HMEM) + (size_t)rr * 1024, 0, lane);
  }
  {
    const size_t n4 = (size_t)TT * 256;
    const size_t np4 = (size_t)TP * 256;
    const size_t stride = (size_t)get_nblk() * NTHR;
    for (size_t i0 = (size_t)get_bid() * NTHR + tid; i0 < n4; i0 += 4 * stride) {
      f32x4 v[4];
#pragma unroll
      for (int q = 0; q < 4; q++) {
        const size_t i = i0 + q * stride;
        const size_t ii = i < n4 ? i : i0;
        v[q] = (ii < np4) ? *(const f32x4*)(P.in[0] + ii * 4) : *(const f32x4*)(P.in[1] + (ii - np4) * 4);
      }
#pragma unroll
      for (int q = 0; q < 4; q++) {
        const size_t i = i0 + q * stride;
        if (i < n4) *(f32x4*)(P.out + i * 4) = v[q];
      }
    }
  }
}

DI void phase_norm(const Params& P, const float* g, int cache_layer) {
  const int tid = get_tid(P.wv), lane = tid & 63;
  const int gw = get_bid() * NWV + (tid >> 6), nw = get_nblk() * NWV;
  u16* h = (u16*)(P.ws + WS_ACTA);
  for (int row = gw; row < TT; row += 4 * nw) {
    const int nv = (TT - row + nw - 1) / nw;
    rms_rows<4, false>(P.out + (size_t)row * 1024, (size_t)nw * 1024, nv < 4 ? nv : 4, g, h + (size_t)row * 1024, (size_t)nw * 1024, lane);
  }
  if (cache_layer >= 0) {
    const int l = cache_layer;
    cvt_job(P.in[3] + (size_t)l * DB * PAST * 512, (u16*)(P.ws + WS_FOXK) + (size_t)TP * 512, DB, (size_t)PAST * 512, (size_t)PAST * 512, (size_t)SKS * 512, P.wv);
    cvt_job(P.in[4] + (size_t)l * DB * PAST * 512, (u16*)(P.ws + WS_FOXV) + (size_t)TP * 512, DB, (size_t)PAST * 512, (size_t)PAST * 512, (size_t)SKS * 512, P.wv);
    cvt_job(P.in[6] + (size_t)l * DB * PAST * 128, (u16*)(P.ws + WS_CKV) + (size_t)TP * 128, DB, (size_t)PAST * 128, (size_t)PAST * 128, (size_t)SKS * 128, P.wv);
    cvt_job(P.in[7] + (size_t)l * DB * PAST * 64, (u16*)(P.ws + WS_KROPE) + (size_t)TP * 64, DB, (size_t)PAST * 64, (size_t)PAST * 64, (size_t)SKS * 64, P.wv);
  }
}

DI void phase_final(const Params& P) {
  const int tid = get_tid(P.wv), lane = tid & 63;
  const int gw = get_bid() * NWV + (tid >> 6), nw = get_nblk() * NWV;
  const float* g = P.in[27];
  for (int row = gw; row < TT; row += 4 * nw) {
    const int nv = (TT - row + nw - 1) / nw;
    rms_rows<4, true>(P.out + (size_t)row * 1024, (size_t)nw * 1024, nv < 4 ? nv : 4, g, P.out + (size_t)row * 1024, (size_t)nw * 1024, lane);
  }
}

DI void phase_post(const Params& P, int l, char* smem) {
  const int tid = get_tid(P.wv), lane = tid & 63;
  const int gw = get_bid() * NWV + (tid >> 6), nw = get_nblk() * NWV;
  const float* zc = (const float*)(P.ws + WS_ZC);
  u16* cqn = (u16*)(P.ws + WS_CQN);
  u16* ckv = (u16*)(P.ws + WS_CKV);
  u16* krp = (u16*)(P.ws + WS_KROPE);
  const f32x2* rt = (const f32x2*)(P.ws + WS_ROPE);
  const float* gq = P.in[13] + l * 256;
  const float* gkv = P.in[15] + l * 128;
  for (int tok0 = gw; tok0 < TT; tok0 += 4 * nw) {
    f32x4 vq[4]; f32x2 vk[4]; float vr[4];
#pragma unroll
    for (int j = 0; j < 4; j++) {
      const int tk = tok0 + j * nw;
      const float* z = zc + (size_t)(tk < TT ? tk : tok0) * 448;
      vq[j] = *(const f32x4*)(z + lane * 4);
      vk[j] = *(const f32x2*)(z + 256 + lane * 2);
      vr[j] = z[384 + lane];
    }
    const f32x4 ggq = *(const f32x4*)(gq + lane * 4);
    const f32x2 ggk = *(const f32x2*)(gkv + lane * 2);
#pragma unroll
    for (int j = 0; j < 4; j++) {
      const int tok = tok0 + j * nw;
      if (tok >= TT) break;
      const bool isp = tok < TP;
      const size_t orow = isp ? ((size_t)l * TP + tok) : ((size_t)l * TS + (tok - TP));
      const int kr = tok_krow(tok);
      {
        const f32x4 v = vq[j];
        const float ss = wave_sum(v[0] * v[0] + v[1] * v[1] + v[2] * v[2] + v[3] * v[3]);
        const float rs = rsqrtf(ss * (1.f / 256.f) + 1e-6f);
        u32x2 w;
        w[0] = pk2(v[0] * rs * ggq[0], v[1] * rs * ggq[1]);
        w[1] = pk2(v[2] * rs * ggq[2], v[3] * rs * ggq[3]);
        *(u32x2*)(cqn + (size_t)tok * 256 + lane * 4) = w;
      }
      {
        const f32x2 v = vk[j];
        const float ss = wave_sum(v[0] * v[0] + v[1] * v[1]);
        const float rs = rsqrtf(ss * (1.f / 128.f) + 1e-6f);
        f32x2 o; o[0] = v[0] * rs * ggk[0]; o[1] = v[1] * rs * ggk[1];
        *(f32x2*)(P.out + (isp ? O_CKP : O_CKS) + orow * 128 + lane * 2) = o;
        *(unsigned*)(ckv + (size_t)kr * 128 + lane * 2) = pk2(o[0], o[1]);
      }
      {
        const float x = vr[j];
        const float y = __shfl_xor(x, 32);
        const f32x2 cs = rt[tok_pos(tok) * 32 + (lane & 31)];
        const float o = (lane < 32) ? (x * cs[0] - y * cs[1]) : (x * cs[0] + y * cs[1]);
        P.out[(isp ? O_KRP : O_KRS) + orow * 64 + lane] = o;
        krp[(size_t)kr * 64 + lane] = f2bf(o);
      }
    }
  }
  float* cum = (float*)(P.ws + WS_CUM);
  float* wtot = (float*)smem;
  const int wave = tid >> 6;
  for (int it = get_bid(); it < NB + DB; it += get_nblk()) {
    const bool isp = it < NB;
    const int b = isp ? it : it - NB;
    const int ppt = isp ? 16 : 9;
    const int npos = isp ? SEQ : SKS;
    const float* srcA; const float* srcB; int nA;
    size_t krow0;
    if (isp) { srcA = P.out + O_FLP + ((size_t)l * TP + (size_t)b * SEQ) * 8; srcB = srcA; nA = SEQ; krow0 = (size_t)b * SEQ; }
    else {
      srcA = P.in[5] + ((size_t)l * DB + b) * PAST * 8;
      srcB = P.out + O_FLS + ((size_t)l * TS + (size_t)b * DS) * 8 - (size_t)PAST * 8;
      nA = PAST; krow0 = (size_t)TP + (size_t)b * SKS;
    }
    const int p0 = tid * ppt;
    f32x4 va[16], vb[16];
#pragma unroll
    for (int j = 0; j < 16; j++) {
      const int p = p0 + j;
      f32x4 z = {0.f, 0.f, 0.f, 0.f};
      va[j] = z; vb[j] = z;
      if (j < ppt && p < npos) {
        const float* s = (p < nA ? srcA : srcB) + (size_t)p * 8;
        va[j] = *(const f32x4*)s; vb[j] = *(const f32x4*)(s + 4);
      }
    }
#pragma unroll
    for (int j = 1; j < 16; j++) { va[j] += va[j - 1]; vb[j] += vb[j - 1]; }
    f32x4 ta = va[15], tb = vb[15];
#pragma unroll
    for (int d = 1; d < 64; d <<= 1) {
#pragma unroll
      for (int e = 0; e < 4; e++) {
        const float ua = __shfl_up(ta[e], d), ub = __shfl_up(tb[e], d);
        if (lane >= d) { ta[e] += ua; tb[e] += ub; }
      }
    }
    __syncthreads();
    if (lane == 63) { *(f32x4*)(wtot + wave * 8) = ta; *(f32x4*)(wtot + wave * 8 + 4) = tb; }
    __syncthreads();
    f32x4 pa = ta - va[15], pb = tb - vb[15];
    for (int w2 = 0; w2 < wave; w2++) { pa += *(const f32x4*)(wtot + w2 * 8); pb += *(const f32x4*)(wtot + w2 * 8 + 4); }
#pragma unroll
    for (int j = 0; j < 16; j++) {
      const int p = p0 + j;
      if (j < ppt && p < npos) {
        float* d = cum + (krow0 + p) * 8;
        *(f32x4*)d = va[j] + pa; *(f32x4*)(d + 4) = vb[j] + pb;
      }
    }
  }
}

template <int EPI>
DI void gemm_phase(const Params& P, int l, const u16* __restrict__ A, int lda, const u16* __restrict__ Bt, int ldb, int K, int M, int N,
                   char* smem, int& rot) {
  constexpr int MI = 4;
  constexpr int STAGE = 32768;
  constexpr int NSLOT = SMEM_BYTES / STAGE;
  constexpr int DEPTH = NSLOT - 1;
  constexpr int GPS = 4;
  static_assert(NSLOT == 4, "ring waits are written for 4 slots");
  const int tid = get_tid(P.wv), wave = tid >> 6, lane = tid & 63, r = lane & 31, h = lane >> 5;
  const int wm = wave >> 2, wn = wave & 3;
  const int TM = M >> 8, TN = N >> 8;
  const int ntiles = TM * TN;
  const int G = get_nblk();
  const int bid = get_bid();
  const bool xmap = (G == 256);
  int t0, tstep;
  if (xmap) {
    const int nun = (ntiles + 31) >> 5;
    const int xs = (bid + 8 - (rot & 7)) & 7;
    t0 = xs * 32 + (bid >> 3); tstep = 256;
    rot += nun;
  } else {
    t0 = (bid + G - (rot % G)) % G; tstep = G;
    rot += ntiles;
  }
  const int nk = K >> 5;
  constexpr bool SPLITK = (EPI == EPI_RESID || EPI == EPI_RESID0);
  const bool sk = SPLITK && xmap && (TN == 4) && (((TM * nk) & 63) == 0);
  const int skS = (TM * nk) >> 6;
  const int sknt = (bid >> 3) & 3;
  const int p_begin = sk ? ((bid & 7) * 8 + (bid >> 5)) * skS : t0;
  const int p_end = sk ? p_begin + skS : ntiles;
  if (p_begin >= p_end) return;
  const int lrow = tid >> 2, lc = tid & 3;
  const int pc = (lc ^ ((tid >> 4) & 3)) * 8;
  const int sw = (r >> 2) & 3;
  const int xo0 = ((0 + h) ^ sw) * 16, xo1 = ((2 + h) ^ sw) * 16;
  const int aro = (wm * 128 + r) * 64, bro = 16384 + (wn * 64 + r) * 64;
  auto tile_of = [&](int t, int& m0, int& n0) { const int mt = t / TN; m0 = mt << 8; n0 = (t - mt * TN) << 8; };
  auto issue = [&](int m0, int n0, int ks, int slot) {
    const u16* ag = A + (size_t)(m0 + lrow) * lda + pc + ks * 32;
    const u16* bg = Bt + (size_t)(n0 + lrow) * ldb + pc + ks * 32;
    char* dst = smem + slot * STAGE + tid * 16;
#pragma unroll
    for (int i = 0; i < 2; i++)
      __builtin_amdgcn_global_load_lds((const unsigned*)(ag + (size_t)i * 128 * lda), (__attribute__((address_space(3))) unsigned*)(dst + i * 8192), 16, 0, 0);
#pragma unroll
    for (int i = 0; i < 2; i++)
      __builtin_amdgcn_global_load_lds((const unsigned*)(bg + (size_t)i * 128 * ldb), (__attribute__((address_space(3))) unsigned*)(dst + 16384 + i * 8192), 16, 0, 0);
  };
  auto unit_at = [&](int p, int& m0, int& n0, int& kb, int& nkk) {
    if (sk) { const int mt = p / nk; kb = p - mt * nk; const int rem = p_end - p; nkk = (nk - kb) < rem ? (nk - kb) : rem; m0 = mt << 8; n0 = sknt << 8; }
    else { tile_of(p, m0, n0); kb = 0; nkk = nk; }
  };
  int t = p_begin, m0, n0, kb, nkk;
  unit_at(t, m0, n0, kb, nkk);
  int ti = p_begin, ki = 0, mi0 = m0, ni0 = n0, kbi = kb, nki = nkk;
  bool idone = false;
  int pend = 0;
  unsigned g = 0;
  asm volatile("s_waitcnt vmcnt(0) lgkmcnt(0)" ::: "memory");
  __builtin_amdgcn_s_barrier();
#pragma unroll 1
  for (int s = 0; s < DEPTH; s++) {
    if (!idone) {
      issue(mi0, ni0, kbi + ki, (g + pend) % NSLOT);
      pend++;
      if (++ki == nki) { ki = 0; ti = sk ? ti + nki : ti + tstep; if (ti < p_end) unit_at(ti, mi0, ni0, kbi, nki); else idone = true; }
    }
  }
  while (true) {
    f32x16 acc[MI][2];
#pragma unroll
    for (int a = 0; a < MI; a++)
#pragma unroll
      for (int b = 0; b < 2; b++)
#pragma unroll
        for (int i = 0; i < 16; i++) acc[a][b][i] = 0.f;
    s16x8 a2[MI], b2, b3;
    {
      const s16x8 z = {0, 0, 0, 0, 0, 0, 0, 0};
#pragma unroll
      for (int i = 0; i < MI; i++) a2[i] = z;
      b2 = z; b3 = z;
    }
#pragma unroll 1
    for (int kt = 0; kt < nkk; kt++) {
      if (pend >= 3) asm volatile("s_waitcnt vmcnt(%0)" ::"n"(2 * GPS) : "memory");
      else if (pend == 2) asm volatile("s_waitcnt vmcnt(%0)" ::"n"(GPS) : "memory");
      else asm volatile("s_waitcnt vmcnt(0)" ::: "memory");
      asm volatile("" ::: "memory");
      __builtin_amdgcn_s_waitcnt(0xC07F);
      __builtin_amdgcn_s_barrier();
      asm volatile("" ::: "memory");
      if (!idone) {
        issue(mi0, ni0, kbi + ki, (g + pend) % NSLOT);
        if (++ki == nki) { ki = 0; ti = sk ? ti + nki : ti + tstep; if (ti < p_end) unit_at(ti, mi0, ni0, kbi, nki); else idone = true; }
      } else {
        pend--;
      }
      const char* sb = smem + (g % NSLOT) * STAGE;
      g++;
      s16x8 a[MI];
#pragma unroll
      for (int i = 0; i < MI; i++) a[i] = *(const s16x8*)(sb + aro + i * 32 * 64 + xo0);
      const s16x8 b0 = *(const s16x8*)(sb + bro + xo0);
      const s16x8 b1 = *(const s16x8*)(sb + bro + 32 * 64 + xo0);
      if (kt > 0) {
#pragma unroll
        for (int i = 0; i < MI; i++) { acc[i][0] = mfma(a2[i], b2, acc[i][0]); acc[i][1] = mfma(a2[i], b3, acc[i][1]); }
      }
#pragma unroll
      for (int i = 0; i < MI; i++) a2[i] = *(const s16x8*)(sb + aro + i * 32 * 64 + xo1);
      b2 = *(const s16x8*)(sb + bro + xo1);
      b3 = *(const s16x8*)(sb + bro + 32 * 64 + xo1);
#pragma unroll
      for (int i = 0; i < MI; i++) { acc[i][0] = mfma(a[i], b0, acc[i][0]); acc[i][1] = mfma(a[i], b1, acc[i][1]); }
    }
#pragma unroll
    for (int i = 0; i < MI; i++) { acc[i][0] = mfma(a2[i], b2, acc[i][0]); acc[i][1] = mfma(a2[i], b3, acc[i][1]); }
    epilogue<EPI, MI>(P, l, acc, m0 + wm * 128, n0 + wn * 64, r, h);
    t = sk ? t + nkk : t + tstep;
    if (t >= p_end) break;
    unit_at(t, m0, n0, kb, nkk);
  }
  asm volatile("s_waitcnt vmcnt(0) lgkmcnt(0)" ::: "memory");
}

DI int next_item(unsigned* ctr, char* smem, int wv) {
  volatile int* slot = (volatile int*)(smem + SMEM_BYTES - 16);
  __syncthreads();
  if (wv == 0 && lane_id() == 0) *slot = (int)__hip_atomic_fetch_add(ctr, 1u, __ATOMIC_RELAXED, __HIP_MEMORY_SCOPE_AGENT);
  __syncthreads();
  return *slot;
}

DI void phase_attn(const Params& P, int l, char* smem) {
  const u16* qf = (const u16*)(P.ws + WS_QF);
  const u16* fk = (const u16*)(P.ws + WS_FOXK);
  const u16* fv = (const u16*)(P.ws + WS_FOXV);
  const float* cum = (const float*)(P.ws + WS_CUM);
  const u16* qm = (const u16*)(P.ws + WS_R1 + R1_QM);
  const u16* kv = (const u16*)(P.ws + WS_R1 + R1_KV);
  const u16* krp = (const u16*)(P.ws + WS_KROPE);
  u16* mixed = (u16*)(P.ws + WS_ACTA);
  constexpr float LOG2E = 1.4426950408889634f;
  const int total = 384 + 16 * 96;
  unsigned* ctr = (unsigned*)(P.ws + WS_CTR) + (l * 2 + 0) * 64;
  for (int t = next_item(ctr, smem, P.wv); t < total; t = next_item(ctr, smem, P.wv)) {
    bool isfox, issample; int b, hd, qb = 0;
    if (t < 128) { isfox = false; issample = true; b = t >> 2; hd = t & 3; }
    else if (t < 384) { isfox = true; issample = true; const int u = t - 128; b = u >> 3; hd = u & 7; }
    else {
      const int u = t - 384; const int grp = u / 96; int w = u % 96; qb = 15 - grp; issample = false;
      if (w < 32) { isfox = false; b = w >> 2; hd = w & 3; }
      else { w -= 32; isfox = true; b = w >> 3; hd = w & 7; }
    }
    AttnJob J;
    J.wv = P.wv;
    size_t tok0, krow0;
    if (issample) { tok0 = (size_t)TP + (size_t)b * DS; krow0 = (size_t)TP + (size_t)b * SKS; J.nq = DS; J.Sk = SKS; J.qpos0 = PAST; }
    else { tok0 = (size_t)b * SEQ + (size_t)qb * 256; krow0 = (size_t)b * SEQ; J.nq = 256; J.Sk = SEQ; J.qpos0 = qb * 256; }
    if (isfox) {
      J.Q = qf + tok0 * 512 + hd * 64; J.ldq = 512;
      J.K1 = fk + krow0 * 512 + hd * 64; J.ldk1 = 512; J.K2 = J.K1; J.ldk2 = 512;
      J.V = fv + krow0 * 512 + hd * 64; J.ldv = 512;
      J.O = mixed + tok0 * 1024 + hd * 64; J.ldo = 1024;
      J.cq = cum + (krow0 + (size_t)J.qpos0) * 8 + hd;
      J.ck = cum + krow0 * 8 + hd;
      J.scale_log2 = 0.125f * LOG2E;
      if (issample) attn_block<64, 64, 64, MASK_FRAME, true, FOX_PF, 512, 512, 512, 512, 1024, 256, true>(J, smem);
      else attn_block<64, 64, 64, MASK_FRAME, true, FOX_PF, 512, 512, 512, 512, 1024, FOX_KT>(J, smem);
    } else {
      J.Q = qm + tok0 * 768 + hd * 192; J.ldq = 768;
      J.K1 = kv + krow0 * 1024 + hd * 256; J.ldk1 = 1024;
      J.K2 = krp + krow0 * 64; J.ldk2 = 64;
      J.V = kv + krow0 * 1024 + hd * 256 + 128; J.ldv = 1024;
      J.O = mixed + tok0 * 1024 + 512 + hd * 128; J.ldo = 1024;
      J.cq = nullptr; J.ck = nullptr;
      J.scale_log2 = 0.07216878364870322f * LOG2E;
      if (issample) attn_block<192, 128, 128, MASK_CHUNK, false, MLA_PF, 768, 1024, 64, 1024, 1024, 128, true>(J, smem);
      else attn_block<192, 128, 128, MASK_CHUNK, false, MLA_PF, 768, 1024, 64, 1024, 1024, 64>(J, smem);
    }
  }
}

DI void phase_cross(const Params& P, int l, char* smem) {
  const u16* xq = (const u16*)(P.ws + WS_R1 + R1_XQ);
  const u16* mk = (const u16*)(P.ws + WS_MEMK) + (size_t)l * MB * NMEM * 1024;
  const u16* mv = (const u16*)(P.ws + WS_MEMV) + (size_t)l * MB * NMEM * 1024;
  u16* xo = (u16*)(P.ws + WS_ACTA);
  constexpr float LOG2E = 1.4426950408889634f;
  const int nsamp = DB * 4 * 2;
  const int total = nsamp + 128 * 4 * 2;
  unsigned* ctr = (unsigned*)(P.ws + WS_CTR) + (l * 2 + 1) * 64;
  for (int t = next_item(ctr, smem, P.wv); t < total; t = next_item(ctr, smem, P.wv)) {
    AttnJob J;
    J.wv = P.wv;
    size_t tok0; int mb, hd, half;
    if (t < nsamp) { const int b = t >> 3; hd = (t >> 1) & 3; half = t & 1; tok0 = (size_t)TP + (size_t)b * DS; mb = NB + b; J.nq = DS; }
    else { const int u = t - nsamp; const int qbk = u >> 3; hd = (u >> 1) & 3; half = u & 1; tok0 = (size_t)qbk * 256; mb = qbk >> 4; J.nq = 256; }
    J.Sk = NMEM; J.qpos0 = 0;
    J.Q = xq + tok0 * 1024 + hd * 256; J.ldq = 1024;
    J.K1 = mk + (size_t)mb * NMEM * 1024 + hd * 256; J.ldk1 = 1024; J.K2 = J.K1; J.ldk2 = 1024;
    J.V = mv + (size_t)mb * NMEM * 1024 + hd * 256 + half * 128; J.ldv = 1024;
    J.O = xo + tok0 * 1024 + hd * 256 + half * 128; J.ldo = 1024;
    J.cq = nullptr; J.ck = nullptr;
    J.scale_log2 = 0.0625f * LOG2E;
    attn_block<256, 256, 128, MASK_NONE, false, false, 1024, 1024, 1024, 1024, 1024, 64>(J, smem);
  }
}

#define XB_TMO      128
#define XB_XCNT(j)  (256  + 64 * (j))
#define XB_XSUB(j)  (1280 + 64 * (j))
#define XB_XGEN(j)  (2304 + 64 * (j))
#define XB_TOP      3328
#define XB_TOPGEN   3392
#define XCD_BAR_WORDS 3456
#define XB_SPIN_CAP (1u << 20)
DI unsigned xb_ld(unsigned* p) { return __hip_atomic_load(p, __ATOMIC_RELAXED, __HIP_MEMORY_SCOPE_AGENT); }
DI unsigned xb_add(unsigned* p, unsigned v) { return __hip_atomic_fetch_add(p, v, __ATOMIC_RELAXED, __HIP_MEMORY_SCOPE_AGENT); }
DI unsigned xb_xcc_id() { return (unsigned)__builtin_amdgcn_s_getreg((3 << 11) | 20) & 0xFu; }
#define XB_SPIN(cond, bar) do { unsigned _sp = 0; while (cond) { __builtin_amdgcn_s_sleep(1); \
    if ((++_sp & 255u) == 0u) { if (xb_ld(&(bar)[XB_TMO])) break; if (_sp > XB_SPIN_CAP) { atomicAdd(&(bar)[XB_TMO], 1u); break; } } } } while (0)
DI void xb_census(unsigned* bar, unsigned x, unsigned& nloc, unsigned& nx) {
  const unsigned G = gridDim.x;
  unsigned sum, cnt, mine, sp = 0u;
  for (;;) {
    sum = 0u; cnt = 0u; mine = 0u;
#pragma unroll
    for (unsigned j = 0; j < 16; ++j) { const unsigned c = xb_ld(&bar[XB_XCNT(j)]); sum += c; cnt += (c > 0u) ? 1u : 0u; mine = (j == x) ? c : mine; }
    if (sum == G) break;
    __builtin_amdgcn_s_sleep(1);
    if ((++sp & 255u) == 0u) { if (xb_ld(&bar[XB_TMO])) break; if (sp > XB_SPIN_CAP) { atomicAdd(&bar[XB_TMO], 1u); break; } }
  }
  nloc = mine > 0u ? mine : 1u; nx = cnt > 0u ? cnt : 1u;
}
DI void xcd_barrier(unsigned* bar, unsigned x, unsigned nloc, unsigned nx, int wv) {
  asm volatile("s_waitcnt vmcnt(0)" ::: "memory");
  __syncthreads();
  if (wv == 0 && lane_id() == 0) {
    __builtin_amdgcn_s_waitcnt(0);
    const unsigned old = xb_add(&bar[XB_XSUB(x)], 1u);
    const unsigned gen = old / nloc;
    if (old + 1u == (gen + 1u) * nloc) {
      __builtin_amdgcn_fence(__ATOMIC_RELEASE, "agent");
      asm volatile("s_waitcnt vmcnt(0)" ::: "memory");
      const unsigned og = xb_add(&bar[XB_TOP], 1u);
      const unsigned tg = og / nx;
      if (og + 1u == (tg + 1u) * nx) xb_add(&bar[XB_TOPGEN], 1u);
      else XB_SPIN(xb_ld(&bar[XB_TOPGEN]) == tg, bar);
      __builtin_amdgcn_fence(__ATOMIC_ACQUIRE, "agent");
      xb_add(&bar[XB_XGEN(x)], 1u);
      asm volatile("s_waitcnt vmcnt(0)" ::: "memory");
    } else {
      XB_SPIN(xb_ld(&bar[XB_XGEN(x)]) == gen, bar);
      __builtin_amdgcn_fence(__ATOMIC_ACQUIRE, "agent");
      asm volatile("s_waitcnt vmcnt(0)" ::: "memory");
    }
  }
  __syncthreads();
}

constexpr int NPHASE = 2 + 13 * NL;

DI void run_phase(const Params& P, int ph, char* smem, bool dup = false) {
  if (ph == 0) { phase_prep(P, smem); return; }
  if (ph == NPHASE - 1) { phase_final(P); return; }
  const int l = (ph - 1) / 13, k = (ph - 1) % 13;
  char* ws = P.ws;
  const u16* actA = (const u16*)(ws + WS_ACTA);
  int rot = 0;
  switch (k) {
    case 0: phase_norm(P, P.in[10] + l * 1024, l); break;
    case 1:
      gemm_phase<EPI_IN>(P, l, actA, 1024, wt_ptr(P, l, WE_IN), 1024, 1024, TT, INP, smem, rot);
      if (l == 0) {
        for (int l2 = 0; l2 < NL; l2++)
          gemm_phase<EPI_MEM>(P, l2, (const u16*)(ws + WS_HMEM) + (size_t)l2 * NB * NMEM * 1024, 1024, wt_ptr(P, l2, WE_MKV), 1024, 1024,
                              NB * NMEM, 2048, smem, rot);
      }
      break;
    case 2: phase_post(P, l, smem); break;
    case 3:
      gemm_phase<EPI_KV>(P, l, (const u16*)(ws + WS_CKV), 128, wt_ptr(P, l, WE_UKV), 128, 128, KROWS, 1024, smem, rot);
      gemm_phase<EPI_UQ>(P, l, (const u16*)(ws + WS_CQN), 256, wt_ptr(P, l, WE_UQ), 256, 256, TT, 768, smem, rot);
      break;
    case 4: phase_attn(P, l, smem); break;
    case 5: if (dup) gemm_phase<EPI_RESID0>(P, l, actA, 1024, wt_ptr(P, l, WE_OUT), 1024, 1024, TT, 1024, smem, rot); else gemm_phase<EPI_RESID>(P, l, actA, 1024, wt_ptr(P, l, WE_OUT), 1024, 1024, TT, 1024, smem, rot); break;
    case 6: phase_norm(P, P.in[18] + l * 1024, -1); break;
    case 7: gemm_phase<EPI_XQ>(P, l, actA, 1024, wt_ptr(P, l, WE_XQ), 1024, 1024, TT, 1024, smem, rot); break;
    case 8: phase_cross(P, l, smem); break;
    case 9: if (dup) gemm_phase<EPI_RESID0>(P, l, actA, 1024, wt_ptr(P, l, WE_XO), 1024, 1024, TT, 1024, smem, rot); else gemm_phase<EPI_RESID>(P, l, actA, 1024, wt_ptr(P, l, WE_XO), 1024, 1024, TT, 1024, smem, rot); break;
    case 10: phase_norm(P, P.in[24] + l * 1024, -1); break;
    case 11: gemm_phase<EPI_UP>(P, l, actA, 1024, wt_ptr(P, l, WE_UP), 1024, 1024, TT, DFF, smem, rot); break;
    case 12: if (dup) gemm_phase<EPI_RESID0>(P, l, (const u16*)(ws + WS_R1 + R1_U), DFF, wt_ptr(P, l, WE_DN), DFF, DFF, TT, 1024, smem, rot); else gemm_phase<EPI_RESID>(P, l, (const u16*)(ws + WS_R1 + R1_U), DFF, wt_ptr(P, l, WE_DN), DFF, DFF, TT, 1024, smem, rot); break;
  }
}

__global__ void __launch_bounds__(NTHR) mega(Params P, int ph_lo, int ph_hi) {
  extern __shared__ __attribute__((aligned(16))) char smem[];
  cg::grid_group grid = cg::this_grid();
  if (ph_hi > 4096) grid.sync();
  unsigned* bar = (unsigned*)(P.ws + WS_BAR);
  const unsigned xb_x = xb_xcc_id();
  unsigned xb_nloc = 1u, xb_nx = 1u;
  if (threadIdx.x == 0) { (void)xb_add(&bar[XB_XCNT(xb_x)], 1u); xb_census(bar, xb_x, xb_nloc, xb_nx); }
  xb_nloc = __builtin_amdgcn_readfirstlane(xb_nloc);
  xb_nx = __builtin_amdgcn_readfirstlane(xb_nx);
  unsigned xb_pack = xb_nloc | (xb_nx << 16) | (xb_x << 24) | ((unsigned)__builtin_amdgcn_readfirstlane(threadIdx.x >> 6) << 28);
  asm volatile("" : "+s"(xb_pack));
  for (int ph = ph_lo; ph < ph_hi; ph++) {
    Params Q = P;
    unsigned pk = xb_pack;
    asm volatile("" : "+s"(Q.out), "+s"(Q.ws), "+s"(pk));
    Q.wv = (int)(pk >> 28);
    run_phase(Q, ph, smem);
    if (ph + 1 < ph_hi) {
      unsigned pk2 = xb_pack;
      asm volatile("" : "+s"(pk2));
      xcd_barrier((unsigned*)(Q.ws + WS_BAR), (pk2 >> 24) & 0xfu, pk2 & 0xffffu, (pk2 >> 16) & 0xffu, (int)(pk2 >> 28));
    }
  }
}

extern "C" void kernel_launch(void* const* d_in, const int* in_sizes, int n_in, void* d_out, int out_size, void* d_ws,
                              size_t ws_size, hipStream_t stream) {
  static int grid_blocks = 0;
  if (!grid_blocks) {
    int dev = 0, cus = 0, per_cu = 0;
    hipGetDevice(&dev);
    hipDeviceGetAttribute(&cus, hipDeviceAttributeMultiprocessorCount, dev);
    hipFuncSetAttribute((const void*)mega, hipFuncAttributeMaxDynamicSharedMemorySize, SMEM_BYTES);
    hipOccupancyMaxActiveBlocksPerMultiprocessor(&per_cu, mega, NTHR, SMEM_BYTES);
    per_cu = 1;
    grid_blocks = cus * per_cu;
  }
  if (n_in != 28 || (size_t)out_size != O_END || ws_size < WS_END) {
    fprintf(stderr, "kernel_launch: shape/ws mismatch n_in %d out %d (want %zu) ws %zu (want %zu)\n", n_in, out_size, (size_t)O_END, ws_size, (size_t)WS_END);
    return;
  }
  Params p;
  memset(&p, 0, sizeof(p));
  for (int i = 0; i < 28; i++) p.in[i] = (const float*)d_in[i];
  p.out = (float*)d_out;
  p.ws = (char*)d_ws;
  hipMemsetAsync((char*)d_ws + WS_BAR, 0, XCD_BAR_WORDS * 4 + 4 * 256, stream);
  int lo = 0, hi = NPHASE;
  void* args[] = {&p, &lo, &hi};
  hipError_t e = hipLaunchCooperativeKernel((void*)mega, dim3(grid_blocks), dim3(NTHR), args, SMEM_BYTES, stream);
  if (e != hipSuccess) fprintf(stderr, "cooperative launch failed: %s (grid %d)\n", hipGetErrorString(e), grid_blocks);
}
```

```cpp
#include <hip/hip_runtime.h>
#include <hip/hip_cooperative_groups.h>
#include <stdint.h>
#include <string.h>
#include <stdio.h>
namespace cg = cooperative_groups;

#ifndef COOP
#define COOP 1
#endif

#ifndef FOX_KT
#define FOX_KT 128
#endif
#ifndef FOX_PF
#define FOX_PF true
#endif
#ifndef MLA_PF
#define MLA_PF true
#endif
#ifndef LB_MIN
#define LB_MIN 2
#endif
#ifndef BM_BIG
#define BM_BIG 256
#endif
constexpr int NTHR = 512, NWV = 8;
#define DI __device__ __forceinline__
typedef unsigned short u16;
typedef short s16x8 __attribute__((ext_vector_type(8)));
typedef short s16x4 __attribute__((ext_vector_type(4)));
typedef __bf16 bfx8 __attribute__((ext_vector_type(8)));
typedef __bf16 bfx2 __attribute__((ext_vector_type(2)));
typedef float f32x16 __attribute__((ext_vector_type(16)));
typedef float f32x4 __attribute__((ext_vector_type(4)));
typedef float f32x2 __attribute__((ext_vector_type(2)));
typedef unsigned u32x4 __attribute__((ext_vector_type(4)));
typedef unsigned u32x2 __attribute__((ext_vector_type(2)));

constexpr int DM = 1024, NB = 8, SEQ = 4096, NL = 2, DB = 32, DS = 32, PAST = 2048;
constexpr int TP = NB * SEQ;
constexpr int TS = DB * DS;
constexpr int TT = TP + TS;
constexpr int SKS = PAST + DS;
constexpr int KROWS = TP + DB * SKS;
constexpr int INC = 1992, INP = 2048;
constexpr int NMEM = 256, MB = NB + DB;
constexpr int DFF = 4096;

constexpr size_t O_Y = 0;
constexpr size_t O_FKP = (size_t)TT * DM;
constexpr size_t O_FVP = O_FKP + (size_t)NL * TP * 512;
constexpr size_t O_FLP = O_FVP + (size_t)NL * TP * 512;
constexpr size_t O_CKP = O_FLP + (size_t)NL * TP * 8;
constexpr size_t O_KRP = O_CKP + (size_t)NL * TP * 128;
constexpr size_t O_MKP = O_KRP + (size_t)NL * TP * 64;
constexpr size_t O_MVP = O_MKP + (size_t)NL * NB * NMEM * 1024;
constexpr size_t O_FKS = O_MVP + (size_t)NL * NB * NMEM * 1024;
constexpr size_t O_FVS = O_FKS + (size_t)NL * TS * 512;
constexpr size_t O_FLS = O_FVS + (size_t)NL * TS * 512;
constexpr size_t O_CKS = O_FLS + (size_t)NL * TS * 8;
constexpr size_t O_KRS = O_CKS + (size_t)NL * TS * 128;
constexpr size_t O_END = O_KRS + (size_t)NL * TS * 64;

constexpr size_t al256(size_t x) { return (x + 255) / 256 * 256; }
constexpr size_t WE_IN = 0;
constexpr size_t WE_UQ = WE_IN + (size_t)INP * 1024;
constexpr size_t WE_UKV = WE_UQ + (size_t)768 * 256;
constexpr size_t WE_OUT = WE_UKV + (size_t)1024 * 128;
constexpr size_t WE_XQ = WE_OUT + (size_t)1024 * 1024;
constexpr size_t WE_MKV = WE_XQ + (size_t)1024 * 1024;
constexpr size_t WE_XO = WE_MKV + (size_t)2048 * 1024;
constexpr size_t WE_UP = WE_XO + (size_t)1024 * 1024;
constexpr size_t WE_DN = WE_UP + (size_t)4096 * 1024;
constexpr size_t WE_LAYER = WE_DN + (size_t)1024 * 4096;
constexpr size_t WS_WT = 0;
constexpr size_t WS_ROPE = al256(WS_WT + WE_LAYER * 2 * NL);
constexpr size_t WS_ACTA = al256(WS_ROPE + (size_t)4096 * 32 * 8);
constexpr size_t WS_QF = al256(WS_ACTA + (size_t)TT * 1024 * 2);
constexpr size_t WS_FOXK = al256(WS_QF + (size_t)TT * 512 * 2);
constexpr size_t WS_FOXV = al256(WS_FOXK + (size_t)KROWS * 512 * 2);
constexpr size_t WS_CUM = al256(WS_FOXV + (size_t)KROWS * 512 * 2);
constexpr size_t WS_ZC = al256(WS_CUM + (size_t)KROWS * 8 * 4);
constexpr size_t WS_CQN = al256(WS_ZC + (size_t)TT * 448 * 4);
constexpr size_t WS_CKV = al256(WS_CQN + (size_t)TT * 256 * 2);
constexpr size_t WS_KROPE = al256(WS_CKV + (size_t)KROWS * 128 * 2);
constexpr size_t WS_MEMK = al256(WS_KROPE + (size_t)KROWS * 64 * 2);
constexpr size_t WS_MEMV = al256(WS_MEMK + (size_t)NL * MB * NMEM * 1024 * 2);
constexpr size_t WS_HMEM = al256(WS_MEMV + (size_t)NL * MB * NMEM * 1024 * 2);
constexpr size_t WS_R1 = al256(WS_HMEM + (size_t)NL * NB * NMEM * 1024 * 2);
constexpr size_t R1_KV = 0;
constexpr size_t R1_QM = al256((size_t)KROWS * 1024 * 2);
constexpr size_t R1_U = 0;
constexpr size_t R1_XQ = 0;
constexpr size_t WS_BAR = al256(WS_R1 + (size_t)TT * 4096 * 2);
constexpr size_t WS_CTR = WS_BAR + 3456 * 4;
constexpr size_t WS_END = al256(WS_CTR + 4 * 256);
static_assert(R1_QM + (size_t)TT * 768 * 2 <= (size_t)TT * 4096 * 2, "R1 overflow");

constexpr int SMEM_BYTES = 131072;

struct Params {
  const float* in[28];
  float* out;
  char* ws;
  int wv;
  int pad;
};

DI int get_bid() { int t = blockIdx.x; asm volatile("" : "+s"(t)); return t; }
DI int get_nblk() { int t = gridDim.x; asm volatile("" : "+s"(t)); return t; }
DI int lane_id() { return (int)__builtin_amdgcn_mbcnt_hi(~0u, __builtin_amdgcn_mbcnt_lo(~0u, 0u)); }
DI int get_tid(int wv) { int t = (wv << 6) | lane_id(); asm volatile("" : "+v"(t)); return t; }
DI unsigned pk2(float a, float b) { f32x2 v = {a, b}; return __builtin_bit_cast(unsigned, __builtin_convertvector(v, bfx2)); }
DI u16 f2bf(float a) { return (u16)(pk2(a, 0.f) & 0xffffu); }
DI f32x16 mfma(s16x8 a, s16x8 b, f32x16 c) {
  return __builtin_amdgcn_mfma_f32_32x32x16_bf16(__builtin_bit_cast(bfx8, a), __builtin_bit_cast(bfx8, b), c, 0, 0, 0);
}
DI int crow(int i, int h) { return (i & 3) + 8 * (i >> 2) + 4 * h; }
DI float wave_sum(float v) {
#pragma unroll
  for (int m = 32; m >= 1; m >>= 1) v += __shfl_xor(v, m);
  return v;
}
DI float xhalf_max(float v) {
  auto rr = __builtin_amdgcn_permlane32_swap(__float_as_uint(v), __float_as_uint(v), false, false);
  return fmaxf(__uint_as_float(rr[0]), __uint_as_float(rr[1]));
}
DI float xhalf_sum(float v) {
  auto rr = __builtin_amdgcn_permlane32_swap(__float_as_uint(v), __float_as_uint(v), false, false);
  return __uint_as_float(rr[0]) + __uint_as_float(rr[1]);
}
DI int tok_krow(int tok) {
  if (tok < TP) return tok;
  const int s = tok - TP;
  return TP + (s >> 5) * SKS + PAST + (s & 31);
}
DI int tok_pos(int tok) { return tok < TP ? (tok & (SEQ - 1)) : PAST + ((tok - TP) & 31); }

enum { EPI_IN = 0, EPI_MEM, EPI_UQ, EPI_KV, EPI_RESID, EPI_XQ, EPI_UP, EPI_RESID0 };

template <int EPI, int MI, int NI = 2>
DI void epilogue(const Params& P, int l, f32x16 (&acc)[MI][NI], int mw, int nw, int r, int h) {
  float* out = P.out;
  char* ws = P.ws;
  if constexpr (EPI == EPI_IN) {
    u16* qf = (u16*)(ws + WS_QF);
    u16* fk = (u16*)(ws + WS_FOXK);
    u16* fv = (u16*)(ws + WS_FOXV);
    float* zc = (float*)(ws + WS_ZC);
    const float* bfg = P.in[12] + l * 8;
#pragma unroll
    for (int mi = 0; mi < MI; mi++) {
#pragma unroll
      for (int i = 0; i < 16; i++) {
        const int row = mw + mi * 32 + crow(i, h);
        const int kr = tok_krow(row);
        const bool isp = row < TP;
        const size_t orow = isp ? ((size_t)l * TP + row) : ((size_t)l * TS + (row - TP));
#pragma unroll
        for (int ni = 0; ni < NI; ni++) {
          const int col = nw + ni * 32 + r;
          const float v = acc[mi][ni][i];
          if (col < 512) {
            qf[(size_t)row * 512 + col] = f2bf(v);
          } else if (col < 1024) {
            const int c = col - 512;
            out[(isp ? O_FKP : O_FKS) + orow * 512 + c] = v;
            fk[(size_t)kr * 512 + c] = f2bf(v);
          } else if (col < 1536) {
            const int c = col - 1024;
            out[(isp ? O_FVP : O_FVS) + orow * 512 + c] = v;
            fv[(size_t)kr * 512 + c] = f2bf(v);
          } else if (col < 1544) {
            const int c = col - 1536;
            const float g = v + bfg[c];
            const float ls = fminf(g, 0.f) - __logf(1.f + __expf(-fabsf(g)));
            out[(isp ? O_FLP : O_FLS) + orow * 8 + c] = ls;
          } else if (col < INC) {
            zc[(size_t)row * 448 + (col - 1544)] = v;
          }
        }
      }
    }
  } else if constexpr (EPI == EPI_MEM) {
    u16* mk = (u16*)(ws + WS_MEMK);
    u16* mv = (u16*)(ws + WS_MEMV);
#pragma unroll
    for (int mi = 0; mi < MI; mi++) {
#pragma unroll
      for (int i = 0; i < 16; i++) {
        const int row = mw + mi * 32 + crow(i, h);
#pragma unroll
        for (int ni = 0; ni < NI; ni++) {
          const int col = nw + ni * 32 + r;
          const float v = acc[mi][ni][i];
          const int c = col & 1023;
          const size_t oidx = ((size_t)l * (NB * NMEM) + row) * 1024 + c;
          const size_t bidx = ((size_t)l * (MB * NMEM) + row) * 1024 + c;
          if (col < 1024) { out[O_MKP + oidx] = v; mk[bidx] = f2bf(v); }
          else { out[O_MVP + oidx] = v; mv[bidx] = f2bf(v); }
        }
      }
    }
  } else if constexpr (EPI == EPI_UQ) {
    u16* qm = (u16*)(ws + WS_R1 + R1_QM);
    const f32x2* rt = (const f32x2*)(ws + WS_ROPE);
    const bool isrope = (nw % 192) == 128;
#pragma unroll
    for (int mi = 0; mi < MI; mi++) {
#pragma unroll
      for (int i = 0; i < 16; i++) {
        const int row = mw + mi * 32 + crow(i, h);
        float x1 = acc[mi][0][i], x2 = acc[mi][1][i];
        if (isrope) {
          const f32x2 cs = rt[tok_pos(row) * 32 + r];
          const float o1 = x1 * cs[0] - x2 * cs[1];
          const float o2 = x2 * cs[0] + x1 * cs[1];
          x1 = o1; x2 = o2;
        }
        qm[(size_t)row * 768 + nw + r] = f2bf(x1);
        qm[(size_t)row * 768 + nw + 32 + r] = f2bf(x2);
      }
    }
  } else if constexpr (EPI == EPI_KV || EPI == EPI_XQ || EPI == EPI_UP) {
    u16* dst; int ld;
    if constexpr (EPI == EPI_KV) { dst = (u16*)(ws + WS_R1 + R1_KV); ld = 1024; }
    else if constexpr (EPI == EPI_XQ) { dst = (u16*)(ws + WS_R1 + R1_XQ); ld = 1024; }
    else { dst = (u16*)(ws + WS_R1 + R1_U); ld = DFF; }
    const bool odd = r & 1;
    const int colb = nw + (r & ~1);
#pragma unroll
    for (int mi = 0; mi < MI; mi++) {
#pragma unroll
      for (int i = 0; i < 16; i += 2) {
        const int row = mw + mi * 32 + crow(i, h) + (odd ? 1 : 0);
#pragma unroll
        for (int ni = 0; ni < NI; ni++) {
          float v0 = acc[mi][ni][i], v1 = acc[mi][ni][i + 1];
          if constexpr (EPI == EPI_UP) { v0 = fmaxf(v0, 0.f); v0 = v0 * v0; v1 = fmaxf(v1, 0.f); v1 = v1 * v1; }
          const float send = odd ? v0 : v1;
          const float recv = __int_as_float(__builtin_amdgcn_mov_dpp(__float_as_int(send), 0xB1, 0xF, 0xF, true));
          const unsigned w = odd ? pk2(recv, v1) : pk2(v0, recv);
          *(unsigned*)(dst + (size_t)row * ld + colb + ni * 32) = w;
        }
      }
    }
  } else if constexpr (EPI == EPI_RESID || EPI == EPI_RESID0) {
#pragma unroll
    for (int mi = 0; mi < MI; mi++) {
#pragma unroll
      for (int i = 0; i < 16; i++) {
        const int row = mw + mi * 32 + crow(i, h);
#pragma unroll
        for (int ni = 0; ni < NI; ni++) {
          unsafeAtomicAdd(out + (size_t)row * DM + nw + ni * 32 + r, EPI == EPI_RESID0 ? acc[mi][ni][i] * 0.f : acc[mi][ni][i]);
        }
      }
    }
  }
}

enum { MASK_NONE = 0, MASK_FRAME = 1, MASK_CHUNK = 2 };
struct AttnJob {
  const u16* Q; int ldq;
  const u16* K1; int ldk1;
  const u16* K2; int ldk2;
  const u16* V; int ldv;
  u16* O; int ldo;
  const float* cq;
  const float* ck;
  int nq, Sk, qpos0;
  float scale_log2;
  int wv;
};

template <int DQK, int D1, int DVT, int MASK, bool BIAS, bool PREFETCH, int LDQ, int LDK1, int LDK2, int LDV, int LDO, int KT, bool KSPLIT = false>
DI void attn_block(const AttnJob& J, char* smem) {
  constexpr int KP = DQK * 2 + 16;
  constexpr int VP = DVT * 2;
  constexpr int CV = DVT / 8;
  constexpr int NKK = DQK / 16, NDV = DVT / 32;
  constexpr float LOG2E = 1.4426950408889634f;
  char* Ks = smem;
  char* Vs = smem + KT * KP;
  float* cks = (float*)(smem + KT * KP + KT * VP);
  const int tid = get_tid(J.wv), wave = tid >> 6, lane = tid & 63, r = lane & 31, h = lane >> 5;
  const int wq0 = KSPLIT ? 0 : wave * 32;
  const bool active = wq0 < J.nq;
  const int qi = wq0 + r;
  const int qpos = J.qpos0 + qi;
  const int wqmax = J.qpos0 + wq0 + 31;
  const int qmax = J.qpos0 + J.nq - 1;
  const int ntk = (J.Sk + KT - 1) / KT;
  int nt = ntk;
  if (MASK != MASK_NONE) { const int t2 = qmax / KT + 1; nt = t2 < ntk ? t2 : ntk; }

  s16x8 qf[NKK];
  {
    const u16* qp = J.Q + (size_t)qi * LDQ + h * 8;
#pragma unroll
    for (int kk = 0; kk < NKK; kk++) {
      if (active) qf[kk] = *(const s16x8*)(qp + kk * 16);
      else { s16x8 z = {0, 0, 0, 0, 0, 0, 0, 0}; qf[kk] = z; }
    }
  }

  f32x16 o[NDV];
#pragma unroll
  for (int d = 0; d < NDV; d++)
#pragma unroll
    for (int i = 0; i < 16; i++) o[d][i] = 0.f;
  float m_run = -1e30f, l_run = 0.f;

  constexpr int CK1 = D1 / 8, CK2 = (DQK - D1) / 8;
  constexpr int RP1 = NTHR / CK1, NP1 = KT / RP1;
  constexpr int RP2 = CK2 ? NTHR / (CK2 ? CK2 : 1) : 64, NP2 = CK2 ? KT / RP2 : 0;
  constexpr int RPV = NTHR / CV, NPV = KT / RPV;
  u32x4 rk1[NP1], rk2[NP2 ? NP2 : 1], rv[NPV];
  float rck = 0.f;
  const int tq = (lane & 15) >> 2, tp = lane & 3, tblk = (lane >> 4) & 1;
  const int vswz = (DVT >= 128) ? tq : (tq >> 1);
  const int r1 = tid / CK1, c1 = tid % CK1;
  const int r2 = CK2 ? tid / (CK2 ? CK2 : 1) : 0, c2 = CK2 ? tid % (CK2 ? CK2 : 1) : 0;
  const int r3 = tid / CV, c3 = tid % CV;
  const unsigned k1o = (unsigned)(r1 * LDK1 + c1 * 8) * 2u;
  const unsigned k2o = (unsigned)(r2 * LDK2 + c2 * 8) * 2u;
  const unsigned vo = (unsigned)(r3 * LDV + c3 * 8) * 2u;
  const int k1so = r1 * KP + c1 * 16;
  const int k2so = r2 * KP + D1 * 2 + c2 * 16;
  const int vsw = (DVT >= 128) ? (r3 & 3) : ((r3 >> 1) & 1);
  const int vso = KT * KP + r3 * VP + (((c3 >> 2) ^ vsw) * 64) + (c3 & 3) * 16;
  const int vro = KT * KP + (4 * h + tq) * VP + (16 * tblk + 4 * tp) * 2;
  const int kro = r * KP + h * 16;

  auto load_tile = [&](int j) {
    const int kb = j * KT;
#pragma unroll
    for (int i = 0; i < NP1; i++) {
      u32x4 v = {0u, 0u, 0u, 0u};
      if (kb + r1 + i * RP1 < J.Sk) v = *(const u32x4*)((const char*)(J.K1 + (size_t)(kb + i * RP1) * LDK1) + k1o);
      rk1[i] = v;
    }
#pragma unroll
    for (int i = 0; i < NP2; i++) {
      u32x4 v = {0u, 0u, 0u, 0u};
      if (kb + r2 + i * RP2 < J.Sk) v = *(const u32x4*)((const char*)(J.K2 + (size_t)(kb + i * RP2) * LDK2) + k2o);
      rk2[i] = v;
    }
#pragma unroll
    for (int i = 0; i < NPV; i++) {
      u32x4 v = {0u, 0u, 0u, 0u};
      if (kb + r3 + i * RPV < J.Sk) v = *(const u32x4*)((const char*)(J.V + (size_t)(kb + i * RPV) * LDV) + vo);
      rv[i] = v;
    }
    if (BIAS) {
      if (tid < KT) { const int key = kb + tid; rck = key < J.Sk ? -J.ck[(size_t)key * 8] * LOG2E : 0.f; }
    }
  };
  auto store_tile = [&]() {
    int a1 = k1so, a2 = k2so, a3 = vso;
    asm volatile("" : "+v"(a1), "+v"(a2), "+v"(a3));
#pragma unroll
    for (int i = 0; i < NP1; i++) *(u32x4*)(smem + a1 + i * RP1 * KP) = rk1[i];
#pragma unroll
    for (int i = 0; i < NP2; i++) *(u32x4*)(smem + a2 + i * RP2 * KP) = rk2[i];
#pragma unroll
    for (int i = 0; i < NPV; i++) *(u32x4*)(smem + a3 + i * RPV * VP) = rv[i];
    if (BIAS) { if (tid < KT) cks[tid] = rck; }
  };

  if (PREFETCH) load_tile(0);
  for (int j = 0; j < nt; j++) {
    __syncthreads();
    if (!PREFETCH) load_tile(j);
    store_tile();
    __syncthreads();
    if (PREFETCH) { if (j + 1 < nt) load_tile(j + 1); }
    const bool need = active && (MASK == MASK_NONE || j * KT <= wqmax);
    if (need) {
      int kro_l = kro, vro_l = vro;
      asm volatile("" : "+v"(kro_l), "+v"(vro_l));
      const char* krd = smem + kro_l;
      const bool needmask = (MASK == MASK_FRAME && j * KT + KT - 1 > J.qpos0 + wq0) || (j * KT + KT - 1 >= J.Sk);
      const int dq = (MASK == MASK_FRAME ? min(qpos, J.Sk - 1) : J.Sk - 1) - j * KT - 4 * h;
#pragma unroll
      for (int hb = 0; hb < KT / 32; hb++) {
        if (KSPLIT && hb != J.wv) continue;
        if (MASK == MASK_FRAME && j * KT + hb * 32 > wqmax) continue;
        f32x16 p;
#pragma unroll
        for (int i = 0; i < 16; i++) p[i] = 0.f;
#pragma unroll
        for (int kk = 0; kk < NKK; kk++) {
          const s16x8 kf = *(const s16x8*)(krd + hb * 32 * KP + kk * 32);
          p = mfma(kf, qf[kk], p);
        }
        if (BIAS) {
#pragma unroll
          for (int g = 0; g < 4; g++) {
            const f32x4 c0 = *(const f32x4*)(cks + hb * 32 + 8 * g + 4 * h);
#pragma unroll
            for (int e = 0; e < 4; e++) p[4 * g + e] = fmaf(p[4 * g + e], J.scale_log2, c0[e]);
          }
        } else {
#pragma unroll
          for (int i = 0; i < 16; i++) p[i] *= J.scale_log2;
        }
        if (needmask) {
#pragma unroll
          for (int i = 0; i < 16; i++) {
            const int cc = (i & 3) + 8 * (i >> 2) + 32 * hb;
            p[i] = (cc <= dq) ? p[i] : -1e30f;
          }
        }
        float mx = p[0];
#pragma unroll
        for (int i = 1; i < 16; i++) mx = fmaxf(mx, p[i]);
        mx = xhalf_max(mx);
        if (__any(mx > m_run + 8.f)) {
          const float m_new = fmaxf(m_run, mx);
          const float alpha = __builtin_amdgcn_exp2f(m_run - m_new);
          m_run = m_new;
          l_run *= alpha;
#pragma unroll
          for (int d = 0; d < NDV; d++)
#pragma unroll
            for (int i = 0; i < 16; i++) o[d][i] *= alpha;
        }
        float ps = 0.f;
#pragma unroll
        for (int i = 0; i < 16; i++) { p[i] = __builtin_amdgcn_exp2f(p[i] - m_run); ps += p[i]; }
        l_run += ps;
        s16x8 pb[2];
        {
          u32x4 w;
          w[0] = pk2(p[0], p[1]); w[1] = pk2(p[2], p[3]); w[2] = pk2(p[4], p[5]); w[3] = pk2(p[6], p[7]);
          pb[0] = __builtin_bit_cast(s16x8, w);
          w[0] = pk2(p[8], p[9]); w[1] = pk2(p[10], p[11]); w[2] = pk2(p[12], p[13]); w[3] = pk2(p[14], p[15]);
          pb[1] = __builtin_bit_cast(s16x8, w);
        }
#pragma unroll
        for (int d = 0; d < NDV; d++) {
          const char* vb = smem + (vro_l + ((d ^ vswz) * 64)) + hb * 32 * VP;
#pragma unroll
          for (int s = 0; s < 2; s++) {
            const s16x4 lo = __builtin_amdgcn_ds_read_tr16_b64_v4i16(
                (__attribute__((address_space(3))) s16x4*)(uintptr_t)(vb + (16 * s) * VP));
            const s16x4 hi = __builtin_amdgcn_ds_read_tr16_b64_v4i16(
                (__attribute__((address_space(3))) s16x4*)(uintptr_t)(vb + (16 * s + 8) * VP));
            const s16x8 vf = __builtin_shufflevector(lo, hi, 0, 1, 2, 3, 4, 5, 6, 7);
            o[d] = mfma(vf, pb[s], o[d]);
          }
        }
      }
    }
  }
  float lt = xhalf_sum(l_run);
  bool writer = active && qi < J.nq;
  if (KSPLIT) {
    constexpr int NWS = KT / 32;
    constexpr int NV = NDV * 16 + 2;
    float* mb = (float*)smem;
    __syncthreads();
    if (wave < NWS) {
      float* w = mb + (size_t)wave * NV * 64 + lane;
#pragma unroll
      for (int d = 0; d < NDV; d++)
#pragma unroll
        for (int i = 0; i < 16; i++) w[(d * 16 + i) * 64] = o[d][i];
      w[(NDV * 16) * 64] = m_run;
      w[(NDV * 16 + 1) * 64] = lt;
    }
    __syncthreads();
    writer = writer && (wave == 0);
    if (wave == 0) {
      float M = -1e30f;
#pragma unroll
      for (int w2 = 0; w2 < NWS; w2++) M = fmaxf(M, mb[((size_t)w2 * NV + NDV * 16) * 64 + lane]);
      float L = 0.f;
#pragma unroll
      for (int d = 0; d < NDV; d++)
#pragma unroll
        for (int i = 0; i < 16; i++) o[d][i] = 0.f;
#pragma unroll 1
      for (int w2 = 0; w2 < NWS; w2++) {
        const float* rsrc = mb + (size_t)w2 * NV * 64 + lane;
        const float sc = __builtin_amdgcn_exp2f(rsrc[(NDV * 16) * 64] - M);
        L += rsrc[(NDV * 16 + 1) * 64] * sc;
#pragma unroll
        for (int d = 0; d < NDV; d++)
#pragma unroll
          for (int i = 0; i < 16; i++) o[d][i] += rsrc[(d * 16 + i) * 64] * sc;
      }
      lt = L;
    }
  }
  if (writer) {
    const float inv = 1.f / lt;
    u16* op = J.O + (size_t)qi * LDO + 4 * h;
#pragma unroll
    for (int d = 0; d < NDV; d++) {
#pragma unroll
      for (int g = 0; g < 4; g++) {
        u32x2 w;
        w[0] = pk2(o[d][4 * g] * inv, o[d][4 * g + 1] * inv);
        w[1] = pk2(o[d][4 * g + 2] * inv, o[d][4 * g + 3] * inv);
        *(u32x2*)(op + d * 32 + 8 * g) = w;
      }
    }
  }
}

template <int NR, bool F32OUT>
DI void rms_rows(const float* __restrict__ xbase, size_t rstride, int nvalid, const float* __restrict__ g, void* dbase, size_t dstride, int lane) {
  f32x4 v[NR][4];
#pragma unroll
  for (int j = 0; j < NR; j++)
#pragma unroll
    for (int i = 0; i < 4; i++) {
      if (j < nvalid) v[j][i] = *(const f32x4*)(xbase + (size_t)j * rstride + i * 256 + lane * 4);
      else { f32x4 z = {0.f, 0.f, 0.f, 0.f}; v[j][i] = z; }
    }
  f32x4 gg[4];
#pragma unroll
  for (int i = 0; i < 4; i++) gg[i] = *(const f32x4*)(g + i * 256 + lane * 4);
#pragma unroll
  for (int j = 0; j < NR; j++) {
    float ss = 0.f;
#pragma unroll
    for (int i = 0; i < 4; i++) ss += v[j][i][0] * v[j][i][0] + v[j][i][1] * v[j][i][1] + v[j][i][2] * v[j][i][2] + v[j][i][3] * v[j][i][3];
    ss = wave_sum(ss);
    const float rs = rsqrtf(ss * (1.f / 1024.f) + 1e-6f);
    if (j < nvalid) {
#pragma unroll
      for (int i = 0; i < 4; i++) {
        if (F32OUT) {
          f32x4 w;
          w[0] = v[j][i][0] * rs * gg[i][0]; w[1] = v[j][i][1] * rs * gg[i][1]; w[2] = v[j][i][2] * rs * gg[i][2]; w[3] = v[j][i][3] * rs * gg[i][3];
          *(f32x4*)((float*)dbase + (size_t)j * dstride + i * 256 + lane * 4) = w;
        } else {
          u32x2 w;
          w[0] = pk2(v[j][i][0] * rs * gg[i][0], v[j][i][1] * rs * gg[i][1]);
          w[1] = pk2(v[j][i][2] * rs * gg[i][2], v[j][i][3] * rs * gg[i][3]);
          *(u32x2*)((u16*)dbase + (size_t)j * dstride + i * 256 + lane * 4) = w;
        }
      }
    }
  }
}

DI void cvt_job(const float* __restrict__ src, u16* __restrict__ dst, int nseg, size_t seglen, size_t sstride, size_t dstride, int wv) {
  const size_t upseg = seglen / 8;
  const size_t total = upseg * nseg;
  const size_t stride = (size_t)get_nblk() * NTHR;
  for (size_t u0 = (size_t)get_bid() * NTHR + get_tid(wv); u0 < total; u0 += 4 * stride) {
    f32x4 a[4], b[4];
    size_t so[4], dd[4];
#pragma unroll
    for (int q = 0; q < 4; q++) {
      const size_t u = u0 + q * stride;
      const size_t uu = u < total ? u : u0;
      const size_t sg = uu / upseg, off = (uu - sg * upseg) * 8;
      so[q] = sg * sstride + off; dd[q] = sg * dstride + off;
      a[q] = *(const f32x4*)(src + so[q]);
      b[q] = *(const f32x4*)(src + so[q] + 4);
    }
#pragma unroll
    for (int q = 0; q < 4; q++) {
      if (u0 + q * stride < total) {
        u32x4 w;
        w[0] = pk2(a[q][0], a[q][1]); w[1] = pk2(a[q][2], a[q][3]); w[2] = pk2(b[q][0], b[q][1]); w[3] = pk2(b[q][2], b[q][3]);
        *(u32x4*)(dst + dd[q]) = w;
      }
    }
  }
}

DI void transpose_job(const float* __restrict__ src, u16* __restrict__ dst, int K, int N, int Npad, int& rot, char* smem, int wv) {
  float* tile = (float*)smem;
  const int tk = K / 64, tn = Npad / 64, ntiles = tk * tn;
  const int G = get_nblk();
  const int tid = get_tid(wv);
  for (int t = (get_bid() + G - (rot % G)) % G; t < ntiles; t += G) {
    const int k0 = (t % tk) * 64, n0 = (t / tk) * 64;
    float v[8];
#pragma unroll
    for (int i = 0; i < 8; i++) {
      const int k = i * 8 + (tid >> 6), n = tid & 63;
      v[i] = (n0 + n < N) ? src[(size_t)(k0 + k) * N + n0 + n] : 0.f;
    }
    __syncthreads();
#pragma unroll
    for (int i = 0; i < 8; i++) {
      const int k = i * 8 + (tid >> 6), n = tid & 63;
      tile[k * 65 + n] = v[i];
    }
    __syncthreads();
#pragma unroll
    for (int i = 0; i < 4; i++) {
      const int n = i * 16 + (tid >> 5), k = (tid & 31) * 2;
      *(unsigned*)(dst + (size_t)(n0 + n) * K + k0 + k) = pk2(tile[k * 65 + n], tile[(k + 1) * 65 + n]);
    }
  }
  rot += ntiles;
}

DI u16* wt_ptr(const Params& P, int l, size_t eoff) { return (u16*)(P.ws + WS_WT) + (size_t)l * WE_LAYER + eoff; }

DI void phase_prep(const Params& P, char* smem) {
  const int tid = get_tid(P.wv), lane = tid & 63;
  const int gw = get_bid() * NWV + (tid >> 6), nw = get_nblk() * NWV;
  int rot = 0;
  for (int l = 0; l < NL; l++) {
    transpose_job(P.in[11] + (size_t)l * 1024 * INC, wt_ptr(P, l, WE_IN), 1024, INC, INP, rot, smem, P.wv);
    transpose_job(P.in[14] + (size_t)l * 256 * 768, wt_ptr(P, l, WE_UQ), 256, 768, 768, rot, smem, P.wv);
    transpose_job(P.in[16] + (size_t)l * 128 * 1024, wt_ptr(P, l, WE_UKV), 128, 1024, 1024, rot, smem, P.wv);
    transpose_job(P.in[17] + (size_t)l * 1024 * 1024, wt_ptr(P, l, WE_OUT), 1024, 1024, 1024, rot, smem, P.wv);
    transpose_job(P.in[20] + (size_t)l * 1024 * 1024, wt_ptr(P, l, WE_XQ), 1024, 1024, 1024, rot, smem, P.wv);
    transpose_job(P.in[21] + (size_t)l * 1024 * 1024, wt_ptr(P, l, WE_MKV), 1024, 1024, 1024, rot, smem, P.wv);
    transpose_job(P.in[22] + (size_t)l * 1024 * 1024, wt_ptr(P, l, WE_MKV) + (size_t)1024 * 1024, 1024, 1024, 1024, rot, smem, P.wv);
    transpose_job(P.in[23] + (size_t)l * 1024 * 1024, wt_ptr(P, l, WE_XO), 1024, 1024, 1024, rot, smem, P.wv);
    transpose_job(P.in[25] + (size_t)l * 1024 * 4096, wt_ptr(P, l, WE_UP), 1024, 4096, 4096, rot, smem, P.wv);
    transpose_job(P.in[26] + (size_t)l * 4096 * 1024, wt_ptr(P, l, WE_DN), 4096, 1024, 1024, rot, smem, P.wv);
  }
  {
    f32x2* rt = (f32x2*)(P.ws + WS_ROPE);
    for (int i = get_bid() * NTHR + tid; i < 4096 * 32; i += get_nblk() * NTHR) {
      const int pos = i >> 5, j = i & 31;
      const float inv = powf(10000.f, -(float)j / 32.f);
      const float ang = (float)pos * inv;
      f32x2 cs; cs[0] = cosf(ang); cs[1] = sinf(ang);
      rt[i] = cs;
    }
  }
  for (int l = 0; l < NL; l++) {
    const size_t seg = (size_t)DB * NMEM * 1024;
    cvt_job(P.in[8] + l * seg, (u16*)(P.ws + WS_MEMK) + ((size_t)l * MB + NB) * NMEM * 1024, 1, seg, 0, 0, P.wv);
    cvt_job(P.in[9] + l * seg, (u16*)(P.ws + WS_MEMV) + ((size_t)l * MB + NB) * NMEM * 1024, 1, seg, 0, 0, P.wv);
  }
  for (int rr = gw; rr < NL * NB * NMEM; rr += nw) {
    const int l = rr / (NB * NMEM), row = rr % (NB * NMEM);
    rms_rows<1, false>(P.in[2] + (size_t)row * 1024, 0, 1, P.in[19] + l * 1024, (u16*)(P.ws + WS_HMEM) + (size_t)rr * 1024, 0, lane);
  }
  {
    const size_t n4 = (size_t)TT * 256;
    const size_t np4 = (size_t)TP * 256;
    const size_t stride = (size_t)get_nblk() * NTHR;
    for (size_t i0 = (size_t)get_bid() * NTHR + tid; i0 < n4; i0 += 4 * stride) {
      f32x4 v[4];
#pragma unroll
      for (int q = 0; q < 4; q++) {
        const size_t i = i0 + q * stride;
        const size_t ii = i < n4 ? i : i0;
        v[q] = (ii < np4) ? *(const f32x4*)(P.in[0] + ii * 4) : *(const f32x4*)(P.in[1] + (ii - np4) * 4);
      }
#pragma unroll
      for (int q = 0; q < 4; q++) {
        const size_t i = i0 + q * stride;
        if (i < n4) *(f32x4*)(P.out + i * 4) = v[q];
      }
    }
  }
}

DI void phase_norm(const Params& P, const float* g, int cache_layer) {
  const int tid = get_tid(P.wv), lane = tid & 63;
  const int gw = get_bid() * NWV + (tid >> 6), nw = get_nblk() * NWV;
  u16* h = (u16*)(P.ws + WS_ACTA);
  for (int row = gw; row < TT; row += 4 * nw) {
    const int nv = (TT - row + nw - 1) / nw;
    rms_rows<4, false>(P.out + (size_t)row * 1024, (size_t)nw * 1024, nv < 4 ? nv : 4, g, h + (size_t)row * 1024, (size_t)nw * 1024, lane);
  }
  if (cache_layer >= 0) {
    const int l = cache_layer;
    cvt_job(P.in[3] + (size_t)l * DB * PAST * 512, (u16*)(P.ws + WS_FOXK) + (size_t)TP * 512, DB, (size_t)PAST * 512, (size_t)PAST * 512, (size_t)SKS * 512, P.wv);
    cvt_job(P.in[4] + (size_t)l * DB * PAST * 512, (u16*)(P.ws + WS_FOXV) + (size_t)TP * 512, DB, (size_t)PAST * 512, (size_t)PAST * 512, (size_t)SKS * 512, P.wv);
    cvt_job(P.in[6] + (size_t)l * DB * PAST * 128, (u16*)(P.ws + WS_CKV) + (size_t)TP * 128, DB, (size_t)PAST * 128, (size_t)PAST * 128, (size_t)SKS * 128, P.wv);
    cvt_job(P.in[7] + (size_t)l * DB * PAST * 64, (u16*)(P.ws + WS_KROPE) + (size_t)TP * 64, DB, (size_t)PAST * 64, (size_t)PAST * 64, (size_t)SKS * 64, P.wv);
  }
}

DI void phase_final(const Params& P) {
  const int tid = get_tid(P.wv), lane = tid & 63;
  const int gw = get_bid() * NWV + (tid >> 6), nw = get_nblk() * NWV;
  const float* g = P.in[27];
  for (int row = gw; row < TT; row += 4 * nw) {
    const int nv = (TT - row + nw - 1) / nw;
    rms_rows<4, true>(P.out + (size_t)row * 1024, (size_t)nw * 1024, nv < 4 ? nv : 4, g, P.out + (size_t)row * 1024, (size_t)nw * 1024, lane);
  }
}

DI void phase_post(const Params& P, int l, char* smem) {
  const int tid = get_tid(P.wv), lane = tid & 63;
  const int gw = get_bid() * NWV + (tid >> 6), nw = get_nblk() * NWV;
  const float* zc = (const float*)(P.ws + WS_ZC);
  u16* cqn = (u16*)(P.ws + WS_CQN);
  u16* ckv = (u16*)(P.ws + WS_CKV);
  u16* krp = (u16*)(P.ws + WS_KROPE);
  const f32x2* rt = (const f32x2*)(P.ws + WS_ROPE);
  const float* gq = P.in[13] + l * 256;
  const float* gkv = P.in[15] + l * 128;
  for (int tok0 = gw; tok0 < TT; tok0 += 4 * nw) {
    f32x4 vq[4]; f32x2 vk[4]; float vr[4];
#pragma unroll
    for (int j = 0; j < 4; j++) {
      const int tk = tok0 + j * nw;
      const float* z = zc + (size_t)(tk < TT ? tk : tok0) * 448;
      vq[j] = *(const f32x4*)(z + lane * 4);
      vk[j] = *(const f32x2*)(z + 256 + lane * 2);
      vr[j] = z[384 + lane];
    }
    const f32x4 ggq = *(const f32x4*)(gq + lane * 4);
    const f32x2 ggk = *(const f32x2*)(gkv + lane * 2);
#pragma unroll
    for (int j = 0; j < 4; j++) {
      const int tok = tok0 + j * nw;
      if (tok >= TT) break;
      const bool isp = tok < TP;
      const size_t orow = isp ? ((size_t)l * TP + tok) : ((size_t)l * TS + (tok - TP));
      const int kr = tok_krow(tok);
      {
        const f32x4 v = vq[j];
        const float ss = wave_sum(v[0] * v[0] + v[1] * v[1] + v[2] * v[2] + v[3] * v[3]);
        const float rs = rsqrtf(ss * (1.f / 256.f) + 1e-6f);
        u32x2 w;
        w[0] = pk2(v[0] * rs * ggq[0], v[1] * rs * ggq[1]);
        w[1] = pk2(v[2] * rs * ggq[2], v[3] * rs * ggq[3]);
        *(u32x2*)(cqn + (size_t)tok * 256 + lane * 4) = w;
      }
      {
        const f32x2 v = vk[j];
        const float ss = wave_sum(v[0] * v[0] + v[1] * v[1]);
        const float rs = rsqrtf(ss * (1.f / 128.f) + 1e-6f);
        f32x2 o; o[0] = v[0] * rs * ggk[0]; o[1] = v[1] * rs * ggk[1];
        *(f32x2*)(P.out + (isp ? O_CKP : O_CKS) + orow * 128 + lane * 2) = o;
        *(unsigned*)(ckv + (size_t)kr * 128 + lane * 2) = pk2(o[0], o[1]);
      }
      {
        const float x = vr[j];
        const float y = __shfl_xor(x, 32);
        const f32x2 cs = rt[tok_pos(tok) * 32 + (lane & 31)];
        const float o = (lane < 32) ? (x * cs[0] - y * cs[1]) : (x * cs[0] + y * cs[1]);
        P.out[(isp ? O_KRP : O_KRS) + orow * 64 + lane] = o;
        krp[(size_t)kr * 64 + lane] = f2bf(o);
      }
    }
  }
  float* cum = (float*)(P.ws + WS_CUM);
  float* wtot = (float*)smem;
  const int wave = tid >> 6;
  for (int it = get_bid(); it < NB + DB; it += get_nblk()) {
    const bool isp = it < NB;
    const int b = isp ? it : it - NB;
    const int ppt = isp ? 16 : 9;
    const int npos = isp ? SEQ : SKS;
    const float* srcA; const float* srcB; int nA;
    size_t krow0;
    if (isp) { srcA = P.out + O_FLP + ((size_t)l * TP + (size_t)b * SEQ) * 8; srcB = srcA; nA = SEQ; krow0 = (size_t)b * SEQ; }
    else {
      srcA = P.in[5] + ((size_t)l * DB + b) * PAST * 8;
      srcB = P.out + O_FLS + ((size_t)l * TS + (size_t)b * DS) * 8 - (size_t)PAST * 8;
      nA = PAST; krow0 = (size_t)TP + (size_t)b * SKS;
    }
    const int p0 = tid * ppt;
    f32x4 va[16], vb[16];
#pragma unroll
    for (int j = 0; j < 16; j++) {
      const int p = p0 + j;
      f32x4 z = {0.f, 0.f, 0.f, 0.f};
      va[j] = z; vb[j] = z;
      if (j < ppt && p < npos) {
        const float* s = (p < nA ? srcA : srcB) + (size_t)p * 8;
        va[j] = *(const f32x4*)s; vb[j] = *(const f32x4*)(s + 4);
      }
    }
#pragma unroll
    for (int j = 1; j < 16; j++) { va[j] += va[j - 1]; vb[j] += vb[j - 1]; }
    f32x4 ta = va[15], tb = vb[15];
#pragma unroll
    for (int d = 1; d < 64; d <<= 1) {
#pragma unroll
      for (int e = 0; e < 4; e++) {
        const float ua = __shfl_up(ta[e], d), ub = __shfl_up(tb[e], d);
        if (lane >= d) { ta[e] += ua; tb[e] += ub; }
      }
    }
    __syncthreads();
    if (lane == 63) { *(f32x4*)(wtot + wave * 8) = ta; *(f32x4*)(wtot + wave * 8 + 4) = tb; }
    __syncthreads();
    f32x4 pa = ta - va[15], pb = tb - vb[15];
    for (int w2 = 0; w2 < wave; w2++) { pa += *(const f32x4*)(wtot + w2 * 8); pb += *(const f32x4*)(wtot + w2 * 8 + 4); }
#pragma unroll
    for (int j = 0; j < 16; j++) {
      const int p = p0 + j;
      if (j < ppt && p < npos) {
        float* d = cum + (krow0 + p) * 8;
        *(f32x4*)d = va[j] + pa; *(f32x4*)(d + 4) = vb[j] + pb;
      }
    }
  }
}

template <int EPI>
DI void gemm_phase(const Params& P, int l, const u16* __restrict__ A, int lda, const u16* __restrict__ Bt, int ldb, int K, int M, int N,
                   char* smem, int& rot) {
  constexpr int MI = 4;
  constexpr int STAGE = 32768;
  constexpr int NSLOT = SMEM_BYTES / STAGE;
  constexpr int DEPTH = NSLOT - 1;
  constexpr int GPS = 4;
  static_assert(NSLOT == 4, "ring waits are written for 4 slots");
  const int tid = get_tid(P.wv), wave = tid >> 6, lane = tid & 63, r = lane & 31, h = lane >> 5;
  const int wm = wave >> 2, wn = wave & 3;
  const int TM = M >> 8, TN = N >> 8;
  const int ntiles = TM * TN;
  const int G = get_nblk();
  const int bid = get_bid();
  const bool xmap = (G == 256);
  const int hsel = (bid + 256 - ((rot * 64) & 255)) & 255;
  int t0, tstep;
  if (xmap) {
    const int nun = (ntiles + 31) >> 5;
    const int xs = (bid + 8 - (rot & 7)) & 7;
    t0 = xs * 32 + (bid >> 3); tstep = 256;
    rot += nun;
  } else {
    t0 = (bid + G - (rot % G)) % G; tstep = G;
    rot += ntiles;
  }
  const int nk = K >> 5;
  constexpr bool SPLITK = (EPI == EPI_RESID || EPI == EPI_RESID0);
  const bool sk = SPLITK && xmap && (TN == 4) && (((TM * nk) & 63) == 0);
  const int skS = (TM * nk) >> 6;
  const int sknt = (bid >> 3) & 3;
  constexpr bool HALFOK = (EPI == EPI_IN || EPI == EPI_XQ || EPI == EPI_UP || EPI == EPI_KV || EPI == EPI_MEM);
  int nfull = ntiles, hR = 0;
  if (HALFOK && xmap) { const int fr = ntiles >> 8; const int R = ntiles - (fr << 8); if (R > 0 && R <= 128) { nfull = fr << 8; hR = R; } }
  const int p_begin = sk ? ((bid & 7) * 8 + (bid >> 5)) * skS : t0;
  const int p_end = sk ? p_begin + skS : nfull;
  const int lrow = tid >> 2, lc = tid & 3;
  const int pc = (lc ^ ((tid >> 4) & 3)) * 8;
  const int sw = (r >> 2) & 3;
  const int xo0 = ((0 + h) ^ sw) * 16, xo1 = ((2 + h) ^ sw) * 16;
  const int aro = (wm * 128 + r) * 64, bro = 16384 + (wn * 64 + r) * 64;
  auto tile_of = [&](int t, int& m0, int& n0) { const int mt = t / TN; m0 = mt << 8; n0 = (t - mt * TN) << 8; };
  auto issue = [&](int m0, int n0, int ks, int slot) {
    const u16* ag = A + (size_t)(m0 + lrow) * lda + pc + ks * 32;
    const u16* bg = Bt + (size_t)(n0 + lrow) * ldb + pc + ks * 32;
    char* dst = smem + slot * STAGE + tid * 16;
#pragma unroll
    for (int i = 0; i < 2; i++)
      __builtin_amdgcn_global_load_lds((const unsigned*)(ag + (size_t)i * 128 * lda), (__attribute__((address_space(3))) unsigned*)(dst + i * 8192), 16, 0, 0);
#pragma unroll
    for (int i = 0; i < 2; i++)
      __builtin_amdgcn_global_load_lds((const unsigned*)(bg + (size_t)i * 128 * ldb), (__attribute__((address_space(3))) unsigned*)(dst + 16384 + i * 8192), 16, 0, 0);
  };
  auto unit_at = [&](int p, int& m0, int& n0, int& kb, int& nkk) {
    if (sk) { const int mt = p / nk; kb = p - mt * nk; const int rem = p_end - p; nkk = (nk - kb) < rem ? (nk - kb) : rem; m0 = mt << 8; n0 = sknt << 8; }
    else { tile_of(p, m0, n0); kb = 0; nkk = nk; }
  };
  if (p_begin < p_end) {
  int t = p_begin, m0, n0, kb, nkk;
  unit_at(t, m0, n0, kb, nkk);
  int ti = p_begin, ki = 0, mi0 = m0, ni0 = n0, kbi = kb, nki = nkk;
  bool idone = false;
  int pend = 0;
  unsigned g = 0;
  asm volatile("s_waitcnt vmcnt(0) lgkmcnt(0)" ::: "memory");
  __builtin_amdgcn_s_barrier();
#pragma unroll 1
  for (int s = 0; s < DEPTH; s++) {
    if (!idone) {
      issue(mi0, ni0, kbi + ki, (g + pend) % NSLOT);
      pend++;
      if (++ki == nki) { ki = 0; ti = sk ? ti + nki : ti + tstep; if (ti < p_end) unit_at(ti, mi0, ni0, kbi, nki); else idone = true; }
    }
  }
  while (true) {
    f32x16 acc[MI][2];
#pragma unroll
    for (int a = 0; a < MI; a++)
#pragma unroll
      for (int b = 0; b < 2; b++)
#pragma unroll
        for (int i = 0; i < 16; i++) acc[a][b][i] = 0.f;
    s16x8 a2[MI], b2, b3;
    {
      const s16x8 z = {0, 0, 0, 0, 0, 0, 0, 0};
#pragma unroll
      for (int i = 0; i < MI; i++) a2[i] = z;
      b2 = z; b3 = z;
    }
#pragma unroll 1
    for (int kt = 0; kt < nkk; kt++) {
      if (pend >= 3) asm volatile("s_waitcnt vmcnt(%0)" ::"n"(2 * GPS) : "memory");
      else if (pend == 2) asm volatile("s_waitcnt vmcnt(%0)" ::"n"(GPS) : "memory");
      else asm volatile("s_waitcnt vmcnt(0)" ::: "memory");
      asm volatile("" ::: "memory");
      __builtin_amdgcn_s_waitcnt(0xC07F);
      __builtin_amdgcn_s_barrier();
      asm volatile("" ::: "memory");
      if (!idone) {
        issue(mi0, ni0, kbi + ki, (g + pend) % NSLOT);
        if (++ki == nki) { ki = 0; ti = sk ? ti + nki : ti + tstep; if (ti < p_end) unit_at(ti, mi0, ni0, kbi, nki); else idone = true; }
      } else {
        pend--;
      }
      const char* sb = smem + (g % NSLOT) * STAGE;
      g++;
      s16x8 a[MI];
#pragma unroll
      for (int i = 0; i < MI; i++) a[i] = *(const s16x8*)(sb + aro + i * 32 * 64 + xo0);
      const s16x8 b0 = *(const s16x8*)(sb + bro + xo0);
      const s16x8 b1 = *(const s16x8*)(sb + bro + 32 * 64 + xo0);
      if (kt > 0) {
#pragma unroll
        for (int i = 0; i < MI; i++) { acc[i][0] = mfma(a2[i], b2, acc[i][0]); acc[i][1] = mfma(a2[i], b3, acc[i][1]); }
      }
#pragma unroll
      for (int i = 0; i < MI; i++) a2[i] = *(const s16x8*)(sb + aro + i * 32 * 64 + xo1);
      b2 = *(const s16x8*)(sb + bro + xo1);
      b3 = *(const s16x8*)(sb + bro + 32 * 64 + xo1);
#pragma unroll
      for (int i = 0; i < MI; i++) { acc[i][0] = mfma(a[i], b0, acc[i][0]); acc[i][1] = mfma(a[i], b1, acc[i][1]); }
    }
#pragma unroll
    for (int i = 0; i < MI; i++) { acc[i][0] = mfma(a2[i], b2, acc[i][0]); acc[i][1] = mfma(a2[i], b3, acc[i][1]); }
    epilogue<EPI, MI>(P, l, acc, m0 + wm * 128, n0 + wn * 64, r, h);
    t = sk ? t + nkk : t + tstep;
    if (t >= p_end) break;
    unit_at(t, m0, n0, kb, nkk);
  }
  }
  if constexpr (HALFOK) {
    if (hR > 0 && hsel < 2 * hR) {
      int m0, n0;
      tile_of(nfull + (hsel >> 1), m0, n0);
      const int half = hsel & 1;
      const int broh = 16384 + (half * 128 + wn * 32 + r) * 64;
      asm volatile("s_waitcnt vmcnt(0) lgkmcnt(0)" ::: "memory");
      __builtin_amdgcn_s_barrier();
      int pend = 0, ki = 0;
      unsigned g = 0;
#pragma unroll 1
      for (int s = 0; s < DEPTH; s++) { if (ki < nk) { issue(m0, n0, ki, (g + pend) % NSLOT); ki++; pend++; } }
      f32x16 acc1[MI][1];
#pragma unroll
      for (int a = 0; a < MI; a++)
#pragma unroll
        for (int i = 0; i < 16; i++) acc1[a][0][i] = 0.f;
#pragma unroll 1
      for (int kt = 0; kt < nk; kt++) {
        if (pend >= 3) asm volatile("s_waitcnt vmcnt(%0)" ::"n"(2 * GPS) : "memory");
        else if (pend == 2) asm volatile("s_waitcnt vmcnt(%0)" ::"n"(GPS) : "memory");
        else asm volatile("s_waitcnt vmcnt(0)" ::: "memory");
        asm volatile("" ::: "memory");
        __builtin_amdgcn_s_waitcnt(0xC07F);
        __builtin_amdgcn_s_barrier();
        asm volatile("" ::: "memory");
        if (ki < nk) { issue(m0, n0, ki, (g + pend) % NSLOT); ki++; } else pend--;
        const char* sb = smem + (g % NSLOT) * STAGE;
        g++;
        s16x8 a[MI], a2[MI];
#pragma unroll
        for (int i = 0; i < MI; i++) { a[i] = *(const s16x8*)(sb + aro + i * 32 * 64 + xo0); a2[i] = *(const s16x8*)(sb + aro + i * 32 * 64 + xo1); }
        const s16x8 b0 = *(const s16x8*)(sb + broh + xo0);
        const s16x8 b2 = *(const s16x8*)(sb + broh + xo1);
#pragma unroll
        for (int i = 0; i < MI; i++) acc1[i][0] = mfma(a[i], b0, acc1[i][0]);
#pragma unroll
        for (int i = 0; i < MI; i++) acc1[i][0] = mfma(a2[i], b2, acc1[i][0]);
      }
      epilogue<EPI, MI, 1>(P, l, acc1, m0 + wm * 128, n0 + half * 128 + wn * 32, r, h);
    }
  }
  asm volatile("s_waitcnt vmcnt(0) lgkmcnt(0)" ::: "memory");
}

DI int next_item(unsigned* ctr, char* smem, int wv) {
  volatile int* slot = (volatile int*)(smem + SMEM_BYTES - 16);
  __syncthreads();
  if (wv == 0 && lane_id() == 0) *slot = (int)__hip_atomic_fetch_add(ctr, 1u, __ATOMIC_RELAXED, __HIP_MEMORY_SCOPE_AGENT);
  __syncthreads();
  return *slot;
}

DI void phase_attn(const Params& P, int l, char* smem) {
  const u16* qf = (const u16*)(P.ws + WS_QF);
  const u16* fk = (const u16*)(P.ws + WS_FOXK);
  const u16* fv = (const u16*)(P.ws + WS_FOXV);
  const float* cum = (const float*)(P.ws + WS_CUM);
  const u16* qm = (const u16*)(P.ws + WS_R1 + R1_QM);
  const u16* kv = (const u16*)(P.ws + WS_R1 + R1_KV);
  const u16* krp = (const u16*)(P.ws + WS_KROPE);
  u16* mixed = (u16*)(P.ws + WS_ACTA);
  constexpr float LOG2E = 1.4426950408889634f;
  const int total = 384 + 16 * 96;
  unsigned* ctr = (unsigned*)(P.ws + WS_CTR) + (l * 2 + 0) * 64;
  for (int t = next_item(ctr, smem, P.wv); t < total; t = next_item(ctr, smem, P.wv)) {
    bool isfox, issample; int b, hd, qb = 0;
    if (t < 128) { isfox = false; issample = true; b = t >> 2; hd = t & 3; }
    else if (t < 384) { isfox = true; issample = true; const int u = t - 128; b = u >> 3; hd = u & 7; }
    else {
      const int u = t - 384; const int grp = u / 96; int w = u % 96; qb = 15 - grp; issample = false;
      if (w < 32) { isfox = false; b = w >> 2; hd = w & 3; }
      else { w -= 32; isfox = true; b = w >> 3; hd = w & 7; }
    }
    AttnJob J;
    J.wv = P.wv;
    size_t tok0, krow0;
    if (issample) { tok0 = (size_t)TP + (size_t)b * DS; krow0 = (size_t)TP + (size_t)b * SKS; J.nq = DS; J.Sk = SKS; J.qpos0 = PAST; }
    else { tok0 = (size_t)b * SEQ + (size_t)qb * 256; krow0 = (size_t)b * SEQ; J.nq = 256; J.Sk = SEQ; J.qpos0 = qb * 256; }
    if (isfox) {
      J.Q = qf + tok0 * 512 + hd * 64; J.ldq = 512;
      J.K1 = fk + krow0 * 512 + hd * 64; J.ldk1 = 512; J.K2 = J.K1; J.ldk2 = 512;
      J.V = fv + krow0 * 512 + hd * 64; J.ldv = 512;
      J.O = mixed + tok0 * 1024 + hd * 64; J.ldo = 1024;
      J.cq = cum + (krow0 + (size_t)J.qpos0) * 8 + hd;
      J.ck = cum + krow0 * 8 + hd;
      J.scale_log2 = 0.125f * LOG2E;
      if (issample) attn_block<64, 64, 64, MASK_FRAME, true, FOX_PF, 512, 512, 512, 512, 1024, 256, true>(J, smem);
      else attn_block<64, 64, 64, MASK_FRAME, true, FOX_PF, 512, 512, 512, 512, 1024, FOX_KT>(J, smem);
    } else {
      J.Q = qm + tok0 * 768 + hd * 192; J.ldq = 768;
      J.K1 = kv + krow0 * 1024 + hd * 256; J.ldk1 = 1024;
      J.K2 = krp + krow0 * 64; J.ldk2 = 64;
      J.V = kv + krow0 * 1024 + hd * 256 + 128; J.ldv = 1024;
      J.O = mixed + tok0 * 1024 + 512 + hd * 128; J.ldo = 1024;
      J.cq = nullptr; J.ck = nullptr;
      J.scale_log2 = 0.07216878364870322f * LOG2E;
      if (issample) attn_block<192, 128, 128, MASK_CHUNK, false, MLA_PF, 768, 1024, 64, 1024, 1024, 128, true>(J, smem);
      else attn_block<192, 128, 128, MASK_CHUNK, false, MLA_PF, 768, 1024, 64, 1024, 1024, 64>(J, smem);
    }
  }
}

DI void phase_cross(const Params& P, int l, char* smem) {
  const u16* xq = (const u16*)(P.ws + WS_R1 + R1_XQ);
  const u16* mk = (const u16*)(P.ws + WS_MEMK) + (size_t)l * MB * NMEM * 1024;
  const u16* mv = (const u16*)(P.ws + WS_MEMV) + (size_t)l * MB * NMEM * 1024;
  u16* xo = (u16*)(P.ws + WS_ACTA);
  constexpr float LOG2E = 1.4426950408889634f;
  const int nsamp = DB * 4 * 2;
  const int total = nsamp + 128 * 4 * 2;
  unsigned* ctr = (unsigned*)(P.ws + WS_CTR) + (l * 2 + 1) * 64;
  for (int t = next_item(ctr, smem, P.wv); t < total; t = next_item(ctr, smem, P.wv)) {
    AttnJob J;
    J.wv = P.wv;
    size_t tok0; int mb, hd, half;
    if (t < nsamp) { const int b = t >> 3; hd = (t >> 1) & 3; half = t & 1; tok0 = (size_t)TP + (size_t)b * DS; mb = NB + b; J.nq = DS; }
    else { const int u = t - nsamp; const int qbk = u >> 3; hd = (u >> 1) & 3; half = u & 1; tok0 = (size_t)qbk * 256; mb = qbk >> 4; J.nq = 256; }
    J.Sk = NMEM; J.qpos0 = 0;
    J.Q = xq + tok0 * 1024 + hd * 256; J.ldq = 1024;
    J.K1 = mk + (size_t)mb * NMEM * 1024 + hd * 256; J.ldk1 = 1024; J.K2 = J.K1; J.ldk2 = 1024;
    J.V = mv + (size_t)mb * NMEM * 1024 + hd * 256 + half * 128; J.ldv = 1024;
    J.O = xo + tok0 * 1024 + hd * 256 + half * 128; J.ldo = 1024;
    J.cq = nullptr; J.ck = nullptr;
    J.scale_log2 = 0.0625f * LOG2E;
    attn_block<256, 256, 128, MASK_NONE, false, false, 1024, 1024, 1024, 1024, 1024, 64>(J, smem);
  }
}

#define XB_TMO      128
#define XB_XCNT(j)  (256  + 64 * (j))
#define XB_XSUB(j)  (1280 + 64 * (j))
#define XB_XGEN(j)  (2304 + 64 * (j))
#define XB_TOP      3328
#define XB_TOPGEN   3392
#define XCD_BAR_WORDS 3456
#define XB_SPIN_CAP (1u << 20)
DI unsigned xb_ld(unsigned* p) { return __hip_atomic_load(p, __ATOMIC_RELAXED, __HIP_MEMORY_SCOPE_AGENT); }
DI unsigned xb_add(unsigned* p, unsigned v) { return __hip_atomic_fetch_add(p, v, __ATOMIC_RELAXED, __HIP_MEMORY_SCOPE_AGENT); }
DI unsigned xb_xcc_id() { return (unsigned)__builtin_amdgcn_s_getreg((3 << 11) | 20) & 0xFu; }
#define XB_SPIN(cond, bar) do { unsigned _sp = 0; while (cond) { __builtin_amdgcn_s_sleep(1); \
    if ((++_sp & 255u) == 0u) { if (xb_ld(&(bar)[XB_TMO])) break; if (_sp > XB_SPIN_CAP) { atomicAdd(&(bar)[XB_TMO], 1u); break; } } } } while (0)
DI void xb_census(unsigned* bar, unsigned x, unsigned& nloc, unsigned& nx) {
  const unsigned G = gridDim.x;
  unsigned sum, cnt, mine, sp = 0u;
  for (;;) {
    sum = 0u; cnt = 0u; mine = 0u;
#pragma unroll
    for (unsigned j = 0; j < 16; ++j) { const unsigned c = xb_ld(&bar[XB_XCNT(j)]); sum += c; cnt += (c > 0u) ? 1u : 0u; mine = (j == x) ? c : mine; }
    if (sum == G) break;
    __builtin_amdgcn_s_sleep(1);
    if ((++sp & 255u) == 0u) { if (xb_ld(&bar[XB_TMO])) break; if (sp > XB_SPIN_CAP) { atomicAdd(&bar[XB_TMO], 1u); break; } }
  }
  nloc = mine > 0u ? mine : 1u; nx = cnt > 0u ? cnt : 1u;
}
DI void xcd_barrier(unsigned* bar, unsigned x, unsigned nloc, unsigned nx, int wv) {
  asm volatile("s_waitcnt vmcnt(0)" ::: "memory");
  __syncthreads();
  if (wv == 0 && lane_id() == 0) {
    __builtin_amdgcn_s_waitcnt(0);
    const unsigned old = xb_add(&bar[XB_XSUB(x)], 1u);
    const unsigned gen = old / nloc;
    if (old + 1u == (gen + 1u) * nloc) {
      __builtin_amdgcn_fence(__ATOMIC_RELEASE, "agent");
      asm volatile("s_waitcnt vmcnt(0)" ::: "memory");
      const unsigned og = xb_add(&bar[XB_TOP], 1u);
      const unsigned tg = og / nx;
      if (og + 1u == (tg + 1u) * nx) xb_add(&bar[XB_TOPGEN], 1u);
      else XB_SPIN(xb_ld(&bar[XB_TOPGEN]) == tg, bar);
      __builtin_amdgcn_fence(__ATOMIC_ACQUIRE, "agent");
      xb_add(&bar[XB_XGEN(x)], 1u);
      asm volatile("s_waitcnt vmcnt(0)" ::: "memory");
    } else {
      XB_SPIN(xb_ld(&bar[XB_XGEN(x)]) == gen, bar);
      __builtin_amdgcn_fence(__ATOMIC_ACQUIRE, "agent");
      asm volatile("s_waitcnt vmcnt(0)" ::: "memory");
    }
  }
  __syncthreads();
}

constexpr int NPHASE = 2 + 13 * NL;

DI void run_phase(const Params& P, int ph, char* smem, bool dup = false) {
  if (ph == 0) { phase_prep(P, smem); return; }
  if (ph == NPHASE - 1) { phase_final(P); return; }
  const int l = (ph - 1) / 13, k = (ph - 1) % 13;
  char* ws = P.ws;
  const u16* actA = (const u16*)(ws + WS_ACTA);
  int rot = 0;
  switch (k) {
    case 0: phase_norm(P, P.in[10] + l * 1024, l); break;
    case 1:
      gemm_phase<EPI_IN>(P, l, actA, 1024, wt_ptr(P, l, WE_IN), 1024, 1024, TT, INP, smem, rot);
      if (l == 0) {
        for (int l2 = 0; l2 < NL; l2++)
          gemm_phase<EPI_MEM>(P, l2, (const u16*)(ws + WS_HMEM) + (size_t)l2 * NB * NMEM * 1024, 1024, wt_ptr(P, l2, WE_MKV), 1024, 1024,
                              NB * NMEM, 2048, smem, rot);
      }
      break;
    case 2: phase_post(P, l, smem); break;
    case 3:
      gemm_phase<EPI_KV>(P, l, (const u16*)(ws + WS_CKV), 128, wt_ptr(P, l, WE_UKV), 128, 128, KROWS, 1024, smem, rot);
      gemm_phase<EPI_UQ>(P, l, (const u16*)(ws + WS_CQN), 256, wt_ptr(P, l, WE_UQ), 256, 256, TT, 768, smem, rot);
      break;
    case 4: phase_attn(P, l, smem); break;
    case 5: if (dup) gemm_phase<EPI_RESID0>(P, l, actA, 1024, wt_ptr(P, l, WE_OUT), 1024, 1024, TT, 1024, smem, rot); else gemm_phase<EPI_RESID>(P, l, actA, 1024, wt_ptr(P, l, WE_OUT), 1024, 1024, TT, 1024, smem, rot); break;
    case 6: phase_norm(P, P.in[18] + l * 1024, -1); break;
    case 7: gemm_phase<EPI_XQ>(P, l, actA, 1024, wt_ptr(P, l, WE_XQ), 1024, 1024, TT, 1024, smem, rot); break;
    case 8: phase_cross(P, l, smem); break;
    case 9: if (dup) gemm_phase<EPI_RESID0>(P, l, actA, 1024, wt_ptr(P, l, WE_XO), 1024, 1024, TT, 1024, smem, rot); else gemm_phase<EPI_RESID>(P, l, actA, 1024, wt_ptr(P, l, WE_XO), 1024, 1024, TT, 1024, smem, rot); break;
    case 10: phase_norm(P, P.in[24] + l * 1024, -1); break;
    case 11: gemm_phase<EPI_UP>(P, l, actA, 1024, wt_ptr(P, l, WE_UP), 1024, 1024, TT, DFF, smem, rot); break;
    case 12: if (dup) gemm_phase<EPI_RESID0>(P, l, (const u16*)(ws + WS_R1 + R1_U), DFF, wt_ptr(P, l, WE_DN), DFF, DFF, TT, 1024, smem, rot); else gemm_phase<EPI_RESID>(P, l, (const u16*)(ws + WS_R1 + R1_U), DFF, wt_ptr(P, l, WE_DN), DFF, DFF, TT, 1024, smem, rot); break;
  }
}

__global__ void __launch_bounds__(NTHR) mega(Params P, int ph_lo, int ph_hi) {
  extern __shared__ __attribute__((aligned(16))) char smem[];
  cg::grid_group grid = cg::this_grid();
  if (ph_hi > 4096) grid.sync();
  unsigned* bar = (unsigned*)(P.ws + WS_BAR);
  const unsigned xb_x = xb_xcc_id();
  unsigned xb_nloc = 1u, xb_nx = 1u;
  if (threadIdx.x == 0) { (void)xb_add(&bar[XB_XCNT(xb_x)], 1u); xb_census(bar, xb_x, xb_nloc, xb_nx); }
  xb_nloc = __builtin_amdgcn_readfirstlane(xb_nloc);
  xb_nx = __builtin_amdgcn_readfirstlane(xb_nx);
  unsigned xb_pack = xb_nloc | (xb_nx << 16) | (xb_x << 24) | ((unsigned)__builtin_amdgcn_readfirstlane(threadIdx.x >> 6) << 28);
  asm volatile("" : "+s"(xb_pack));
  for (int ph = ph_lo; ph < ph_hi; ph++) {
    Params Q = P;
    unsigned pk = xb_pack;
    asm volatile("" : "+s"(Q.out), "+s"(Q.ws), "+s"(pk));
    Q.wv = (int)(pk >> 28);
    run_phase(Q, ph, smem);
    if (ph + 1 < ph_hi) {
      unsigned pk2 = xb_pack;
      asm volatile("" : "+s"(pk2));
      xcd_barrier((unsigned*)(Q.ws + WS_BAR), (pk2 >> 24) & 0xfu, pk2 & 0xffffu, (pk2 >> 16) & 0xffu, (int)(pk2 >> 28));
    }
  }
}

extern "C" void kernel_launch(void* const* d_in, const int* in_sizes, int n_in, void* d_out, int out_size, void* d_ws,
                              size_t ws_size, hipStream_t stream) {
  static int grid_blocks = 0;
  if (!grid_blocks) {
    int dev = 0, cus = 0, per_cu = 0;
    hipGetDevice(&dev);
    hipDeviceGetAttribute(&cus, hipDeviceAttributeMultiprocessorCount, dev);
    hipFuncSetAttribute((const void*)mega, hipFuncAttributeMaxDynamicSharedMemorySize, SMEM_BYTES);
    hipOccupancyMaxActiveBlocksPerMultiprocessor(&per_cu, mega, NTHR, SMEM_BYTES);
    per_cu = 1;
    grid_blocks = cus * per_cu;
  }
  if (n_in != 28 || (size_t)out_size != O_END || ws_size < WS_END) {
    fprintf(stderr, "kernel_launch: shape/ws mismatch n_in %d out %d (want %zu) ws %zu (want %zu)\n", n_in, out_size, (size_t)O_END, ws_size, (size_t)WS_END);
    return;
  }
  Params p;
  memset(&p, 0, sizeof(p));
  for (int i = 0; i < 28; i++) p.in[i] = (const float*)d_in[i];
  p.out = (float*)d_out;
  p.ws = (char*)d_ws;
  hipMemsetAsync((char*)d_ws + WS_BAR, 0, XCD_BAR_WORDS * 4 + 4 * 256, stream);
  int lo = 0, hi = NPHASE;
  void* args[] = {&p, &lo, &hi};
  hipError_t e = hipLaunchCooperativeKernel((void*)mega, dim3(grid_blocks), dim3(NTHR), args, SMEM_BYTES, stream);
  if (e != hipSuccess) fprintf(stderr, "cooperative launch failed: %s (grid %d)\n", hipGetErrorString(e), grid_blocks);
}
```

```cpp
#include <hip/hip_runtime.h>
#include <hip/hip_cooperative_groups.h>
#include <stdint.h>
#include <string.h>
#include <stdio.h>
namespace cg = cooperative_groups;

#ifndef COOP
#define COOP 1
#endif

#ifndef FOX_KT
#define FOX_KT 128
#endif
#ifndef FOX_PF
#define FOX_PF true
#endif
#ifndef MLA_PF
#define MLA_PF true
#endif
#ifndef LB_MIN
#define LB_MIN 2
#endif
#ifndef BM_BIG
#define BM_BIG 256
#endif
constexpr int NTHR = 512, NWV = 8;
#define DI __device__ __forceinline__
typedef unsigned short u16;
typedef short s16x8 __attribute__((ext_vector_type(8)));
typedef short s16x4 __attribute__((ext_vector_type(4)));
typedef __bf16 bfx8 __attribute__((ext_vector_type(8)));
typedef __bf16 bfx2 __attribute__((ext_vector_type(2)));
typedef float f32x16 __attribute__((ext_vector_type(16)));
typedef float f32x4 __attribute__((ext_vector_type(4)));
typedef float f32x2 __attribute__((ext_vector_type(2)));
typedef unsigned u32x4 __attribute__((ext_vector_type(4)));
typedef unsigned u32x2 __attribute__((ext_vector_type(2)));

constexpr int DM = 1024, NB = 8, SEQ = 4096, NL = 2, DB = 32, DS = 32, PAST = 2048;
constexpr int TP = NB * SEQ;
constexpr int TS = DB * DS;
constexpr int TT = TP + TS;
constexpr int SKS = PAST + DS;
constexpr int KROWS = TP + DB * SKS;
constexpr int INC = 1992, INP = 2048;
constexpr int NMEM = 256, MB = NB + DB;
constexpr int DFF = 4096;

constexpr size_t O_Y = 0;
constexpr size_t O_FKP = (size_t)TT * DM;
constexpr size_t O_FVP = O_FKP + (size_t)NL * TP * 512;
constexpr size_t O_FLP = O_FVP + (size_t)NL * TP * 512;
constexpr size_t O_CKP = O_FLP + (size_t)NL * TP * 8;
constexpr size_t O_KRP = O_CKP + (size_t)NL * TP * 128;
constexpr size_t O_MKP = O_KRP + (size_t)NL * TP * 64;
constexpr size_t O_MVP = O_MKP + (size_t)NL * NB * NMEM * 1024;
constexpr size_t O_FKS = O_MVP + (size_t)NL * NB * NMEM * 1024;
constexpr size_t O_FVS = O_FKS + (size_t)NL * TS * 512;
constexpr size_t O_FLS = O_FVS + (size_t)NL * TS * 512;
constexpr size_t O_CKS = O_FLS + (size_t)NL * TS * 8;
constexpr size_t O_KRS = O_CKS + (size_t)NL * TS * 128;
constexpr size_t O_END = O_KRS + (size_t)NL * TS * 64;

constexpr size_t al256(size_t x) { return (x + 255) / 256 * 256; }
constexpr size_t WE_IN = 0;
constexpr size_t WE_UQ = WE_IN + (size_t)INP * 1024;
constexpr size_t WE_UKV = WE_UQ + (size_t)768 * 256;
constexpr size_t WE_OUT = WE_UKV + (size_t)1024 * 128;
constexpr size_t WE_XQ = WE_OUT + (size_t)1024 * 1024;
constexpr size_t WE_MKV = WE_XQ + (size_t)1024 * 1024;
constexpr size_t WE_XO = WE_MKV + (size_t)2048 * 1024;
constexpr size_t WE_UP = WE_XO + (size_t)1024 * 1024;
constexpr size_t WE_DN = WE_UP + (size_t)4096 * 1024;
constexpr size_t WE_LAYER = WE_DN + (size_t)1024 * 4096;
constexpr size_t WS_WT = 0;
constexpr size_t WS_ROPE = al256(WS_WT + WE_LAYER * 2 * NL);
constexpr size_t WS_ACTA = al256(WS_ROPE + (size_t)4096 * 32 * 8);
constexpr size_t WS_QF = al256(WS_ACTA + (size_t)TT * 1024 * 2);
constexpr size_t WS_FOXK = al256(WS_QF + (size_t)TT * 512 * 2);
constexpr size_t WS_FOXV = al256(WS_FOXK + (size_t)KROWS * 512 * 2);
constexpr size_t WS_CUM = al256(WS_FOXV + (size_t)KROWS * 512 * 2);
constexpr size_t WS_ZC = al256(WS_CUM + (size_t)KROWS * 8 * 4);
constexpr size_t WS_CQN = al256(WS_ZC + (size_t)TT * 448 * 4);
constexpr size_t WS_CKV = al256(WS_CQN + (size_t)TT * 256 * 2);
constexpr size_t WS_KROPE = al256(WS_CKV + (size_t)KROWS * 128 * 2);
constexpr size_t WS_MEMK = al256(WS_KROPE + (size_t)KROWS * 64 * 2);
constexpr size_t WS_MEMV = al256(WS_MEMK + (size_t)NL * MB * NMEM * 1024 * 2);
constexpr size_t WS_HMEM = al256(WS_MEMV + (size_t)NL * MB * NMEM * 1024 * 2);
constexpr size_t WS_R1 = al256(WS_HMEM + (size_t)NL * NB * NMEM * 1024 * 2);
constexpr size_t R1_KV = 0;
constexpr size_t R1_QM = al256((size_t)KROWS * 1024 * 2);
constexpr size_t R1_U = 0;
constexpr size_t R1_XQ = 0;
constexpr size_t WS_BAR = al256(WS_R1 + (size_t)TT * 4096 * 2);
constexpr size_t WS_CTR = WS_BAR + 3456 * 4;
constexpr size_t WS_END = al256(WS_CTR + 4 * 256);
static_assert(R1_QM + (size_t)TT * 768 * 2 <= (size_t)TT * 4096 * 2, "R1 overflow");

constexpr int SMEM_BYTES = 131072;

struct Params {
  const float* in[28];
  float* out;
  char* ws;
  int wv;
  int pad;
};

DI int get_bid() { int t = blockIdx.x; asm volatile("" : "+s"(t)); return t; }
DI int get_nblk() { int t = gridDim.x; asm volatile("" : "+s"(t)); return t; }
DI int lane_id() { return (int)__builtin_amdgcn_mbcnt_hi(~0u, __builtin_amdgcn_mbcnt_lo(~0u, 0u)); }
DI int get_tid(int wv) { int t = (wv << 6) | lane_id(); asm volatile("" : "+v"(t)); return t; }
DI unsigned pk2(float a, float b) { f32x2 v = {a, b}; return __builtin_bit_cast(unsigned, __builtin_convertvector(v, bfx2)); }
DI u16 f2bf(float a) { return (u16)(pk2(a, 0.f) & 0xffffu); }
DI f32x16 mfma(s16x8 a, s16x8 b, f32x16 c) {
  return __builtin_amdgcn_mfma_f32_32x32x16_bf16(__builtin_bit_cast(bfx8, a), __builtin_bit_cast(bfx8, b), c, 0, 0, 0);
}
DI int crow(int i, int h) { return (i & 3) + 8 * (i >> 2) + 4 * h; }
DI float wave_sum(float v) {
#pragma unroll
  for (int m = 32; m >= 1; m >>= 1) v += __shfl_xor(v, m);
  return v;
}
DI float xhalf_max(float v) {
  auto rr = __builtin_amdgcn_permlane32_swap(__float_as_uint(v), __float_as_uint(v), false, false);
  return fmaxf(__uint_as_float(rr[0]), __uint_as_float(rr[1]));
}
DI float xhalf_sum(float v) {
  auto rr = __builtin_amdgcn_permlane32_swap(__float_as_uint(v), __float_as_uint(v), false, false);
  return __uint_as_float(rr[0]) + __uint_as_float(rr[1]);
}
DI int tok_krow(int tok) {
  if (tok < TP) return tok;
  const int s = tok - TP;
  return TP + (s >> 5) * SKS + PAST + (s & 31);
}
DI int tok_pos(int tok) { return tok < TP ? (tok & (SEQ - 1)) : PAST + ((tok - TP) & 31); }

enum { EPI_IN = 0, EPI_MEM, EPI_UQ, EPI_KV, EPI_RESID, EPI_XQ, EPI_UP, EPI_RESID0 };

template <int EPI, int MI, int NI = 2>
DI void epilogue(const Params& P, int l, f32x16 (&acc)[MI][NI], int mw, int nw, int r, int h) {
  float* out = P.out;
  char* ws = P.ws;
  if constexpr (EPI == EPI_IN) {
    u16* qf = (u16*)(ws + WS_QF);
    u16* fk = (u16*)(ws + WS_FOXK);
    u16* fv = (u16*)(ws + WS_FOXV);
    float* zc = (float*)(ws + WS_ZC);
    const float* bfg = P.in[12] + l * 8;
#pragma unroll
    for (int mi = 0; mi < MI; mi++) {
#pragma unroll
      for (int i = 0; i < 16; i++) {
        const int row = mw + mi * 32 + crow(i, h);
        const int kr = tok_krow(row);
        const bool isp = row < TP;
        const size_t orow = isp ? ((size_t)l * TP + row) : ((size_t)l * TS + (row - TP));
#pragma unroll
        for (int ni = 0; ni < NI; ni++) {
          const int col = nw + ni * 32 + r;
          const float v = acc[mi][ni][i];
          if (col < 512) {
            qf[(size_t)row * 512 + col] = f2bf(v);
          } else if (col < 1024) {
            const int c = col - 512;
            out[(isp ? O_FKP : O_FKS) + orow * 512 + c] = v;
            fk[(size_t)kr * 512 + c] = f2bf(v);
          } else if (col < 1536) {
            const int c = col - 1024;
            out[(isp ? O_FVP : O_FVS) + orow * 512 + c] = v;
            fv[(size_t)kr * 512 + c] = f2bf(v);
          } else if (col < 1544) {
            const int c = col - 1536;
            const float g = v + bfg[c];
            const float ls = fminf(g, 0.f) - __logf(1.f + __expf(-fabsf(g)));
            out[(isp ? O_FLP : O_FLS) + orow * 8 + c] = ls;
          } else if (col < INC) {
            zc[(size_t)row * 448 + (col - 1544)] = v;
          }
        }
      }
    }
  } else if constexpr (EPI == EPI_MEM) {
    u16* mk = (u16*)(ws + WS_MEMK);
    u16* mv = (u16*)(ws + WS_MEMV);
#pragma unroll
    for (int mi = 0; mi < MI; mi++) {
#pragma unroll
      for (int i = 0; i < 16; i++) {
        const int row = mw + mi * 32 + crow(i, h);
#pragma unroll
        for (int ni = 0; ni < NI; ni++) {
          const int col = nw + ni * 32 + r;
          const float v = acc[mi][ni][i];
          const int c = col & 1023;
          const size_t oidx = ((size_t)l * (NB * NMEM) + row) * 1024 + c;
          const size_t bidx = ((size_t)l * (MB * NMEM) + row) * 1024 + c;
          if (col < 1024) { out[O_MKP + oidx] = v; mk[bidx] = f2bf(v); }
          else { out[O_MVP + oidx] = v; mv[bidx] = f2bf(v); }
        }
      }
    }
  } else if constexpr (EPI == EPI_UQ) {
    u16* qm = (u16*)(ws + WS_R1 + R1_QM);
    const f32x2* rt = (const f32x2*)(ws + WS_ROPE);
    const bool isrope = (nw % 192) == 128;
#pragma unroll
    for (int mi = 0; mi < MI; mi++) {
#pragma unroll
      for (int i = 0; i < 16; i++) {
        const int row = mw + mi * 32 + crow(i, h);
        float x1 = acc[mi][0][i], x2 = acc[mi][1][i];
        if (isrope) {
          const f32x2 cs = rt[tok_pos(row) * 32 + r];
          const float o1 = x1 * cs[0] - x2 * cs[1];
          const float o2 = x2 * cs[0] + x1 * cs[1];
          x1 = o1; x2 = o2;
        }
        qm[(size_t)row * 768 + nw + r] = f2bf(x1);
        qm[(size_t)row * 768 + nw + 32 + r] = f2bf(x2);
      }
    }
  } else if constexpr (EPI == EPI_KV || EPI == EPI_XQ || EPI == EPI_UP) {
    u16* dst; int ld;
    if constexpr (EPI == EPI_KV) { dst = (u16*)(ws + WS_R1 + R1_KV); ld = 1024; }
    else if constexpr (EPI == EPI_XQ) { dst = (u16*)(ws + WS_R1 + R1_XQ); ld = 1024; }
    else { dst = (u16*)(ws + WS_R1 + R1_U); ld = DFF; }
    const bool odd = r & 1;
    const int colb = nw + (r & ~1);
#pragma unroll
    for (int mi = 0; mi < MI; mi++) {
#pragma unroll
      for (int i = 0; i < 16; i += 2) {
        const int row = mw + mi * 32 + crow(i, h) + (odd ? 1 : 0);
#pragma unroll
        for (int ni = 0; ni < NI; ni++) {
          float v0 = acc[mi][ni][i], v1 = acc[mi][ni][i + 1];
          if constexpr (EPI == EPI_UP) { v0 = fmaxf(v0, 0.f); v0 = v0 * v0; v1 = fmaxf(v1, 0.f); v1 = v1 * v1; }
          const float send = odd ? v0 : v1;
          const float recv = __int_as_float(__builtin_amdgcn_mov_dpp(__float_as_int(send), 0xB1, 0xF, 0xF, true));
          const unsigned w = odd ? pk2(recv, v1) : pk2(v0, recv);
          *(unsigned*)(dst + (size_t)row * ld + colb + ni * 32) = w;
        }
      }
    }
  } else if constexpr (EPI == EPI_RESID || EPI == EPI_RESID0) {
#pragma unroll
    for (int mi = 0; mi < MI; mi++) {
#pragma unroll
      for (int i = 0; i < 16; i++) {
        const int row = mw + mi * 32 + crow(i, h);
#pragma unroll
        for (int ni = 0; ni < NI; ni++) {
          unsafeAtomicAdd(out + (size_t)row * DM + nw + ni * 32 + r, EPI == EPI_RESID0 ? acc[mi][ni][i] * 0.f : acc[mi][ni][i]);
        }
      }
    }
  }
}

enum { MASK_NONE = 0, MASK_FRAME = 1, MASK_CHUNK = 2 };
struct AttnJob {
  const u16* Q; int ldq;
  const u16* K1; int ldk1;
  const u16* K2; int ldk2;
  const u16* V; int ldv;
  u16* O; int ldo;
  const float* cq;
  const float* ck;
  int nq, Sk, qpos0;
  float scale_log2;
  int wv;
};

template <int DQK, int D1, int DVT, int MASK, bool BIAS, bool PREFETCH, int LDQ, int LDK1, int LDK2, int LDV, int LDO, int KT, bool KSPLIT = false>
DI void attn_block(const AttnJob& J, char* smem) {
  constexpr int KP = DQK * 2 + 16;
  constexpr int VP = DVT * 2;
  constexpr int CV = DVT / 8;
  constexpr int NKK = DQK / 16, NDV = DVT / 32;
  constexpr float LOG2E = 1.4426950408889634f;
  char* Ks = smem;
  char* Vs = smem + KT * KP;
  float* cks = (float*)(smem + KT * KP + KT * VP);
  const int tid = get_tid(J.wv), wave = tid >> 6, lane = tid & 63, r = lane & 31, h = lane >> 5;
  const int wq0 = KSPLIT ? 0 : wave * 32;
  const bool active = wq0 < J.nq;
  const int qi = wq0 + r;
  const int qpos = J.qpos0 + qi;
  const int wqmax = J.qpos0 + wq0 + 31;
  const int qmax = J.qpos0 + J.nq - 1;
  const int ntk = (J.Sk + KT - 1) / KT;
  int nt = ntk;
  if (MASK != MASK_NONE) { const int t2 = qmax / KT + 1; nt = t2 < ntk ? t2 : ntk; }

  s16x8 qf[NKK];
  {
    const u16* qp = J.Q + (size_t)qi * LDQ + h * 8;
#pragma unroll
    for (int kk = 0; kk < NKK; kk++) {
      if (active) qf[kk] = *(const s16x8*)(qp + kk * 16);
      else { s16x8 z = {0, 0, 0, 0, 0, 0, 0, 0}; qf[kk] = z; }
    }
  }

  f32x16 o[NDV];
#pragma unroll
  for (int d = 0; d < NDV; d++)
#pragma unroll
    for (int i = 0; i < 16; i++) o[d][i] = 0.f;
  float m_run = -1e30f, l_run = 0.f;

  constexpr int CK1 = D1 / 8, CK2 = (DQK - D1) / 8;
  constexpr int RP1 = NTHR / CK1, NP1 = KT / RP1;
  constexpr int RP2 = CK2 ? NTHR / (CK2 ? CK2 : 1) : 64, NP2 = CK2 ? KT / RP2 : 0;
  constexpr int RPV = NTHR / CV, NPV = KT / RPV;
  u32x4 rk1[NP1], rk2[NP2 ? NP2 : 1], rv[NPV];
  float rck = 0.f;
  const int tq = (lane & 15) >> 2, tp = lane & 3, tblk = (lane >> 4) & 1;
  const int vswz = (DVT >= 128) ? tq : (tq >> 1);
  const int r1 = tid / CK1, c1 = tid % CK1;
  const int r2 = CK2 ? tid / (CK2 ? CK2 : 1) : 0, c2 = CK2 ? tid % (CK2 ? CK2 : 1) : 0;
  const int r3 = tid / CV, c3 = tid % CV;
  const unsigned k1o = (unsigned)(r1 * LDK1 + c1 * 8) * 2u;
  const unsigned k2o = (unsigned)(r2 * LDK2 + c2 * 8) * 2u;
  const unsigned vo = (unsigned)(r3 * LDV + c3 * 8) * 2u;
  const int k1so = r1 * KP + c1 * 16;
  const int k2so = r2 * KP + D1 * 2 + c2 * 16;
  const int vsw = (DVT >= 128) ? (r3 & 3) : ((r3 >> 1) & 1);
  const int vso = KT * KP + r3 * VP + (((c3 >> 2) ^ vsw) * 64) + (c3 & 3) * 16;
  const int vro = KT * KP + (4 * h + tq) * VP + (16 * tblk + 4 * tp) * 2;
  const int kro = r * KP + h * 16;

  auto load_tile = [&](int j) {
    const int kb = j * KT;
#pragma unroll
    for (int i = 0; i < NP1; i++) {
      u32x4 v = {0u, 0u, 0u, 0u};
      if (kb + r1 + i * RP1 < J.Sk) v = *(const u32x4*)((const char*)(J.K1 + (size_t)(kb + i * RP1) * LDK1) + k1o);
      rk1[i] = v;
    }
#pragma unroll
    for (int i = 0; i < NP2; i++) {
      u32x4 v = {0u, 0u, 0u, 0u};
      if (kb + r2 + i * RP2 < J.Sk) v = *(const u32x4*)((const char*)(J.K2 + (size_t)(kb + i * RP2) * LDK2) + k2o);
      rk2[i] = v;
    }
#pragma unroll
    for (int i = 0; i < NPV; i++) {
      u32x4 v = {0u, 0u, 0u, 0u};
      if (kb + r3 + i * RPV < J.Sk) v = *(const u32x4*)((const char*)(J.V + (size_t)(kb + i * RPV) * LDV) + vo);
      rv[i] = v;
    }
    if (BIAS) {
      if (tid < KT) { const int key = kb + tid; rck = key < J.Sk ? -J.ck[(size_t)key * 8] * LOG2E : 0.f; }
    }
  };
  auto store_tile = [&]() {
    int a1 = k1so, a2 = k2so, a3 = vso;
    asm volatile("" : "+v"(a1), "+v"(a2), "+v"(a3));
#pragma unroll
    for (int i = 0; i < NP1; i++) *(u32x4*)(smem + a1 + i * RP1 * KP) = rk1[i];
#pragma unroll
    for (int i = 0; i < NP2; i++) *(u32x4*)(smem + a2 + i * RP2 * KP) = rk2[i];
#pragma unroll
    for (int i = 0; i < NPV; i++) *(u32x4*)(smem + a3 + i * RPV * VP) = rv[i];
    if (BIAS) { if (tid < KT) cks[tid] = rck; }
  };

  if (PREFETCH) load_tile(0);
  for (int j = 0; j < nt; j++) {
    __syncthreads();
    if (!PREFETCH) load_tile(j);
    store_tile();
    __syncthreads();
    if (PREFETCH) { if (j + 1 < nt) load_tile(j + 1); }
    const bool need = active && (MASK == MASK_NONE || j * KT <= wqmax);
    if (need) {
      int kro_l = kro, vro_l = vro;
      asm volatile("" : "+v"(kro_l), "+v"(vro_l));
      const char* krd = smem + kro_l;
      const bool needmask = (MASK == MASK_FRAME && j * KT + KT - 1 > J.qpos0 + wq0) || (j * KT + KT - 1 >= J.Sk);
      const int dq = (MASK == MASK_FRAME ? min(qpos, J.Sk - 1) : J.Sk - 1) - j * KT - 4 * h;
      auto qk = [&](int hb) {
        f32x16 p;
#pragma unroll
        for (int i = 0; i < 16; i++) p[i] = 0.f;
#pragma unroll
        for (int kk = 0; kk < NKK; kk++) {
          const s16x8 kf = *(const s16x8*)(krd + hb * 32 * KP + kk * 32);
          p = mfma(kf, qf[kk], p);
        }
        return p;
      };
      auto soft_pv = [&](int hb, f32x16 p, f32x16* pnext_out, bool issue_next) {
        if (BIAS) {
#pragma unroll
          for (int g = 0; g < 4; g++) {
            const f32x4 c0 = *(const f32x4*)(cks + hb * 32 + 8 * g + 4 * h);
#pragma unroll
            for (int e = 0; e < 4; e++) p[4 * g + e] = fmaf(p[4 * g + e], J.scale_log2, c0[e]);
          }
        } else {
#pragma unroll
          for (int i = 0; i < 16; i++) p[i] *= J.scale_log2;
        }
        if (needmask) {
#pragma unroll
          for (int i = 0; i < 16; i++) {
            const int cc = (i & 3) + 8 * (i >> 2) + 32 * hb;
            p[i] = (cc <= dq) ? p[i] : -1e30f;
          }
        }
        float mx = p[0];
#pragma unroll
        for (int i = 1; i < 16; i++) mx = fmaxf(mx, p[i]);
        mx = xhalf_max(mx);
        if (__any(mx > m_run + 8.f)) {
          const float m_new = fmaxf(m_run, mx);
          const float alpha = __builtin_amdgcn_exp2f(m_run - m_new);
          m_run = m_new;
          l_run *= alpha;
#pragma unroll
          for (int d = 0; d < NDV; d++)
#pragma unroll
            for (int i = 0; i < 16; i++) o[d][i] *= alpha;
        }
        if (issue_next) *pnext_out = qk(hb + 1);
        float ps = 0.f;
#pragma unroll
        for (int i = 0; i < 16; i++) { p[i] = __builtin_amdgcn_exp2f(p[i] - m_run); ps += p[i]; }
        l_run += ps;
        s16x8 pb[2];
        {
          u32x4 w;
          w[0] = pk2(p[0], p[1]); w[1] = pk2(p[2], p[3]); w[2] = pk2(p[4], p[5]); w[3] = pk2(p[6], p[7]);
          pb[0] = __builtin_bit_cast(s16x8, w);
          w[0] = pk2(p[8], p[9]); w[1] = pk2(p[10], p[11]); w[2] = pk2(p[12], p[13]); w[3] = pk2(p[14], p[15]);
          pb[1] = __builtin_bit_cast(s16x8, w);
        }
#pragma unroll
        for (int d = 0; d < NDV; d++) {
          const char* vb = smem + (vro_l + ((d ^ vswz) * 64)) + hb * 32 * VP;
#pragma unroll
          for (int s = 0; s < 2; s++) {
            const s16x4 lo = __builtin_amdgcn_ds_read_tr16_b64_v4i16(
                (__attribute__((address_space(3))) s16x4*)(uintptr_t)(vb + (16 * s) * VP));
            const s16x4 hi = __builtin_amdgcn_ds_read_tr16_b64_v4i16(
                (__attribute__((address_space(3))) s16x4*)(uintptr_t)(vb + (16 * s + 8) * VP));
            const s16x8 vf = __builtin_shufflevector(lo, hi, 0, 1, 2, 3, 4, 5, 6, 7);
            o[d] = mfma(vf, pb[s], o[d]);
          }
        }
      };
      if constexpr (KSPLIT) {
#pragma unroll
        for (int hb = 0; hb < KT / 32; hb++) {
          if (hb != J.wv) continue;
          if (MASK == MASK_FRAME && j * KT + hb * 32 > wqmax) continue;
          soft_pv(hb, qk(hb), nullptr, false);
        }
      } else {
        f32x16 pcur = qk(0);
        if (!needmask) {
#pragma unroll
          for (int hb = 0; hb < KT / 32; hb++) {
            f32x16 pnext = pcur;
            soft_pv(hb, pcur, &pnext, hb + 1 < KT / 32);
            pcur = pnext;
          }
        } else {
          bool vcur = true;
#pragma unroll
          for (int hb = 0; hb < KT / 32; hb++) {
            f32x16 pnext = pcur;
            bool vnext = false;
            if (hb + 1 < KT / 32) {
              vnext = !(MASK == MASK_FRAME && j * KT + (hb + 1) * 32 > wqmax);
              if (vnext) pnext = qk(hb + 1);
            }
            if (vcur) soft_pv(hb, pcur, nullptr, false);
            pcur = pnext; vcur = vnext;
          }
        }
      }
    }
  }
  float lt = xhalf_sum(l_run);
  bool writer = active && qi < J.nq;
  if (KSPLIT) {
    constexpr int NWS = KT / 32;
    constexpr int NV = NDV * 16 + 2;
    float* mb = (float*)smem;
    __syncthreads();
    if (wave < NWS) {
      float* w = mb + (size_t)wave * NV * 64 + lane;
#pragma unroll
      for (int d = 0; d < NDV; d++)
#pragma unroll
        for (int i = 0; i < 16; i++) w[(d * 16 + i) * 64] = o[d][i];
      w[(NDV * 16) * 64] = m_run;
      w[(NDV * 16 + 1) * 64] = lt;
    }
    __syncthreads();
    writer = writer && (wave == 0);
    if (wave == 0) {
      float M = -1e30f;
#pragma unroll
      for (int w2 = 0; w2 < NWS; w2++) M = fmaxf(M, mb[((size_t)w2 * NV + NDV * 16) * 64 + lane]);
      float L = 0.f;
#pragma unroll
      for (int d = 0; d < NDV; d++)
#pragma unroll
        for (int i = 0; i < 16; i++) o[d][i] = 0.f;
#pragma unroll 1
      for (int w2 = 0; w2 < NWS; w2++) {
        const float* rsrc = mb + (size_t)w2 * NV * 64 + lane;
        const float sc = __builtin_amdgcn_exp2f(rsrc[(NDV * 16) * 64] - M);
        L += rsrc[(NDV * 16 + 1) * 64] * sc;
#pragma unroll
        for (int d = 0; d < NDV; d++)
#pragma unroll
          for (int i = 0; i < 16; i++) o[d][i] += rsrc[(d * 16 + i) * 64] * sc;
      }
      lt = L;
    }
  }
  if (writer) {
    const float inv = 1.f / lt;
    u16* op = J.O + (size_t)qi * LDO + 4 * h;
#pragma unroll
    for (int d = 0; d < NDV; d++) {
#pragma unroll
      for (int g = 0; g < 4; g++) {
        u32x2 w;
        w[0] = pk2(o[d][4 * g] * inv, o[d][4 * g + 1] * inv);
        w[1] = pk2(o[d][4 * g + 2] * inv, o[d][4 * g + 3] * inv);
        *(u32x2*)(op + d * 32 + 8 * g) = w;
      }
    }
  }
}

template <int NR, bool F32OUT>
DI void rms_rows(const float* __restrict__ xbase, size_t rstride, int nvalid, const float* __restrict__ g, void* dbase, size_t dstride, int lane) {
  f32x4 v[NR][4];
#pragma unroll
  for (int j = 0; j < NR; j++)
#pragma unroll
    for (int i = 0; i < 4; i++) {
      if (j < nvalid) v[j][i] = *(const f32x4*)(xbase + (size_t)j * rstride + i * 256 + lane * 4);
      else { f32x4 z = {0.f, 0.f, 0.f, 0.f}; v[j][i] = z; }
    }
  f32x4 gg[4];
#pragma unroll
  for (int i = 0; i < 4; i++) gg[i] = *(const f32x4*)(g + i * 256 + lane * 4);
#pragma unroll
  for (int j = 0; j < NR; j++) {
    float ss = 0.f;
#pragma unroll
    for (int i = 0; i < 4; i++) ss += v[j][i][0] * v[j][i][0] + v[j][i][1] * v[j][i][1] + v[j][i][2] * v[j][i][2] + v[j][i][3] * v[j][i][3];
    ss = wave_sum(ss);
    const float rs = rsqrtf(ss * (1.f / 1024.f) + 1e-6f);
    if (j < nvalid) {
#pragma unroll
      for (int i = 0; i < 4; i++) {
        if (F32OUT) {
          f32x4 w;
          w[0] = v[j][i][0] * rs * gg[i][0]; w[1] = v[j][i][1] * rs * gg[i][1]; w[2] = v[j][i][2] * rs * gg[i][2]; w[3] = v[j][i][3] * rs * gg[i][3];
          *(f32x4*)((float*)dbase + (size_t)j * dstride + i * 256 + lane * 4) = w;
        } else {
          u32x2 w;
          w[0] = pk2(v[j][i][0] * rs * gg[i][0], v[j][i][1] * rs * gg[i][1]);
          w[1] = pk2(v[j][i][2] * rs * gg[i][2], v[j][i][3] * rs * gg[i][3]);
          *(u32x2*)((u16*)dbase + (size_t)j * dstride + i * 256 + lane * 4) = w;
        }
      }
    }
  }
}

DI void cvt_job(const float* __restrict__ src, u16* __restrict__ dst, int nseg, size_t seglen, size_t sstride, size_t dstride, int wv) {
  const size_t upseg = seglen / 8;
  const size_t total = upseg * nseg;
  const size_t stride = (size_t)get_nblk() * NTHR;
  for (size_t u0 = (size_t)get_bid() * NTHR + get_tid(wv); u0 < total; u0 += 4 * stride) {
    f32x4 a[4], b[4];
    size_t so[4], dd[4];
#pragma unroll
    for (int q = 0; q < 4; q++) {
      const size_t u = u0 + q * stride;
      const size_t uu = u < total ? u : u0;
      const size_t sg = uu / upseg, off = (uu - sg * upseg) * 8;
      so[q] = sg * sstride + off; dd[q] = sg * dstride + off;
      a[q] = *(const f32x4*)(src + so[q]);
      b[q] = *(const f32x4*)(src + so[q] + 4);
    }
#pragma unroll
    for (int q = 0; q < 4; q++) {
      if (u0 + q * stride < total) {
        u32x4 w;
        w[0] = pk2(a[q][0], a[q][1]); w[1] = pk2(a[q][2], a[q][3]); w[2] = pk2(b[q][0], b[q][1]); w[3] = pk2(b[q][2], b[q][3]);
        *(u32x4*)(dst + dd[q]) = w;
      }
    }
  }
}

DI void transpose_job(const float* __restrict__ src, u16* __restrict__ dst, int K, int N, int Npad, int& rot, char* smem, int wv) {
  float* tile = (float*)smem;
  const int tk = K / 64, tn = Npad / 64, ntiles = tk * tn;
  const int G = get_nblk();
  const int tid = get_tid(wv);
  for (int t = (get_bid() + G - (rot % G)) % G; t < ntiles; t += G) {
    const int k0 = (t % tk) * 64, n0 = (t / tk) * 64;
    float v[8];
#pragma unroll
    for (int i = 0; i < 8; i++) {
      const int k = i * 8 + (tid >> 6), n = tid & 63;
      v[i] = (n0 + n < N) ? src[(size_t)(k0 + k) * N + n0 + n] : 0.f;
    }
    __syncthreads();
#pragma unroll
    for (int i = 0; i < 8; i++) {
      const int k = i * 8 + (tid >> 6), n = tid & 63;
      tile[k * 65 + n] = v[i];
    }
    __syncthreads();
#pragma unroll
    for (int i = 0; i < 4; i++) {
      const int n = i * 16 + (tid >> 5), k = (tid & 31) * 2;
      *(unsigned*)(dst + (size_t)(n0 + n) * K + k0 + k) = pk2(tile[k * 65 + n], tile[(k + 1) * 65 + n]);
    }
  }
  rot += ntiles;
}

DI u16* wt_ptr(const Params& P, int l, size_t eoff) { return (u16*)(P.ws + WS_WT) + (size_t)l * WE_LAYER + eoff; }

DI void phase_prep(const Params& P, char* smem) {
  const int tid = get_tid(P.wv), lane = tid & 63;
  const int gw = get_bid() * NWV + (tid >> 6), nw = get_nblk() * NWV;
  int rot = 0;
  for (int l = 0; l < NL; l++) {
    transpose_job(P.in[11] + (size_t)l * 1024 * INC, wt_ptr(P, l, WE_IN), 1024, INC, INP, rot, smem, P.wv);
    transpose_job(P.in[14] + (size_t)l * 256 * 768, wt_ptr(P, l, WE_UQ), 256, 768, 768, rot, smem, P.wv);
    transpose_job(P.in[16] + (size_t)l * 128 * 1024, wt_ptr(P, l, WE_UKV), 128, 1024, 1024, rot, smem, P.wv);
    transpose_job(P.in[17] + (size_t)l * 1024 * 1024, wt_ptr(P, l, WE_OUT), 1024, 1024, 1024, rot, smem, P.wv);
    transpose_job(P.in[20] + (size_t)l * 1024 * 1024, wt_ptr(P, l, WE_XQ), 1024, 1024, 1024, rot, smem, P.wv);
    transpose_job(P.in[21] + (size_t)l * 1024 * 1024, wt_ptr(P, l, WE_MKV), 1024, 1024, 1024, rot, smem, P.wv);
    transpose_job(P.in[22] + (size_t)l * 1024 * 1024, wt_ptr(P, l, WE_MKV) + (size_t)1024 * 1024, 1024, 1024, 1024, rot, smem, P.wv);
    transpose_job(P.in[23] + (size_t)l * 1024 * 1024, wt_ptr(P, l, WE_XO), 1024, 1024, 1024, rot, smem, P.wv);
    transpose_job(P.in[25] + (size_t)l * 1024 * 4096, wt_ptr(P, l, WE_UP), 1024, 4096, 4096, rot, smem, P.wv);
    transpose_job(P.in[26] + (size_t)l * 4096 * 1024, wt_ptr(P, l, WE_DN), 4096, 1024, 1024, rot, smem, P.wv);
  }
  {
    f32x2* rt = (f32x2*)(P.ws + WS_ROPE);
    for (int i = get_bid() * NTHR + tid; i < 4096 * 32; i += get_nblk() * NTHR) {
      const int pos = i >> 5, j = i & 31;
      const float inv = powf(10000.f, -(float)j / 32.f);
      const float ang = (float)pos * inv;
      f32x2 cs; cs[0] = cosf(ang); cs[1] = sinf(ang);
      rt[i] = cs;
    }
  }
  for (int l = 0; l < NL; l++) {
    const size_t seg = (size_t)DB * NMEM * 1024;
    cvt_job(P.in[8] + l * seg, (u16*)(P.ws + WS_MEMK) + ((size_t)l * MB + NB) * NMEM * 1024, 1, seg, 0, 0, P.wv);
    cvt_job(P.in[9] + l * seg, (u16*)(P.ws + WS_MEMV) + ((size_t)l * MB + NB) * NMEM * 1024, 1, seg, 0, 0, P.wv);
  }
  for (int rr = gw; rr < NL * NB * NMEM; rr += nw) {
    const int l = rr / (NB * NMEM), row = rr % (NB * NMEM);
    rms_rows<1, false>(P.in[2] + (size_t)row * 1024, 0, 1, P.in[19] + l * 1024, (u16*)(P.ws + WS_HMEM) + (size_t)rr * 1024, 0, lane);
  }
  {
    const size_t n4 = (size_t)TT * 256;
    const size_t np4 = (size_t)TP * 256;
    const size_t stride = (size_t)get_nblk() * NTHR;
    for (size_t i0 = (size_t)get_bid() * NTHR + tid; i0 < n4; i0 += 4 * stride) {
      f32x4 v[4];
#pragma unroll
      for (int q = 0; q < 4; q++) {
        const size_t i = i0 + q * stride;
        const size_t ii = i < n4 ? i : i0;
        v[q] = (ii < np4) ? *(const f32x4*)(P.in[0] + ii * 4) : *(const f32x4*)(P.in[1] + (ii - np4) * 4);
      }
#pragma unroll
      for (int q = 0; q < 4; q++) {
        const size_t i = i0 + q * stride;
        if (i < n4) *(f32x4*)(P.out + i * 4) = v[q];
      }
    }
  }
}

DI void phase_norm(const Params& P, const float* g, int cache_layer) {
  const int tid = get_tid(P.wv), lane = tid & 63;
  const int gw = get_bid() * NWV + (tid >> 6), nw = get_nblk() * NWV;
  u16* h = (u16*)(P.ws + WS_ACTA);
  for (int row = gw; row < TT; row += 4 * nw) {
    const int nv = (TT - row + nw - 1) / nw;
    rms_rows<4, false>(P.out + (size_t)row * 1024, (size_t)nw * 1024, nv < 4 ? nv : 4, g, h + (size_t)row * 1024, (size_t)nw * 1024, lane);
  }
  if (cache_layer >= 0) {
    const int l = cache_layer;
    cvt_job(P.in[3] + (size_t)l * DB * PAST * 512, (u16*)(P.ws + WS_FOXK) + (size_t)TP * 512, DB, (size_t)PAST * 512, (size_t)PAST * 512, (size_t)SKS * 512, P.wv);
    cvt_job(P.in[4] + (size_t)l * DB * PAST * 512, (u16*)(P.ws + WS_FOXV) + (size_t)TP * 512, DB, (size_t)PAST * 512, (size_t)PAST * 512, (size_t)SKS * 512, P.wv);
    cvt_job(P.in[6] + (size_t)l * DB * PAST * 128, (u16*)(P.ws + WS_CKV) + (size_t)TP * 128, DB, (size_t)PAST * 128, (size_t)PAST * 128, (size_t)SKS * 128, P.wv);
    cvt_job(P.in[7] + (size_t)l * DB * PAST * 64, (u16*)(P.ws + WS_KROPE) + (size_t)TP * 64, DB, (size_t)PAST * 64, (size_t)PAST * 64, (size_t)SKS * 64, P.wv);
  }
}

DI void phase_final(const Params& P) {
  const int tid = get_tid(P.wv), lane = tid & 63;
  const int gw = get_bid() * NWV + (tid >> 6), nw = get_nblk() * NWV;
  const float* g = P.in[27];
  for (int row = gw; row < TT; row += 4 * nw) {
    const int nv = (TT - row + nw - 1) / nw;
    rms_rows<4, true>(P.out + (size_t)row * 1024, (size_t)nw * 1024, nv < 4 ? nv : 4, g, P.out + (size_t)row * 1024, (size_t)nw * 1024, lane);
  }
}

DI void phase_post(const Params& P, int l, char* smem) {
  const int tid = get_tid(P.wv), lane = tid & 63;
  const int gw = get_bid() * NWV + (tid >> 6), nw = get_nblk() * NWV;
  const float* zc = (const float*)(P.ws + WS_ZC);
  u16* cqn = (u16*)(P.ws + WS_CQN);
  u16* ckv = (u16*)(P.ws + WS_CKV);
  u16* krp = (u16*)(P.ws + WS_KROPE);
  const f32x2* rt = (const f32x2*)(P.ws + WS_ROPE);
  const float* gq = P.in[13] + l * 256;
  const float* gkv = P.in[15] + l * 128;
  for (int tok0 = gw; tok0 < TT; tok0 += 4 * nw) {
    f32x4 vq[4]; f32x2 vk[4]; float vr[4];
#pragma unroll
    for (int j = 0; j < 4; j++) {
      const int tk = tok0 + j * nw;
      const float* z = zc + (size_t)(tk < TT ? tk : tok0) * 448;
      vq[j] = *(const f32x4*)(z + lane * 4);
      vk[j] = *(const f32x2*)(z + 256 + lane * 2);
      vr[j] = z[384 + lane];
    }
    const f32x4 ggq = *(const f32x4*)(gq + lane * 4);
    const f32x2 ggk = *(const f32x2*)(gkv + lane * 2);
#pragma unroll
    for (int j = 0; j < 4; j++) {
      const int tok = tok0 + j * nw;
      if (tok >= TT) break;
      const bool isp = tok < TP;
      const size_t orow = isp ? ((size_t)l * TP + tok) : ((size_t)l * TS + (tok - TP));
      const int kr = tok_krow(tok);
      {
        const f32x4 v = vq[j];
        const float ss = wave_sum(v[0] * v[0] + v[1] * v[1] + v[2] * v[2] + v[3] * v[3]);
        const float rs = rsqrtf(ss * (1.f / 256.f) + 1e-6f);
        u32x2 w;
        w[0] = pk2(v[0] * rs * ggq[0], v[1] * rs * ggq[1]);
        w[1] = pk2(v[2] * rs * ggq[2], v[3] * rs * ggq[3]);
        *(u32x2*)(cqn + (size_t)tok * 256 + lane * 4) = w;
      }
      {
        const f32x2 v = vk[j];
        const float ss = wave_sum(v[0] * v[0] + v[1] * v[1]);
        const float rs = rsqrtf(ss * (1.f / 128.f) + 1e-6f);
        f32x2 o; o[0] = v[0] * rs * ggk[0]; o[1] = v[1] * rs * ggk[1];
        *(f32x2*)(P.out + (isp ? O_CKP : O_CKS) + orow * 128 + lane * 2) = o;
        *(unsigned*)(ckv + (size_t)kr * 128 + lane * 2) = pk2(o[0], o[1]);
      }
      {
        const float x = vr[j];
        const float y = __shfl_xor(x, 32);
        const f32x2 cs = rt[tok_pos(tok) * 32 + (lane & 31)];
        const float o = (lane < 32) ? (x * cs[0] - y * cs[1]) : (x * cs[0] + y * cs[1]);
        P.out[(isp ? O_KRP : O_KRS) + orow * 64 + lane] = o;
        krp[(size_t)kr * 64 + lane] = f2bf(o);
      }
    }
  }
  float* cum = (float*)(P.ws + WS_CUM);
  float* wtot = (float*)smem;
  const int wave = tid >> 6;
  for (int it = get_bid(); it < NB + DB; it += get_nblk()) {
    const bool isp = it < NB;
    const int b = isp ? it : it - NB;
    const int ppt = isp ? 16 : 9;
    const int npos = isp ? SEQ : SKS;
    const float* srcA; const float* srcB; int nA;
    size_t krow0;
    if (isp) { srcA = P.out + O_FLP + ((size_t)l * TP + (size_t)b * SEQ) * 8; srcB = srcA; nA = SEQ; krow0 = (size_t)b * SEQ; }
    else {
      srcA = P.in[5] + ((size_t)l * DB + b) * PAST * 8;
      srcB = P.out + O_FLS + ((size_t)l * TS + (size_t)b * DS) * 8 - (size_t)PAST * 8;
      nA = PAST; krow0 = (size_t)TP + (size_t)b * SKS;
    }
    const int p0 = tid * ppt;
    f32x4 va[16], vb[16];
#pragma unroll
    for (int j = 0; j < 16; j++) {
      const int p = p0 + j;
      f32x4 z = {0.f, 0.f, 0.f, 0.f};
      va[j] = z; vb[j] = z;
      if (j < ppt && p < npos) {
        const float* s = (p < nA ? srcA : srcB) + (size_t)p * 8;
        va[j] = *(const f32x4*)s; vb[j] = *(const f32x4*)(s + 4);
      }
    }
#pragma unroll
    for (int j = 1; j < 16; j++) { va[j] += va[j - 1]; vb[j] += vb[j - 1]; }
    f32x4 ta = va[15], tb = vb[15];
#pragma unroll
    for (int d = 1; d < 64; d <<= 1) {
#pragma unroll
      for (int e = 0; e < 4; e++) {
        const float ua = __shfl_up(ta[e], d), ub = __shfl_up(tb[e], d);
        if (lane >= d) { ta[e] += ua; tb[e] += ub; }
      }
    }
    __syncthreads();
    if (lane == 63) { *(f32x4*)(wtot + wave * 8) = ta; *(f32x4*)(wtot + wave * 8 + 4) = tb; }
    __syncthreads();
    f32x4 pa = ta - va[15], pb = tb - vb[15];
    for (int w2 = 0; w2 < wave; w2++) { pa += *(const f32x4*)(wtot + w2 * 8); pb += *(const f32x4*)(wtot + w2 * 8 + 4); }
#pragma unroll
    for (int j = 0; j < 16; j++) {
      const int p = p0 + j;
      if (j < ppt && p < npos) {
        float* d = cum + (krow0 + p) * 8;
        *(f32x4*)d = va[j] + pa; *(f32x4*)(d + 4) = vb[j] + pb;
      }
    }
  }
}

template <int EPI>
DI void gemm_phase(const Params& P, int l, const u16* __restrict__ A, int lda, const u16* __restrict__ Bt, int ldb, int K, int M, int N,
                   char* smem, int& rot) {
  constexpr int MI = 4;
  constexpr int STAGE = 32768;
  constexpr int NSLOT = SMEM_BYTES / STAGE;
  constexpr int DEPTH = NSLOT - 1;
  constexpr int GPS = 4;
  static_assert(NSLOT == 4, "ring waits are written for 4 slots");
  const int tid = get_tid(P.wv), wave = tid >> 6, lane = tid & 63, r = lane & 31, h = lane >> 5;
  const int wm = wave >> 2, wn = wave & 3;
  const int TM = M >> 8, TN = N >> 8;
  const int ntiles = TM * TN;
  const int G = get_nblk();
  const int bid = get_bid();
  const bool xmap = (G == 256);
  const int hsel = (bid + 256 - ((rot * 64) & 255)) & 255;
  int t0, tstep;
  if (xmap) {
    const int nun = (ntiles + 31) >> 5;
    const int xs = (bid + 8 - (rot & 7)) & 7;
    t0 = xs * 32 + (bid >> 3); tstep = 256;
    rot += nun;
  } else {
    t0 = (bid + G - (rot % G)) % G; tstep = G;
    rot += ntiles;
  }
  const int nk = K >> 5;
  constexpr bool SPLITK = (EPI == EPI_RESID || EPI == EPI_RESID0);
  const bool sk = SPLITK && xmap && (TN == 4) && (((TM * nk) & 63) == 0);
  const int skS = (TM * nk) >> 6;
  const int sknt = (bid >> 3) & 3;
  constexpr bool HALFOK = (EPI == EPI_IN || EPI == EPI_XQ || EPI == EPI_UP || EPI == EPI_KV || EPI == EPI_MEM);
  int nfull = ntiles, hR = 0;
  if (HALFOK && xmap) { const int fr = ntiles >> 8; const int R = ntiles - (fr << 8); if (R > 0 && R <= 128) { nfull = fr << 8; hR = R; } }
  const int p_begin = sk ? ((bid & 7) * 8 + (bid >> 5)) * skS : t0;
  const int p_end = sk ? p_begin + skS : nfull;
  const int lrow = tid >> 2, lc = tid & 3;
  const int pc = (lc ^ ((tid >> 4) & 3)) * 8;
  const int sw = (r >> 2) & 3;
  const int xo0 = ((0 + h) ^ sw) * 16, xo1 = ((2 + h) ^ sw) * 16;
  const int aro = (wm * 128 + r) * 64, bro = 16384 + (wn * 64 + r) * 64;
  auto tile_of = [&](int t, int& m0, int& n0) { const int mt = t / TN; m0 = mt << 8; n0 = (t - mt * TN) << 8; };
  auto issue = [&](int m0, int n0, int ks, int slot) {
    const u16* ag = A + (size_t)(m0 + lrow) * lda + pc + ks * 32;
    const u16* bg = Bt + (size_t)(n0 + lrow) * ldb + pc + ks * 32;
    char* dst = smem + slot * STAGE + tid * 16;
#pragma unroll
    for (int i = 0; i < 2; i++)
      __builtin_amdgcn_global_load_lds((const unsigned*)(ag + (size_t)i * 128 * lda), (__attribute__((address_space(3))) unsigned*)(dst + i * 8192), 16, 0, 0);
#pragma unroll
    for (int i = 0; i < 2; i++)
      __builtin_amdgcn_global_load_lds((const unsigned*)(bg + (size_t)i * 128 * ldb), (__attribute__((address_space(3))) unsigned*)(dst + 16384 + i * 8192), 16, 0, 0);
  };
  auto unit_at = [&](int p, int& m0, int& n0, int& kb, int& nkk) {
    if (sk) { const int mt = p / nk; kb = p - mt * nk; const int rem = p_end - p; nkk = (nk - kb) < rem ? (nk - kb) : rem; m0 = mt << 8; n0 = sknt << 8; }
    else { tile_of(p, m0, n0); kb = 0; nkk = nk; }
  };
  if (p_begin < p_end) {
  int t = p_begin, m0, n0, kb, nkk;
  unit_at(t, m0, n0, kb, nkk);
  int ti = p_begin, ki = 0, mi0 = m0, ni0 = n0, kbi = kb, nki = nkk;
  bool idone = false;
  int pend = 0;
  unsigned g = 0;
  asm volatile("s_waitcnt vmcnt(0) lgkmcnt(0)" ::: "memory");
  __builtin_amdgcn_s_barrier();
#pragma unroll 1
  for (int s = 0; s < DEPTH; s++) {
    if (!idone) {
      issue(mi0, ni0, kbi + ki, (g + pend) % NSLOT);
      pend++;
      if (++ki == nki) { ki = 0; ti = sk ? ti + nki : ti + tstep; if (ti < p_end) unit_at(ti, mi0, ni0, kbi, nki); else idone = true; }
    }
  }
  while (true) {
    f32x16 acc[MI][2];
#pragma unroll
    for (int a = 0; a < MI; a++)
#pragma unroll
      for (int b = 0; b < 2; b++)
#pragma unroll
        for (int i = 0; i < 16; i++) acc[a][b][i] = 0.f;
    s16x8 a2[MI], b2, b3;
    {
      const s16x8 z = {0, 0, 0, 0, 0, 0, 0, 0};
#pragma unroll
      for (int i = 0; i < MI; i++) a2[i] = z;
      b2 = z; b3 = z;
    }
#pragma unroll 1
    for (int kt = 0; kt < nkk; kt++) {
      if (pend >= 3) asm volatile("s_waitcnt vmcnt(%0)" ::"n"(2 * GPS) : "memory");
      else if (pend == 2) asm volatile("s_waitcnt vmcnt(%0)" ::"n"(GPS) : "memory");
      else asm volatile("s_waitcnt vmcnt(0)" ::: "memory");
      asm volatile("" ::: "memory");
      __builtin_amdgcn_s_waitcnt(0xC07F);
      __builtin_amdgcn_s_barrier();
      asm volatile("" ::: "memory");
      if (!idone) {
        issue(mi0, ni0, kbi + ki, (g + pend) % NSLOT);
        if (++ki == nki) { ki = 0; ti = sk ? ti + nki : ti + tstep; if (ti < p_end) unit_at(ti, mi0, ni0, kbi, nki); else idone = true; }
      } else {
        pend--;
      }
      const char* sb = smem + (g % NSLOT) * STAGE;
      g++;
      s16x8 a[MI];
#pragma unroll
      for (int i = 0; i < MI; i++) a[i] = *(const s16x8*)(sb + aro + i * 32 * 64 + xo0);
      const s16x8 b0 = *(const s16x8*)(sb + bro + xo0);
      const s16x8 b1 = *(const s16x8*)(sb + bro + 32 * 64 + xo0);
      if (kt > 0) {
#pragma unroll
        for (int i = 0; i < MI; i++) { acc[i][0] = mfma(a2[i], b2, acc[i][0]); acc[i][1] = mfma(a2[i], b3, acc[i][1]); }
      }
#pragma unroll
      for (int i = 0; i < MI; i++) a2[i] = *(const s16x8*)(sb + aro + i * 32 * 64 + xo1);
      b2 = *(const s16x8*)(sb + bro + xo1);
      b3 = *(const s16x8*)(sb + bro + 32 * 64 + xo1);
#pragma unroll
      for (int i = 0; i < MI; i++) { acc[i][0] = mfma(a[i], b0, acc[i][0]); acc[i][1] = mfma(a[i], b1, acc[i][1]); }
    }
#pragma unroll
    for (int i = 0; i < MI; i++) { acc[i][0] = mfma(a2[i], b2, acc[i][0]); acc[i][1] = mfma(a2[i], b3, acc[i][1]); }
    epilogue<EPI, MI>(P, l, acc, m0 + wm * 128, n0 + wn * 64, r, h);
    t = sk ? t + nkk : t + tstep;
    if (t >= p_end) break;
    unit_at(t, m0, n0, kb, nkk);
  }
  }
  if constexpr (HALFOK) {
    if (hR > 0 && hsel < 2 * hR) {
      int m0, n0;
      tile_of(nfull + (hsel >> 1), m0, n0);
      const int half = hsel & 1;
      const int broh = 16384 + (half * 128 + wn * 32 + r) * 64;
      asm volatile("s_waitcnt vmcnt(0) lgkmcnt(0)" ::: "memory");
      __builtin_amdgcn_s_barrier();
      int pend = 0, ki = 0;
      unsigned g = 0;
#pragma unroll 1
      for (int s = 0; s < DEPTH; s++) { if (ki < nk) { issue(m0, n0, ki, (g + pend) % NSLOT); ki++; pend++; } }
      f32x16 acc1[MI][1];
#pragma unroll
      for (int a = 0; a < MI; a++)
#pragma unroll
        for (int i = 0; i < 16; i++) acc1[a][0][i] = 0.f;
#pragma unroll 1
      for (int kt = 0; kt < nk; kt++) {
        if (pend >= 3) asm volatile("s_waitcnt vmcnt(%0)" ::"n"(2 * GPS) : "memory");
        else if (pend == 2) asm volatile("s_waitcnt vmcnt(%0)" ::"n"(GPS) : "memory");
        else asm volatile("s_waitcnt vmcnt(0)" ::: "memory");
        asm volatile("" ::: "memory");
        __builtin_amdgcn_s_waitcnt(0xC07F);
        __builtin_amdgcn_s_barrier();
        asm volatile("" ::: "memory");
        if (ki < nk) { issue(m0, n0, ki, (g + pend) % NSLOT); ki++; } else pend--;
        const char* sb = smem + (g % NSLOT) * STAGE;
        g++;
        s16x8 a[MI], a2[MI];
#pragma unroll
        for (int i = 0; i < MI; i++) { a[i] = *(const s16x8*)(sb + aro + i * 32 * 64 + xo0); a2[i] = *(const s16x8*)(sb + aro + i * 32 * 64 + xo1); }
        const s16x8 b0 = *(const s16x8*)(sb + broh + xo0);
        const s16x8 b2 = *(const s16x8*)(sb + broh + xo1);
#pragma unroll
        for (int i = 0; i < MI; i++) acc1[i][0] = mfma(a[i], b0, acc1[i][0]);
#pragma unroll
        for (int i = 0; i < MI; i++) acc1[i][0] = mfma(a2[i], b2, acc1[i][0]);
      }
      epilogue<EPI, MI, 1>(P, l, acc1, m0 + wm * 128, n0 + half * 128 + wn * 32, r, h);
    }
  }
  asm volatile("s_waitcnt vmcnt(0) lgkmcnt(0)" ::: "memory");
}

DI int next_item(unsigned* ctr, char* smem, int wv) {
  volatile int* slot = (volatile int*)(smem + SMEM_BYTES - 16);
  __syncthreads();
  if (wv == 0 && lane_id() == 0) *slot = (int)__hip_atomic_fetch_add(ctr, 1u, __ATOMIC_RELAXED, __HIP_MEMORY_SCOPE_AGENT);
  __syncthreads();
  return *slot;
}

DI void phase_attn(const Params& P, int l, char* smem) {
  const u16* qf = (const u16*)(P.ws + WS_QF);
  const u16* fk = (const u16*)(P.ws + WS_FOXK);
  const u16* fv = (const u16*)(P.ws + WS_FOXV);
  const float* cum = (const float*)(P.ws + WS_CUM);
  const u16* qm = (const u16*)(P.ws + WS_R1 + R1_QM);
  const u16* kv = (const u16*)(P.ws + WS_R1 + R1_KV);
  const u16* krp = (const u16*)(P.ws + WS_KROPE);
  u16* mixed = (u16*)(P.ws + WS_ACTA);
  constexpr float LOG2E = 1.4426950408889634f;
  const int total = 384 + 16 * 96;
  unsigned* ctr = (unsigned*)(P.ws + WS_CTR) + (l * 2 + 0) * 64;
  for (int t = next_item(ctr, smem, P.wv); t < total; t = next_item(ctr, smem, P.wv)) {
    bool isfox, issample; int b, hd, qb = 0;
    if (t < 128) { isfox = false; issample = true; b = t >> 2; hd = t & 3; }
    else if (t < 384) { isfox = true; issample = true; const int u = t - 128; b = u >> 3; hd = u & 7; }
    else {
      const int u = t - 384; const int grp = u / 96; int w = u % 96; qb = 15 - grp; issample = false;
      if (w < 32) { isfox = false; b = w >> 2; hd = w & 3; }
      else { w -= 32; isfox = true; b = w >> 3; hd = w & 7; }
    }
    AttnJob J;
    J.wv = P.wv;
    size_t tok0, krow0;
    if (issample) { tok0 = (size_t)TP + (size_t)b * DS; krow0 = (size_t)TP + (size_t)b * SKS; J.nq = DS; J.Sk = SKS; J.qpos0 = PAST; }
    else { tok0 = (size_t)b * SEQ + (size_t)qb * 256; krow0 = (size_t)b * SEQ; J.nq = 256; J.Sk = SEQ; J.qpos0 = qb * 256; }
    if (isfox) {
      J.Q = qf + tok0 * 512 + hd * 64; J.ldq = 512;
      J.K1 = fk + krow0 * 512 + hd * 64; J.ldk1 = 512; J.K2 = J.K1; J.ldk2 = 512;
      J.V = fv + krow0 * 512 + hd * 64; J.ldv = 512;
      J.O = mixed + tok0 * 1024 + hd * 64; J.ldo = 1024;
      J.cq = cum + (krow0 + (size_t)J.qpos0) * 8 + hd;
      J.ck = cum + krow0 * 8 + hd;
      J.scale_log2 = 0.125f * LOG2E;
      if (issample) attn_block<64, 64, 64, MASK_FRAME, true, FOX_PF, 512, 512, 512, 512, 1024, 256, true>(J, smem);
      else attn_block<64, 64, 64, MASK_FRAME, true, FOX_PF, 512, 512, 512, 512, 1024, FOX_KT>(J, smem);
    } else {
      J.Q = qm + tok0 * 768 + hd * 192; J.ldq = 768;
      J.K1 = kv + krow0 * 1024 + hd * 256; J.ldk1 = 1024;
      J.K2 = krp + krow0 * 64; J.ldk2 = 64;
      J.V = kv + krow0 * 1024 + hd * 256 + 128; J.ldv = 1024;
      J.O = mixed + tok0 * 1024 + 512 + hd * 128; J.ldo = 1024;
      J.cq = nullptr; J.ck = nullptr;
      J.scale_log2 = 0.07216878364870322f * LOG2E;
      if (issample) attn_block<192, 128, 128, MASK_CHUNK, false, MLA_PF, 768, 1024, 64, 1024, 1024, 128, true>(J, smem);
      else attn_block<192, 128, 128, MASK_CHUNK, false, MLA_PF, 768, 1024, 64, 1024, 1024, 64>(J, smem);
    }
  }
}

DI void phase_cross(const Params& P, int l, char* smem) {
  const u16* xq = (const u16*)(P.ws + WS_R1 + R1_XQ);
  const u16* mk = (const u16*)(P.ws + WS_MEMK) + (size_t)l * MB * NMEM * 1024;
  const u16* mv = (const u16*)(P.ws + WS_MEMV) + (size_t)l * MB * NMEM * 1024;
  u16* xo = (u16*)(P.ws + WS_ACTA);
  constexpr float LOG2E = 1.4426950408889634f;
  const int nsamp = DB * 4 * 2;
  const int total = nsamp + 128 * 4 * 2;
  unsigned* ctr = (unsigned*)(P.ws + WS_CTR) + (l * 2 + 1) * 64;
  for (int t = next_item(ctr, smem, P.wv); t < total; t = next_item(ctr, smem, P.wv)) {
    AttnJob J;
    J.wv = P.wv;
    size_t tok0; int mb, hd, half;
    if (t < nsamp) { const int b = t >> 3; hd = (t >> 1) & 3; half = t & 1; tok0 = (size_t)TP + (size_t)b * DS; mb = NB + b; J.nq = DS; }
    else { const int u = t - nsamp; const int qbk = u >> 3; hd = (u >> 1) & 3; half = u & 1; tok0 = (size_t)qbk * 256; mb = qbk >> 4; J.nq = 256; }
    J.Sk = NMEM; J.qpos0 = 0;
    J.Q = xq + tok0 * 1024 + hd * 256; J.ldq = 1024;
    J.K1 = mk + (size_t)mb * NMEM * 1024 + hd * 256; J.ldk1 = 1024; J.K2 = J.K1; J.ldk2 = 1024;
    J.V = mv + (size_t)mb * NMEM * 1024 + hd * 256 + half * 128; J.ldv = 1024;
    J.O = xo + tok0 * 1024 + hd * 256 + half * 128; J.ldo = 1024;
    J.cq = nullptr; J.ck = nullptr;
    J.scale_log2 = 0.0625f * LOG2E;
    attn_block<256, 256, 128, MASK_NONE, false, false, 1024, 1024, 1024, 1024, 1024, 64>(J, smem);
  }
}

#define XB_TMO      128
#define XB_XCNT(j)  (256  + 64 * (j))
#define XB_XSUB(j)  (1280 + 64 * (j))
#define XB_XGEN(j)  (2304 + 64 * (j))
#define XB_TOP      3328
#define XB_TOPGEN   3392
#define XCD_BAR_WORDS 3456
#define XB_SPIN_CAP (1u << 20)
DI unsigned xb_ld(unsigned* p) { return __hip_atomic_load(p, __ATOMIC_RELAXED, __HIP_MEMORY_SCOPE_AGENT); }
DI unsigned xb_add(unsigned* p, unsigned v) { return __hip_atomic_fetch_add(p, v, __ATOMIC_RELAXED, __HIP_MEMORY_SCOPE_AGENT); }
DI unsigned xb_xcc_id() { return (unsigned)__builtin_amdgcn_s_getreg((3 << 11) | 20) & 0xFu; }
#define XB_SPIN(cond, bar) do { unsigned _sp = 0; while (cond) { __builtin_amdgcn_s_sleep(1); \
    if ((++_sp & 255u) == 0u) { if (xb_ld(&(bar)[XB_TMO])) break; if (_sp > XB_SPIN_CAP) { atomicAdd(&(bar)[XB_TMO], 1u); break; } } } } while (0)
DI void xb_census(unsigned* bar, unsigned x, unsigned& nloc, unsigned& nx) {
  const unsigned G = gridDim.x;
  unsigned sum, cnt, mine, sp = 0u;
  for (;;) {
    sum = 0u; cnt = 0u; mine = 0u;
#pragma unroll
    for (unsigned j = 0; j < 16; ++j) { const unsigned c = xb_ld(&bar[XB_XCNT(j)]); sum += c; cnt += (c > 0u) ? 1u : 0u; mine = (j == x) ? c : mine; }
    if (sum == G) break;
    __builtin_amdgcn_s_sleep(1);
    if ((++sp & 255u) == 0u) { if (xb_ld(&bar[XB_TMO])) break; if (sp > XB_SPIN_CAP) { atomicAdd(&bar[XB_TMO], 1u); break; } }
  }
  nloc = mine > 0u ? mine : 1u; nx = cnt > 0u ? cnt : 1u;
}
DI void xcd_barrier(unsigned* bar, unsigned x, unsigned nloc, unsigned nx, int wv) {
  asm volatile("s_waitcnt vmcnt(0)" ::: "memory");
  __syncthreads();
  if (wv == 0 && lane_id() == 0) {
    __builtin_amdgcn_s_waitcnt(0);
    const unsigned old = xb_add(&bar[XB_XSUB(x)], 1u);
    const unsigned gen = old / nloc;
    if (old + 1u == (gen + 1u) * nloc) {
      __builtin_amdgcn_fence(__ATOMIC_RELEASE, "agent");
      asm volatile("s_waitcnt vmcnt(0)" ::: "memory");
      const unsigned og = xb_add(&bar[XB_TOP], 1u);
      const unsigned tg = og / nx;
      if (og + 1u == (tg + 1u) * nx) xb_add(&bar[XB_TOPGEN], 1u);
      else XB_SPIN(xb_ld(&bar[XB_TOPGEN]) == tg, bar);
      __builtin_amdgcn_fence(__ATOMIC_ACQUIRE, "agent");
      xb_add(&bar[XB_XGEN(x)], 1u);
      asm volatile("s_waitcnt vmcnt(0)" ::: "memory");
    } else {
      XB_SPIN(xb_ld(&bar[XB_XGEN(x)]) == gen, bar);
      __builtin_amdgcn_fence(__ATOMIC_ACQUIRE, "agent");
      asm volatile("s_waitcnt vmcnt(0)" ::: "memory");
    }
  }
  __syncthreads();
}

constexpr int NPHASE = 2 + 13 * NL;

DI void run_phase(const Params& P, int ph, char* smem, bool dup = false) {
  if (ph == 0) { phase_prep(P, smem); return; }
  if (ph == NPHASE - 1) { phase_final(P); return; }
  const int l = (ph - 1) / 13, k = (ph - 1) % 13;
  char* ws = P.ws;
  const u16* actA = (const u16*)(ws + WS_ACTA);
  int rot = 0;
  switch (k) {
    case 0: phase_norm(P, P.in[10] + l * 1024, l); break;
    case 1:
      gemm_phase<EPI_IN>(P, l, actA, 1024, wt_ptr(P, l, WE_IN), 1024, 1024, TT, INP, smem, rot);
      if (l == 0) {
        for (int l2 = 0; l2 < NL; l2++)
          gemm_phase<EPI_MEM>(P, l2, (const u16*)(ws + WS_HMEM) + (size_t)l2 * NB * NMEM * 1024, 1024, wt_ptr(P, l2, WE_MKV), 1024, 1024,
                              NB * NMEM, 2048, smem, rot);
      }
      break;
    case 2: phase_post(P, l, smem); break;
    case 3:
      gemm_phase<EPI_KV>(P, l, (const u16*)(ws + WS_CKV), 128, wt_ptr(P, l, WE_UKV), 128, 128, KROWS, 1024, smem, rot);
      gemm_phase<EPI_UQ>(P, l, (const u16*)(ws + WS_CQN), 256, wt_ptr(P, l, WE_UQ), 256, 256, TT, 768, smem, rot);
      break;
    case 4: phase_attn(P, l, smem); break;
    case 5: if (dup) gemm_phase<EPI_RESID0>(P, l, actA, 1024, wt_ptr(P, l, WE_OUT), 1024, 1024, TT, 1024, smem, rot); else gemm_phase<EPI_RESID>(P, l, actA, 1024, wt_ptr(P, l, WE_OUT), 1024, 1024, TT, 1024, smem, rot); break;
    case 6: phase_norm(P, P.in[18] + l * 1024, -1); break;
    case 7: gemm_phase<EPI_XQ>(P, l, actA, 1024, wt_ptr(P, l, WE_XQ), 1024, 1024, TT, 1024, smem, rot); break;
    case 8: phase_cross(P, l, smem); break;
    case 9: if (dup) gemm_phase<EPI_RESID0>(P, l, actA, 1024, wt_ptr(P, l, WE_XO), 1024, 1024, TT, 1024, smem, rot); else gemm_phase<EPI_RESID>(P, l, actA, 1024, wt_ptr(P, l, WE_XO), 1024, 1024, TT, 1024, smem, rot); break;
    case 10: phase_norm(P, P.in[24] + l * 1024, -1); break;
    case 11: gemm_phase<EPI_UP>(P, l, actA, 1024, wt_ptr(P, l, WE_UP), 1024, 1024, TT, DFF, smem, rot); break;
    case 12: if (dup) gemm_phase<EPI_RESID0>(P, l, (const u16*)(ws + WS_R1 + R1_U), DFF, wt_ptr(P, l, WE_DN), DFF, DFF, TT, 1024, smem, rot); else gemm_phase<EPI_RESID>(P, l, (const u16*)(ws + WS_R1 + R1_U), DFF, wt_ptr(P, l, WE_DN), DFF, DFF, TT, 1024, smem, rot); break;
  }
}

__global__ void __launch_bounds__(NTHR) mega(Params P, int ph_lo, int ph_hi) {
  extern __shared__ __attribute__((aligned(16))) char smem[];
  cg::grid_group grid = cg::this_grid();
  if (ph_hi > 4096) grid.sync();
  unsigned* bar = (unsigned*)(P.ws + WS_BAR);
  const unsigned xb_x = xb_xcc_id();
  unsigned xb_nloc = 1u, xb_nx = 1u;
  if (threadIdx.x == 0) { (void)xb_add(&bar[XB_XCNT(xb_x)], 1u); xb_census(bar, xb_x, xb_nloc, xb_nx); }
  xb_nloc = __builtin_amdgcn_readfirstlane(xb_nloc);
  xb_nx = __builtin_amdgcn_readfirstlane(xb_nx);
  unsigned xb_pack = xb_nloc | (xb_nx << 16) | (xb_x << 24) | ((unsigned)__builtin_amdgcn_readfirstlane(threadIdx.x >> 6) << 28);
  asm volatile("" : "+s"(xb_pack));
  for (int ph = ph_lo; ph < ph_hi; ph++) {
    Params Q = P;
    unsigned pk = xb_pack;
    asm volatile("" : "+s"(Q.out), "+s"(Q.ws), "+s"(pk));
    Q.wv = (int)(pk >> 28);
    run_phase(Q, ph, smem);
    if (ph + 1 < ph_hi) {
      unsigned pk2 = xb_pack;
      asm volatile("" : "+s"(pk2));
      xcd_barrier((unsigned*)(Q.ws + WS_BAR), (pk2 >> 24) & 0xfu, pk2 & 0xffffu, (pk2 >> 16) & 0xffu, (int)(pk2 >> 28));
    }
  }
}

extern "C" void kernel_launch(void* const* d_in, const int* in_sizes, int n_in, void* d_out, int out_size, void* d_ws,
                              size_t ws_size, hipStream_t stream) {
  static int grid_blocks = 0;
  if (!grid_blocks) {
    int dev = 0, cus = 0, per_cu = 0;
    hipGetDevice(&dev);
    hipDeviceGetAttribute(&cus, hipDeviceAttributeMultiprocessorCount, dev);
    hipFuncSetAttribute((const void*)mega, hipFuncAttributeMaxDynamicSharedMemorySize, SMEM_BYTES);
    hipOccupancyMaxActiveBlocksPerMultiprocessor(&per_cu, mega, NTHR, SMEM_BYTES);
    per_cu = 1;
    grid_blocks = cus * per_cu;
  }
  if (n_in != 28 || (size_t)out_size != O_END || ws_size < WS_END) {
    fprintf(stderr, "kernel_launch: shape/ws mismatch n_in %d out %d (want %zu) ws %zu (want %zu)\n", n_in, out_size, (size_t)O_END, ws_size, (size_t)WS_END);
    return;
  }
  Params p;
  memset(&p, 0, sizeof(p));
  for (int i = 0; i < 28; i++) p.in[i] = (const float*)d_in[i];
  p.out = (float*)d_out;
  p.ws = (char*)d_ws;
  hipMemsetAsync((char*)d_ws + WS_BAR, 0, XCD_BAR_WORDS * 4 + 4 * 256, stream);
  int lo = 0, hi = NPHASE;
  void* args[] = {&p, &lo, &hi};
  hipError_t e = hipLaunchCooperativeKernel((void*)mega, dim3(grid_blocks), dim3(NTHR), args, SMEM_BYTES, stream);
  if (e != hipSuccess) fprintf(stderr, "cooperative launch failed: %s (grid %d)\n", hipGetErrorString(e), grid_blocks);
}
```

```cpp
#include <hip/hip_runtime.h>
#include <hip/hip_cooperative_groups.h>
#include <stdint.h>
#include <string.h>
#include <stdio.h>
namespace cg = cooperative_groups;

#ifndef COOP
#define COOP 1
#endif

#ifndef FOX_KT
#define FOX_KT 128
#endif
#ifndef FOX_PF
#define FOX_PF true
#endif
#ifndef MLA_PF
#define MLA_PF true
#endif
#ifndef LB_MIN
#define LB_MIN 2
#endif
#ifndef BM_BIG
#define BM_BIG 256
#endif
constexpr int NTHR = 512, NWV = 8;
#define DI __device__ __forceinline__
typedef unsigned short u16;
typedef short s16x8 __attribute__((ext_vector_type(8)));
typedef short s16x4 __attribute__((ext_vector_type(4)));
typedef __bf16 bfx8 __attribute__((ext_vector_type(8)));
typedef __bf16 bfx2 __attribute__((ext_vector_type(2)));
typedef float f32x16 __attribute__((ext_vector_type(16)));
typedef float f32x4 __attribute__((ext_vector_type(4)));
typedef float f32x2 __attribute__((ext_vector_type(2)));
typedef unsigned u32x4 __attribute__((ext_vector_type(4)));
typedef unsigned u32x2 __attribute__((ext_vector_type(2)));

constexpr int DM = 1024, NB = 8, SEQ = 4096, NL = 2, DB = 32, DS = 32, PAST = 2048;
constexpr int TP = NB * SEQ;
constexpr int TS = DB * DS;
constexpr int TT = TP + TS;
constexpr int SKS = PAST + DS;
constexpr int KROWS = TP + DB * SKS;
constexpr int INC = 1992, INP = 2048;
constexpr int NMEM = 256, MB = NB + DB;
constexpr int DFF = 4096;

constexpr size_t O_Y = 0;
constexpr size_t O_FKP = (size_t)TT * DM;
constexpr size_t O_FVP = O_FKP + (size_t)NL * TP * 512;
constexpr size_t O_FLP = O_FVP + (size_t)NL * TP * 512;
constexpr size_t O_CKP = O_FLP + (size_t)NL * TP * 8;
constexpr size_t O_KRP = O_CKP + (size_t)NL * TP * 128;
constexpr size_t O_MKP = O_KRP + (size_t)NL * TP * 64;
constexpr size_t O_MVP = O_MKP + (size_t)NL * NB * NMEM * 1024;
constexpr size_t O_FKS = O_MVP + (size_t)NL * NB * NMEM * 1024;
constexpr size_t O_FVS = O_FKS + (size_t)NL * TS * 512;
constexpr size_t O_FLS = O_FVS + (size_t)NL * TS * 512;
constexpr size_t O_CKS = O_FLS + (size_t)NL * TS * 8;
constexpr size_t O_KRS = O_CKS + (size_t)NL * TS * 128;
constexpr size_t O_END = O_KRS + (size_t)NL * TS * 64;

constexpr size_t al256(size_t x) { return (x + 255) / 256 * 256; }
constexpr size_t WE_IN = 0;
constexpr size_t WE_UQ = WE_IN + (size_t)INP * 1024;
constexpr size_t WE_UKV = WE_UQ + (size_t)768 * 256;
constexpr size_t WE_OUT = WE_UKV + (size_t)1024 * 128;
constexpr size_t WE_XQ = WE_OUT + (size_t)1024 * 1024;
constexpr size_t WE_MKV = WE_XQ + (size_t)1024 * 1024;
constexpr size_t WE_XO = WE_MKV + (size_t)2048 * 1024;
constexpr size_t WE_UP = WE_XO + (size_t)1024 * 1024;
constexpr size_t WE_DN = WE_UP + (size_t)4096 * 1024;
constexpr size_t WE_LAYER = WE_DN + (size_t)1024 * 4096;
constexpr size_t WS_WT = 0;
constexpr size_t WS_ROPE = al256(WS_WT + WE_LAYER * 2 * NL);
constexpr size_t WS_ACTA = al256(WS_ROPE + (size_t)4096 * 32 * 8);
constexpr size_t WS_QF = al256(WS_ACTA + (size_t)TT * 1024 * 2);
constexpr size_t WS_FOXK = al256(WS_QF + (size_t)TT * 512 * 2);
constexpr size_t WS_FOXV = al256(WS_FOXK + (size_t)KROWS * 512 * 2);
constexpr size_t WS_CUM = al256(WS_FOXV + (size_t)KROWS * 512 * 2);
constexpr size_t WS_ZC = al256(WS_CUM + (size_t)KROWS * 8 * 4);
constexpr size_t WS_CQN = al256(WS_ZC + (size_t)TT * 448 * 4);
constexpr size_t WS_CKV = al256(WS_CQN + (size_t)TT * 256 * 2);
constexpr size_t WS_KROPE = al256(WS_CKV + (size_t)KROWS * 128 * 2);
constexpr size_t WS_MEMK = al256(WS_KROPE + (size_t)KROWS * 64 * 2);
constexpr size_t WS_MEMV = al256(WS_MEMK + (size_t)NL * MB * NMEM * 1024 * 2);
constexpr size_t WS_HMEM = al256(WS_MEMV + (size_t)NL * MB * NMEM * 1024 * 2);
constexpr size_t WS_R1 = al256(WS_HMEM + (size_t)NL * NB * NMEM * 1024 * 2);
constexpr size_t R1_KV = 0;
constexpr size_t R1_QM = al256((size_t)KROWS * 1024 * 2);
constexpr size_t R1_U = 0;
constexpr size_t R1_XQ = 0;
constexpr size_t WS_BAR = al256(WS_R1 + (size_t)TT * 4096 * 2);
constexpr size_t WS_CTR = WS_BAR + 3456 * 4;
constexpr size_t WS_END = al256(WS_CTR + 4 * 256);
static_assert(R1_QM + (size_t)TT * 768 * 2 <= (size_t)TT * 4096 * 2, "R1 overflow");

constexpr int SMEM_BYTES = 131072;

struct Params {
  const float* in[28];
  float* out;
  char* ws;
  int wv;
  int pad;
};

DI int get_bid() { int t = blockIdx.x; asm volatile("" : "+s"(t)); return t; }
DI int get_nblk() { int t = gridDim.x; asm volatile("" : "+s"(t)); return t; }
DI int lane_id() { return (int)__builtin_amdgcn_mbcnt_hi(~0u, __builtin_amdgcn_mbcnt_lo(~0u, 0u)); }
DI int get_tid(int wv) { int t = (wv << 6) | lane_id(); asm volatile("" : "+v"(t)); return t; }
DI unsigned pk2(float a, float b) { f32x2 v = {a, b}; return __builtin_bit_cast(unsigned, __builtin_convertvector(v, bfx2)); }
DI u16 f2bf(float a) { return (u16)(pk2(a, 0.f) & 0xffffu); }
DI f32x16 mfma(s16x8 a, s16x8 b, f32x16 c) {
  return __builtin_amdgcn_mfma_f32_32x32x16_bf16(__builtin_bit_cast(bfx8, a), __builtin_bit_cast(bfx8, b), c, 0, 0, 0);
}
DI int crow(int i, int h) { return (i & 3) + 8 * (i >> 2) + 4 * h; }
DI float wave_sum(float v) {
#pragma unroll
  for (int m = 32; m >= 1; m >>= 1) v += __shfl_xor(v, m);
  return v;
}
DI float xhalf_max(float v) {
  auto rr = __builtin_amdgcn_permlane32_swap(__float_as_uint(v), __float_as_uint(v), false, false);
  return fmaxf(__uint_as_float(rr[0]), __uint_as_float(rr[1]));
}
DI float xhalf_sum(float v) {
  auto rr = __builtin_amdgcn_permlane32_swap(__float_as_uint(v), __float_as_uint(v), false, false);
  return __uint_as_float(rr[0]) + __uint_as_float(rr[1]);
}
DI int tok_krow(int tok) {
  if (tok < TP) return tok;
  const int s = tok - TP;
  return TP + (s >> 5) * SKS + PAST + (s & 31);
}
DI int tok_pos(int tok) { return tok < TP ? (tok & (SEQ - 1)) : PAST + ((tok - TP) & 31); }

enum { EPI_IN = 0, EPI_MEM, EPI_UQ, EPI_KV, EPI_RESID, EPI_XQ, EPI_UP, EPI_RESID0 };

template <int EPI, int MI, int NI = 2>
DI void epilogue(const Params& P, int l, f32x16 (&acc)[MI][NI], int mw, int nw, int r, int h) {
  float* out = P.out;
  char* ws = P.ws;
  if constexpr (EPI == EPI_IN) {
    u16* qf = (u16*)(ws + WS_QF);
    u16* fk = (u16*)(ws + WS_FOXK);
    u16* fv = (u16*)(ws + WS_FOXV);
    float* zc = (float*)(ws + WS_ZC);
    const float* bfg = P.in[12] + l * 8;
#pragma unroll
    for (int mi = 0; mi < MI; mi++) {
#pragma unroll
      for (int i = 0; i < 16; i++) {
        const int row = mw + mi * 32 + crow(i, h);
        const int kr = tok_krow(row);
        const bool isp = row < TP;
        const size_t orow = isp ? ((size_t)l * TP + row) : ((size_t)l * TS + (row - TP));
#pragma unroll
        for (int ni = 0; ni < NI; ni++) {
          const int col = nw + ni * 32 + r;
          const float v = acc[mi][ni][i];
          if (col < 512) {
            qf[(size_t)row * 512 + col] = f2bf(v);
          } else if (col < 1024) {
            const int c = col - 512;
            out[(isp ? O_FKP : O_FKS) + orow * 512 + c] = v;
            fk[(size_t)kr * 512 + c] = f2bf(v);
          } else if (col < 1536) {
            const int c = col - 1024;
            out[(isp ? O_FVP : O_FVS) + orow * 512 + c] = v;
            fv[(size_t)kr * 512 + c] = f2bf(v);
          } else if (col < 1544) {
            const int c = col - 1536;
            const float g = v + bfg[c];
            const float ls = fminf(g, 0.f) - __logf(1.f + __expf(-fabsf(g)));
            out[(isp ? O_FLP : O_FLS) + orow * 8 + c] = ls;
          } else if (col < INC) {
            zc[(size_t)row * 448 + (col - 1544)] = v;
          }
        }
      }
    }
  } else if constexpr (EPI == EPI_MEM) {
    u16* mk = (u16*)(ws + WS_MEMK);
    u16* mv = (u16*)(ws + WS_MEMV);
#pragma unroll
    for (int mi = 0; mi < MI; mi++) {
#pragma unroll
      for (int i = 0; i < 16; i++) {
        const int row = mw + mi * 32 + crow(i, h);
#pragma unroll
        for (int ni = 0; ni < NI; ni++) {
          const int col = nw + ni * 32 + r;
          const float v = acc[mi][ni][i];
          const int c = col & 1023;
          const size_t oidx = ((size_t)l * (NB * NMEM) + row) * 1024 + c;
          const size_t bidx = ((size_t)l * (MB * NMEM) + row) * 1024 + c;
          if (col < 1024) { out[O_MKP + oidx] = v; mk[bidx] = f2bf(v); }
          else { out[O_MVP + oidx] = v; mv[bidx] = f2bf(v); }
        }
      }
    }
  } else if constexpr (EPI == EPI_UQ) {
    u16* qm = (u16*)(ws + WS_R1 + R1_QM);
    const f32x2* rt = (const f32x2*)(ws + WS_ROPE);
    const bool isrope = (nw % 192) == 128;
#pragma unroll
    for (int mi = 0; mi < MI; mi++) {
#pragma unroll
      for (int i = 0; i < 16; i++) {
        const int row = mw + mi * 32 + crow(i, h);
        float x1 = acc[mi][0][i], x2 = acc[mi][1][i];
        if (isrope) {
          const f32x2 cs = rt[tok_pos(row) * 32 + r];
          const float o1 = x1 * cs[0] - x2 * cs[1];
          const float o2 = x2 * cs[0] + x1 * cs[1];
          x1 = o1; x2 = o2;
        }
        qm[(size_t)row * 768 + nw + r] = f2bf(x1);
        qm[(size_t)row * 768 + nw + 32 + r] = f2bf(x2);
      }
    }
  } else if constexpr (EPI == EPI_KV || EPI == EPI_XQ || EPI == EPI_UP) {
    u16* dst; int ld;
    if constexpr (EPI == EPI_KV) { dst = (u16*)(ws + WS_R1 + R1_KV); ld = 1024; }
    else if constexpr (EPI == EPI_XQ) { dst = (u16*)(ws + WS_R1 + R1_XQ); ld = 1024; }
    else { dst = (u16*)(ws + WS_R1 + R1_U); ld = DFF; }
    const bool odd = r & 1;
    const int colb = nw + (r & ~1);
#pragma unroll
    for (int mi = 0; mi < MI; mi++) {
#pragma unroll
      for (int i = 0; i < 16; i += 2) {
        const int row = mw + mi * 32 + crow(i, h) + (odd ? 1 : 0);
#pragma unroll
        for (int ni = 0; ni < NI; ni++) {
          float v0 = acc[mi][ni][i], v1 = acc[mi][ni][i + 1];
          if constexpr (EPI == EPI_UP) { v0 = fmaxf(v0, 0.f); v0 = v0 * v0; v1 = fmaxf(v1, 0.f); v1 = v1 * v1; }
          const float send = odd ? v0 : v1;
          const float recv = __int_as_float(__builtin_amdgcn_mov_dpp(__float_as_int(send), 0xB1, 0xF, 0xF, true));
          const unsigned w = odd ? pk2(recv, v1) : pk2(v0, recv);
          *(unsigned*)(dst + (size_t)row * ld + colb + ni * 32) = w;
        }
      }
    }
  } else if constexpr (EPI == EPI_RESID || EPI == EPI_RESID0) {
#pragma unroll
    for (int mi = 0; mi < MI; mi++) {
#pragma unroll
      for (int i = 0; i < 16; i++) {
        const int row = mw + mi * 32 + crow(i, h);
#pragma unroll
        for (int ni = 0; ni < NI; ni++) {
          unsafeAtomicAdd(out + (size_t)row * DM + nw + ni * 32 + r, EPI == EPI_RESID0 ? acc[mi][ni][i] * 0.f : acc[mi][ni][i]);
        }
      }
    }
  }
}

enum { MASK_NONE = 0, MASK_FRAME = 1, MASK_CHUNK = 2 };
struct AttnJob {
  const u16* Q; int ldq;
  const u16* K1; int ldk1;
  const u16* K2; int ldk2;
  const u16* V; int ldv;
  u16* O; int ldo;
  const float* cq;
  const float* ck;
  int nq, Sk, qpos0;
  float scale_log2;
  int wv;
};

template <int DQK, int D1, int DVT, int MASK, bool BIAS, bool PREFETCH, int LDQ, int LDK1, int LDK2, int LDV, int LDO, int KT, bool KSPLIT = false>
DI void attn_block(const AttnJob& J, char* smem) {
  constexpr int KP = DQK * 2 + 16;
  constexpr int VP = DVT * 2;
  constexpr int CV = DVT / 8;
  constexpr int NKK = DQK / 16, NDV = DVT / 32;
  constexpr float LOG2E = 1.4426950408889634f;
  char* Ks = smem;
  char* Vs = smem + KT * KP;
  float* cks = (float*)(smem + KT * KP + KT * VP);
  const int tid = get_tid(J.wv), wave = tid >> 6, lane = tid & 63, r = lane & 31, h = lane >> 5;
  const int wq0 = KSPLIT ? 0 : wave * 32;
  const bool active = wq0 < J.nq;
  const int qi = wq0 + r;
  const int qpos = J.qpos0 + qi;
  const int wqmax = J.qpos0 + wq0 + 31;
  const int qmax = J.qpos0 + J.nq - 1;
  const int ntk = (J.Sk + KT - 1) / KT;
  int nt = ntk;
  if (MASK != MASK_NONE) { const int t2 = qmax / KT + 1; nt = t2 < ntk ? t2 : ntk; }

  s16x8 qf[NKK];
  {
    const u16* qp = J.Q + (size_t)qi * LDQ + h * 8;
#pragma unroll
    for (int kk = 0; kk < NKK; kk++) {
      if (active) qf[kk] = *(const s16x8*)(qp + kk * 16);
      else { s16x8 z = {0, 0, 0, 0, 0, 0, 0, 0}; qf[kk] = z; }
    }
  }

  f32x16 o[NDV];
#pragma unroll
  for (int d = 0; d < NDV; d++)
#pragma unroll
    for (int i = 0; i < 16; i++) o[d][i] = 0.f;
  float m_run = -1e30f, l_run = 0.f;

  constexpr int CK1 = D1 / 8, CK2 = (DQK - D1) / 8;
  constexpr int RP1 = NTHR / CK1, NP1 = KT / RP1;
  constexpr int RP2 = CK2 ? NTHR / (CK2 ? CK2 : 1) : 64, NP2 = CK2 ? KT / RP2 : 0;
  constexpr int RPV = NTHR / CV, NPV = KT / RPV;
  u32x4 rk1[NP1], rk2[NP2 ? NP2 : 1], rv[NPV];
  float rck = 0.f;
  const int tq = (lane & 15) >> 2, tp = lane & 3, tblk = (lane >> 4) & 1;
  const int vswz = (DVT >= 128) ? tq : (tq >> 1);
  const int r1 = tid / CK1, c1 = tid % CK1;
  const int r2 = CK2 ? tid / (CK2 ? CK2 : 1) : 0, c2 = CK2 ? tid % (CK2 ? CK2 : 1) : 0;
  const int r3 = tid / CV, c3 = tid % CV;
  const unsigned k1o = (unsigned)(r1 * LDK1 + c1 * 8) * 2u;
  const unsigned k2o = (unsigned)(r2 * LDK2 + c2 * 8) * 2u;
  const unsigned vo = (unsigned)(r3 * LDV + c3 * 8) * 2u;
  const int k1so = r1 * KP + c1 * 16;
  const int k2so = r2 * KP + D1 * 2 + c2 * 16;
  const int vsw = (DVT >= 128) ? (r3 & 3) : ((r3 >> 1) & 1);
  const int vso = KT * KP + r3 * VP + (((c3 >> 2) ^ vsw) * 64) + (c3 & 3) * 16;
  const int vro = KT * KP + (4 * h + tq) * VP + (16 * tblk + 4 * tp) * 2;
  const int kro = r * KP + h * 16;

  auto load_tile = [&](int j) {
    const int kb = j * KT;
#pragma unroll
    for (int i = 0; i < NP1; i++) {
      u32x4 v = {0u, 0u, 0u, 0u};
      if (kb + r1 + i * RP1 < J.Sk) v = *(const u32x4*)((const char*)(J.K1 + (size_t)(kb + i * RP1) * LDK1) + k1o);
      rk1[i] = v;
    }
#pragma unroll
    for (int i = 0; i < NP2; i++) {
      u32x4 v = {0u, 0u, 0u, 0u};
      if (kb + r2 + i * RP2 < J.Sk) v = *(const u32x4*)((const char*)(J.K2 + (size_t)(kb + i * RP2) * LDK2) + k2o);
      rk2[i] = v;
    }
#pragma unroll
    for (int i = 0; i < NPV; i++) {
      u32x4 v = {0u, 0u, 0u, 0u};
      if (kb + r3 + i * RPV < J.Sk) v = *(const u32x4*)((const char*)(J.V + (size_t)(kb + i * RPV) * LDV) + vo);
      rv[i] = v;
    }
    if (BIAS) {
      if (tid < KT) { const int key = kb + tid; rck = key < J.Sk ? -J.ck[(size_t)key * 8] * LOG2E : 0.f; }
    }
  };
  auto store_tile = [&]() {
    int a1 = k1so, a2 = k2so, a3 = vso;
    asm volatile("" : "+v"(a1), "+v"(a2), "+v"(a3));
#pragma unroll
    for (int i = 0; i < NP1; i++) *(u32x4*)(smem + a1 + i * RP1 * KP) = rk1[i];
#pragma unroll
    for (int i = 0; i < NP2; i++) *(u32x4*)(smem + a2 + i * RP2 * KP) = rk2[i];
#pragma unroll
    for (int i = 0; i < NPV; i++) *(u32x4*)(smem + a3 + i * RPV * VP) = rv[i];
    if (BIAS) { if (tid < KT) cks[tid] = rck; }
  };

  if (PREFETCH) load_tile(0);
  for (int j = 0; j < nt; j++) {
    __syncthreads();
    if (!PREFETCH) load_tile(j);
    store_tile();
    __syncthreads();
    if (PREFETCH) { if (j + 1 < nt) load_tile(j + 1); }
    const bool need = active && (MASK == MASK_NONE || j * KT <= wqmax);
    if (need) {
      int kro_l = kro, vro_l = vro;
      asm volatile("" : "+v"(kro_l), "+v"(vro_l));
      const char* krd = smem + kro_l;
      const bool needmask = (MASK == MASK_FRAME && j * KT + KT - 1 > J.qpos0 + wq0) || (j * KT + KT - 1 >= J.Sk);
      const int dq = (MASK == MASK_FRAME ? min(qpos, J.Sk - 1) : J.Sk - 1) - j * KT - 4 * h;
      auto qk = [&](int hb) {
        f32x16 p;
#pragma unroll
        for (int i = 0; i < 16; i++) p[i] = 0.f;
#pragma unroll
        for (int kk = 0; kk < NKK; kk++) {
          const s16x8 kf = *(const s16x8*)(krd + hb * 32 * KP + kk * 32);
          p = mfma(kf, qf[kk], p);
        }
        return p;
      };
      auto soft_pv = [&](int hb, f32x16 p, f32x16* pnext_out, bool issue_next) {
        if (BIAS) {
#pragma unroll
          for (int g = 0; g < 4; g++) {
            const f32x4 c0 = *(const f32x4*)(cks + hb * 32 + 8 * g + 4 * h);
#pragma unroll
            for (int e = 0; e < 4; e++) p[4 * g + e] = fmaf(p[4 * g + e], J.scale_log2, c0[e]);
          }
        } else {
#pragma unroll
          for (int i = 0; i < 16; i++) p[i] *= J.scale_log2;
        }
        if (needmask) {
#pragma unroll
          for (int i = 0; i < 16; i++) {
            const int cc = (i & 3) + 8 * (i >> 2) + 32 * hb;
            p[i] = (cc <= dq) ? p[i] : -1e30f;
          }
        }
        float mx = p[0];
#pragma unroll
        for (int i = 1; i < 16; i++) mx = fmaxf(mx, p[i]);
        mx = xhalf_max(mx);
        if (__any(mx > m_run + 8.f)) {
          const float m_new = fmaxf(m_run, mx);
          const float alpha = __builtin_amdgcn_exp2f(m_run - m_new);
          m_run = m_new;
          l_run *= alpha;
#pragma unroll
          for (int d = 0; d < NDV; d++)
#pragma unroll
            for (int i = 0; i < 16; i++) o[d][i] *= alpha;
        }
        if (issue_next) *pnext_out = qk(hb + 1);
        float ps = 0.f;
#pragma unroll
        for (int i = 0; i < 16; i++) { p[i] = __builtin_amdgcn_exp2f(p[i] - m_run); ps += p[i]; }
        l_run += ps;
        s16x8 pb[2];
        {
          u32x4 w;
          w[0] = pk2(p[0], p[1]); w[1] = pk2(p[2], p[3]); w[2] = pk2(p[4], p[5]); w[3] = pk2(p[6], p[7]);
          pb[0] = __builtin_bit_cast(s16x8, w);
          w[0] = pk2(p[8], p[9]); w[1] = pk2(p[10], p[11]); w[2] = pk2(p[12], p[13]); w[3] = pk2(p[14], p[15]);
          pb[1] = __builtin_bit_cast(s16x8, w);
        }
#pragma unroll
        for (int d = 0; d < NDV; d++) {
          const char* vb = smem + (vro_l + ((d ^ vswz) * 64)) + hb * 32 * VP;
#pragma unroll
          for (int s = 0; s < 2; s++) {
            const s16x4 lo = __builtin_amdgcn_ds_read_tr16_b64_v4i16(
                (__attribute__((address_space(3))) s16x4*)(uintptr_t)(vb + (16 * s) * VP));
            const s16x4 hi = __builtin_amdgcn_ds_read_tr16_b64_v4i16(
                (__attribute__((address_space(3))) s16x4*)(uintptr_t)(vb + (16 * s + 8) * VP));
            const s16x8 vf = __builtin_shufflevector(lo, hi, 0, 1, 2, 3, 4, 5, 6, 7);
            o[d] = mfma(vf, pb[s], o[d]);
          }
        }
      };
      if constexpr (KSPLIT) {
#pragma unroll
        for (int hb = 0; hb < KT / 32; hb++) {
          if (hb != J.wv) continue;
          if (MASK == MASK_FRAME && j * KT + hb * 32 > wqmax) continue;
          soft_pv(hb, qk(hb), nullptr, false);
        }
      } else {
        f32x16 pcur = qk(0);
        if (!needmask) {
#pragma unroll
          for (int hb = 0; hb < KT / 32; hb++) {
            f32x16 pnext = pcur;
            soft_pv(hb, pcur, &pnext, hb + 1 < KT / 32);
            pcur = pnext;
          }
        } else {
          bool vcur = true;
#pragma unroll
          for (int hb = 0; hb < KT / 32; hb++) {
            f32x16 pnext = pcur;
            bool vnext = false;
            if (hb + 1 < KT / 32) {
              vnext = !(MASK == MASK_FRAME && j * KT + (hb + 1) * 32 > wqmax);
              if (vnext) pnext = qk(hb + 1);
            }
            if (vcur) soft_pv(hb, pcur, nullptr, false);
            pcur = pnext; vcur = vnext;
          }
        }
      }
    }
  }
  float lt = xhalf_sum(l_run);
  bool writer = active && qi < J.nq;
  if (KSPLIT) {
    constexpr int NWS = KT / 32;
    constexpr int NV = NDV * 16 + 2;
    float* mb = (float*)smem;
    __syncthreads();
    if (wave < NWS) {
      float* w = mb + (size_t)wave * NV * 64 + lane;
#pragma unroll
      for (int d = 0; d < NDV; d++)
#pragma unroll
        for (int i = 0; i < 16; i++) w[(d * 16 + i) * 64] = o[d][i];
      w[(NDV * 16) * 64] = m_run;
      w[(NDV * 16 + 1) * 64] = lt;
    }
    __syncthreads();
    writer = writer && (wave == 0);
    if (wave == 0) {
      float M = -1e30f;
#pragma unroll
      for (int w2 = 0; w2 < NWS; w2++) M = fmaxf(M, mb[((size_t)w2 * NV + NDV * 16) * 64 + lane]);
      float L = 0.f;
#pragma unroll
      for (int d = 0; d < NDV; d++)
#pragma unroll
        for (int i = 0; i < 16; i++) o[d][i] = 0.f;
#pragma unroll 1
      for (int w2 = 0; w2 < NWS; w2++) {
        const float* rsrc = mb + (size_t)w2 * NV * 64 + lane;
        const float sc = __builtin_amdgcn_exp2f(rsrc[(NDV * 16) * 64] - M);
        L += rsrc[(NDV * 16 + 1) * 64] * sc;
#pragma unroll
        for (int d = 0; d < NDV; d++)
#pragma unroll
          for (int i = 0; i < 16; i++) o[d][i] += rsrc[(d * 16 + i) * 64] * sc;
      }
      lt = L;
    }
  }
  if (writer) {
    const float inv = 1.f / lt;
    u16* op = J.O + (size_t)qi * LDO + 4 * h;
#pragma unroll
    for (int d = 0; d < NDV; d++) {
#pragma unroll
      for (int g = 0; g < 4; g++) {
        u32x2 w;
        w[0] = pk2(o[d][4 * g] * inv, o[d][4 * g + 1] * inv);
        w[1] = pk2(o[d][4 * g + 2] * inv, o[d][4 * g + 3] * inv);
        *(u32x2*)(op + d * 32 + 8 * g) = w;
      }
    }
  }
}

template <int NR, bool F32OUT>
DI void rms_rows(const float* __restrict__ xbase, size_t rstride, int nvalid, const float* __restrict__ g, void* dbase, size_t dstride, int lane) {
  f32x4 v[NR][4];
#pragma unroll
  for (int j = 0; j < NR; j++)
#pragma unroll
    for (int i = 0; i < 4; i++) {
      if (j < nvalid) v[j][i] = *(const f32x4*)(xbase + (size_t)j * rstride + i * 256 + lane * 4);
      else { f32x4 z = {0.f, 0.f, 0.f, 0.f}; v[j][i] = z; }
    }
  f32x4 gg[4];
#pragma unroll
  for (int i = 0; i < 4; i++) gg[i] = *(const f32x4*)(g + i * 256 + lane * 4);
#pragma unroll
  for (int j = 0; j < NR; j++) {
    float ss = 0.f;
#pragma unroll
    for (int i = 0; i < 4; i++) ss += v[j][i][0] * v[j][i][0] + v[j][i][1] * v[j][i][1] + v[j][i][2] * v[j][i][2] + v[j][i][3] * v[j][i][3];
    ss = wave_sum(ss);
    const float rs = rsqrtf(ss * (1.f / 1024.f) + 1e-6f);
    if (j < nvalid) {
#pragma unroll
      for (int i = 0; i < 4; i++) {
        if (F32OUT) {
          f32x4 w;
          w[0] = v[j][i][0] * rs * gg[i][0]; w[1] = v[j][i][1] * rs * gg[i][1]; w[2] = v[j][i][2] * rs * gg[i][2]; w[3] = v[j][i][3] * rs * gg[i][3];
          *(f32x4*)((float*)dbase + (size_t)j * dstride + i * 256 + lane * 4) = w;
        } else {
          u32x2 w;
          w[0] = pk2(v[j][i][0] * rs * gg[i][0], v[j][i][1] * rs * gg[i][1]);
          w[1] = pk2(v[j][i][2] * rs * gg[i][2], v[j][i][3] * rs * gg[i][3]);
          *(u32x2*)((u16*)dbase + (size_t)j * dstride + i * 256 + lane * 4) = w;
        }
      }
    }
  }
}

DI void cvt_job(const float* __restrict__ src, u16* __restrict__ dst, int nseg, size_t seglen, size_t sstride, size_t dstride, int wv) {
  const size_t upseg = seglen / 8;
  const size_t total = upseg * nseg;
  const size_t stride = (size_t)get_nblk() * NTHR;
  for (size_t u0 = (size_t)get_bid() * NTHR + get_tid(wv); u0 < total; u0 += 4 * stride) {
    f32x4 a[4], b[4];
    size_t so[4], dd[4];
#pragma unroll
    for (int q = 0; q < 4; q++) {
      const size_t u = u0 + q * stride;
      const size_t uu = u < total ? u : u0;
      const size_t sg = uu / upseg, off = (uu - sg * upseg) * 8;
      so[q] = sg * sstride + off; dd[q] = sg * dstride + off;
      a[q] = *(const f32x4*)(src + so[q]);
      b[q] = *(const f32x4*)(src + so[q] + 4);
    }
#pragma unroll
    for (int q = 0; q < 4; q++) {
      if (u0 + q * stride < total) {
        u32x4 w;
        w[0] = pk2(a[q][0], a[q][1]); w[1] = pk2(a[q][2], a[q][3]); w[2] = pk2(b[q][0], b[q][1]); w[3] = pk2(b[q][2], b[q][3]);
        *(u32x4*)(dst + dd[q]) = w;
      }
    }
  }
}

DI void transpose_job(const float* __restrict__ src, u16* __restrict__ dst, int K, int N, int Npad, int& rot, char* smem, int wv) {
  float* tile = (float*)smem;
  const int tk = K / 64, tn = Npad / 64, ntiles = tk * tn;
  const int G = get_nblk();
  const int tid = get_tid(wv);
  for (int t = (get_bid() + G - (rot % G)) % G; t < ntiles; t += G) {
    const int k0 = (t % tk) * 64, n0 = (t / tk) * 64;
    float v[8];
#pragma unroll
    for (int i = 0; i < 8; i++) {
      const int k = i * 8 + (tid >> 6), n = tid & 63;
      v[i] = (n0 + n < N) ? src[(size_t)(k0 + k) * N + n0 + n] : 0.f;
    }
    __syncthreads();
#pragma unroll
    for (int i = 0; i < 8; i++) {
      const int k = i * 8 + (tid >> 6), n = tid & 63;
      tile[k * 65 + n] = v[i];
    }
    __syncthreads();
#pragma unroll
    for (int i = 0; i < 4; i++) {
      const int n = i * 16 + (tid >> 5), k = (tid & 31) * 2;
      *(unsigned*)(dst + (size_t)(n0 + n) * K + k0 + k) = pk2(tile[k * 65 + n], tile[(k + 1) * 65 + n]);
    }
  }
  rot += ntiles;
}

DI u16* wt_ptr(const Params& P, int l, size_t eoff) { return (u16*)(P.ws + WS_WT) + (size_t)l * WE_LAYER + eoff; }

DI void phase_prep(const Params& P, char* smem) {
  const int tid = get_tid(P.wv), lane = tid & 63;
  const int gw = get_bid() * NWV + (tid >> 6), nw = get_nblk() * NWV;
  int rot = 0;
  for (int l = 0; l < NL; l++) {
    transpose_job(P.in[11] + (size_t)l * 1024 * INC, wt_ptr(P, l, WE_IN), 1024, INC, INP, rot, smem, P.wv);
    transpose_job(P.in[14] + (size_t)l * 256 * 768, wt_ptr(P, l, WE_UQ), 256, 768, 768, rot, smem, P.wv);
    transpose_job(P.in[16] + (size_t)l * 128 * 1024, wt_ptr(P, l, WE_UKV), 128, 1024, 1024, rot, smem, P.wv);
    transpose_job(P.in[17] + (size_t)l * 1024 * 1024, wt_ptr(P, l, WE_OUT), 1024, 1024, 1024, rot, smem, P.wv);
    transpose_job(P.in[20] + (size_t)l * 1024 * 1024, wt_ptr(P, l, WE_XQ), 1024, 1024, 1024, rot, smem, P.wv);
    transpose_job(P.in[21] + (size_t)l * 1024 * 1024, wt_ptr(P, l, WE_MKV), 1024, 1024, 1024, rot, smem, P.wv);
    transpose_job(P.in[22] + (size_t)l * 1024 * 1024, wt_ptr(P, l, WE_MKV) + (size_t)1024 * 1024, 1024, 1024, 1024, rot, smem, P.wv);
    transpose_job(P.in[23] + (size_t)l * 1024 * 1024, wt_ptr(P, l, WE_XO), 1024, 1024, 1024, rot, smem, P.wv);
    transpose_job(P.in[25] + (size_t)l * 1024 * 4096, wt_ptr(P, l, WE_UP), 1024, 4096, 4096, rot, smem, P.wv);
    transpose_job(P.in[26] + (size_t)l * 4096 * 1024, wt_ptr(P, l, WE_DN), 4096, 1024, 1024, rot, smem, P.wv);
  }
  {
    f32x2* rt = (f32x2*)(P.ws + WS_ROPE);
    for (int i = get_bid() * NTHR + tid; i < 4096 * 32; i += get_nblk() * NTHR) {
      const int pos = i >> 5, j = i & 31;
      const float inv = powf(10000.f, -(float)j / 32.f);
      const float ang = (float)pos * inv;
      f32x2 cs; cs[0] = cosf(ang); cs[1] = sinf(ang);
      rt[i] = cs;
    }
  }
  for (int l = 0; l < NL; l++) {
    const size_t seg = (size_t)DB * NMEM * 1024;
    cvt_job(P.in[8] + l * seg, (u16*)(P.ws + WS_MEMK) + ((size_t)l * MB + NB) * NMEM * 1024, 1, seg, 0, 0, P.wv);
    cvt_job(P.in[9] + l * seg, (u16*)(P.ws + WS_MEMV) + ((size_t)l * MB + NB) * NMEM * 1024, 1, seg, 0, 0, P.wv);
  }
  for (int rr = gw; rr < NL * NB * NMEM; rr += nw) {
    const int l = rr / (NB * NMEM), row = rr % (NB * NMEM);
    rms_rows<1, false>(P.in[2] + (size_t)row * 1024, 0, 1, P.in[19] + l * 1024, (u16*)(P.ws + WS_HMEM) + (size_t)rr * 1024, 0, lane);
  }
  {
    const size_t n4 = (size_t)TT * 256;
    const size_t np4 = (size_t)TP * 256;
    const size_t stride = (size_t)get_nblk() * NTHR;
    for (size_t i0 = (size_t)get_bid() * NTHR + tid; i0 < n4; i0 += 4 * stride) {
      f32x4 v[4];
#pragma unroll
      for (int q = 0; q < 4; q++) {
        const size_t i = i0 + q * stride;
        const size_t ii = i < n4 ? i : i0;
        v[q] = (ii < np4) ? *(const f32x4*)(P.in[0] + ii * 4) : *(const f32x4*)(P.in[1] + (ii - np4) * 4);
      }
#pragma unroll
      for (int q = 0; q < 4; q++) {
        const size_t i = i0 + q * stride;
        if (i < n4) *(f32x4*)(P.out + i * 4) = v[q];
      }
    }
  }
}

DI void phase_norm(const Params& P, const float* g, int cache_layer) {
  const int tid = get_tid(P.wv), lane = tid & 63;
  const int gw = get_bid() * NWV + (tid >> 6), nw = get_nblk() * NWV;
  u16* h = (u16*)(P.ws + WS_ACTA);
  for (int row = gw; row < TT; row += 4 * nw) {
    const int nv = (TT - row + nw - 1) / nw;
    rms_rows<4, false>(P.out + (size_t)row * 1024, (size_t)nw * 1024, nv < 4 ? nv : 4, g, h + (size_t)row * 1024, (size_t)nw * 1024, lane);
  }
  if (cache_layer >= 0) {
    const int l = cache_layer;
    cvt_job(P.in[3] + (size_t)l * DB * PAST * 512, (u16*)(P.ws + WS_FOXK) + (size_t)TP * 512, DB, (size_t)PAST * 512, (size_t)PAST * 512, (size_t)SKS * 512, P.wv);
    cvt_job(P.in[4] + (size_t)l * DB * PAST * 512, (u16*)(P.ws + WS_FOXV) + (size_t)TP * 512, DB, (size_t)PAST * 512, (size_t)PAST * 512, (size_t)SKS * 512, P.wv);
    cvt_job(P.in[6] + (size_t)l * DB * PAST * 128, (u16*)(P.ws + WS_CKV) + (size_t)TP * 128, DB, (size_t)PAST * 128, (size_t)PAST * 128, (size_t)SKS * 128, P.wv);
    cvt_job(P.in[7] + (size_t)l * DB * PAST * 64, (u16*)(P.ws + WS_KROPE) + (size_t)TP * 64, DB, (size_t)PAST * 64, (size_t)PAST * 64, (size_t)SKS * 64, P.wv);
  }
}

DI void phase_final(const Params& P) {
  const int tid = get_tid(P.wv), lane = tid & 63;
  const int gw = get_bid() * NWV + (tid >> 6), nw = get_nblk() * NWV;
  const float* g = P.in[27];
  for (int row = gw; row < TT; row += 4 * nw) {
    const int nv = (TT - row + nw - 1) / nw;
    rms_rows<4, true>(P.out + (size_t)row * 1024, (size_t)nw * 1024, nv < 4 ? nv : 4, g, P.out + (size_t)row * 1024, (size_t)nw * 1024, lane);
  }
}

DI void phase_post(const Params& P, int l, char* smem) {
  const int tid = get_tid(P.wv), lane = tid & 63;
  const int gw = get_bid() * NWV + (tid >> 6), nw = get_nblk() * NWV;
  const float* zc = (const float*)(P.ws + WS_ZC);
  u16* cqn = (u16*)(P.ws + WS_CQN);
  u16* ckv = (u16*)(P.ws + WS_CKV);
  u16* krp = (u16*)(P.ws + WS_KROPE);
  const f32x2* rt = (const f32x2*)(P.ws + WS_ROPE);
  const float* gq = P.in[13] + l * 256;
  const float* gkv = P.in[15] + l * 128;
  for (int tok0 = gw; tok0 < TT; tok0 += 4 * nw) {
    f32x4 vq[4]; f32x2 vk[4]; float vr[4];
#pragma unroll
    for (int j = 0; j < 4; j++) {
      const int tk = tok0 + j * nw;
      const float* z = zc + (size_t)(tk < TT ? tk : tok0) * 448;
      vq[j] = *(const f32x4*)(z + lane * 4);
      vk[j] = *(const f32x2*)(z + 256 + lane * 2);
      vr[j] = z[384 + lane];
    }
    const f32x4 ggq = *(const f32x4*)(gq + lane * 4);
    const f32x2 ggk = *(const f32x2*)(gkv + lane * 2);
#pragma unroll
    for (int j = 0; j < 4; j++) {
      const int tok = tok0 + j * nw;
      if (tok >= TT) break;
      const bool isp = tok < TP;
      const size_t orow = isp ? ((size_t)l * TP + tok) : ((size_t)l * TS + (tok - TP));
      const int kr = tok_krow(tok);
      {
        const f32x4 v = vq[j];
        const float ss = wave_sum(v[0] * v[0] + v[1] * v[1] + v[2] * v[2] + v[3] * v[3]);
        const float rs = rsqrtf(ss * (1.f / 256.f) + 1e-6f);
        u32x2 w;
        w[0] = pk2(v[0] * rs * ggq[0], v[1] * rs * ggq[1]);
        w[1] = pk2(v[2] * rs * ggq[2], v[3] * rs * ggq[3]);
        *(u32x2*)(cqn + (size_t)tok * 256 + lane * 4) = w;
      }
      {
        const f32x2 v = vk[j];
        const float ss = wave_sum(v[0] * v[0] + v[1] * v[1]);
        const float rs = rsqrtf(ss * (1.f / 128.f) + 1e-6f);
        f32x2 o; o[0] = v[0] * rs * ggk[0]; o[1] = v[1] * rs * ggk[1];
        *(f32x2*)(P.out + (isp ? O_CKP : O_CKS) + orow * 128 + lane * 2) = o;
        *(unsigned*)(ckv + (size_t)kr * 128 + lane * 2) = pk2(o[0], o[1]);
      }
      {
        const float x = vr[j];
        const float y = __shfl_xor(x, 32);
        const f32x2 cs = rt[tok_pos(tok) * 32 + (lane & 31)];
        const float o = (lane < 32) ? (x * cs[0] - y * cs[1]) : (x * cs[0] + y * cs[1]);
        P.out[(isp ? O_KRP : O_KRS) + orow * 64 + lane] = o;
        krp[(size_t)kr * 64 + lane] = f2bf(o);
      }
    }
  }
  float* cum = (float*)(P.ws + WS_CUM);
  float* wtot = (float*)smem;
  const int wave = tid >> 6;
  for (int it = get_bid(); it < NB + DB; it += get_nblk()) {
    const bool isp = it < NB;
    const int b = isp ? it : it - NB;
    const int ppt = isp ? 16 : 9;
    const int npos = isp ? SEQ : SKS;
    const float* srcA; const float* srcB; int nA;
    size_t krow0;
    if (isp) { srcA = P.out + O_FLP + ((size_t)l * TP + (size_t)b * SEQ) * 8; srcB = srcA; nA = SEQ; krow0 = (size_t)b * SEQ; }
    else {
      srcA = P.in[5] + ((size_t)l * DB + b) * PAST * 8;
      srcB = P.out + O_FLS + ((size_t)l * TS + (size_t)b * DS) * 8 - (size_t)PAST * 8;
      nA = PAST; krow0 = (size_t)TP + (size_t)b * SKS;
    }
    const int p0 = tid * ppt;
    f32x4 va[16], vb[16];
#pragma unroll
    for (int j = 0; j < 16; j++) {
      const int p = p0 + j;
      f32x4 z = {0.f, 0.f, 0.f, 0.f};
      va[j] = z; vb[j] = z;
      if (j < ppt && p < npos) {
        const float* s = (p < nA ? srcA : srcB) + (size_t)p * 8;
        va[j] = *(const f32x4*)s; vb[j] = *(const f32x4*)(s + 4);
      }
    }
#pragma unroll
    for (int j = 1; j < 16; j++) { va[j] += va[j - 1]; vb[j] += vb[j - 1]; }
    f32x4 ta = va[15], tb = vb[15];
#pragma unroll
    for (int d = 1; d < 64; d <<= 1) {
#pragma unroll
      for (int e = 0; e < 4; e++) {
        const float ua = __shfl_up(ta[e], d), ub = __shfl_up(tb[e], d);
        if (lane >= d) { ta[e] += ua; tb[e] += ub; }
      }
    }
    __syncthreads();
    if (lane == 63) { *(f32x4*)(wtot + wave * 8) = ta; *(f32x4*)(wtot + wave * 8 + 4) = tb; }
    __syncthreads();
    f32x4 pa = ta - va[15], pb = tb - vb[15];
    for (int w2 = 0; w2 < wave; w2++) { pa += *(const f32x4*)(wtot + w2 * 8); pb += *(const f32x4*)(wtot + w2 * 8 + 4); }
#pragma unroll
    for (int j = 0; j < 16; j++) {
      const int p = p0 + j;
      if (j < ppt && p < npos) {
        float* d = cum + (krow0 + p) * 8;
        *(f32x4*)d = va[j] + pa; *(f32x4*)(d + 4) = vb[j] + pb;
      }
    }
  }
}

template <int EPI>
DI void gemm_phase(const Params& P, int l, const u16* __restrict__ A, int lda, const u16* __restrict__ Bt, int ldb, int K, int M, int N,
                   char* smem, int& rot) {
  constexpr int MI = 4;
  constexpr int STAGE = 32768;
  constexpr int NSLOT = SMEM_BYTES / STAGE;
  constexpr int DEPTH = NSLOT - 1;
  constexpr int GPS = 4;
  static_assert(NSLOT == 4, "ring waits are written for 4 slots");
  const int tid = get_tid(P.wv), wave = tid >> 6, lane = tid & 63, r = lane & 31, h = lane >> 5;
  const int wm = wave >> 2, wn = wave & 3;
  const int TM = M >> 8, TN = N >> 8;
  const int ntiles = TM * TN;
  const int G = get_nblk();
  const int bid = get_bid();
  const bool xmap = (G == 256);
  const int hsel = (bid + 256 - ((rot * 64) & 255)) & 255;
  int t0, tstep;
  if (xmap) {
    const int nun = (ntiles + 31) >> 5;
    const int xs = (bid + 8 - (rot & 7)) & 7;
    t0 = xs * 32 + (bid >> 3); tstep = 256;
    rot += nun;
  } else {
    t0 = (bid + G - (rot % G)) % G; tstep = G;
    rot += ntiles;
  }
  const int nk = K >> 5;
  constexpr bool SPLITK = (EPI == EPI_RESID || EPI == EPI_RESID0);
  const bool sk = SPLITK && xmap && (TN == 4) && (((TM * nk) & 63) == 0);
  const int skS = (TM * nk) >> 6;
  const int sknt = (bid >> 3) & 3;
  constexpr bool HALFOK = (EPI == EPI_IN || EPI == EPI_XQ || EPI == EPI_UP || EPI == EPI_KV || EPI == EPI_MEM);
  int nfull = ntiles, hR = 0;
  if (HALFOK && xmap) { const int fr = ntiles >> 8; const int R = ntiles - (fr << 8); if (R > 0 && R <= 128) { nfull = fr << 8; hR = R; } }
  const int p_begin = sk ? ((bid & 7) * 8 + (bid >> 5)) * skS : t0;
  const int p_end = sk ? p_begin + skS : nfull;
  const int lrow = tid >> 2, lc = tid & 3;
  const int pc = (lc ^ ((tid >> 4) & 3)) * 8;
  const int sw = (r >> 2) & 3;
  const int xo0 = ((0 + h) ^ sw) * 16, xo1 = ((2 + h) ^ sw) * 16;
  const int aro = (wm * 128 + r) * 64, bro = 16384 + (wn * 64 + r) * 64;
  auto tile_of = [&](int t, int& m0, int& n0) { const int mt = t / TN; m0 = mt << 8; n0 = (t - mt * TN) << 8; };
  auto issue = [&](int m0, int n0, int ks, int slot) {
    const u16* ag = A + (size_t)(m0 + lrow) * lda + pc + ks * 32;
    const u16* bg = Bt + (size_t)(n0 + lrow) * ldb + pc + ks * 32;
    char* dst = smem + slot * STAGE + tid * 16;
#pragma unroll
    for (int i = 0; i < 2; i++)
      __builtin_amdgcn_global_load_lds((const unsigned*)(ag + (size_t)i * 128 * lda), (__attribute__((address_space(3))) unsigned*)(dst + i * 8192), 16, 0, 0);
#pragma unroll
    for (int i = 0; i < 2; i++)
      __builtin_amdgcn_global_load_lds((const unsigned*)(bg + (size_t)i * 128 * ldb), (__attribute__((address_space(3))) unsigned*)(dst + 16384 + i * 8192), 16, 0, 0);
  };
  auto unit_at = [&](int p, int& m0, int& n0, int& kb, int& nkk) {
    if (sk) { const int mt = p / nk; kb = p - mt * nk; const int rem = p_end - p; nkk = (nk - kb) < rem ? (nk - kb) : rem; m0 = mt << 8; n0 = sknt << 8; }
    else { tile_of(p, m0, n0); kb = 0; nkk = nk; }
  };
  if (p_begin < p_end) {
  int t = p_begin, m0, n0, kb, nkk;
  unit_at(t, m0, n0, kb, nkk);
  int ti = p_begin, ki = 0, mi0 = m0, ni0 = n0, kbi = kb, nki = nkk;
  bool idone = false;
  int pend = 0;
  unsigned g = 0;
  asm volatile("s_waitcnt vmcnt(0) lgkmcnt(0)" ::: "memory");
  __builtin_amdgcn_s_barrier();
#pragma unroll 1
  for (int s = 0; s < DEPTH; s++) {
    if (!idone) {
      issue(mi0, ni0, kbi + ki, (g + pend) % NSLOT);
      pend++;
      if (++ki == nki) { ki = 0; ti = sk ? ti + nki : ti + tstep; if (ti < p_end) unit_at(ti, mi0, ni0, kbi, nki); else idone = true; }
    }
  }
  while (true) {
    f32x16 acc[MI][2];
#pragma unroll
    for (int a = 0; a < MI; a++)
#pragma unroll
      for (int b = 0; b < 2; b++)
#pragma unroll
        for (int i = 0; i < 16; i++) acc[a][b][i] = 0.f;
    s16x8 a2[MI], b2, b3;
    {
      const s16x8 z = {0, 0, 0, 0, 0, 0, 0, 0};
#pragma unroll
      for (int i = 0; i < MI; i++) a2[i] = z;
      b2 = z; b3 = z;
    }
#pragma unroll 1
    for (int kt = 0; kt < nkk; kt++) {
      if (pend >= 3) asm volatile("s_waitcnt vmcnt(%0)" ::"n"(2 * GPS) : "memory");
      else if (pend == 2) asm volatile("s_waitcnt vmcnt(%0)" ::"n"(GPS) : "memory");
      else asm volatile("s_waitcnt vmcnt(0)" ::: "memory");
      asm volatile("" ::: "memory");
      __builtin_amdgcn_s_waitcnt(0xC07F);
      __builtin_amdgcn_s_barrier();
      asm volatile("" ::: "memory");
      if (!idone) {
        issue(mi0, ni0, kbi + ki, (g + pend) % NSLOT);
        if (++ki == nki) { ki = 0; ti = sk ? ti + nki : ti + tstep; if (ti < p_end) unit_at(ti, mi0, ni0, kbi, nki); else idone = true; }
      } else {
        pend--;
      }
      const char* sb = smem + (g % NSLOT) * STAGE;
      g++;
      s16x8 a[MI];
#pragma unroll
      for (int i = 0; i < MI; i++) a[i] = *(const s16x8*)(sb + aro + i * 32 * 64 + xo0);
      const s16x8 b0 = *(const s16x8*)(sb + bro + xo0);
      const s16x8 b1 = *(const s16x8*)(sb + bro + 32 * 64 + xo0);
      if (kt > 0) {
#pragma unroll
        for (int i = 0; i < MI; i++) { acc[i][0] = mfma(a2[i], b2, acc[i][0]); acc[i][1] = mfma(a2[i], b3, acc[i][1]); }
      }
#pragma unroll
      for (int i = 0; i < MI; i++) a2[i] = *(const s16x8*)(sb + aro + i * 32 * 64 + xo1);
      b2 = *(const s16x8*)(sb + bro + xo1);
      b3 = *(const s16x8*)(sb + bro + 32 * 64 + xo1);
#pragma unroll
      for (int i = 0; i < MI; i++) { acc[i][0] = mfma(a[i], b0, acc[i][0]); acc[i][1] = mfma(a[i], b1, acc[i][1]); }
    }
#pragma unroll
    for (int i = 0; i < MI; i++) { acc[i][0] = mfma(a2[i], b2, acc[i][0]); acc[i][1] = mfma(a2[i], b3, acc[i][1]); }
    epilogue<EPI, MI>(P, l, acc, m0 + wm * 128, n0 + wn * 64, r, h);
    t = sk ? t + nkk : t + tstep;
    if (t >= p_end) break;
    unit_at(t, m0, n0, kb, nkk);
  }
  }
  if constexpr (HALFOK) {
    if (hR > 0 && hsel < 2 * hR) {
      int m0, n0;
      tile_of(nfull + (hsel >> 1), m0, n0);
      const int half = hsel & 1;
      const int broh = 16384 + (half * 128 + wn * 32 + r) * 64;
      asm volatile("s_waitcnt vmcnt(0) lgkmcnt(0)" ::: "memory");
      __builtin_amdgcn_s_barrier();
      int pend = 0, ki = 0;
      unsigned g = 0;
#pragma unroll 1
      for (int s = 0; s < DEPTH; s++) { if (ki < nk) { issue(m0, n0, ki, (g + pend) % NSLOT); ki++; pend++; } }
      f32x16 acc1[MI][1];
#pragma unroll
      for (int a = 0; a < MI; a++)
#pragma unroll
        for (int i = 0; i < 16; i++) acc1[a][0][i] = 0.f;
#pragma unroll 1
      for (int kt = 0; kt < nk; kt++) {
        if (pend >= 3) asm volatile("s_waitcnt vmcnt(%0)" ::"n"(2 * GPS) : "memory");
        else if (pend == 2) asm volatile("s_waitcnt vmcnt(%0)" ::"n"(GPS) : "memory");
        else asm volatile("s_waitcnt vmcnt(0)" ::: "memory");
        asm volatile("" ::: "memory");
        __builtin_amdgcn_s_waitcnt(0xC07F);
        __builtin_amdgcn_s_barrier();
        asm volatile("" ::: "memory");
        if (ki < nk) { issue(m0, n0, ki, (g + pend) % NSLOT); ki++; } else pend--;
        const char* sb = smem + (g % NSLOT) * STAGE;
        g++;
        s16x8 a[MI], a2[MI];
#pragma unroll
        for (int i = 0; i < MI; i++) { a[i] = *(const s16x8*)(sb + aro + i * 32 * 64 + xo0); a2[i] = *(const s16x8*)(sb + aro + i * 32 * 64 + xo1); }
        const s16x8 b0 = *(const s16x8*)(sb + broh + xo0);
        const s16x8 b2 = *(const s16x8*)(sb + broh + xo1);
#pragma unroll
        for (int i = 0; i < MI; i++) acc1[i][0] = mfma(a[i], b0, acc1[i][0]);
#pragma unroll
        for (int i = 0; i < MI; i++) acc1[i][0] = mfma(a2[i], b2, acc1[i][0]);
      }
      epilogue<EPI, MI, 1>(P, l, acc1, m0 + wm * 128, n0 + half * 128 + wn * 32, r, h);
    }
  }
  asm volatile("s_waitcnt vmcnt(0) lgkmcnt(0)" ::: "memory");
}

DI int next_item(unsigned* ctr, char* smem, int wv) {
  volatile int* slot = (volatile int*)(smem + SMEM_BYTES - 16);
  __syncthreads();
  if (wv == 0 && lane_id() == 0) *slot = (int)__hip_atomic_fetch_add(ctr, 1u, __ATOMIC_RELAXED, __HIP_MEMORY_SCOPE_AGENT);
  __syncthreads();
  return *slot;
}

DI void phase_attn(const Params& P, int l, char* smem) {
  const u16* qf = (const u16*)(P.ws + WS_QF);
  const u16* fk = (const u16*)(P.ws + WS_FOXK);
  const u16* fv = (const u16*)(P.ws + WS_FOXV);
  const float* cum = (const float*)(P.ws + WS_CUM);
  const u16* qm = (const u16*)(P.ws + WS_R1 + R1_QM);
  const u16* kv = (const u16*)(P.ws + WS_R1 + R1_KV);
  const u16* krp = (const u16*)(P.ws + WS_KROPE);
  u16* mixed = (u16*)(P.ws + WS_ACTA);
  constexpr float LOG2E = 1.4426950408889634f;
  const int total = 384 + 16 * 96;
  unsigned* ctr = (unsigned*)(P.ws + WS_CTR) + (l * 2 + 0) * 64;
  for (int t = next_item(ctr, smem, P.wv); t < total; t = next_item(ctr, smem, P.wv)) {
    bool isfox, issample; int b, hd, qb = 0;
    if (t < 128) { isfox = false; issample = true; b = t >> 2; hd = t & 3; }
    else if (t < 384) { isfox = true; issample = true; const int u = t - 128; b = u >> 3; hd = u & 7; }
    else {
      const int u = t - 384; const int grp = u / 96; int w = u % 96; qb = 15 - grp; issample = false;
      if (w < 32) { isfox = false; b = w >> 2; hd = w & 3; }
      else { w -= 32; isfox = true; b = w >> 3; hd = w & 7; }
    }
    AttnJob J;
    J.wv = P.wv;
    size_t tok0, krow0;
    if (issample) { tok0 = (size_t)TP + (size_t)b * DS; krow0 = (size_t)TP + (size_t)b * SKS; J.nq = DS; J.Sk = SKS; J.qpos0 = PAST; }
    else { tok0 = (size_t)b * SEQ + (size_t)qb * 256; krow0 = (size_t)b * SEQ; J.nq = 256; J.Sk = SEQ; J.qpos0 = qb * 256; }
    if (isfox) {
      J.Q = qf + tok0 * 512 + hd * 64; J.ldq = 512;
      J.K1 = fk + krow0 * 512 + hd * 64; J.ldk1 = 512; J.K2 = J.K1; J.ldk2 = 512;
      J.V = fv + krow0 * 512 + hd * 64; J.ldv = 512;
      J.O = mixed + tok0 * 1024 + hd * 64; J.ldo = 1024;
      J.cq = cum + (krow0 + (size_t)J.qpos0) * 8 + hd;
      J.ck = cum + krow0 * 8 + hd;
      J.scale_log2 = 0.125f * LOG2E;
      if (issample) attn_block<64, 64, 64, MASK_FRAME, true, FOX_PF, 512, 512, 512, 512, 1024, 256, true>(J, smem);
      else attn_block<64, 64, 64, MASK_FRAME, true, FOX_PF, 512, 512, 512, 512, 1024, FOX_KT>(J, smem);
    } else {
      J.Q = qm + tok0 * 768 + hd * 192; J.ldq = 768;
      J.K1 = kv + krow0 * 1024 + hd * 256; J.ldk1 = 1024;
      J.K2 = krp + krow0 * 64; J.ldk2 = 64;
      J.V = kv + krow0 * 1024 + hd * 256 + 128; J.ldv = 1024;
      J.O = mixed + tok0 * 1024 + 512 + hd * 128; J.ldo = 1024;
      J.cq = nullptr; J.ck = nullptr;
      J.scale_log2 = 0.07216878364870322f * LOG2E;
      if (issample) attn_block<192, 128, 128, MASK_CHUNK, false, MLA_PF, 768, 1024, 64, 1024, 1024, 128, true>(J, smem);
      else attn_block<192, 128, 128, MASK_CHUNK, false, MLA_PF, 768, 1024, 64, 1024, 1024, 64>(J, smem);
    }
  }
}

DI void phase_cross(const Params& P, int l, char* smem) {
  const u16* xq = (const u16*)(P.ws + WS_R1 + R1_XQ);
  const u16* mk = (const u16*)(P.ws + WS_MEMK) + (size_t)l * MB * NMEM * 1024;
  const u16* mv = (const u16*)(P.ws + WS_MEMV) + (size_t)l * MB * NMEM * 1024;
  u16* xo = (u16*)(P.ws + WS_ACTA);
  constexpr float LOG2E = 1.4426950408889634f;
  const int nsamp = DB * 4 * 2;
  const int total = nsamp + 128 * 4 * 2;
  unsigned* ctr = (unsigned*)(P.ws + WS_CTR) + (l * 2 + 1) * 64;
  for (int t = next_item(ctr, smem, P.wv); t < total; t = next_item(ctr, smem, P.wv)) {
    AttnJob J;
    J.wv = P.wv;
    size_t tok0; int mb, hd, half;
    if (t < nsamp) { const int b = t >> 3; hd = (t >> 1) & 3; half = t & 1; tok0 = (size_t)TP + (size_t)b * DS; mb = NB + b; J.nq = DS; }
    else { const int u = t - nsamp; const int qbk = u >> 3; hd = (u >> 1) & 3; half = u & 1; tok0 = (size_t)qbk * 256; mb = qbk >> 4; J.nq = 256; }
    J.Sk = NMEM; J.qpos0 = 0;
    J.Q = xq + tok0 * 1024 + hd * 256; J.ldq = 1024;
    J.K1 = mk + (size_t)mb * NMEM * 1024 + hd * 256; J.ldk1 = 1024; J.K2 = J.K1; J.ldk2 = 1024;
    J.V = mv + (size_t)mb * NMEM * 1024 + hd * 256 + half * 128; J.ldv = 1024;
    J.O = xo + tok0 * 1024 + hd * 256 + half * 128; J.ldo = 1024;
    J.cq = nullptr; J.ck = nullptr;
    J.scale_log2 = 0.0625f * LOG2E;
    attn_block<256, 256, 128, MASK_NONE, false, false, 1024, 1024, 1024, 1024, 1024, 128>(J, smem);
  }
}

#define XB_TMO      128
#define XB_XCNT(j)  (256  + 64 * (j))
#define XB_XSUB(j)  (1280 + 64 * (j))
#define XB_XGEN(j)  (2304 + 64 * (j))
#define XB_TOP      3328
#define XB_TOPGEN   3392
#define XCD_BAR_WORDS 3456
#define XB_SPIN_CAP (1u << 20)
DI unsigned xb_ld(unsigned* p) { return __hip_atomic_load(p, __ATOMIC_RELAXED, __HIP_MEMORY_SCOPE_AGENT); }
DI unsigned xb_add(unsigned* p, unsigned v) { return __hip_atomic_fetch_add(p, v, __ATOMIC_RELAXED, __HIP_MEMORY_SCOPE_AGENT); }
DI unsigned xb_xcc_id() { return (unsigned)__builtin_amdgcn_s_getreg((3 << 11) | 20) & 0xFu; }
#define XB_SPIN(cond, bar) do { unsigned _sp = 0; while (cond) { __builtin_amdgcn_s_sleep(1); \
    if ((++_sp & 255u) == 0u) { if (xb_ld(&(bar)[XB_TMO])) break; if (_sp > XB_SPIN_CAP) { atomicAdd(&(bar)[XB_TMO], 1u); break; } } } } while (0)
DI void xb_census(unsigned* bar, unsigned x, unsigned& nloc, unsigned& nx) {
  const unsigned G = gridDim.x;
  unsigned sum, cnt, mine, sp = 0u;
  for (;;) {
    sum = 0u; cnt = 0u; mine = 0u;
#pragma unroll
    for (unsigned j = 0; j < 16; ++j) { const unsigned c = xb_ld(&bar[XB_XCNT(j)]); sum += c; cnt += (c > 0u) ? 1u : 0u; mine = (j == x) ? c : mine; }
    if (sum == G) break;
    __builtin_amdgcn_s_sleep(1);
    if ((++sp & 255u) == 0u) { if (xb_ld(&bar[XB_TMO])) break; if (sp > XB_SPIN_CAP) { atomicAdd(&bar[XB_TMO], 1u); break; } }
  }
  nloc = mine > 0u ? mine : 1u; nx = cnt > 0u ? cnt : 1u;
}
DI void xcd_barrier(unsigned* bar, unsigned x, unsigned nloc, unsigned nx, int wv) {
  asm volatile("s_waitcnt vmcnt(0)" ::: "memory");
  __syncthreads();
  if (wv == 0 && lane_id() == 0) {
    __builtin_amdgcn_s_waitcnt(0);
    const unsigned old = xb_add(&bar[XB_XSUB(x)], 1u);
    const unsigned gen = old / nloc;
    if (old + 1u == (gen + 1u) * nloc) {
      __builtin_amdgcn_fence(__ATOMIC_RELEASE, "agent");
      asm volatile("s_waitcnt vmcnt(0)" ::: "memory");
      const unsigned og = xb_add(&bar[XB_TOP], 1u);
      const unsigned tg = og / nx;
      if (og + 1u == (tg + 1u) * nx) xb_add(&bar[XB_TOPGEN], 1u);
      else XB_SPIN(xb_ld(&bar[XB_TOPGEN]) == tg, bar);
      __builtin_amdgcn_fence(__ATOMIC_ACQUIRE, "agent");
      xb_add(&bar[XB_XGEN(x)], 1u);
      asm volatile("s_waitcnt vmcnt(0)" ::: "memory");
    } else {
      XB_SPIN(xb_ld(&bar[XB_XGEN(x)]) == gen, bar);
      __builtin_amdgcn_fence(__ATOMIC_ACQUIRE, "agent");
      asm volatile("s_waitcnt vmcnt(0)" ::: "memory");
    }
  }
  __syncthreads();
}

constexpr int NPHASE = 2 + 13 * NL;

DI void run_phase(const Params& P, int ph, char* smem, bool dup = false) {
  if (ph == 0) { phase_prep(P, smem); return; }
  if (ph == NPHASE - 1) { phase_final(P); return; }
  const int l = (ph - 1) / 13, k = (ph - 1) % 13;
  char* ws = P.ws;
  const u16* actA = (const u16*)(ws + WS_ACTA);
  int rot = 0;
  switch (k) {
    case 0: phase_norm(P, P.in[10] + l * 1024, l); break;
    case 1:
      gemm_phase<EPI_IN>(P, l, actA, 1024, wt_ptr(P, l, WE_IN), 1024, 1024, TT, INP, smem, rot);
      if (l == 0) {
        for (int l2 = 0; l2 < NL; l2++)
          gemm_phase<EPI_MEM>(P, l2, (const u16*)(ws + WS_HMEM) + (size_t)l2 * NB * NMEM * 1024, 1024, wt_ptr(P, l2, WE_MKV), 1024, 1024,
                              NB * NMEM, 2048, smem, rot);
      }
      break;
    case 2: phase_post(P, l, smem); break;
    case 3:
      gemm_phase<EPI_KV>(P, l, (const u16*)(ws + WS_CKV), 128, wt_ptr(P, l, WE_UKV), 128, 128, KROWS, 1024, smem, rot);
      gemm_phase<EPI_UQ>(P, l, (const u16*)(ws + WS_CQN), 256, wt_ptr(P, l, WE_UQ), 256, 256, TT, 768, smem, rot);
      break;
    case 4: phase_attn(P, l, smem); break;
    case 5: if (dup) gemm_phase<EPI_RESID0>(P, l, actA, 1024, wt_ptr(P, l, WE_OUT), 1024, 1024, TT, 1024, smem, rot); else gemm_phase<EPI_RESID>(P, l, actA, 1024, wt_ptr(P, l, WE_OUT), 1024, 1024, TT, 1024, smem, rot); break;
    case 6: phase_norm(P, P.in[18] + l * 1024, -1); break;
    case 7: gemm_phase<EPI_XQ>(P, l, actA, 1024, wt_ptr(P, l, WE_XQ), 1024, 1024, TT, 1024, smem, rot); break;
    case 8: phase_cross(P, l, smem); break;
    case 9: if (dup) gemm_phase<EPI_RESID0>(P, l, actA, 1024, wt_ptr(P, l, WE_XO), 1024, 1024, TT, 1024, smem, rot); else gemm_phase<EPI_RESID>(P, l, actA, 1024, wt_ptr(P, l, WE_XO), 1024, 1024, TT, 1024, smem, rot); break;
    case 10: phase_norm(P, P.in[24] + l * 1024, -1); break;
    case 11: gemm_phase<EPI_UP>(P, l, actA, 1024, wt_ptr(P, l, WE_UP), 1024, 1024, TT, DFF, smem, rot); break;
    case 12: if (dup) gemm_phase<EPI_RESID0>(P, l, (const u16*)(ws + WS_R1 + R1_U), DFF, wt_ptr(P, l, WE_DN), DFF, DFF, TT, 1024, smem, rot); else gemm_phase<EPI_RESID>(P, l, (const u16*)(ws + WS_R1 + R1_U), DFF, wt_ptr(P, l, WE_DN), DFF, DFF, TT, 1024, smem, rot); break;
  }
}

__global__ void __launch_bounds__(NTHR) mega(Params P, int ph_lo, int ph_hi) {
  extern __shared__ __attribute__((aligned(16))) char smem[];
  cg::grid_group grid = cg::this_grid();
  if (ph_hi > 4096) grid.sync();
  unsigned* bar = (unsigned*)(P.ws + WS_BAR);
  const unsigned xb_x = xb_xcc_id();
  unsigned xb_nloc = 1u, xb_nx = 1u;
  if (threadIdx.x == 0) { (void)xb_add(&bar[XB_XCNT(xb_x)], 1u); xb_census(bar, xb_x, xb_nloc, xb_nx); }
  xb_nloc = __builtin_amdgcn_readfirstlane(xb_nloc);
  xb_nx = __builtin_amdgcn_readfirstlane(xb_nx);
  unsigned xb_pack = xb_nloc | (xb_nx << 16) | (xb_x << 24) | ((unsigned)__builtin_amdgcn_readfirstlane(threadIdx.x >> 6) << 28);
  asm volatile("" : "+s"(xb_pack));
  for (int ph = ph_lo; ph < ph_hi; ph++) {
    Params Q = P;
    unsigned pk = xb_pack;
    asm volatile("" : "+s"(Q.out), "+s"(Q.ws), "+s"(pk));
    Q.wv = (int)(pk >> 28);
    run_phase(Q, ph, smem);
    if (ph + 1 < ph_hi) {
      unsigned pk2 = xb_pack;
      asm volatile("" : "+s"(pk2));
      xcd_barrier((unsigned*)(Q.ws + WS_BAR), (pk2 >> 24) & 0xfu, pk2 & 0xffffu, (pk2 >> 16) & 0xffu, (int)(pk2 >> 28));
    }
  }
}

extern "C" void kernel_launch(void* const* d_in, const int* in_sizes, int n_in, void* d_out, int out_size, void* d_ws,
                              size_t ws_size, hipStream_t stream) {
  static int grid_blocks = 0;
  if (!grid_blocks) {
    int dev = 0, cus = 0, per_cu = 0;
    hipGetDevice(&dev);
    hipDeviceGetAttribute(&cus, hipDeviceAttributeMultiprocessorCount, dev);
    hipFuncSetAttribute((const void*)mega, hipFuncAttributeMaxDynamicSharedMemorySize, SMEM_BYTES);
    hipOccupancyMaxActiveBlocksPerMultiprocessor(&per_cu, mega, NTHR, SMEM_BYTES);
    per_cu = 1;
    grid_blocks = cus * per_cu;
  }
  if (n_in != 28 || (size_t)out_size != O_END || ws_size < WS_END) {
    fprintf(stderr, "kernel_launch: shape/ws mismatch n_in %d out %d (want %zu) ws %zu (want %zu)\n", n_in, out_size, (size_t)O_END, ws_size, (size_t)WS_END);
    return;
  }
  Params p;
  memset(&p, 0, sizeof(p));
  for (int i = 0; i < 28; i++) p.in[i] = (const float*)d_in[i];
  p.out = (float*)d_out;
  p.ws = (char*)d_ws;
  hipMemsetAsync((char*)d_ws + WS_BAR, 0, XCD_BAR_WORDS * 4 + 4 * 256, stream);
  int lo = 0, hi = NPHASE;
  void* args[] = {&p, &lo, &hi};
  hipError_t e = hipLaunchCooperativeKernel((void*)mega, dim3(grid_blocks), dim3(NTHR), args, SMEM_BYTES, stream);
  if (e != hipSuccess) fprintf(stderr, "cooperative launch failed: %s (grid %d)\n", hipGetErrorString(e), grid_blocks);
}
```
